# Optimizing an MI355X kernel written in HIP

```python
import math, functools
import jax, jax.numpy as jnp
from jax import lax
import numpy as np

D_MODEL = 1024
BATCH = 8
SEQ = 8192
DEPTH = 2

CTX_LEN = 256
GRID_W = 64
EPS = 1e-6

DA_HEADS = 4
DA_QK = 64
DA_V = 2 * DA_QK
DA_WIDTH = DA_HEADS * DA_V
Q_BLOCK = 128
ROPE_BASE = 10000.0

SSM_HEADS = 8
SSM_P = 64
SSM_WIDTH = SSM_HEADS * SSM_P
SSM_GROUPS = 2
SSM_N = 64
SSM_CONV = 3
SSM_CONV_DIM = SSM_WIDTH + 2 * SSM_GROUPS * SSM_N
SSM_CHUNK = 128

GLA_HEADS = 4
GLA_DK = 64
GLA_DV = 128
GLA_WIDTH = GLA_HEADS * GLA_DV
GLA_RANK = 16
GLA_GATE_NORM = 16.0
GLA_CHUNK = 64

IN_SPLITS = (
    2 * DA_HEADS * DA_QK, 2 * DA_HEADS * DA_QK, DA_WIDTH, DA_WIDTH,
    SSM_WIDTH, SSM_WIDTH, SSM_GROUPS * SSM_N, SSM_GROUPS * SSM_N, 2 * SSM_HEADS,
    GLA_HEADS * GLA_DK, GLA_HEADS * GLA_DK, GLA_WIDTH, GLA_WIDTH, 2 * GLA_RANK,
    D_MODEL, D_MODEL, D_MODEL)
IN_WIDTH = 4 * 512 + 2 * 512 + 2 * 128 + 16 + 2 * 256 + 2 * 512 + 32 + 3 * D_MODEL

kernel_name = "hybrid_diffattn_ssd_gla_prefix_trunk"


def rmsnorm(x, w):
    xf = x.astype(jnp.float32)
    y = xf * lax.rsqrt(jnp.mean(xf * xf, axis=-1, keepdims=True) + EPS)
    return (y * w.astype(jnp.float32)).astype(x.dtype)


def group_rmsnorm(y, w, groups):
    shp = y.shape
    yg = y.reshape(*shp[:-1], groups, shp[-1] // groups)
    return rmsnorm(yg, w.reshape(groups, -1)).reshape(shp)


def split_cols(p, sizes):
    idx = np.cumsum(sizes)[:-1].tolist()
    return jnp.split(p, idx, axis=-1)


def rope_2d_tables(n, dtype):
    rows = n // GRID_W
    row = jnp.repeat(jnp.arange(rows), GRID_W)
    col = jnp.tile(jnp.arange(GRID_W), rows)
    pos = jnp.stack([row, col], axis=-1).astype(jnp.float32)
    nf = DA_QK // 4
    inv = ROPE_BASE ** (-jnp.arange(nf, dtype=jnp.float32) / nf)
    ang = jnp.broadcast_to(pos[:, :, None, None] * inv, (n, 2, 2, nf)).reshape(n, DA_QK)
    return jnp.cos(ang).astype(dtype), jnp.sin(ang).astype(dtype)


def apply_rope_2d(x, cos, sin):
    xr = x.reshape(*x.shape[:-1], 2, 2, DA_QK // 4)
    rot = jnp.stack([-xr[..., 1, :], xr[..., 0, :]], axis=-2).reshape(x.shape)
    return x * cos[:, None, :] + rot * sin[:, None, :]


def depthwise_conv_centred(x, w, b):
    y = lax.conv_general_dilated(x, w[:, None, :].astype(x.dtype), window_strides=(1,), padding='SAME',
                                 dimension_numbers=('NWC', 'WIO', 'NWC'), feature_group_count=x.shape[-1])
    return y + b.astype(x.dtype)


def diff_softmax_attend(q, k, v, lam):
    s = jnp.einsum('bqhd,bkhd->bhqk', q, k).astype(jnp.float32) * (DA_QK ** -0.5)
    pr = jax.nn.softmax(s, axis=-1)
    bsz, _, tq, tk = pr.shape
    pr = pr.reshape(bsz, DA_HEADS, 2, tq, tk)
    wts = pr[:, :, 0] - lam * pr[:, :, 1]
    return jnp.einsum('bhqk,bkhv->bqhv', wts.astype(v.dtype), v)


def da_heads(p):
    bsz, t = p[0].shape[:2]
    q = p[0].reshape(bsz, t, 2 * DA_HEADS, DA_QK)
    k = p[1].reshape(bsz, t, 2 * DA_HEADS, DA_QK)
    v = p[2].reshape(bsz, t, DA_HEADS, DA_V)
    return q, k, v


def da_post(o, z, norm_w, lam_init):
    o = rmsnorm(o, norm_w) * (1.0 - lam_init)
    return o.reshape(*o.shape[:2], DA_WIDTH) * jax.nn.silu(z)


def ssd_chunked(x, dt, bm, cm, h0, a, d_skip):
    f32 = jnp.float32
    bsz, t, nh, p = x.shape
    g, n = bm.shape[2], bm.shape[3]
    hg = nh // g
    L = SSM_CHUNK
    nc = t // L
    xf = x.astype(f32).reshape(bsz, nc, L, g, hg, p)
    dtc = dt.astype(f32).reshape(bsz, nc, L, g, hg)
    bc = bm.astype(f32).reshape(bsz, nc, L, g, n)
    cc = cm.astype(f32).reshape(bsz, nc, L, g, n)
    acs = jnp.cumsum(dtc * a.astype(f32).reshape(g, hg), axis=2)
    tri = jnp.tril(jnp.ones((L, L), dtype=bool))
    seg = acs[:, :, :, None] - acs[:, :, None, :]
    decay = jnp.exp(jnp.where(tri[:, :, None, None], seg, -jnp.inf))
    scores = jnp.einsum('bclgn,bcsgn->bclsg', cc, bc)
    wts = scores[..., None] * decay * dtc[:, :, None]
    y = jnp.einsum('bclsgh,bcsghp->bclghp', wts, xf)
    dte = jnp.exp(acs[:, :, -1:] - acs) * dtc
    states = jnp.einsum('bclgn,bclgh,bclghp->bcghpn', bc, dte, xf)
    chunk_decay = jnp.exp(acs[:, :, -1])

    def step(h, inp):
        st, dec = inp
        return dec[..., None, None] * h + st, h

    h_last, h_starts = lax.scan(step, h0, (jnp.moveaxis(states, 1, 0), jnp.moveaxis(chunk_decay, 1, 0)))
    h_starts = jnp.moveaxis(h_starts, 0, 1)
    y = y + jnp.einsum('bclgn,bcghpn,bclgh->bclghp', cc, h_starts, jnp.exp(acs))
    y = y + d_skip.astype(f32).reshape(g, hg)[:, :, None] * xf
    return y.reshape(bsz, t, nh, p).astype(x.dtype), h_last


def gla_chunked(q, k, v, g, h0):
    f32 = jnp.float32
    bsz, t, nh, dk = q.shape
    dv = v.shape[-1]
    L = GLA_CHUNK
    nc = t // L
    qf = q.astype(f32).reshape(bsz, nc, L, nh, dk) * (dk ** -0.5)
    kf = k.astype(f32).reshape(bsz, nc, L, nh, dk)
    vf = v.astype(f32).reshape(bsz, nc, L, nh, dv)
    gc = jnp.cumsum(g.astype(f32).reshape(bsz, nc, L, nh, dk), axis=2)
    q_dec = qf * jnp.exp(gc)
    k_dec = kf * jnp.exp(-gc)
    tri = jnp.tril(jnp.ones((L, L), dtype=bool))
    att = jnp.where(tri, jnp.einsum('bclhk,bcshk->bchls', q_dec, k_dec), 0.0)
    y = jnp.einsum('bchls,bcshv->bclhv', att, vf)
    g_last = gc[:, :, -1]
    k_end = kf * jnp.exp(g_last[:, :, None] - gc)
    states = jnp.einsum('bclhk,bclhv->bchkv', k_end, vf)

    def step(h, inp):
        st, dec = inp
        return dec[..., None] * h + st, h

    h_last, h_starts = lax.scan(step, h0, (jnp.moveaxis(states, 1, 0), jnp.moveaxis(jnp.exp(g_last), 1, 0)))
    h_starts = jnp.moveaxis(h_starts, 0, 1)
    y = y + jnp.einsum('bclhk,bchkv->bclhv', q_dec, h_starts)
    return y.reshape(bsz, t, nh, dv).astype(v.dtype), h_last


def scan_ctx_then_latent(scan, ctx_in, lat_in, h0, reverse):
    def flip(arrs):
        return tuple(jnp.flip(a, axis=1) for a in arrs)
    if reverse:
        ctx_in, lat_in = flip(ctx_in), flip(lat_in)
    y_ctx, h_ctx = scan(*ctx_in, h0)
    y_lat, _ = scan(*lat_in, h_ctx)
    if reverse:
        y_ctx, y_lat = jnp.flip(y_ctx, axis=1), jnp.flip(y_lat, axis=1)
    return y_ctx, y_lat


def ssm_prep(p, conv_w, conv_b, dt_bias):
    xbc = jax.nn.silu(depthwise_conv_centred(jnp.concatenate([p[4], p[6], p[7]], axis=-1), conv_w, conv_b))
    xs, bm, cm = jnp.split(xbc, [SSM_WIDTH, SSM_WIDTH + SSM_GROUPS * SSM_N], axis=-1)
    bsz, t = xs.shape[:2]
    dt = jax.nn.softplus(p[8].astype(jnp.float32).reshape(bsz, t, 2, SSM_HEADS) + dt_bias.astype(jnp.float32))
    return (xs.reshape(bsz, t, SSM_HEADS, SSM_P), bm.reshape(bsz, t, SSM_GROUPS, SSM_N),
            cm.reshape(bsz, t, SSM_GROUPS, SSM_N), dt)


def ssm_post(y, z, norm_w):
    y = y.reshape(*y.shape[:2], SSM_WIDTH) * jax.nn.silu(z)
    return group_rmsnorm(y, norm_w, SSM_GROUPS)


def gla_prep(p, w_gate, b_gate):
    bsz, t = p[9].shape[:2]
    q = p[9].reshape(bsz, t, GLA_HEADS, GLA_DK)
    k = p[10].reshape(bsz, t, GLA_HEADS, GLA_DK)
    v = p[11].reshape(bsz, t, GLA_HEADS, GLA_DV)
    lr = p[13].reshape(bsz, t, 2, GLA_RANK)
    g = jax.nn.log_sigmoid((jnp.einsum('btdr,drk->btdk', lr, w_gate) + b_gate).astype(jnp.float32)) / GLA_GATE_NORM
    return q, k, v, g.reshape(bsz, t, 2, GLA_HEADS, GLA_DK)


def gla_post(o, z, norm_w):
    o = rmsnorm(o, norm_w)
    return o.reshape(*o.shape[:2], GLA_WIDTH) * jax.nn.silu(z)


def merge_branches(o_da, o_ssm, o_gla, p, w_out_da, w_out_ssm, w_out_gla, w_o):
    u = (jax.nn.sigmoid(p[14]) * (o_da @ w_out_da)
         + jax.nn.sigmoid(p[15]) * (o_ssm @ w_out_ssm)
         + jax.nn.sigmoid(p[16]) * (o_gla @ w_out_gla))
    return u @ w_o


def hybrid_layer(x, cx, c, c_ctx, cos, sin, lam_init, need_ctx,
                 w_mod, b_mod, norm_w, w_in, da_lambda, da_norm_w, w_out_da,
                 conv_w, conv_b, dt_bias, a_log, d_skip, ssm_norm_w, w_out_ssm,
                 gla_w_gate, gla_b_gate, gla_norm_w, w_out_gla, w_o):
    f32 = jnp.float32
    bsz, n = x.shape[:2]
    shift, scale, gate = jnp.split((jax.nn.silu(c) @ w_mod + b_mod)[:, None, :], 3, axis=-1)
    shift_c, scale_c, gate_c = jnp.split(jax.nn.silu(c_ctx) @ w_mod + b_mod, 3, axis=-1)
    h = rmsnorm(x, norm_w) * (1.0 + scale) + shift
    hc = rmsnorm(cx, norm_w) * (1.0 + scale_c) + shift_c
    pl = split_cols(h @ w_in, IN_SPLITS)
    pc = split_cols(hc @ w_in, IN_SPLITS)

    q_l, k_l, v_l = da_heads(pl)
    q_l, k_l = apply_rope_2d(q_l, cos, sin), apply_rope_2d(k_l, cos, sin)
    q_c, k_c, v_c = da_heads(pc)
    lam_f = da_lambda.astype(f32)
    lam = jnp.exp(jnp.sum(lam_f[0] * lam_f[1])) - jnp.exp(jnp.sum(lam_f[2] * lam_f[3])) + lam_init
    k_all = jnp.concatenate([k_c, k_l], axis=1)
    v_all = jnp.concatenate([v_c, v_l], axis=1)
    nb = n // Q_BLOCK
    qb = jnp.swapaxes(q_l.reshape(bsz, nb, Q_BLOCK, 2 * DA_HEADS, DA_QK), 0, 1)
    o = lax.map(lambda qi: diff_softmax_attend(qi, k_all, v_all, lam), qb)
    a_lat = da_post(jnp.swapaxes(o, 0, 1).reshape(bsz, n, DA_HEADS, DA_V), pl[3], da_norm_w, lam_init)

    xs_l, b_l, c_l, dt_l = ssm_prep(pl, conv_w, conv_b, dt_bias)
    xs_c, b_c, c_c, dt_c = ssm_prep(pc, conv_w, conv_b, dt_bias)
    a_neg = -jnp.exp(a_log.astype(f32))
    h0_ssm = jnp.zeros((bsz, SSM_GROUPS, SSM_HEADS // SSM_GROUPS, SSM_P, SSM_N), f32)
    ys_c, ys_l = 0.0, 0.0
    for d in range(2):
        scan = functools.partial(ssd_chunked, a=a_neg[d], d_skip=d_skip[d])
        yc, yl = scan_ctx_then_latent(scan, (xs_c, dt_c[:, :, d], b_c, c_c),
                                      (xs_l, dt_l[:, :, d], b_l, c_l), h0_ssm, d == 1)
        ys_c, ys_l = ys_c + yc, ys_l + yl
    s_lat = ssm_post(ys_l, pl[5], ssm_norm_w)

    gq_l, gk_l, gv_l, gg_l = gla_prep(pl, gla_w_gate, gla_b_gate)
    gq_c, gk_c, gv_c, gg_c = gla_prep(pc, gla_w_gate, gla_b_gate)
    h0_gla = jnp.zeros((bsz, GLA_HEADS, GLA_DK, GLA_DV), f32)
    yg_c, yg_l = 0.0, 0.0
    for d in range(2):
        yc, yl = scan_ctx_then_latent(gla_chunked, (gq_c, gk_c, gv_c, gg_c[:, :, d]),
                                      (gq_l, gk_l, gv_l, gg_l[:, :, d]), h0_gla, d == 1)
        yg_c, yg_l = yg_c + yc, yg_l + yl
    g_lat = gla_post(yg_l, pl[12], gla_norm_w)

    x = x + gate * merge_branches(a_lat, s_lat, g_lat, pl, w_out_da, w_out_ssm, w_out_gla, w_o)
    if need_ctx:
        a_ctx = da_post(diff_softmax_attend(q_c, k_c, v_c, lam), pc[3], da_norm_w, lam_init)
        s_ctx = ssm_post(ys_c, pc[5], ssm_norm_w)
        g_ctx = gla_post(yg_c, pc[12], gla_norm_w)
        cx = cx + gate_c * merge_branches(a_ctx, s_ctx, g_ctx, pc, w_out_da, w_out_ssm, w_out_gla, w_o)
    return x, cx


def setup_inputs(seed: int = 0) -> dict:
    key = jax.random.key(seed)
    ks = jax.random.split(key, 26)
    f32 = jnp.float32

    def nrm(k, shape, scale):
        return jax.random.normal(k, shape, f32) * scale

    dt0 = jnp.exp(jax.random.uniform(ks[13], (DEPTH, 2, SSM_HEADS), f32)
                  * (math.log(0.1) - math.log(0.001)) + math.log(0.001))
    return {
        "x": nrm(ks[0], (BATCH, SEQ, D_MODEL), 1.0),
        "c": nrm(ks[1], (BATCH, D_MODEL), 1.0),
        "ctx": nrm(ks[2], (BATCH, CTX_LEN, D_MODEL), 1.0),
        "c_ctx": nrm(ks[3], (D_MODEL,), 1.0),
        "w_mod": nrm(ks[4], (DEPTH, D_MODEL, 3 * D_MODEL), 0.5 * D_MODEL ** -0.5),
        "b_mod": nrm(ks[5], (DEPTH, 3 * D_MODEL), 0.02),
        "norm_w": 1.0 + nrm(ks[6], (DEPTH, D_MODEL), 0.02),
        "w_in": nrm(ks[7], (DEPTH, D_MODEL, IN_WIDTH), D_MODEL ** -0.5),
        "da_lambda": nrm(ks[8], (DEPTH, 4, DA_QK), 0.1),
        "da_norm_w": 1.0 + nrm(ks[9], (DEPTH, DA_V), 0.02),
        "w_out_da": nrm(ks[10], (DEPTH, DA_WIDTH, D_MODEL), DA_WIDTH ** -0.5),
        "ssm_conv_w": nrm(ks[11], (DEPTH, SSM_CONV, SSM_CONV_DIM), SSM_CONV ** -0.5),
        "ssm_conv_b": nrm(ks[12], (DEPTH, SSM_CONV_DIM), 0.02),
        "ssm_dt_bias": dt0 + jnp.log(-jnp.expm1(-dt0)),
        "ssm_a_log": jnp.log(jax.random.uniform(ks[14], (DEPTH, 2, SSM_HEADS), f32, 1.0, 16.0)),
        "ssm_d": 1.0 + nrm(ks[15], (DEPTH, 2, SSM_HEADS), 0.1),
        "ssm_norm_w": 1.0 + nrm(ks[16], (DEPTH, SSM_WIDTH), 0.02),
        "w_out_ssm": nrm(ks[17], (DEPTH, SSM_WIDTH, D_MODEL), SSM_WIDTH ** -0.5),
        "gla_w_gate": nrm(ks[18], (DEPTH, 2, GLA_RANK, GLA_HEADS * GLA_DK), GLA_RANK ** -0.5),
        "gla_b_gate": nrm(ks[19], (DEPTH, 2, GLA_HEADS * GLA_DK), 0.02),
        "gla_norm_w": 1.0 + nrm(ks[20], (DEPTH, GLA_DV), 0.02),
        "w_out_gla": nrm(ks[21], (DEPTH, GLA_WIDTH, D_MODEL), GLA_WIDTH ** -0.5),
        "w_o": nrm(ks[22], (DEPTH, D_MODEL, D_MODEL), D_MODEL ** -0.5),
        "final_norm_w": 1.0 + nrm(ks[23], (D_MODEL,), 0.02),
    }


def reference(x, c, ctx, c_ctx, w_mod, b_mod, norm_w, w_in, da_lambda, da_norm_w, w_out_da,
              ssm_conv_w, ssm_conv_b, ssm_dt_bias, ssm_a_log, ssm_d, ssm_norm_w, w_out_ssm,
              gla_w_gate, gla_b_gate, gla_norm_w, w_out_gla, w_o, final_norm_w):
    n = x.shape[1]
    cos, sin = rope_2d_tables(n, x.dtype)
    cx = ctx
    for l in range(DEPTH):
        lam_init = 0.8 - 0.6 * math.exp(-0.3 * l)
        x, cx = hybrid_layer(x, cx, c, c_ctx, cos, sin, lam_init, l < DEPTH - 1,
                             w_mod[l], b_mod[l], norm_w[l], w_in[l], da_lambda[l], da_norm_w[l], w_out_da[l],
                             ssm_conv_w[l], ssm_conv_b[l], ssm_dt_bias[l], ssm_a_log[l], ssm_d[l],
                             ssm_norm_w[l], w_out_ssm[l],
                             gla_w_gate[l], gla_b_gate[l], gla_norm_w[l], w_out_gla[l], w_o[l])
    return rmsnorm(x, final_norm_w)
```

```cpp
#include <hip/hip_runtime.h>
#include <hip/hip_cooperative_groups.h>
#include <stdint.h>
#include <stdio.h>
namespace cg = cooperative_groups;

typedef unsigned short bf16;
using bf16x8 = __attribute__((ext_vector_type(8))) short;
using f32x16 = __attribute__((ext_vector_type(16))) float;
using u32x8 = __attribute__((ext_vector_type(8))) unsigned int;
#define DI __device__ __forceinline__
#define MFMA32(a, b, c) __builtin_amdgcn_mfma_f32_32x32x16_bf16((a), (b), (c), 0, 0, 0)

typedef __bf16 hbf16x2 __attribute__((ext_vector_type(2)));
typedef float f32x2 __attribute__((ext_vector_type(2)));
DI uint32_t pack2(float a, float b) { f32x2 v = {a, b}; return __builtin_bit_cast(uint32_t, __builtin_convertvector(v, hbf16x2)); }
DI bf16 f2b(float x) { return (bf16)(pack2(x, x) & 0xffffu); }
DI float blo(uint32_t u) { return __uint_as_float(u << 16); }
DI float bhi(uint32_t u) { return __uint_as_float(u & 0xffff0000u); }
DI float siluf(float x) { return x / (1.f + __expf(-x)); }
DI float sigmf(float x) { return 1.f / (1.f + __expf(-x)); }

constexpr int NB = 8, SEQ = 8192, CTX = 256, DM = 1024;
constexpr int NL = NB * SEQ;
constexpr int NC = NB * CTX;
constexpr int NT = NL + NC;
constexpr int KEYS = CTX + SEQ;
constexpr int INW = 7984;
constexpr int N1 = 3456, N2 = 1536, N3 = 3072;
constexpr float EPS = 1e-6f;
constexpr float QSCALE = 0.125f * 1.4426950408889634f;

constexpr size_t al256(size_t x) { return (x + 255) & ~(size_t)255; }
constexpr size_t SZ_W1 = (size_t)N1 * 1024 * 2, SZ_W2 = (size_t)N2 * 1024 * 2, SZ_W3 = (size_t)N3 * 1024 * 2;
constexpr size_t SZ_WOUT = (size_t)1024 * 512 * 2, SZ_WO = (size_t)1024 * 1024 * 2;
constexpr size_t LW = SZ_W1 + SZ_W2 + SZ_W3 + 3 * SZ_WOUT + SZ_WO;
constexpr size_t OFF_W = 0;
constexpr size_t OFF_MOD = OFF_W + 2 * LW;
constexpr size_t OFF_ROPE = OFF_MOD + al256((size_t)2 * 9 * 3072 * 4);
constexpr size_t OFF_MISC = OFF_ROPE + (size_t)128 * 16 * 2 * 4;
constexpr size_t OFF_H = OFF_MISC + 256;
constexpr size_t OFF_QA = OFF_H + (size_t)NT * 1024 * 2;
constexpr size_t OFF_KA = OFF_QA + (size_t)NT * 512 * 2;
constexpr size_t OFF_VT = OFF_KA + (size_t)NT * 512 * 2;
constexpr size_t OFF_XBC = OFF_VT + (size_t)NT * 512 * 2;
constexpr size_t OFF_XBC2 = OFF_XBC + (size_t)NT * 768 * 2;
constexpr size_t OFF_GQ = OFF_XBC2 + (size_t)NT * 768 * 2;
constexpr size_t OFF_GK = OFF_GQ + (size_t)NT * 256 * 2;
constexpr size_t OFF_GV = OFF_GK + (size_t)NT * 256 * 2;
constexpr size_t OFF_DTLR = OFF_GV + (size_t)NT * 512 * 2;
constexpr size_t OFF_YSF = OFF_DTLR + (size_t)NT * 48 * 4;
constexpr size_t OFF_YSB = OFF_YSF + (size_t)NT * 512 * 2;
constexpr size_t OFF_YGF = OFF_YSB + (size_t)NT * 512 * 2;
constexpr size_t OFF_YGB = OFF_YGF + (size_t)NT * 512 * 2;
constexpr size_t OFF_CTX1 = OFF_YGB + (size_t)NT * 512 * 2;
constexpr size_t WS_TOTAL = OFF_CTX1 + (size_t)NC * 1024 * 4;
constexpr size_t OFF_Z = OFF_KA;
constexpr size_t OFF_U = OFF_GQ;
static_assert(WS_TOTAL <= ((size_t)1 << 30), "workspace too large");
static_assert((size_t)NT * 1536 * 2 <= OFF_XBC2 - OFF_KA, "Z overlay");
static_assert((size_t)NT * 1024 * 2 <= OFF_DTLR - OFF_GQ, "U overlay");

struct Params {
  const float *x, *c, *ctx, *c_ctx, *w_mod, *b_mod, *norm_w, *w_in, *da_lambda, *da_norm_w, *w_out_da;
  const float *conv_w, *conv_b, *dt_bias, *a_log, *ssm_d, *ssm_norm_w, *w_out_ssm;
  const float *gla_w_gate, *gla_b_gate, *gla_norm_w, *w_out_gla, *w_o, *final_norm_w;
  float* out;
  char* ws;
  int wid, pad_;
};
DI int tid_fresh(const Params& p, const int wid) {
  int t = wid * 64 + (int)__builtin_amdgcn_mbcnt_hi(~0u, __builtin_amdgcn_mbcnt_lo(~0u, 0u));
  asm volatile("" : "+v"(t));
  return t;
}

constexpr int LDS_BYTES = 70 * 1024;

DI int map_w1(int n) {
  if (n < 1536) return n;
  if (n < 2048) return 2048 + (n - 1536);
  if (n < 2304) return 3072 + (n - 2048);
  if (n < 3328) return 3344 + (n - 2304);
  if (n < 3344) return 3328 + (n - 3328);
  if (n < 3376) return 4880 + (n - 3344);
  return -1;
}
DI int map_w2(int n) {
  if (n < 512) return 1536 + n;
  if (n < 1024) return 2560 + (n - 512);
  return 4368 + (n - 1024);
}

DI void tr_tile(const Params& p, const int wid, const float* __restrict__ src, int ldsrc, bf16* __restrict__ dst, int K, int n0, int k0, int mapk, float* tile) {
  const int tid = tid_fresh(p, wid), tx = tid & 63, ty = tid >> 6;
  const int n = n0 + tx;
  int col = n;
  if (mapk == 1) col = map_w1(n); else if (mapk == 2) col = map_w2(n); else if (mapk == 3) col = 4912 + n;
#pragma unroll
  for (int i = 0; i < 16; ++i) {
    int kk = ty + 4 * i;
    tile[kk * 65 + tx] = (col >= 0) ? src[(size_t)(k0 + kk) * ldsrc + col] : 0.f;
  }
  __syncthreads();
#pragma unroll
  for (int i = 0; i < 16; ++i) {
    int nn = ty + 4 * i;
    dst[(size_t)(n0 + nn) * K + k0 + tx] = f2b(tile[tx * 65 + nn]);
  }
  __syncthreads();
}

constexpr int TR_PER_LAYER = 864 + 384 + 768 + 384 + 256;
constexpr int P0_ITEMS = 2 * TR_PER_LAYER + 96 + 1;

DI void phase0(const Params& p, const int wid, char* lds) {
  const int tid = tid_fresh(p, wid);
  float* fl = (float*)lds;
  for (int item = blockIdx.x; item < P0_ITEMS; item += gridDim.x) {
    if (item < 2 * TR_PER_LAYER) {
      const int layer = item / TR_PER_LAYER;
      int j = item % TR_PER_LAYER;
      char* wb = p.ws + OFF_W + (size_t)layer * LW;
      const float* win = p.w_in + (size_t)layer * 1024 * INW;
      if (j < 864) {
        tr_tile(p, wid, win, INW, (bf16*)wb, 1024, (j >> 4) * 64, (j & 15) * 64, 1, fl);
      } else if (j < 1248) {
        j -= 864;
        tr_tile(p, wid, win, INW, (bf16*)(wb + SZ_W1), 1024, (j >> 4) * 64, (j & 15) * 64, 2, fl);
      } else if (j < 2016) {
        j -= 1248;
        tr_tile(p, wid, win, INW, (bf16*)(wb + SZ_W1 + SZ_W2), 1024, (j >> 4) * 64, (j & 15) * 64, 3, fl);
      } else if (j < 2400) {
        j -= 2016;
        const int br = j >> 7, r = j & 127;
        const float* src = (br == 0 ? p.w_out_da : br == 1 ? p.w_out_ssm : p.w_out_gla) + (size_t)layer * 512 * 1024;
        tr_tile(p, wid, src, 1024, (bf16*)(wb + SZ_W1 + SZ_W2 + SZ_W3 + (size_t)br * SZ_WOUT), 512, (r >> 3) * 64, (r & 7) * 64, 0, fl);
      } else {
        j -= 2400;
        tr_tile(p, wid, p.w_o + (size_t)layer * 1024 * 1024, 1024, (bf16*)(wb + SZ_W1 + SZ_W2 + SZ_W3 + 3 * SZ_WOUT), 1024,
                (j >> 4) * 64, (j & 15) * 64, 0, fl);
      }
    } else if (item < 2 * TR_PER_LAYER + 96) {
      const int m = item - 2 * TR_PER_LAYER;
      const int layer = m / 48, nc = (m % 48) * 64;
      float* sc = fl;
      float* red = fl + 9 * 1024;
      for (int idx = tid; idx < 9 * 1024; idx += 256) {
        int j = idx >> 10, k = idx & 1023;
        float v = j < 8 ? p.c[j * 1024 + k] : p.c_ctx[k];
        sc[idx] = v / (1.f + expf(-v));
      }
      __syncthreads();
      const int tx = tid & 63, q = tid >> 6;
      float acc[9];
#pragma unroll
      for (int j = 0; j < 9; ++j) acc[j] = 0.f;
      const float* wm = p.w_mod + (size_t)layer * 1024 * 3072 + nc + tx;
#pragma unroll 4
      for (int k = q * 256; k < q * 256 + 256; ++k) {
        float wv = wm[(size_t)k * 3072];
#pragma unroll
        for (int j = 0; j < 9; ++j) acc[j] = fmaf(sc[j * 1024 + k], wv, acc[j]);
      }
#pragma unroll
      for (int j = 0; j < 9; ++j) red[(q * 9 + j) * 64 + tx] = acc[j];
      __syncthreads();
      float* modv = (float*)(p.ws + OFF_MOD);
      for (int idx = tid; idx < 9 * 64; idx += 256) {
        int j = idx >> 6, t = idx & 63;
        float s = red[(0 * 9 + j) * 64 + t] + red[(1 * 9 + j) * 64 + t] + red[(2 * 9 + j) * 64 + t] + red[(3 * 9 + j) * 64 + t];
        modv[(size_t)(layer * 9 + j) * 3072 + nc + t] = s + p.b_mod[layer * 3072 + nc + t];
      }
      __syncthreads();
    } else {
      float* rope = (float*)(p.ws + OFF_ROPE);
      for (int idx = tid; idx < 2048; idx += 256) {
        int pos = idx >> 4, f = idx & 15;
        float inv = (float)exp(-(double)f / 16.0 * 9.210340371976184);
        float angf = (float)pos * inv;
        double a = (double)angf;
        double r = a - 6.283185307179586477 * rint(a * 0.15915494309189533577);
        double r2 = r * r;
        double ts = r, ss = r, tc = 1.0, cs = 1.0;
#pragma unroll 1
        for (int n = 1; n <= 12; ++n) {
          tc *= -r2 / (double)((2 * n - 1) * (2 * n));
          cs += tc;
          ts *= -r2 / (double)((2 * n) * (2 * n + 1));
          ss += ts;
        }
        rope[idx * 2] = (float)cs;
        rope[idx * 2 + 1] = (float)ss;
      }
      float* misc = (float*)(p.ws + OFF_MISC);
      if (tid < 2) {
        const float* lm = p.da_lambda + tid * 4 * 64;
        float s1 = 0.f, s2 = 0.f;
        for (int i = 0; i < 64; ++i) { s1 += lm[i] * lm[64 + i]; s2 += lm[128 + i] * lm[192 + i]; }
        float lam_init = 0.8f - 0.6f * expf(-0.3f * (float)tid);
        misc[tid] = expf(s1) - expf(s2) + lam_init;
      }
      if (tid < 16) ((unsigned*)(p.ws + OFF_MISC + 64))[tid] = 0u;
    }
  }
}

DI float wave_sum(float v) {
#pragma unroll
  for (int m = 32; m >= 1; m >>= 1) v += __shfl_xor(v, m);
  return v;
}

DI void phase_h(const Params& p, const int wid, int layer, const float* xl, const float* xc, int M) {
  const int tidf = tid_fresh(p, wid); const int lane = tidf & 63, wave = tidf >> 6;
  bf16* h = (bf16*)(p.ws + OFF_H);
  const float* modv = (const float*)(p.ws + OFF_MOD) + (size_t)layer * 9 * 3072;
  const float* nw = p.norm_w + layer * 1024;
  const int stride = gridDim.x * 4;
  for (int row0 = blockIdx.x * 4 + wave; row0 < M; row0 += 2 * stride) {
    float4 v[2][4];
    float ss[2] = {0.f, 0.f};
#pragma unroll
    for (int r = 0; r < 2; ++r) {
      int row = row0 + r * stride;
      if (row >= M) row = row0;
      const float* src = row < NL ? xl + (size_t)row * 1024 : xc + (size_t)(row - NL) * 1024;
#pragma unroll
      for (int i = 0; i < 4; ++i) v[r][i] = *(const float4*)(src + (i * 64 + lane) * 4);
    }
#pragma unroll
    for (int r = 0; r < 2; ++r) {
#pragma unroll
      for (int i = 0; i < 4; ++i) ss[r] += v[r][i].x * v[r][i].x + v[r][i].y * v[r][i].y + v[r][i].z * v[r][i].z + v[r][i].w * v[r][i].w;
      ss[r] = wave_sum(ss[r]);
    }
#pragma unroll
    for (int r = 0; r < 2; ++r) {
      const int row = row0 + r * stride;
      if (row < M) {
        const int j = row < NL ? (row >> 13) : 8;
        const float* shift = modv + j * 3072;
        const float* scale = shift + 1024;
        const float rstd = rsqrtf(ss[r] * (1.f / 1024.f) + EPS);
#pragma unroll
        for (int i = 0; i < 4; ++i) {
          const int c = (i * 64 + lane) * 4;
          float4 w4 = *(const float4*)(nw + c), sc4 = *(const float4*)(scale + c), sh4 = *(const float4*)(shift + c);
          float o0 = v[r][i].x * rstd * w4.x * (1.f + sc4.x) + sh4.x;
          float o1 = v[r][i].y * rstd * w4.y * (1.f + sc4.y) + sh4.y;
          float o2 = v[r][i].z * rstd * w4.z * (1.f + sc4.z) + sh4.z;
          float o3 = v[r][i].w * rstd * w4.w * (1.f + sc4.w) + sh4.w;
          uint2 pk; pk.x = pack2(o0, o1); pk.y = pack2(o2, o3);
          *(uint2*)(h + (size_t)row * 1024 + c) = pk;
        }
      }
    }
  }
}

DI void gemm_main128(const bf16* __restrict__ A, int lda, const bf16* __restrict__ Bt, int ldb, int K,
                     f32x16 (&acc)[2][2], char* lds, const int tid) {
  bf16* As = (bf16*)lds;
  bf16* Bs = As + 128 * 72;
  const int lane = tid & 63, wave = tid >> 6, wm = wave >> 1, wn = wave & 1;
  const int l31 = lane & 31, lh = lane >> 5;
  const uint32_t aoff = (uint32_t)(((tid >> 3) * lda + (tid & 7) * 8) * 2);
  const uint32_t boff = (uint32_t)(((tid >> 3) * ldb + (tid & 7) * 8) * 2);
  const uint32_t soff = (uint32_t)(((tid >> 3) * 72 + (tid & 7) * 8) * 2);
  const char* Ab = (const char*)A;
  const char* Bb = (const char*)Bt;
  char* Asb = (char*)As;
  char* Bsb = (char*)Bs;
  const size_t astep = (size_t)32 * lda * 2, bstep = (size_t)32 * ldb * 2;
  uint4 ra0, ra1, ra2, ra3, rb0, rb1, rb2, rb3;
#define ALD(i, kb) (*(const uint4*)(Ab + ((size_t)(i) * astep + (kb)) + aoff))
#define BLD(i, kb) (*(const uint4*)(Bb + ((size_t)(i) * bstep + (kb)) + boff))
#define LDALL(kb)                                                          \
  ra0 = ALD(0, kb); ra1 = ALD(1, kb); ra2 = ALD(2, kb); ra3 = ALD(3, kb);  \
  rb0 = BLD(0, kb); rb1 = BLD(1, kb); rb2 = BLD(2, kb); rb3 = BLD(3, kb);
#define SST(base, i, val) (*(uint4*)((base) + (i) * (32 * 72 * 2) + soff) = (val))
  LDALL((size_t)0)
#pragma unroll 1
  for (int k0 = 0; k0 < K; k0 += 64) {
    SST(Asb, 0, ra0); SST(Asb, 1, ra1); SST(Asb, 2, ra2); SST(Asb, 3, ra3);
    SST(Bsb, 0, rb0); SST(Bsb, 1, rb1); SST(Bsb, 2, rb2); SST(Bsb, 3, rb3);
    __syncthreads();
    if (k0 + 64 < K) {
      const size_t kb = (size_t)(k0 + 64) * 2;
      LDALL(kb)
    }
#pragma unroll
    for (int ks = 0; ks < 4; ++ks) {
      const bf16x8 af0 = *(const bf16x8*)(As + (wm * 64 + l31) * 72 + ks * 16 + lh * 8);
      const bf16x8 af1 = *(const bf16x8*)(As + (wm * 64 + 32 + l31) * 72 + ks * 16 + lh * 8);
      const bf16x8 bf0 = *(const bf16x8*)(Bs + (wn * 64 + l31) * 72 + ks * 16 + lh * 8);
      const bf16x8 bf1 = *(const bf16x8*)(Bs + (wn * 64 + 32 + l31) * 72 + ks * 16 + lh * 8);
      acc[0][0] = MFMA32(af0, bf0, acc[0][0]);
      acc[1][0] = MFMA32(af1, bf0, acc[1][0]);
      acc[0][1] = MFMA32(af0, bf1, acc[0][1]);
      acc[1][1] = MFMA32(af1, bf1, acc[1][1]);
      __builtin_amdgcn_sched_barrier(0);
    }
    __syncthreads();
  }
#undef LDALL
#undef ALD
#undef BLD
#undef SST
}

template <int TM, int WN>
DI void zero_acc(f32x16 (&acc)[TM][WN]) {
#pragma unroll
  for (int a = 0; a < TM; ++a)
#pragma unroll
    for (int b = 0; b < WN; ++b)
#pragma unroll
      for (int i = 0; i < 16; ++i) acc[a][b][i] = 0.f;
}

DI void gemm_main256(const bf16* __restrict__ A, int lda, const bf16* __restrict__ Bt, int ldb, int K,
                     f32x16 (&acc)[4][2], char* lds, const int tid) {
  bf16* As = (bf16*)lds;
  bf16* Bs = As + 256 * 72;
  const int lane = tid & 63, wave = tid >> 6, wm = wave >> 1, wn = wave & 1;
  const int l31 = lane & 31, lh = lane >> 5;
  const uint32_t aoff = (uint32_t)(((tid >> 3) * lda + (tid & 7) * 8) * 2);
  const uint32_t boff = (uint32_t)(((tid >> 3) * ldb + (tid & 7) * 8) * 2);
  const uint32_t soff = (uint32_t)(((tid >> 3) * 72 + (tid & 7) * 8) * 2);
  const char* Ab = (const char*)A;
  const char* Bb = (const char*)Bt;
  char* Asb = (char*)As;
  char* Bsb = (char*)Bs;
  const size_t astep = (size_t)32 * lda * 2, bstep = (size_t)32 * ldb * 2;
  uint4 ra0, ra1, ra2, ra3, ra4, ra5, ra6, ra7, rb0, rb1, rb2, rb3;
#define ALD(i, kb) (*(const uint4*)(Ab + ((size_t)(i) * astep + (kb)) + aoff))
#define BLD(i, kb) (*(const uint4*)(Bb + ((size_t)(i) * bstep + (kb)) + boff))
#define LDALL(kb)                                                                      \
  ra0 = ALD(0, kb); ra1 = ALD(1, kb); ra2 = ALD(2, kb); ra3 = ALD(3, kb);              \
  ra4 = ALD(4, kb); ra5 = ALD(5, kb); ra6 = ALD(6, kb); ra7 = ALD(7, kb);              \
  rb0 = BLD(0, kb); rb1 = BLD(1, kb); rb2 = BLD(2, kb); rb3 = BLD(3, kb);
#define SST(base, i, val) (*(uint4*)((base) + (i) * (32 * 72 * 2) + soff) = (val))
  LDALL((size_t)0)
#pragma unroll 1
  for (int k0 = 0; k0 < K; k0 += 64) {
    SST(Asb, 0, ra0); SST(Asb, 1, ra1); SST(Asb, 2, ra2); SST(Asb, 3, ra3);
    SST(Asb, 4, ra4); SST(Asb, 5, ra5); SST(Asb, 6, ra6); SST(Asb, 7, ra7);
    SST(Bsb, 0, rb0); SST(Bsb, 1, rb1); SST(Bsb, 2, rb2); SST(Bsb, 3, rb3);
    __syncthreads();
    if (k0 + 64 < K) {
      const size_t kb = (size_t)(k0 + 64) * 2;
      LDALL(kb)
    }
#pragma unroll
    for (int ks = 0; ks < 4; ++ks) {
      const bf16x8 bf0 = *(const bf16x8*)(Bs + (wn * 64 + l31) * 72 + ks * 16 + lh * 8);
      const bf16x8 bf1 = *(const bf16x8*)(Bs + (wn * 64 + 32 + l31) * 72 + ks * 16 + lh * 8);
#pragma unroll
      for (int tm = 0; tm < 4; ++tm) {
        const bf16x8 af = *(const bf16x8*)(As + (wm * 128 + tm * 32 + l31) * 72 + ks * 16 + lh * 8);
        acc[tm][0] = MFMA32(af, bf0, acc[tm][0]);
        acc[tm][1] = MFMA32(af, bf1, acc[tm][1]);
      }
      __builtin_amdgcn_sched_barrier(0);
    }
    __syncthreads();
  }
#undef LDALL
#undef ALD
#undef BLD
#undef SST
}

DI bool xcd_tile(int it, int MT, int NTN, int PN, int& mt, int& nt) {
  const int x = blockIdx.x & 7, slot = blockIdx.x >> 3, nslots = gridDim.x >> 3;
  const int MTx = MT >> 3;
  const int lt = slot + it * nslots;
  if (lt >= MTx * NTN) return false;
  const int per_panel = MTx * PN;
  const int pn = lt / per_panel, r = lt - pn * per_panel;
  mt = x * MTx + r / PN;
  nt = pn * PN + r % PN;
  return true;
}

DI void phase_p1(const Params& p, const int wid, int layer, int M, char* lds) {
  const bf16* h = (const bf16*)(p.ws + OFF_H);
  const bf16* W1 = (const bf16*)(p.ws + OFF_W + (size_t)layer * LW);
  const float2* rope = (const float2*)(p.ws + OFF_ROPE);
  bf16* Qa = (bf16*)(p.ws + OFF_QA);
  bf16* Ka = (bf16*)(p.ws + OFF_KA);
  bf16* Vt = (bf16*)(p.ws + OFF_VT);
  bf16* xbc = (bf16*)(p.ws + OFF_XBC);
  bf16* gq = (bf16*)(p.ws + OFF_GQ);
  bf16* gk = (bf16*)(p.ws + OFF_GK);
  bf16* gv = (bf16*)(p.ws + OFF_GV);
  float* dtlr = (float*)(p.ws + OFF_DTLR);
  const int tidf = tid_fresh(p, wid); const int lane = tidf & 63, wave = tidf >> 6, wm = wave >> 1, wn = wave & 1, l31 = lane & 31, lh = lane >> 5;
  constexpr int NTN = N1 / 128;
  int mt_, nt_;
  for (int it = 0; xcd_tile(it, M / 256, NTN, 9, mt_, nt_); ++it) {
    const int m0 = mt_ * 256, n0 = nt_ * 128;
    f32x16 acc[4][2];
    zero_acc<4, 2>(acc);
    gemm_main256(h + (size_t)m0 * 1024, 1024, W1 + (size_t)n0 * 1024, 1024, 1024, acc, lds, tidf);
    const bool lat = m0 < NL;
#pragma unroll
    for (int tm = 0; tm < 4; ++tm)
#pragma unroll
      for (int tn = 0; tn < 2; ++tn) {
        const int col = n0 + wn * 64 + tn * 32 + l31;
        const int rowb = m0 + wm * 128 + tm * 32 + 4 * lh;
        if (n0 < 1024) {
          const int d = col & 63, axis = d >> 5, half = (d >> 4) & 1, f = d & 15;
          bf16* dst = n0 < 512 ? Qa : Ka;
#pragma unroll
          for (int i = 0; i < 16; ++i) {
            const int row = rowb + (i & 3) + 8 * (i >> 2);
            float v = acc[tm][tn][i];
            float partner = __shfl_xor(v, 16);
            if (lat) {
              const int t = row & 8191;
              const int pos = axis ? (t & 63) : (t >> 6);
              float2 cs = rope[pos * 16 + f];
              v = v * cs.x + (half ? partner : -partner) * cs.y;
            }
            if (n0 < 512) v *= QSCALE;
            dst[(size_t)row * 512 + (col & 511)] = f2b(v);
          }
        } else if (n0 < 1536) {
          const int hd = (col - 1024) >> 7, vv = (col - 1024) & 127;
#pragma unroll
          for (int g = 0; g < 4; ++g) {
            const int row0 = rowb + 8 * g;
            int b, key;
            if (lat) { b = row0 >> 13; key = 256 + (row0 & 8191); } else { b = (row0 - NL) >> 8; key = (row0 - NL) & 255; }
            uint2 pk;
            pk.x = pack2(acc[tm][tn][4 * g], acc[tm][tn][4 * g + 1]);
            pk.y = pack2(acc[tm][tn][4 * g + 2], acc[tm][tn][4 * g + 3]);
            *(uint2*)(Vt + ((size_t)((b * 4 + hd) * 128 + vv)) * KEYS + key) = pk;
          }
        } else if (n0 < 3328) {
          bf16* dst; int ld, cc;
          if (n0 < 2304) { dst = xbc; ld = 768; cc = col - 1536; }
          else if (n0 < 2560) { dst = gq; ld = 256; cc = col - 2304; }
          else if (n0 < 2816) { dst = gk; ld = 256; cc = col - 2560; }
          else { dst = gv; ld = 512; cc = col - 2816; }
#pragma unroll
          for (int i = 0; i < 16; ++i) {
            const int row = rowb + (i & 3) + 8 * (i >> 2);
            dst[(size_t)row * ld + cc] = f2b(acc[tm][tn][i]);
          }
        } else {
          const int cc = col - 3328;
          if (cc < 48) {
#pragma unroll
            for (int i = 0; i < 16; ++i) {
              const int row = rowb + (i & 3) + 8 * (i >> 2);
              dtlr[(size_t)row * 48 + cc] = acc[tm][tn][i];
            }
          }
        }
      }
  }
}

DI void phase_conv(const Params& p, const int wid, int layer) {
  const bf16* xin = (const bf16*)(p.ws + OFF_XBC);
  bf16* xo = (bf16*)(p.ws + OFF_XBC2);
  const float* cw = p.conv_w + layer * 3 * 768;
  const float* cb = p.conv_b + layer * 768;
  const int total = NT * 96;
  for (int idx = blockIdx.x * 256 + tid_fresh(p, wid); idx < total; idx += gridDim.x * 256) {
    const int row = idx / 96, c0 = (idx % 96) * 8;
    int t, L;
    if (row < NL) { t = row & 8191; L = 8192; } else { t = (row - NL) & 255; L = 256; }
    uint4 cur = *(const uint4*)(xin + (size_t)row * 768 + c0);
    uint4 prv = make_uint4(0, 0, 0, 0), nxt = make_uint4(0, 0, 0, 0);
    if (t > 0) prv = *(const uint4*)(xin + (size_t)(row - 1) * 768 + c0);
    if (t < L - 1) nxt = *(const uint4*)(xin + (size_t)(row + 1) * 768 + c0);
    const uint32_t cu[4] = {cur.x, cur.y, cur.z, cur.w}, pu[4] = {prv.x, prv.y, prv.z, prv.w}, nu[4] = {nxt.x, nxt.y, nxt.z, nxt.w};
    uint32_t ou[4];
#pragma unroll
    for (int q = 0; q < 4; ++q) {
      const int c = c0 + 2 * q;
      float a0 = cw[c] * blo(pu[q]) + cw[768 + c] * blo(cu[q]) + cw[1536 + c] * blo(nu[q]) + cb[c];
      float a1 = cw[c + 1] * bhi(pu[q]) + cw[768 + c + 1] * bhi(cu[q]) + cw[1536 + c + 1] * bhi(nu[q]) + cb[c + 1];
      ou[q] = pack2(siluf(a0), siluf(a1));
    }
    *(uint4*)(xo + (size_t)row * 768 + c0) = make_uint4(ou[0], ou[1], ou[2], ou[3]);
  }
}

DI int scan_row(int b, int dir, int s) {
  if (s < 256) { int t = dir ? 255 - s : s; return NL + b * 256 + t; }
  int t = s - 256;
  if (dir) t = 8191 - t;
  return b * 8192 + t;
}

template <bool GLA>
DI void scan_item(const Params& p, const int wid, int layer, int item, char* lds) {
  constexpr int CT = 16;
  constexpr int V = GLA ? 128 : 64;
  constexpr int NJ = V / 32;
  constexpr int BV = V / 16;
  float* a_s = (float*)lds;
  float* c_s = a_s + CT * 64;
  float* w_s = c_s + CT * 64;
  float* b_s = w_s + CT * 64;
  float* x_s = b_s + CT * V;
  float* op = x_s + (GLA ? 0 : CT * V);
  float* wg_s = op + CT * 4 * V;
  const int tid = tid_fresh(p, wid), lane = tid & 63, wave = tid >> 6;
  int head, dir, b;
  if (GLA) { head = item & 3; dir = (item >> 2) & 1; b = item >> 3; } else { head = item & 7; dir = (item >> 3) & 1; b = item >> 4; }
  const bf16* xbc = (const bf16*)(p.ws + OFF_XBC2);
  const bf16* gq = (const bf16*)(p.ws + OFF_GQ);
  const bf16* gk = (const bf16*)(p.ws + OFF_GK);
  const bf16* gv = (const bf16*)(p.ws + OFF_GV);
  const float* dtlr = (const float*)(p.ws + OFF_DTLR);
  bf16* yout = (bf16*)(p.ws + (GLA ? (dir ? OFF_YGB : OFF_YGF) : (dir ? OFF_YSB : OFF_YSF)));
  const int ocol = head * V;
  float Aneg = 0.f, Dsk = 0.f, dtb = 0.f;
  if (!GLA) {
    Aneg = -expf(p.a_log[layer * 16 + dir * 8 + head]);
    Dsk = p.ssm_d[layer * 16 + dir * 8 + head];
    dtb = p.dt_bias[layer * 16 + dir * 8 + head];
  } else {
    const float* wg = p.gla_w_gate + ((size_t)(layer * 2 + dir) * 16) * 256 + head * 64;
    for (int idx = tid; idx < 16 * 64; idx += 256) wg_s[idx] = wg[(idx >> 6) * 256 + (idx & 63)];
    if (tid < 64) wg_s[1024 + tid] = p.gla_b_gate[(layer * 2 + dir) * 256 + head * 64 + tid];
  }
  const int st = tid >> 4, sk4 = (tid & 15) * 4, sv = (tid & 15) * BV;
  const int vq = lane & 31, kg = wave * 2 + (lane >> 5);
  float S[8][NJ];
#pragma unroll
  for (int i = 0; i < 8; ++i)
#pragma unroll
    for (int j = 0; j < NJ; ++j) S[i][j] = 0.f;

  uint2 ra, rc; uint4 rbv; float rdt = 0.f; float4 rlr0, rlr1, rlr2, rlr3;
  rlr0 = rlr1 = rlr2 = rlr3 = make_float4(0.f, 0.f, 0.f, 0.f);
  rbv = make_uint4(0, 0, 0, 0);
#define SCAN_PREFETCH(chunk_)                                                                   \
  {                                                                                             \
    const int row_ = scan_row(b, dir, (chunk_) * CT + st);                                      \
    if (GLA) {                                                                                  \
      ra = *(const uint2*)(gk + (size_t)row_ * 256 + head * 64 + sk4);                          \
      rc = *(const uint2*)(gq + (size_t)row_ * 256 + head * 64 + sk4);                          \
      rbv = *(const uint4*)(gv + (size_t)row_ * 512 + head * 128 + sv);                         \
      const float* lr_ = dtlr + (size_t)row_ * 48 + 16 + dir * 16;                              \
      rlr0 = *(const float4*)(lr_); rlr1 = *(const float4*)(lr_ + 4);                           \
      rlr2 = *(const float4*)(lr_ + 8); rlr3 = *(const float4*)(lr_ + 12);                      \
    } else {                                                                                    \
      const int g_ = head >> 2;                                                                 \
      ra = *(const uint2*)(xbc + (size_t)row_ * 768 + 512 + g_ * 64 + sk4);                     \
      rc = *(const uint2*)(xbc + (size_t)row_ * 768 + 640 + g_ * 64 + sk4);                     \
      const uint2 t_ = *(const uint2*)(xbc + (size_t)row_ * 768 + head * 64 + sv);              \
      rbv.x = t_.x; rbv.y = t_.y;                                                               \
      rdt = dtlr[(size_t)row_ * 48 + dir * 8 + head];                                           \
    }                                                                                           \
  }
  SCAN_PREFETCH(0);
  constexpr int NCH = KEYS / CT;
  for (int chunk = 0; chunk < NCH; ++chunk) {
    {
      const float cscale = GLA ? 0.125f : 1.f;
      *(float4*)(a_s + st * 64 + sk4) = make_float4(blo(ra.x), bhi(ra.x), blo(ra.y), bhi(ra.y));
      *(float4*)(c_s + st * 64 + sk4) = make_float4(blo(rc.x) * cscale, bhi(rc.x) * cscale, blo(rc.y) * cscale, bhi(rc.y) * cscale);
      if (GLA) {
        *(float4*)(b_s + st * V + sv) = make_float4(blo(rbv.x), bhi(rbv.x), blo(rbv.y), bhi(rbv.y));
        *(float4*)(b_s + st * V + sv + 4) = make_float4(blo(rbv.z), bhi(rbv.z), blo(rbv.w), bhi(rbv.w));
        float4 zb = *(const float4*)(wg_s + 1024 + sk4);
        float z0 = zb.x, z1 = zb.y, z2 = zb.z, z3 = zb.w;
#define GROW(r_, lv_)                                                  \
  {                                                                    \
    const float4 w0_ = *(const float4*)(wg_s + (r_) * 64 + sk4);       \
    z0 = fmaf((lv_), w0_.x, z0); z1 = fmaf((lv_), w0_.y, z1); z2 = fmaf((lv_), w0_.z, z2); z3 = fmaf((lv_), w0_.w, z3); \
  }
        GROW(0, rlr0.x) GROW(1, rlr0.y) GROW(2, rlr0.z) GROW(3, rlr0.w)
        GROW(4, rlr1.x) GROW(5, rlr1.y) GROW(6, rlr1.z) GROW(7, rlr1.w)
        GROW(8, rlr2.x) GROW(9, rlr2.y) GROW(10, rlr2.z) GROW(11, rlr2.w)
        GROW(12, rlr3.x) GROW(13, rlr3.y) GROW(14, rlr3.z) GROW(15, rlr3.w)
#define LSIG16(zz) expf(((zz) >= 0.f ? -log1pf(expf(-(zz))) : (zz) - log1pf(expf(zz))) * (1.f / 16.f))
        *(float4*)(w_s + st * 64 + sk4) = make_float4(LSIG16(z0), LSIG16(z1), LSIG16(z2), LSIG16(z3));
      } else {
        float zz = rdt + dtb;
        float dt = zz > 20.f ? zz : log1pf(expf(zz));
        float4 xv = make_float4(blo(rbv.x), bhi(rbv.x), blo(rbv.y), bhi(rbv.y));
        *(float4*)(b_s + st * V + sv) = make_float4(xv.x * dt, xv.y * dt, xv.z * dt, xv.w * dt);
        *(float4*)(x_s + st * V + sv) = xv;
        if ((tid & 15) == 0) w_s[st] = expf(dt * Aneg);
      }
    }
    __syncthreads();
    if (chunk + 1 < NCH) SCAN_PREFETCH(chunk + 1);
#pragma unroll 4
    for (int tt = 0; tt < CT; ++tt) {
      const float4 a0 = *(const float4*)(a_s + tt * 64 + kg * 8), a1 = *(const float4*)(a_s + tt * 64 + kg * 8 + 4);
      const float4 c0 = *(const float4*)(c_s + tt * 64 + kg * 8), c1 = *(const float4*)(c_s + tt * 64 + kg * 8 + 4);
      const float av[8] = {a0.x, a0.y, a0.z, a0.w, a1.x, a1.y, a1.z, a1.w};
      const float cv[8] = {c0.x, c0.y, c0.z, c0.w, c1.x, c1.y, c1.z, c1.w};
      float wv[8];
      if (GLA) {
        const float4 w0 = *(const float4*)(w_s + tt * 64 + kg * 8), w1 = *(const float4*)(w_s + tt * 64 + kg * 8 + 4);
        wv[0] = w0.x; wv[1] = w0.y; wv[2] = w0.z; wv[3] = w0.w; wv[4] = w1.x; wv[5] = w1.y; wv[6] = w1.z; wv[7] = w1.w;
      } else {
        const float w = w_s[tt];
#pragma unroll
        for (int i = 0; i < 8; ++i) wv[i] = w;
      }
      float bv[NJ], o[NJ];
#pragma unroll
      for (int j = 0; j < NJ; ++j) { bv[j] = b_s[tt * V + vq + 32 * j]; o[j] = 0.f; }
#pragma unroll
      for (int i = 0; i < 8; ++i)
#pragma unroll
        for (int j = 0; j < NJ; ++j) {
          S[i][j] = fmaf(wv[i], S[i][j], av[i] * bv[j]);
          o[j] = fmaf(cv[i], S[i][j], o[j]);
        }
#pragma unroll
      for (int j = 0; j < NJ; ++j) {
        o[j] += __shfl_xor(o[j], 32);
        if (lane < 32) op[(tt * 4 + wave) * V + vq + 32 * j] = o[j];
      }
    }
    __syncthreads();
    {
      const int row = scan_row(b, dir, chunk * CT + st);
#pragma unroll
      for (int q = 0; q < BV / 4; ++q) {
        const int vc = sv + 4 * q;
        float4 o0 = *(const float4*)(op + (st * 4 + 0) * V + vc), o1 = *(const float4*)(op + (st * 4 + 1) * V + vc);
        float4 o2 = *(const float4*)(op + (st * 4 + 2) * V + vc), o3 = *(const float4*)(op + (st * 4 + 3) * V + vc);
        float r0 = o0.x + o1.x + o2.x + o3.x, r1 = o0.y + o1.y + o2.y + o3.y, r2 = o0.z + o1.z + o2.z + o3.z, r3 = o0.w + o1.w + o2.w + o3.w;
        if (!GLA) {
          float4 xv = *(const float4*)(x_s + st * V + vc);
          r0 = fmaf(Dsk, xv.x, r0); r1 = fmaf(Dsk, xv.y, r1); r2 = fmaf(Dsk, xv.z, r2); r3 = fmaf(Dsk, xv.w, r3);
        }
        uint2 pk; pk.x = pack2(r0, r1); pk.y = pack2(r2, r3);
        *(uint2*)(yout + (size_t)row * 512 + ocol + vc) = pk;
      }
    }
  }
  __syncthreads();
#undef SCAN_PREFETCH
#undef GROW
#undef LSIG16
}

DI bf16x8 pack8(const f32x16& x, int s) {
  uint32_t p0 = pack2(x[8 * s], x[8 * s + 1]), p1 = pack2(x[8 * s + 2], x[8 * s + 3]);
  uint32_t p2 = pack2(x[8 * s + 4], x[8 * s + 5]), p3 = pack2(x[8 * s + 6], x[8 * s + 7]);
  uint4 u = make_uint4(p0, p1, p2, p3);
  return __builtin_bit_cast(bf16x8, u);
}

template <bool GLA>
DI void cscan_item(const Params& p, const int wid, int layer, int item, char* lds) {
  constexpr int RS = 72;
  bf16* Qm = (bf16*)lds;
  bf16* Km = Qm + 64 * RS;
  bf16* KeT = Km + 64 * RS;
  bf16* bT = KeT + 64 * RS;
  bf16* ST = bT + 64 * RS;
  char* R = (char*)(ST + 64 * RS);
  float* Gf = (float*)R;
  bf16* Cm = (bf16*)R;
  float* Gs = (float*)(R + 64 * RS * 2);
  float* tot = (float*)(R + 16384);
  float* lr_s = tot + 256;
  const int tid = tid_fresh(p, wid), lane = tid & 63, wave = tid >> 6, l31 = lane & 31, lh = lane >> 5;
  const int nt = wave & 1, vh = wave >> 1;
  int head, dir, b, vhalf = 0;
  if (GLA) { vhalf = item & 1; head = (item >> 1) & 3; } else { head = item & 7; }
  dir = (item >> 3) & 1; b = item >> 4;
  const bf16* xbc = (const bf16*)(p.ws + OFF_XBC2);
  const bf16* gq = (const bf16*)(p.ws + OFF_GQ);
  const bf16* gk = (const bf16*)(p.ws + OFF_GK);
  const bf16* gv = (const bf16*)(p.ws + OFF_GV);
  const float* dtlr = (const float*)(p.ws + OFF_DTLR);
  bf16* yout = (bf16*)(p.ws + (GLA ? (dir ? OFF_YGB : OFF_YGF) : (dir ? OFF_YSB : OFF_YSF)));
  const int ocol = GLA ? head * 128 + vhalf * 64 : head * 64;
  float Aneg = 0.f, Dsk = 0.f, dtb = 0.f, bgk = 0.f;
  float wgk[16];
#pragma unroll
  for (int r = 0; r < 16; ++r) wgk[r] = 0.f;
  if (!GLA) {
    Aneg = -expf(p.a_log[layer * 16 + dir * 8 + head]);
    Dsk = p.ssm_d[layer * 16 + dir * 8 + head];
    dtb = p.dt_bias[layer * 16 + dir * 8 + head];
  } else {
    const float* wg = p.gla_w_gate + ((size_t)(layer * 2 + dir) * 16) * 256 + head * 64 + (tid & 63);
#pragma unroll
    for (int r = 0; r < 16; ++r) wgk[r] = wg[r * 256];
    bgk = p.gla_b_gate[(layer * 2 + dir) * 256 + head * 64 + (tid & 63)];
  }
  const int st = tid >> 2, k16 = (tid & 3) * 16;
  f32x16 Sacc;
#pragma unroll
  for (int i = 0; i < 16; ++i) Sacc[i] = 0.f;

  uint4 ra0, ra1, rc0, rc1, rb0, rb1; float4 rl;
#define CS_PREFETCH(chunk_)                                                                          \
  {                                                                                                  \
    const int row_ = scan_row(b, dir, (chunk_) * 64 + st);                                           \
    if (GLA) {                                                                                       \
      const uint4* ap_ = (const uint4*)(gk + (size_t)row_ * 256 + head * 64 + k16);                  \
      const uint4* cp_ = (const uint4*)(gq + (size_t)row_ * 256 + head * 64 + k16);                  \
      const uint4* bp_ = (const uint4*)(gv + (size_t)row_ * 512 + head * 128 + vhalf * 64 + k16);    \
      ra0 = ap_[0]; ra1 = ap_[1]; rc0 = cp_[0]; rc1 = cp_[1]; rb0 = bp_[0]; rb1 = bp_[1];            \
      rl = *(const float4*)(dtlr + (size_t)row_ * 48 + 16 + dir * 16 + (tid & 3) * 4);               \
    } else {                                                                                         \
      const int g_ = head >> 2;                                                                      \
      const uint4* ap_ = (const uint4*)(xbc + (size_t)row_ * 768 + 512 + g_ * 64 + k16);             \
      const uint4* cp_ = (const uint4*)(xbc + (size_t)row_ * 768 + 640 + g_ * 64 + k16);             \
      const uint4* bp_ = (const uint4*)(xbc + (size_t)row_ * 768 + head * 64 + k16);                 \
      ra0 = ap_[0]; ra1 = ap_[1]; rc0 = cp_[0]; rc1 = cp_[1]; rb0 = bp_[0]; rb1 = bp_[1];            \
      rl.x = dtlr[(size_t)row_ * 48 + dir * 8 + head]; rl.y = 0.f; rl.z = 0.f; rl.w = 0.f;           \
    }                                                                                                \
  }
  CS_PREFETCH(0);
#pragma unroll 1
  for (int chunk = 0; chunk < KEYS / 64; ++chunk) {
    float dt = 0.f;
    if (GLA) {
      *(float4*)(lr_s + st * 16 + (tid & 3) * 4) = rl;
      __syncthreads();
      float Gl[16];
      float run = 0.f;
#pragma unroll
      for (int i = 0; i < 16; ++i) {
        const float* lrp = lr_s + (wave * 16 + i) * 16;
        const float4 l0 = *(const float4*)(lrp), l1 = *(const float4*)(lrp + 4), l2 = *(const float4*)(lrp + 8), l3 = *(const float4*)(lrp + 12);
        float z = bgk;
        z = fmaf(l0.x, wgk[0], z); z = fmaf(l0.y, wgk[1], z); z = fmaf(l0.z, wgk[2], z); z = fmaf(l0.w, wgk[3], z);
        z = fmaf(l1.x, wgk[4], z); z = fmaf(l1.y, wgk[5], z); z = fmaf(l1.z, wgk[6], z); z = fmaf(l1.w, wgk[7], z);
        z = fmaf(l2.x, wgk[8], z); z = fmaf(l2.y, wgk[9], z); z = fmaf(l2.z, wgk[10], z); z = fmaf(l2.w, wgk[11], z);
        z = fmaf(l3.x, wgk[12], z); z = fmaf(l3.y, wgk[13], z); z = fmaf(l3.z, wgk[14], z); z = fmaf(l3.w, wgk[15], z);
        run -= (fmaxf(-z, 0.f) + __logf(1.f + __expf(-fabsf(z)))) * (1.f / 16.f);
        Gl[i] = run;
      }
      tot[wave * 64 + lane] = run;
      __syncthreads();
      float off = 0.f;
      if (wave > 0) off += tot[lane];
      if (wave > 1) off += tot[64 + lane];
      if (wave > 2) off += tot[128 + lane];
#pragma unroll
      for (int i = 0; i < 16; ++i) Gf[(wave * 16 + i) * 64 + lane] = Gl[i] + off;
    } else {
      const float zz = rl.x + dtb;
      dt = zz > 20.f ? zz : log1pf(expf(zz));
      if ((tid & 3) == 0) lr_s[st] = dt;
      __syncthreads();
      if (wave == 0) {
        float g = lr_s[lane] * Aneg;
#pragma unroll
        for (int o = 1; o < 64; o <<= 1) {
          const float v = __shfl_up(g, o);
          if (lane >= o) g += v;
        }
        Gs[lane] = g;
      }
    }
#pragma unroll
    for (int i = 0; i < 16; ++i)
      ST[(32 * (wave >> 1) + (i & 3) + 8 * (i >> 2) + 4 * lh) * RS + 32 * (wave & 1) + l31] = f2b(Sacc[i]);
    __syncthreads();
    {
      const uint32_t au[8] = {ra0.x, ra0.y, ra0.z, ra0.w, ra1.x, ra1.y, ra1.z, ra1.w};
      const uint32_t cu[8] = {rc0.x, rc0.y, rc0.z, rc0.w, rc1.x, rc1.y, rc1.z, rc1.w};
      const uint32_t bu[8] = {rb0.x, rb0.y, rb0.z, rb0.w, rb1.x, rb1.y, rb1.z, rb1.w};
      uint32_t qo[8], ko[8];
      if (GLA) {
#pragma unroll
        for (int q = 0; q < 4; ++q) {
          const float4 G4 = *(const float4*)(Gf + st * 64 + k16 + 4 * q);
          const float4 L4 = *(const float4*)(Gf + 63 * 64 + k16 + 4 * q);
          const float gg[4] = {G4.x, G4.y, G4.z, G4.w}, ll[4] = {L4.x, L4.y, L4.z, L4.w};
#pragma unroll
          for (int h2 = 0; h2 < 2; ++h2) {
            const int w = 2 * q + h2;
            const float a0 = blo(au[w]), a1 = bhi(au[w]), c0 = blo(cu[w]), c1 = bhi(cu[w]);
            const float g0 = gg[2 * h2], g1 = gg[2 * h2 + 1];
            qo[w] = pack2(c0 * 0.125f * __expf(g0), c1 * 0.125f * __expf(g1));
            ko[w] = pack2(a0 * __expf(-g0), a1 * __expf(-g1));
            KeT[(k16 + 2 * w) * RS + st] = f2b(a0 * __expf(ll[2 * h2] - g0));
            KeT[(k16 + 2 * w + 1) * RS + st] = f2b(a1 * __expf(ll[2 * h2 + 1] - g1));
            bT[(k16 + 2 * w) * RS + st] = (bf16)(bu[w] & 0xffffu);
            bT[(k16 + 2 * w + 1) * RS + st] = (bf16)(bu[w] >> 16);
          }
        }
      } else {
        const float Gt = Gs[st], GL = Gs[63];
        const float e1 = __expf(Gt), e3 = __expf(GL - Gt);
#pragma unroll
        for (int w = 0; w < 8; ++w) {
          const float a0 = blo(au[w]), a1 = bhi(au[w]), c0 = blo(cu[w]), c1 = bhi(cu[w]);
          qo[w] = pack2(c0 * e1, c1 * e1);
          ko[w] = au[w];
          KeT[(k16 + 2 * w) * RS + st] = f2b(a0 * e3);
          KeT[(k16 + 2 * w + 1) * RS + st] = f2b(a1 * e3);
          bT[(k16 + 2 * w) * RS + st] = f2b(blo(bu[w]) * dt);
          bT[(k16 + 2 * w + 1) * RS + st] = f2b(bhi(bu[w]) * dt);
        }
        *(uint4*)(Cm + st * RS + k16) = rc0;
        *(uint4*)(Cm + st * RS + k16 + 8) = rc1;
      }
      *(uint4*)(Qm + st * RS + k16) = make_uint4(qo[0], qo[1], qo[2], qo[3]);
      *(uint4*)(Qm + st * RS + k16 + 8) = make_uint4(qo[4], qo[5], qo[6], qo[7]);
      *(uint4*)(Km + st * RS + k16) = make_uint4(ko[0], ko[1], ko[2], ko[3]);
      *(uint4*)(Km + st * RS + k16 + 8) = make_uint4(ko[4], ko[5], ko[6], ko[7]);
    }
    __syncthreads();
    if (chunk + 1 < KEYS / 64) CS_PREFETCH(chunk + 1);
    const int trow = scan_row(b, dir, chunk * 64 + 32 * nt + l31);
    uint2 xr0 = make_uint2(0, 0), xr1 = xr0, xr2 = xr0, xr3 = xr0;
    if (!GLA) {
      const bf16* xp = xbc + (size_t)trow * 768 + head * 64 + 32 * vh + 4 * lh;
      xr0 = *(const uint2*)(xp); xr1 = *(const uint2*)(xp + 8); xr2 = *(const uint2*)(xp + 16); xr3 = *(const uint2*)(xp + 24);
    }
    f32x16 outv;
#pragma unroll
    for (int i = 0; i < 16; ++i) outv[i] = 0.f;
    const bf16* Qp = GLA ? Qm : Cm;
#pragma unroll
    for (int ms = 0; ms < 2; ++ms) {
      if (ms <= nt) {
        f32x16 at;
#pragma unroll
        for (int i = 0; i < 16; ++i) at[i] = 0.f;
#pragma unroll
        for (int ks = 0; ks < 4; ++ks) {
          const bf16x8 kf = *(const bf16x8*)(Km + (32 * ms + l31) * RS + ks * 16 + lh * 8);
          const bf16x8 qf = *(const bf16x8*)(Qp + (32 * nt + l31) * RS + ks * 16 + lh * 8);
          at = MFMA32(kf, qf, at);
        }
        if (!GLA) {
          const float gt = Gs[32 * nt + l31];
#pragma unroll
          for (int g4 = 0; g4 < 4; ++g4) {
            const float4 gs4 = *(const float4*)(Gs + 32 * ms + 8 * g4 + 4 * lh);
            const float gsv[4] = {gs4.x, gs4.y, gs4.z, gs4.w};
#pragma unroll
            for (int j = 0; j < 4; ++j) {
              const int sl = 8 * g4 + 4 * lh + j;
              const bool keep = (ms < nt) || (sl <= l31);
              at[4 * g4 + j] = keep ? at[4 * g4 + j] * __expf(gt - gsv[j]) : 0.f;
            }
          }
        } else if (ms == nt) {
#pragma unroll
          for (int i = 0; i < 16; ++i) {
            const int sl = (i & 3) + 8 * (i >> 2) + 4 * lh;
            at[i] = (sl <= l31) ? at[i] : 0.f;
          }
        }
#pragma unroll
        for (int s2 = 0; s2 < 2; ++s2) {
          const bf16x8 pf = pack8(at, s2);
          const bf16* vp = bT + (32 * vh + l31) * RS + 32 * ms + 16 * s2 + 4 * lh;
          const uint2 lo = *(const uint2*)vp, hi = *(const uint2*)(vp + 8);
          const uint4 u = make_uint4(lo.x, lo.y, hi.x, hi.y);
          outv = MFMA32(__builtin_bit_cast(bf16x8, u), pf, outv);
        }
      }
    }
#pragma unroll
    for (int ks = 0; ks < 4; ++ks) {
      const bf16x8 sf = *(const bf16x8*)(ST + (32 * vh + l31) * RS + ks * 16 + lh * 8);
      const bf16x8 qf = *(const bf16x8*)(Qm + (32 * nt + l31) * RS + ks * 16 + lh * 8);
      outv = MFMA32(sf, qf, outv);
    }
    {
      const float dec = GLA ? __expf(Gf[63 * 64 + 32 * (wave & 1) + l31]) : __expf(Gs[63]);
#pragma unroll
      for (int i = 0; i < 16; ++i) Sacc[i] *= dec;
#pragma unroll
      for (int ks = 0; ks < 4; ++ks) {
        const bf16x8 bf_ = *(const bf16x8*)(bT + (32 * (wave >> 1) + l31) * RS + ks * 16 + lh * 8);
        const bf16x8 kf = *(const bf16x8*)(KeT + (32 * (wave & 1) + l31) * RS + ks * 16 + lh * 8);
        Sacc = MFMA32(bf_, kf, Sacc);
      }
    }
    {
      bf16* yp = yout + (size_t)trow * 512 + ocol + 32 * vh + 4 * lh;
      const uint2 xr[4] = {xr0, xr1, xr2, xr3};
#pragma unroll
      for (int g4 = 0; g4 < 4; ++g4) {
        float r0 = outv[4 * g4], r1 = outv[4 * g4 + 1], r2 = outv[4 * g4 + 2], r3 = outv[4 * g4 + 3];
        if (!GLA) {
          r0 = fmaf(Dsk, blo(xr[g4].x), r0); r1 = fmaf(Dsk, bhi(xr[g4].x), r1);
          r2 = fmaf(Dsk, blo(xr[g4].y), r2); r3 = fmaf(Dsk, bhi(xr[g4].y), r3);
        }
        uint2 pk; pk.x = pack2(r0, r1); pk.y = pack2(r2, r3);
        *(uint2*)(yp + 8 * g4) = pk;
      }
    }
    __syncthreads();
  }
#undef CS_PREFETCH
}


DI void attn_item(const Params& p, const int wid, int layer, int b, int head, int qrow0, int nkeys, char* lds) {
  bf16* Ks = (bf16*)lds;
  bf16* Vs = Ks + 64 * 136;
  bf16* Qa = (bf16*)(p.ws + OFF_QA);
  const bf16* Ka = (const bf16*)(p.ws + OFF_KA);
  const bf16* Vt = (const bf16*)(p.ws + OFF_VT) + (size_t)(b * 4 + head) * 128 * KEYS;
  const int tid = tid_fresh(p, wid), lane = tid & 63, wave = tid >> 6, l31 = lane & 31, lh = lane >> 5;

  bf16* Qs = Vs + 128 * 68;
#pragma unroll
  for (int i = 0; i < 8; ++i) {
    const int ch = tid + 256 * i;
    *(uint4*)(Qs + (ch >> 4) * 136 + (ch & 15) * 8) = *(const uint4*)(Qa + (size_t)(qrow0 + (ch >> 4)) * 512 + head * 128 + (ch & 15) * 8);
  }
  const bf16* qsw = Qs + (wave * 32 + l31) * 136 + lh * 8;
  f32x16 O[2][4];
#pragma unroll
  for (int c = 0; c < 2; ++c)
#pragma unroll
    for (int vt = 0; vt < 4; ++vt)
#pragma unroll
      for (int i = 0; i < 16; ++i) O[c][vt][i] = 0.f;
  float mrun[2] = {-1e30f, -1e30f}, lrun[2] = {0.f, 0.f};

  const int lkey = tid >> 2, lkq = (tid & 3) * 32, lvr = tid >> 1, lvh = (tid & 1) * 32;
#define KROW(key) ((key) < 256 ? NL + b * 256 + (key) : b * 8192 + (key) - 256)
#define KVLOAD(k0_)                                                                                  \
  {                                                                                                  \
    const uint4* kp_ = (const uint4*)(Ka + (size_t)KROW((k0_) + lkey) * 512 + head * 128 + lkq);      \
    rk0 = kp_[0]; rk1 = kp_[1]; rk2 = kp_[2]; rk3 = kp_[3];                                          \
    const uint4* vp_ = (const uint4*)(Vt + (size_t)lvr * KEYS + (k0_) + lvh);                        \
    rv0 = vp_[0]; rv1 = vp_[1]; rv2 = vp_[2]; rv3 = vp_[3];                                          \
  }
#define VST2(dst_, val) { (dst_)[0] = make_uint2((val).x, (val).y); (dst_)[1] = make_uint2((val).z, (val).w); }
  uint4 rk0, rk1, rk2, rk3, rv0, rv1, rv2, rv3;
  KVLOAD(0);
#pragma unroll 1
  for (int k0 = 0; k0 < nkeys; k0 += 64) {
    {
      uint4* kd = (uint4*)(Ks + lkey * 136 + lkq);
      kd[0] = rk0; kd[1] = rk1; kd[2] = rk2; kd[3] = rk3;
      uint2* vd = (uint2*)(Vs + lvr * 68 + lvh);
      VST2(vd, rv0); VST2(vd + 2, rv1); VST2(vd + 4, rv2); VST2(vd + 6, rv3);
    }
    __syncthreads();
    if (k0 + 64 < nkeys) KVLOAD(k0 + 64);
#pragma unroll
    for (int c = 0; c < 2; ++c) {
#pragma unroll
      for (int mt = 0; mt < 2; ++mt) {
        f32x16 sv;
#pragma unroll
        for (int i = 0; i < 16; ++i) sv[i] = 0.f;
#pragma unroll
        for (int ks = 0; ks < 4; ++ks) {
          const bf16x8 qf = *(const bf16x8*)(qsw + c * 64 + ks * 16);
          const bf16x8 kf = *(const bf16x8*)(Ks + (mt * 32 + l31) * 136 + c * 64 + ks * 16 + lh * 8);
          sv = MFMA32(kf, qf, sv);
        }
        __builtin_amdgcn_sched_barrier(0);
        float mx = sv[0];
#pragma unroll
        for (int i = 1; i < 16; ++i) mx = fmaxf(mx, sv[i]);
        mx = fmaxf(mx, __shfl_xor(mx, 32));
        const float mnew = fmaxf(mrun[c], mx);
        if (__any(mnew > mrun[c])) {
          const float alpha = __builtin_amdgcn_exp2f(mrun[c] - mnew);
          mrun[c] = mnew;
          lrun[c] *= alpha;
#pragma unroll
          for (int vt = 0; vt < 4; ++vt)
#pragma unroll
            for (int i = 0; i < 16; ++i) O[c][vt][i] *= alpha;
        }
        float psum = 0.f;
#pragma unroll
        for (int i = 0; i < 16; ++i) {
          float pv = __builtin_amdgcn_exp2f(sv[i] - mrun[c]);
          sv[i] = pv;
          psum += pv;
        }
        lrun[c] += psum;
        __builtin_amdgcn_sched_barrier(0);
#pragma unroll
        for (int st = 0; st < 2; ++st) {
          const bf16x8 pf = pack8(sv, st);
#pragma unroll
          for (int vt = 0; vt < 4; ++vt) {
            const bf16* vp = Vs + (vt * 32 + l31) * 68 + mt * 32 + 16 * st + 4 * lh;
            uint2 lo = *(const uint2*)vp, hi = *(const uint2*)(vp + 8);
            uint4 u = make_uint4(lo.x, lo.y, hi.x, hi.y);
            O[c][vt] = MFMA32(__builtin_bit_cast(bf16x8, u), pf, O[c][vt]);
          }
          __builtin_amdgcn_sched_barrier(0);
        }
      }
    }
    __syncthreads();
  }
  const float lam = ((const float*)(p.ws + OFF_MISC))[layer];
  const float lam_init = layer == 0 ? 0.2f : 0.8f - 0.6f * 0.7408182206817179f;
  const float l1 = lrun[0] + __shfl_xor(lrun[0], 32);
  const float l2 = lrun[1] + __shfl_xor(lrun[1], 32);
  const float i1 = 1.f / l1, i2 = lam / l2;
  float ss = 0.f;
#pragma unroll
  for (int vt = 0; vt < 4; ++vt)
#pragma unroll
    for (int i = 0; i < 16; ++i) {
      float o = O[0][vt][i] * i1 - O[1][vt][i] * i2;
      O[0][vt][i] = o;
      ss += o * o;
    }
  ss += __shfl_xor(ss, 32);
  const float rstd = rsqrtf(ss * (1.f / 128.f) + EPS) * (1.f - lam_init);
  const float* nw = p.da_norm_w + layer * 128;
  bf16* orow = Qa + (size_t)(qrow0 + wave * 32 + l31) * 512 + head * 128;
#pragma unroll
  for (int vt = 0; vt < 4; ++vt)
#pragma unroll
    for (int g = 0; g < 4; ++g) {
      const int v0 = vt * 32 + 8 * g + 4 * lh;
      float4 w4 = *(const float4*)(nw + v0);
      uint2 pk;
      pk.x = pack2(O[0][vt][4 * g] * rstd * w4.x, O[0][vt][4 * g + 1] * rstd * w4.y);
      pk.y = pack2(O[0][vt][4 * g + 2] * rstd * w4.z, O[0][vt][4 * g + 3] * rstd * w4.w);
      *(uint2*)(orow + v0) = pk;
    }
}

DI void phase_mixers(const Params& p, const int wid, int layer, char* lds) {
  __shared__ int s_item;
  const int x = blockIdx.x & 7;
  unsigned* counter = (unsigned*)(p.ws + OFF_MISC + 64) + layer * 8 + x;
  const int total = layer == 0 ? 32 + 256 + 8 : 32 + 256;
  for (;;) {
    if (tid_fresh(p, wid) == 0) s_item = (int)atomicAdd(counter, 1u);
    __syncthreads();
    const int li = s_item;
    __syncthreads();
    if (li >= total) break;
    if (li < 32) {
      const int sid = li * 8 + x;
      if (sid < 128) cscan_item<true>(p, wid, layer, sid, lds);
      else cscan_item<false>(p, wid, layer, sid - 128, lds);
    } else if (li < 288) {
      const int a = li - 32;
      const int bh = x + 8 * (a >> 6), qb = a & 63;
      attn_item(p, wid, layer, bh >> 2, bh & 3, (bh >> 2) * 8192 + qb * 128, KEYS, lds);
    } else {
      const int c = x * 8 + (li - 288);
      const int bh = c >> 1, qb = c & 1;
      attn_item(p, wid, layer, bh >> 2, bh & 3, NL + (bh >> 2) * 256 + qb * 128, 256, lds);
    }
  }
}

DI void phase_z(const Params& p, const int wid, int layer, int M, char* lds) {
  const bf16* h = (const bf16*)(p.ws + OFF_H);
  const bf16* W2 = (const bf16*)(p.ws + OFF_W + (size_t)layer * LW + SZ_W1);
  bf16* Z = (bf16*)(p.ws + OFF_Z);
  const int tidf = tid_fresh(p, wid); const int lane = tidf & 63, wave = tidf >> 6, wm = wave >> 1, wn = wave & 1, l31 = lane & 31, lh = lane >> 5;
  constexpr int NTN = N2 / 128;
  int mt_, nt_;
  for (int it = 0; xcd_tile(it, M / 256, NTN, 12, mt_, nt_); ++it) {
    const int m0 = mt_ * 256, n0 = nt_ * 128;
    f32x16 acc[4][2];
    zero_acc<4, 2>(acc);
    gemm_main256(h + (size_t)m0 * 1024, 1024, W2 + (size_t)n0 * 1024, 1024, 1024, acc, lds, tidf);
#pragma unroll
    for (int tm = 0; tm < 4; ++tm)
#pragma unroll
      for (int tn = 0; tn < 2; ++tn) {
        const int col = n0 + wn * 64 + tn * 32 + l31;
        const int rowb = m0 + wm * 128 + tm * 32 + 4 * lh;
#pragma unroll
        for (int i = 0; i < 16; ++i) {
          const int row = rowb + (i & 3) + 8 * (i >> 2);
          Z[(size_t)row * 1536 + col] = f2b(acc[tm][tn][i]);
        }
      }
  }
}

DI void phase_post(const Params& p, const int wid, int layer, int M) {
  const int tidf = tid_fresh(p, wid); const int lane = tidf & 63, wave = tidf >> 6;
  bf16* Z = (bf16*)(p.ws + OFF_Z);
  const bf16* oda = (const bf16*)(p.ws + OFF_QA);
  const bf16* ysf = (const bf16*)(p.ws + OFF_YSF);
  const bf16* ysb = (const bf16*)(p.ws + OFF_YSB);
  const bf16* ygf = (const bf16*)(p.ws + OFF_YGF);
  const bf16* ygb = (const bf16*)(p.ws + OFF_YGB);
  const float* snw = p.ssm_norm_w + layer * 512;
  const float* gnw = p.gla_norm_w + layer * 128;
  const int c0 = lane * 8;
  for (int row = blockIdx.x * 4 + wave; row < M; row += gridDim.x * 4) {
    bf16* zr = Z + (size_t)row * 1536;
    {
      uint4 o = *(const uint4*)(oda + (size_t)row * 512 + c0);
      uint4 z = *(const uint4*)(zr + c0);
      const uint32_t ou[4] = {o.x, o.y, o.z, o.w}, zu[4] = {z.x, z.y, z.z, z.w};
      uint32_t r[4];
#pragma unroll
      for (int q = 0; q < 4; ++q) r[q] = pack2(blo(ou[q]) * siluf(blo(zu[q])), bhi(ou[q]) * siluf(bhi(zu[q])));
      *(uint4*)(zr + c0) = make_uint4(r[0], r[1], r[2], r[3]);
    }
    {
      uint4 yf = *(const uint4*)(ysf + (size_t)row * 512 + c0), yb = *(const uint4*)(ysb + (size_t)row * 512 + c0);
      uint4 z = *(const uint4*)(zr + 512 + c0);
      const uint32_t fu[4] = {yf.x, yf.y, yf.z, yf.w}, bu[4] = {yb.x, yb.y, yb.z, yb.w}, zu[4] = {z.x, z.y, z.z, z.w};
      float y[8];
      float ss = 0.f;
#pragma unroll
      for (int q = 0; q < 4; ++q) {
        y[2 * q] = (blo(fu[q]) + blo(bu[q])) * siluf(blo(zu[q]));
        y[2 * q + 1] = (bhi(fu[q]) + bhi(bu[q])) * siluf(bhi(zu[q]));
        ss += y[2 * q] * y[2 * q] + y[2 * q + 1] * y[2 * q + 1];
      }
#pragma unroll
      for (int m = 16; m >= 1; m >>= 1) ss += __shfl_xor(ss, m);
      const float rstd = rsqrtf(ss * (1.f / 256.f) + EPS);
      float4 w0 = *(const float4*)(snw + c0), w1 = *(const float4*)(snw + c0 + 4);
      uint32_t r[4];
      r[0] = pack2(y[0] * rstd * w0.x, y[1] * rstd * w0.y); r[1] = pack2(y[2] * rstd * w0.z, y[3] * rstd * w0.w);
      r[2] = pack2(y[4] * rstd * w1.x, y[5] * rstd * w1.y); r[3] = pack2(y[6] * rstd * w1.z, y[7] * rstd * w1.w);
      *(uint4*)(zr + 512 + c0) = make_uint4(r[0], r[1], r[2], r[3]);
    }
    {
      uint4 yf = *(const uint4*)(ygf + (size_t)row * 512 + c0), yb = *(const uint4*)(ygb + (size_t)row * 512 + c0);
      uint4 z = *(const uint4*)(zr + 1024 + c0);
      const uint32_t fu[4] = {yf.x, yf.y, yf.z, yf.w}, bu[4] = {yb.x, yb.y, yb.z, yb.w}, zu[4] = {z.x, z.y, z.z, z.w};
      float y[8];
      float ss = 0.f;
#pragma unroll
      for (int q = 0; q < 4; ++q) {
        y[2 * q] = blo(fu[q]) + blo(bu[q]);
        y[2 * q + 1] = bhi(fu[q]) + bhi(bu[q]);
        ss += y[2 * q] * y[2 * q] + y[2 * q + 1] * y[2 * q + 1];
      }
#pragma unroll
      for (int m = 8; m >= 1; m >>= 1) ss += __shfl_xor(ss, m);
      const float rstd = rsqrtf(ss * (1.f / 128.f) + EPS);
      const int cw = c0 & 127;
      float4 w0 = *(const float4*)(gnw + cw), w1 = *(const float4*)(gnw + cw + 4);
      uint32_t r[4];
      r[0] = pack2(y[0] * rstd * w0.x * siluf(blo(zu[0])), y[1] * rstd * w0.y * siluf(bhi(zu[0])));
      r[1] = pack2(y[2] * rstd * w0.z * siluf(blo(zu[1])), y[3] * rstd * w0.w * siluf(bhi(zu[1])));
      r[2] = pack2(y[4] * rstd * w1.x * siluf(blo(zu[2])), y[5] * rstd * w1.y * siluf(bhi(zu[2])));
      r[3] = pack2(y[6] * rstd * w1.z * siluf(blo(zu[3])), y[7] * rstd * w1.w * siluf(bhi(zu[3])));
      *(uint4*)(zr + 1024 + c0) = make_uint4(r[0], r[1], r[2], r[3]);
    }
  }
}

DI void phase_merge(const Params& p, const int wid, int layer, int M, char* lds) {
  const bf16* h = (const bf16*)(p.ws + OFF_H);
  const bf16* osg = (const bf16*)(p.ws + OFF_Z);
  const char* wb = p.ws + OFF_W + (size_t)layer * LW;
  const bf16* W3 = (const bf16*)(wb + SZ_W1 + SZ_W2);
  const bf16* Wout = (const bf16*)(wb + SZ_W1 + SZ_W2 + SZ_W3);
  bf16* U = (bf16*)(p.ws + OFF_U);
  const int tidf = tid_fresh(p, wid); const int lane = tidf & 63, wave = tidf >> 6, wm = wave >> 1, wn = wave & 1, l31 = lane & 31, lh = lane >> 5;
  constexpr int NTN = 1024 / 128;
  int mt_, nt_;
  for (int it = 0; xcd_tile(it, M / 128, NTN, 8, mt_, nt_); ++it) {
    const int m0 = mt_ * 128, n0 = nt_ * 128;
    f32x16 u[2][2];
    zero_acc<2, 2>(u);
#pragma unroll 1
    for (int br = 0; br < 3; ++br) {
      uint32_t* sgl = (uint32_t*)(lds + 36864) + tidf;
      {
        f32x16 g[2][2];
        zero_acc<2, 2>(g);
        gemm_main128(h + (size_t)m0 * 1024, 1024, W3 + (size_t)(br * 1024 + n0) * 1024, 1024, 1024, g, lds, tidf);
#pragma unroll
        for (int tm = 0; tm < 2; ++tm)
#pragma unroll
          for (int tn = 0; tn < 2; ++tn)
#pragma unroll
            for (int q = 0; q < 8; ++q) sgl[((tm * 2 + tn) * 8 + q) * 256] = pack2(sigmf(g[tm][tn][2 * q]), sigmf(g[tm][tn][2 * q + 1]));
      }
      f32x16 t[2][2];
      zero_acc<2, 2>(t);
      gemm_main128(osg + (size_t)m0 * 1536 + br * 512, 1536, Wout + (size_t)br * 1024 * 512 + (size_t)n0 * 512, 512, 512, t, lds, tidf);
#pragma unroll
      for (int tm = 0; tm < 2; ++tm)
#pragma unroll
        for (int tn = 0; tn < 2; ++tn)
#pragma unroll
          for (int q = 0; q < 8; ++q) {
            const uint32_t sgv = sgl[((tm * 2 + tn) * 8 + q) * 256];
            u[tm][tn][2 * q] = fmaf(blo(sgv), t[tm][tn][2 * q], u[tm][tn][2 * q]);
            u[tm][tn][2 * q + 1] = fmaf(bhi(sgv), t[tm][tn][2 * q + 1], u[tm][tn][2 * q + 1]);
          }
    }
#pragma unroll
    for (int tm = 0; tm < 2; ++tm)
#pragma unroll
      for (int tn = 0; tn < 2; ++tn) {
        const int col = n0 + wn * 64 + tn * 32 + l31;
        const int rowb = m0 + wm * 64 + tm * 32 + 4 * lh;
#pragma unroll
        for (int i = 0; i < 16; ++i) {
          const int row = rowb + (i & 3) + 8 * (i >> 2);
          U[(size_t)row * 1024 + col] = f2b(u[tm][tn][i]);
        }
      }
  }
}

DI void phase_out(const Params& p, const int wid, int layer, int M, const float* xl, const float* xc, float* ol, float* oc, char* lds) {
  const bf16* U = (const bf16*)(p.ws + OFF_U);
  const bf16* Wo = (const bf16*)(p.ws + OFF_W + (size_t)layer * LW + SZ_W1 + SZ_W2 + SZ_W3 + 3 * SZ_WOUT);
  const float* modv = (const float*)(p.ws + OFF_MOD) + (size_t)layer * 9 * 3072;
  const int tidf = tid_fresh(p, wid); const int lane = tidf & 63, wave = tidf >> 6, wm = wave >> 1, wn = wave & 1, l31 = lane & 31, lh = lane >> 5;
  constexpr int NTN = 1024 / 128;
  int mt_, nt_;
  for (int it = 0; xcd_tile(it, M / 256, NTN, 8, mt_, nt_); ++it) {
    const int m0 = mt_ * 256, n0 = nt_ * 128;
    f32x16 acc[4][2];
    zero_acc<4, 2>(acc);
    gemm_main256(U + (size_t)m0 * 1024, 1024, Wo + (size_t)n0 * 1024, 1024, 1024, acc, lds, tidf);
    const bool lat = m0 < NL;
    const int j = lat ? (m0 >> 13) : 8;
    const float* gate = modv + j * 3072 + 2048;
    const float* src = lat ? xl + (size_t)m0 * 1024 : xc + (size_t)(m0 - NL) * 1024;
    float* dst = lat ? ol + (size_t)m0 * 1024 : oc + (size_t)(m0 - NL) * 1024;
    uint32_t eoff = (uint32_t)((wm * 128 + 4 * lh) * 1024 + n0 + wn * 64 + l31);
    asm volatile("" : "+v"(eoff));
    const float* sp = src + eoff;
    float* dp = dst + eoff;
    const float* gp = gate + n0 + wn * 64 + l31;
#pragma unroll
    for (int tm = 0; tm < 4; ++tm)
#pragma unroll
      for (int tn = 0; tn < 2; ++tn) {
        const float gt = gp[tn * 32];
#pragma unroll
        for (int i = 0; i < 16; ++i) {
          const int off = (tm * 32 + (i & 3) + 8 * (i >> 2)) * 1024 + tn * 32;
          dp[off] = sp[off] + gt * acc[tm][tn][i];
        }
        __builtin_amdgcn_sched_barrier(0);
      }
  }
}

DI void phase_final(const Params& p, const int wid) {
  const int tidf = tid_fresh(p, wid); const int lane = tidf & 63, wave = tidf >> 6;
  const int stride = gridDim.x * 4;
  for (int row0 = blockIdx.x * 4 + wave; row0 < NL; row0 += 2 * stride) {
    float4 v[2][4];
    float ss[2] = {0.f, 0.f};
#pragma unroll
    for (int r = 0; r < 2; ++r) {
      int row = row0 + r * stride;
      if (row >= NL) row = row0;
      const float* src = p.out + (size_t)row * 1024;
#pragma unroll
      for (int i = 0; i < 4; ++i) v[r][i] = *(const float4*)(src + (i * 64 + lane) * 4);
    }
#pragma unroll
    for (int r = 0; r < 2; ++r) {
#pragma unroll
      for (int i = 0; i < 4; ++i) ss[r] += v[r][i].x * v[r][i].x + v[r][i].y * v[r][i].y + v[r][i].z * v[r][i].z + v[r][i].w * v[r][i].w;
      ss[r] = wave_sum(ss[r]);
    }
#pragma unroll
    for (int r = 0; r < 2; ++r) {
      const int row = row0 + r * stride;
      if (row < NL) {
        float* dst = p.out + (size_t)row * 1024;
        const float rstd = rsqrtf(ss[r] * (1.f / 1024.f) + EPS);
#pragma unroll
        for (int i = 0; i < 4; ++i) {
          const int c = (i * 64 + lane) * 4;
          float4 w4 = *(const float4*)(p.final_norm_w + c);
          *(float4*)(dst + c) = make_float4(v[r][i].x * rstd * w4.x, v[r][i].y * rstd * w4.y, v[r][i].z * rstd * w4.z, v[r][i].w * rstd * w4.w);
        }
      }
    }
  }
}

__global__ void __launch_bounds__(256, 2) hybrid_trunk_mega(Params p) {
  cg::grid_group grid = cg::this_grid();
  const int wid = __builtin_amdgcn_readfirstlane((int)(threadIdx.x >> 6));
  __shared__ __attribute__((aligned(16))) char lds[LDS_BYTES];
  phase0(p, wid, lds);
  grid.sync();
  float* ctx1 = (float*)(p.ws + OFF_CTX1);
#pragma unroll 1
  for (int layer = 0; layer < 2; ++layer) {
    const float* xl = layer == 0 ? p.x : p.out;
    const float* xc = layer == 0 ? p.ctx : ctx1;
    const int M = layer == 0 ? NT : NL;
    phase_h(p, wid, layer, xl, xc, NT);
    grid.sync();
    phase_p1(p, wid, layer, NT, lds);
    grid.sync();
#ifdef DUP_GEMM
    phase_p1(p, wid, layer, NT, lds);
    grid.sync();
#endif
    phase_conv(p, wid, layer);
    grid.sync();
#ifdef PROBE_SCAN
    for (int it = blockIdx.x; it < 192; it += gridDim.x) { if (it < 64) scan_item<true>(p, wid, layer, it, lds); else scan_item<false>(p, wid, layer, it - 64, lds); }
    grid.sync();
#endif
    phase_mixers(p, wid, layer, lds);
    grid.sync();
    phase_z(p, wid, layer, M, lds);
    grid.sync();
#ifdef DUP_GEMM
    phase_z(p, wid, layer, M, lds);
    grid.sync();
#endif
    phase_post(p, wid, layer, M);
    grid.sync();
    phase_merge(p, wid, layer, M, lds);
    grid.sync();
#ifdef DUP_GEMM
    phase_merge(p, wid, layer, M, lds);
    grid.sync();
#endif
    phase_out(p, wid, layer, M, xl, xc, p.out, ctx1, lds);
    grid.sync();
  }
  phase_final(p, wid);
}

extern "C" void kernel_launch(void* const* d_in, const int* in_sizes, int n_in, void* d_out, int out_size, void* d_ws,
                              size_t ws_size, hipStream_t stream) {
  (void)in_sizes; (void)n_in; (void)out_size;
  static int grid_blocks = 0;
  if (!grid_blocks) {
    int dev = 0, cus = 0, per_cu = 0;
    hipGetDevice(&dev);
    hipDeviceGetAttribute(&cus, hipDeviceAttributeMultiprocessorCount, dev);
    hipOccupancyMaxActiveBlocksPerMultiprocessor(&per_cu, hybrid_trunk_mega, 256, 0);
    (void)per_cu;
    grid_blocks = cus * 2;
  }
  if (ws_size < WS_TOTAL) { fprintf(stderr, "workspace too small: %zu < %zu\n", ws_size, (size_t)WS_TOTAL); return; }
  Params p{};
  const float** f = (const float**)&p;
  for (int i = 0; i < 24; ++i) f[i] = (const float*)d_in[i];
  p.wid = 0; p.pad_ = 0;
  p.out = (float*)d_out;
  p.ws = (char*)d_ws;
  void* args[] = {&p};
  hipError_t e = hipLaunchCooperativeKernel((const void*)hybrid_trunk_mega, dim3(grid_blocks), dim3(256), args, 0, stream);
  if (e != hipSuccess && (grid_blocks & 15) == 0) {
    (void)hipGetLastError();
    grid_blocks >>= 1;
    e = hipLaunchCooperativeKernel((const void*)hybrid_trunk_mega, dim3(grid_blocks), dim3(256), args, 0, stream);
  }
  if (e != hipSuccess) fprintf(stderr, "cooperative launch failed: %s (grid %d)\n", hipGetErrorString(e), grid_blocks);
}
```

```cpp
#include <hip/hip_runtime.h>
#include <hip/hip_cooperative_groups.h>
#include <stdint.h>
#include <stdio.h>
namespace cg = cooperative_groups;

typedef unsigned short bf16;
using bf16x8 = __attribute__((ext_vector_type(8))) short;
using f32x16 = __attribute__((ext_vector_type(16))) float;
using u32x8 = __attribute__((ext_vector_type(8))) unsigned int;
#define DI __device__ __forceinline__
#define MFMA32(a, b, c) __builtin_amdgcn_mfma_f32_32x32x16_bf16((a), (b), (c), 0, 0, 0)

typedef __bf16 hbf16x2 __attribute__((ext_vector_type(2)));
typedef float f32x2 __attribute__((ext_vector_type(2)));
DI uint32_t pack2(float a, float b) { f32x2 v = {a, b}; return __builtin_bit_cast(uint32_t, __builtin_convertvector(v, hbf16x2)); }
DI bf16 f2b(float x) { return (bf16)(pack2(x, x) & 0xffffu); }
DI float blo(uint32_t u) { return __uint_as_float(u << 16); }
DI float bhi(uint32_t u) { return __uint_as_float(u & 0xffff0000u); }
DI float siluf(float x) { return x / (1.f + __expf(-x)); }
DI float sigmf(float x) { return 1.f / (1.f + __expf(-x)); }

constexpr int NB = 8, SEQ = 8192, CTX = 256, DM = 1024;
constexpr int NL = NB * SEQ;
constexpr int NC = NB * CTX;
constexpr int NT = NL + NC;
constexpr int KEYS = CTX + SEQ;
constexpr int INW = 7984;
constexpr int N1 = 3456, N2 = 1536, N3 = 3072;
constexpr float EPS = 1e-6f;
constexpr float QSCALE = 0.125f * 1.4426950408889634f;

constexpr size_t al256(size_t x) { return (x + 255) & ~(size_t)255; }
constexpr size_t SZ_W1 = (size_t)N1 * 1024 * 2, SZ_W2 = (size_t)N2 * 1024 * 2, SZ_W3 = (size_t)N3 * 1024 * 2;
constexpr size_t SZ_WOUT = (size_t)1024 * 512 * 2, SZ_WO = (size_t)1024 * 1024 * 2;
constexpr size_t LW = SZ_W1 + SZ_W2 + SZ_W3 + 3 * SZ_WOUT + SZ_WO;
constexpr size_t OFF_W = 0;
constexpr size_t OFF_MOD = OFF_W + 2 * LW;
constexpr size_t OFF_ROPE = OFF_MOD + al256((size_t)2 * 9 * 3072 * 4);
constexpr size_t OFF_MISC = OFF_ROPE + (size_t)128 * 16 * 2 * 4;
constexpr size_t OFF_H = OFF_MISC + 256;
constexpr size_t OFF_QA = OFF_H + (size_t)NT * 1024 * 2;
constexpr size_t OFF_KA = OFF_QA + (size_t)NT * 512 * 2;
constexpr size_t OFF_VT = OFF_KA + (size_t)NT * 512 * 2;
constexpr size_t OFF_XBC = OFF_VT + (size_t)NT * 512 * 2;
constexpr size_t OFF_XBC2 = OFF_XBC + (size_t)NT * 768 * 2;
constexpr size_t OFF_GQ = OFF_XBC2 + (size_t)NT * 768 * 2;
constexpr size_t OFF_GK = OFF_GQ + (size_t)NT * 256 * 2;
constexpr size_t OFF_GV = OFF_GK + (size_t)NT * 256 * 2;
constexpr size_t OFF_DTLR = OFF_GV + (size_t)NT * 512 * 2;
constexpr size_t OFF_YSF = OFF_DTLR + (size_t)NT * 48 * 4;
constexpr size_t OFF_YSB = OFF_YSF + (size_t)NT * 512 * 2;
constexpr size_t OFF_YGF = OFF_YSB + (size_t)NT * 512 * 2;
constexpr size_t OFF_YGB = OFF_YGF + (size_t)NT * 512 * 2;
constexpr size_t OFF_CTX1 = OFF_YGB + (size_t)NT * 512 * 2;
constexpr size_t WS_TOTAL = OFF_CTX1 + (size_t)NC * 1024 * 4;
constexpr size_t OFF_Z = OFF_KA;
constexpr size_t OFF_U = OFF_GQ;
static_assert(WS_TOTAL <= ((size_t)1 << 30), "workspace too large");
static_assert((size_t)NT * 1536 * 2 <= OFF_XBC2 - OFF_KA, "Z overlay");
static_assert((size_t)NT * 1024 * 2 <= OFF_DTLR - OFF_GQ, "U overlay");

struct Params {
  const float *x, *c, *ctx, *c_ctx, *w_mod, *b_mod, *norm_w, *w_in, *da_lambda, *da_norm_w, *w_out_da;
  const float *conv_w, *conv_b, *dt_bias, *a_log, *ssm_d, *ssm_norm_w, *w_out_ssm;
  const float *gla_w_gate, *gla_b_gate, *gla_norm_w, *w_out_gla, *w_o, *final_norm_w;
  float* out;
  char* ws;
  int wid, pad_;
};
DI int tid_fresh(const Params& p, const int wid) {
  int t = wid * 64 + (int)__builtin_amdgcn_mbcnt_hi(~0u, __builtin_amdgcn_mbcnt_lo(~0u, 0u));
  asm volatile("" : "+v"(t));
  return t;
}

constexpr int LDS_BYTES = 70 * 1024;

DI int map_w1(int n) {
  if (n < 1536) return n;
  if (n < 2048) return 2048 + (n - 1536);
  if (n < 2304) return 3072 + (n - 2048);
  if (n < 3328) return 3344 + (n - 2304);
  if (n < 3344) return 3328 + (n - 3328);
  if (n < 3376) return 4880 + (n - 3344);
  return -1;
}
DI int map_w2(int n) {
  if (n < 512) return 1536 + n;
  if (n < 1024) return 2560 + (n - 512);
  return 4368 + (n - 1024);
}

DI void tr_tile(const Params& p, const int wid, const float* __restrict__ src, int ldsrc, bf16* __restrict__ dst, int K, int n0, int k0, int mapk, float* tile) {
  const int tid = tid_fresh(p, wid), tx = tid & 63, ty = tid >> 6;
  const int n = n0 + tx;
  int col = n;
  if (mapk == 1) col = map_w1(n); else if (mapk == 2) col = map_w2(n); else if (mapk == 3) col = 4912 + n;
#pragma unroll
  for (int i = 0; i < 16; ++i) {
    int kk = ty + 4 * i;
    tile[kk * 65 + tx] = (col >= 0) ? src[(size_t)(k0 + kk) * ldsrc + col] : 0.f;
  }
  __syncthreads();
#pragma unroll
  for (int i = 0; i < 16; ++i) {
    int nn = ty + 4 * i;
    dst[(size_t)(n0 + nn) * K + k0 + tx] = f2b(tile[tx * 65 + nn]);
  }
  __syncthreads();
}

constexpr int TR_PER_LAYER = 864 + 384 + 768 + 384 + 256;
constexpr int P0_ITEMS = 2 * TR_PER_LAYER + 96 + 1;

DI void phase0(const Params& p, const int wid, char* lds) {
  const int tid = tid_fresh(p, wid);
  float* fl = (float*)lds;
  for (int item = blockIdx.x; item < P0_ITEMS; item += gridDim.x) {
    if (item < 2 * TR_PER_LAYER) {
      const int layer = item / TR_PER_LAYER;
      int j = item % TR_PER_LAYER;
      char* wb = p.ws + OFF_W + (size_t)layer * LW;
      const float* win = p.w_in + (size_t)layer * 1024 * INW;
      if (j < 864) {
        tr_tile(p, wid, win, INW, (bf16*)wb, 1024, (j >> 4) * 64, (j & 15) * 64, 1, fl);
      } else if (j < 1248) {
        j -= 864;
        tr_tile(p, wid, win, INW, (bf16*)(wb + SZ_W1), 1024, (j >> 4) * 64, (j & 15) * 64, 2, fl);
      } else if (j < 2016) {
        j -= 1248;
        tr_tile(p, wid, win, INW, (bf16*)(wb + SZ_W1 + SZ_W2), 1024, (j >> 4) * 64, (j & 15) * 64, 3, fl);
      } else if (j < 2400) {
        j -= 2016;
        const int br = j >> 7, r = j & 127;
        const float* src = (br == 0 ? p.w_out_da : br == 1 ? p.w_out_ssm : p.w_out_gla) + (size_t)layer * 512 * 1024;
        tr_tile(p, wid, src, 1024, (bf16*)(wb + SZ_W1 + SZ_W2 + SZ_W3 + (size_t)br * SZ_WOUT), 512, (r >> 3) * 64, (r & 7) * 64, 0, fl);
      } else {
        j -= 2400;
        tr_tile(p, wid, p.w_o + (size_t)layer * 1024 * 1024, 1024, (bf16*)(wb + SZ_W1 + SZ_W2 + SZ_W3 + 3 * SZ_WOUT), 1024,
                (j >> 4) * 64, (j & 15) * 64, 0, fl);
      }
    } else if (item < 2 * TR_PER_LAYER + 96) {
      const int m = item - 2 * TR_PER_LAYER;
      const int layer = m / 48, nc = (m % 48) * 64;
      float* sc = fl;
      float* red = fl + 9 * 1024;
      for (int idx = tid; idx < 9 * 1024; idx += 256) {
        int j = idx >> 10, k = idx & 1023;
        float v = j < 8 ? p.c[j * 1024 + k] : p.c_ctx[k];
        sc[idx] = v / (1.f + expf(-v));
      }
      __syncthreads();
      const int tx = tid & 63, q = tid >> 6;
      float acc[9];
#pragma unroll
      for (int j = 0; j < 9; ++j) acc[j] = 0.f;
      const float* wm = p.w_mod + (size_t)layer * 1024 * 3072 + nc + tx;
#pragma unroll 4
      for (int k = q * 256; k < q * 256 + 256; ++k) {
        float wv = wm[(size_t)k * 3072];
#pragma unroll
        for (int j = 0; j < 9; ++j) acc[j] = fmaf(sc[j * 1024 + k], wv, acc[j]);
      }
#pragma unroll
      for (int j = 0; j < 9; ++j) red[(q * 9 + j) * 64 + tx] = acc[j];
      __syncthreads();
      float* modv = (float*)(p.ws + OFF_MOD);
      for (int idx = tid; idx < 9 * 64; idx += 256) {
        int j = idx >> 6, t = idx & 63;
        float s = red[(0 * 9 + j) * 64 + t] + red[(1 * 9 + j) * 64 + t] + red[(2 * 9 + j) * 64 + t] + red[(3 * 9 + j) * 64 + t];
        modv[(size_t)(layer * 9 + j) * 3072 + nc + t] = s + p.b_mod[layer * 3072 + nc + t];
      }
      __syncthreads();
    } else {
      float* rope = (float*)(p.ws + OFF_ROPE);
      for (int idx = tid; idx < 2048; idx += 256) {
        int pos = idx >> 4, f = idx & 15;
        float inv = (float)exp(-(double)f / 16.0 * 9.210340371976184);
        float angf = (float)pos * inv;
        double a = (double)angf;
        double r = a - 6.283185307179586477 * rint(a * 0.15915494309189533577);
        double r2 = r * r;
        double ts = r, ss = r, tc = 1.0, cs = 1.0;
#pragma unroll 1
        for (int n = 1; n <= 12; ++n) {
          tc *= -r2 / (double)((2 * n - 1) * (2 * n));
          cs += tc;
          ts *= -r2 / (double)((2 * n) * (2 * n + 1));
          ss += ts;
        }
        rope[idx * 2] = (float)cs;
        rope[idx * 2 + 1] = (float)ss;
      }
      float* misc = (float*)(p.ws + OFF_MISC);
      if (tid < 2) {
        const float* lm = p.da_lambda + tid * 4 * 64;
        float s1 = 0.f, s2 = 0.f;
        for (int i = 0; i < 64; ++i) { s1 += lm[i] * lm[64 + i]; s2 += lm[128 + i] * lm[192 + i]; }
        float lam_init = 0.8f - 0.6f * expf(-0.3f * (float)tid);
        misc[tid] = expf(s1) - expf(s2) + lam_init;
      }
      if (tid < 16) ((unsigned*)(p.ws + OFF_MISC + 64))[tid] = 0u;
    }
  }
}

DI float wave_sum(float v) {
#pragma unroll
  for (int m = 32; m >= 1; m >>= 1) v += __shfl_xor(v, m);
  return v;
}

DI void phase_h(const Params& p, const int wid, int layer, const float* xl, const float* xc, int M) {
  const int tidf = tid_fresh(p, wid); const int lane = tidf & 63, wave = tidf >> 6;
  bf16* h = (bf16*)(p.ws + OFF_H);
  const float* modv = (const float*)(p.ws + OFF_MOD) + (size_t)layer * 9 * 3072;
  const float* nw = p.norm_w + layer * 1024;
  const int stride = gridDim.x * 4;
  for (int row0 = blockIdx.x * 4 + wave; row0 < M; row0 += 2 * stride) {
    float4 v[2][4];
    float ss[2] = {0.f, 0.f};
#pragma unroll
    for (int r = 0; r < 2; ++r) {
      int row = row0 + r * stride;
      if (row >= M) row = row0;
      const float* src = row < NL ? xl + (size_t)row * 1024 : xc + (size_t)(row - NL) * 1024;
#pragma unroll
      for (int i = 0; i < 4; ++i) v[r][i] = *(const float4*)(src + (i * 64 + lane) * 4);
    }
#pragma unroll
    for (int r = 0; r < 2; ++r) {
#pragma unroll
      for (int i = 0; i < 4; ++i) ss[r] += v[r][i].x * v[r][i].x + v[r][i].y * v[r][i].y + v[r][i].z * v[r][i].z + v[r][i].w * v[r][i].w;
      ss[r] = wave_sum(ss[r]);
    }
#pragma unroll
    for (int r = 0; r < 2; ++r) {
      const int row = row0 + r * stride;
      if (row < M) {
        const int j = row < NL ? (row >> 13) : 8;
        const float* shift = modv + j * 3072;
        const float* scale = shift + 1024;
        const float rstd = rsqrtf(ss[r] * (1.f / 1024.f) + EPS);
#pragma unroll
        for (int i = 0; i < 4; ++i) {
          const int c = (i * 64 + lane) * 4;
          float4 w4 = *(const float4*)(nw + c), sc4 = *(const float4*)(scale + c), sh4 = *(const float4*)(shift + c);
          float o0 = v[r][i].x * rstd * w4.x * (1.f + sc4.x) + sh4.x;
          float o1 = v[r][i].y * rstd * w4.y * (1.f + sc4.y) + sh4.y;
          float o2 = v[r][i].z * rstd * w4.z * (1.f + sc4.z) + sh4.z;
          float o3 = v[r][i].w * rstd * w4.w * (1.f + sc4.w) + sh4.w;
          uint2 pk; pk.x = pack2(o0, o1); pk.y = pack2(o2, o3);
          *(uint2*)(h + (size_t)row * 1024 + c) = pk;
        }
      }
    }
  }
}

DI void gemm_main128(const bf16* __restrict__ A, int lda, const bf16* __restrict__ Bt, int ldb, int K,
                     f32x16 (&acc)[2][2], char* lds, const int tid) {
  bf16* As = (bf16*)lds;
  bf16* Bs = As + 128 * 72;
  const int lane = tid & 63, wave = tid >> 6, wm = wave >> 1, wn = wave & 1;
  const int l31 = lane & 31, lh = lane >> 5;
  const uint32_t aoff = (uint32_t)(((tid >> 3) * lda + (tid & 7) * 8) * 2);
  const uint32_t boff = (uint32_t)(((tid >> 3) * ldb + (tid & 7) * 8) * 2);
  const uint32_t soff = (uint32_t)(((tid >> 3) * 72 + (tid & 7) * 8) * 2);
  const char* Ab = (const char*)A;
  const char* Bb = (const char*)Bt;
  char* Asb = (char*)As;
  char* Bsb = (char*)Bs;
  const size_t astep = (size_t)32 * lda * 2, bstep = (size_t)32 * ldb * 2;
  uint4 ra0, ra1, ra2, ra3, rb0, rb1, rb2, rb3;
#define ALD(i, kb) (*(const uint4*)(Ab + ((size_t)(i) * astep + (kb)) + aoff))
#define BLD(i, kb) (*(const uint4*)(Bb + ((size_t)(i) * bstep + (kb)) + boff))
#define LDALL(kb)                                                          \
  ra0 = ALD(0, kb); ra1 = ALD(1, kb); ra2 = ALD(2, kb); ra3 = ALD(3, kb);  \
  rb0 = BLD(0, kb); rb1 = BLD(1, kb); rb2 = BLD(2, kb); rb3 = BLD(3, kb);
#define SST(base, i, val) (*(uint4*)((base) + (i) * (32 * 72 * 2) + soff) = (val))
  LDALL((size_t)0)
#pragma unroll 1
  for (int k0 = 0; k0 < K; k0 += 64) {
    SST(Asb, 0, ra0); SST(Asb, 1, ra1); SST(Asb, 2, ra2); SST(Asb, 3, ra3);
    SST(Bsb, 0, rb0); SST(Bsb, 1, rb1); SST(Bsb, 2, rb2); SST(Bsb, 3, rb3);
    __syncthreads();
    if (k0 + 64 < K) {
      const size_t kb = (size_t)(k0 + 64) * 2;
      LDALL(kb)
    }
    {
      const bf16* ap = As + (wm * 64 + l31) * 72 + lh * 8;
      const bf16* bp = Bs + (wn * 64 + l31) * 72 + lh * 8;
#define LDA_(tm, ks) (*(const bf16x8*)(ap + (tm) * 32 * 72 + (ks) * 16))
#define LDB_(tn, ks) (*(const bf16x8*)(bp + (tn) * 32 * 72 + (ks) * 16))
#define STEP(B0_, B1_, N0_, N1_, ks, more)                                              \
  if (more) { N0_ = LDB_(0, (ks) + 1); N1_ = LDB_(1, (ks) + 1); }                       \
  acc[0][0] = MFMA32(a0, B0_, acc[0][0]); acc[0][1] = MFMA32(a0, B1_, acc[0][1]);       \
  if (more) a0 = LDA_(0, (ks) + 1);                                                     \
  acc[1][0] = MFMA32(a1, B0_, acc[1][0]); acc[1][1] = MFMA32(a1, B1_, acc[1][1]);       \
  if (more) a1 = LDA_(1, (ks) + 1);                                                     \
  __builtin_amdgcn_sched_barrier(0);
      bf16x8 a0 = LDA_(0, 0), a1 = LDA_(1, 0);
      bf16x8 p0 = LDB_(0, 0), p1 = LDB_(1, 0), q0, q1;
      __builtin_amdgcn_sched_barrier(0);
      STEP(p0, p1, q0, q1, 0, true)
      STEP(q0, q1, p0, p1, 1, true)
      STEP(p0, p1, q0, q1, 2, true)
      STEP(q0, q1, p0, p1, 3, false)
#undef LDA_
#undef LDB_
#undef STEP
    }
    __syncthreads();
  }
#undef LDALL
#undef ALD
#undef BLD
#undef SST
}

template <int TM, int WN>
DI void zero_acc(f32x16 (&acc)[TM][WN]) {
#pragma unroll
  for (int a = 0; a < TM; ++a)
#pragma unroll
    for (int b = 0; b < WN; ++b)
#pragma unroll
      for (int i = 0; i < 16; ++i) acc[a][b][i] = 0.f;
}

DI void gemm_main256(const bf16* __restrict__ A, int lda, const bf16* __restrict__ Bt, int ldb, int K,
                     f32x16 (&acc)[4][2], char* lds, const int tid) {
  bf16* As = (bf16*)lds;
  bf16* Bs = As + 256 * 72;
  const int lane = tid & 63, wave = tid >> 6, wm = wave >> 1, wn = wave & 1;
  const int l31 = lane & 31, lh = lane >> 5;
  const uint32_t aoff = (uint32_t)(((tid >> 3) * lda + (tid & 7) * 8) * 2);
  const uint32_t boff = (uint32_t)(((tid >> 3) * ldb + (tid & 7) * 8) * 2);
  const uint32_t soff = (uint32_t)(((tid >> 3) * 72 + (tid & 7) * 8) * 2);
  const char* Ab = (const char*)A;
  const char* Bb = (const char*)Bt;
  char* Asb = (char*)As;
  char* Bsb = (char*)Bs;
  const size_t astep = (size_t)32 * lda * 2, bstep = (size_t)32 * ldb * 2;
  uint4 ra0, ra1, ra2, ra3, ra4, ra5, ra6, ra7, rb0, rb1, rb2, rb3;
#define ALD(i, kb) (*(const uint4*)(Ab + ((size_t)(i) * astep + (kb)) + aoff))
#define BLD(i, kb) (*(const uint4*)(Bb + ((size_t)(i) * bstep + (kb)) + boff))
#define LDALL(kb)                                                                      \
  ra0 = ALD(0, kb); ra1 = ALD(1, kb); ra2 = ALD(2, kb); ra3 = ALD(3, kb);              \
  ra4 = ALD(4, kb); ra5 = ALD(5, kb); ra6 = ALD(6, kb); ra7 = ALD(7, kb);              \
  rb0 = BLD(0, kb); rb1 = BLD(1, kb); rb2 = BLD(2, kb); rb3 = BLD(3, kb);
#define SST(base, i, val) (*(uint4*)((base) + (i) * (32 * 72 * 2) + soff) = (val))
  LDALL((size_t)0)
#pragma unroll 1
  for (int k0 = 0; k0 < K; k0 += 64) {
    SST(Asb, 0, ra0); SST(Asb, 1, ra1); SST(Asb, 2, ra2); SST(Asb, 3, ra3);
    SST(Asb, 4, ra4); SST(Asb, 5, ra5); SST(Asb, 6, ra6); SST(Asb, 7, ra7);
    SST(Bsb, 0, rb0); SST(Bsb, 1, rb1); SST(Bsb, 2, rb2); SST(Bsb, 3, rb3);
    __syncthreads();
    if (k0 + 64 < K) {
      const size_t kb = (size_t)(k0 + 64) * 2;
      LDALL(kb)
    }
    {
      const bf16* ap = As + (wm * 128 + l31) * 72 + lh * 8;
      const bf16* bp = Bs + (wn * 64 + l31) * 72 + lh * 8;
#define LDA_(tm, ks) (*(const bf16x8*)(ap + (tm) * 32 * 72 + (ks) * 16))
#define LDB_(tn, ks) (*(const bf16x8*)(bp + (tn) * 32 * 72 + (ks) * 16))
#define STEP(B0_, B1_, N0_, N1_, ks, more)                                              \
  if (more) { N0_ = LDB_(0, (ks) + 1); N1_ = LDB_(1, (ks) + 1); }                       \
  acc[0][0] = MFMA32(a0, B0_, acc[0][0]); acc[0][1] = MFMA32(a0, B1_, acc[0][1]);       \
  if (more) a0 = LDA_(0, (ks) + 1);                                                     \
  acc[1][0] = MFMA32(a1, B0_, acc[1][0]); acc[1][1] = MFMA32(a1, B1_, acc[1][1]);       \
  if (more) a1 = LDA_(1, (ks) + 1);                                                     \
  acc[2][0] = MFMA32(a2, B0_, acc[2][0]); acc[2][1] = MFMA32(a2, B1_, acc[2][1]);       \
  if (more) a2 = LDA_(2, (ks) + 1);                                                     \
  acc[3][0] = MFMA32(a3, B0_, acc[3][0]); acc[3][1] = MFMA32(a3, B1_, acc[3][1]);       \
  if (more) a3 = LDA_(3, (ks) + 1);                                                     \
  __builtin_amdgcn_sched_barrier(0);
      bf16x8 a0 = LDA_(0, 0), a1 = LDA_(1, 0), a2 = LDA_(2, 0), a3 = LDA_(3, 0);
      bf16x8 p0 = LDB_(0, 0), p1 = LDB_(1, 0), q0, q1;
      __builtin_amdgcn_sched_barrier(0);
      STEP(p0, p1, q0, q1, 0, true)
      STEP(q0, q1, p0, p1, 1, true)
      STEP(p0, p1, q0, q1, 2, true)
      STEP(q0, q1, p0, p1, 3, false)
#undef LDA_
#undef LDB_
#undef STEP
    }
    __syncthreads();
  }
#undef LDALL
#undef ALD
#undef BLD
#undef SST
}

DI bool xcd_tile(int it, int MT, int NTN, int PN, int& mt, int& nt) {
  const int x = blockIdx.x & 7, slot = blockIdx.x >> 3, nslots = gridDim.x >> 3;
  const int MTx = MT >> 3;
  const int lt = slot + it * nslots;
  if (lt >= MTx * NTN) return false;
  const int per_panel = MTx * PN;
  const int pn = lt / per_panel, r = lt - pn * per_panel;
  mt = x * MTx + r / PN;
  nt = pn * PN + r % PN;
  return true;
}

DI void phase_p1(const Params& p, const int wid, int layer, int M, char* lds) {
  const bf16* h = (const bf16*)(p.ws + OFF_H);
  const bf16* W1 = (const bf16*)(p.ws + OFF_W + (size_t)layer * LW);
  const float2* rope = (const float2*)(p.ws + OFF_ROPE);
  bf16* Qa = (bf16*)(p.ws + OFF_QA);
  bf16* Ka = (bf16*)(p.ws + OFF_KA);
  bf16* Vt = (bf16*)(p.ws + OFF_VT);
  bf16* xbc = (bf16*)(p.ws + OFF_XBC);
  bf16* gq = (bf16*)(p.ws + OFF_GQ);
  bf16* gk = (bf16*)(p.ws + OFF_GK);
  bf16* gv = (bf16*)(p.ws + OFF_GV);
  float* dtlr = (float*)(p.ws + OFF_DTLR);
  const int tidf = tid_fresh(p, wid); const int lane = tidf & 63, wave = tidf >> 6, wm = wave >> 1, wn = wave & 1, l31 = lane & 31, lh = lane >> 5;
  constexpr int NTN = N1 / 128;
  int mt_, nt_;
  for (int it = 0; xcd_tile(it, M / 256, NTN, 9, mt_, nt_); ++it) {
    const int m0 = mt_ * 256, n0 = nt_ * 128;
    f32x16 acc[4][2];
    zero_acc<4, 2>(acc);
    gemm_main256(h + (size_t)m0 * 1024, 1024, W1 + (size_t)n0 * 1024, 1024, 1024, acc, lds, tidf);
    const bool lat = m0 < NL;
#pragma unroll
    for (int tm = 0; tm < 4; ++tm)
#pragma unroll
      for (int tn = 0; tn < 2; ++tn) {
        const int col = n0 + wn * 64 + tn * 32 + l31;
        const int rowb = m0 + wm * 128 + tm * 32 + 4 * lh;
        if (n0 < 1024) {
          const int d = col & 63, axis = d >> 5, half = (d >> 4) & 1, f = d & 15;
          bf16* dst = n0 < 512 ? Qa : Ka;
#pragma unroll
          for (int i = 0; i < 16; ++i) {
            const int row = rowb + (i & 3) + 8 * (i >> 2);
            float v = acc[tm][tn][i];
            float partner = __shfl_xor(v, 16);
            if (lat) {
              const int t = row & 8191;
              const int pos = axis ? (t & 63) : (t >> 6);
              float2 cs = rope[pos * 16 + f];
              v = v * cs.x + (half ? partner : -partner) * cs.y;
            }
            if (n0 < 512) v *= QSCALE;
            dst[(size_t)row * 512 + (col & 511)] = f2b(v);
          }
        } else if (n0 < 1536) {
          const int hd = (col - 1024) >> 7, vv = (col - 1024) & 127;
#pragma unroll
          for (int g = 0; g < 4; ++g) {
            const int row0 = rowb + 8 * g;
            int b, key;
            if (lat) { b = row0 >> 13; key = 256 + (row0 & 8191); } else { b = (row0 - NL) >> 8; key = (row0 - NL) & 255; }
            uint2 pk;
            pk.x = pack2(acc[tm][tn][4 * g], acc[tm][tn][4 * g + 1]);
            pk.y = pack2(acc[tm][tn][4 * g + 2], acc[tm][tn][4 * g + 3]);
            *(uint2*)(Vt + ((size_t)((b * 4 + hd) * 128 + vv)) * KEYS + key) = pk;
          }
        } else if (n0 < 3328) {
          bf16* dst; int ld, cc;
          if (n0 < 2304) { dst = xbc; ld = 768; cc = col - 1536; }
          else if (n0 < 2560) { dst = gq; ld = 256; cc = col - 2304; }
          else if (n0 < 2816) { dst = gk; ld = 256; cc = col - 2560; }
          else { dst = gv; ld = 512; cc = col - 2816; }
#pragma unroll
          for (int i = 0; i < 16; ++i) {
            const int row = rowb + (i & 3) + 8 * (i >> 2);
            dst[(size_t)row * ld + cc] = f2b(acc[tm][tn][i]);
          }
        } else {
          const int cc = col - 3328;
          if (cc < 48) {
#pragma unroll
            for (int i = 0; i < 16; ++i) {
              const int row = rowb + (i & 3) + 8 * (i >> 2);
              dtlr[(size_t)row * 48 + cc] = acc[tm][tn][i];
            }
          }
        }
      }
  }
}

DI void phase_conv(const Params& p, const int wid, int layer) {
  const bf16* xin = (const bf16*)(p.ws + OFF_XBC);
  bf16* xo = (bf16*)(p.ws + OFF_XBC2);
  const float* cw = p.conv_w + layer * 3 * 768;
  const float* cb = p.conv_b + layer * 768;
  const int total = NT * 96;
  for (int idx = blockIdx.x * 256 + tid_fresh(p, wid); idx < total; idx += gridDim.x * 256) {
    const int row = idx / 96, c0 = (idx % 96) * 8;
    int t, L;
    if (row < NL) { t = row & 8191; L = 8192; } else { t = (row - NL) & 255; L = 256; }
    uint4 cur = *(const uint4*)(xin + (size_t)row * 768 + c0);
    uint4 prv = make_uint4(0, 0, 0, 0), nxt = make_uint4(0, 0, 0, 0);
    if (t > 0) prv = *(const uint4*)(xin + (size_t)(row - 1) * 768 + c0);
    if (t < L - 1) nxt = *(const uint4*)(xin + (size_t)(row + 1) * 768 + c0);
    const uint32_t cu[4] = {cur.x, cur.y, cur.z, cur.w}, pu[4] = {prv.x, prv.y, prv.z, prv.w}, nu[4] = {nxt.x, nxt.y, nxt.z, nxt.w};
    uint32_t ou[4];
#pragma unroll
    for (int q = 0; q < 4; ++q) {
      const int c = c0 + 2 * q;
      float a0 = cw[c] * blo(pu[q]) + cw[768 + c] * blo(cu[q]) + cw[1536 + c] * blo(nu[q]) + cb[c];
      float a1 = cw[c + 1] * bhi(pu[q]) + cw[768 + c + 1] * bhi(cu[q]) + cw[1536 + c + 1] * bhi(nu[q]) + cb[c + 1];
      ou[q] = pack2(siluf(a0), siluf(a1));
    }
    *(uint4*)(xo + (size_t)row * 768 + c0) = make_uint4(ou[0], ou[1], ou[2], ou[3]);
  }
}

DI int scan_row(int b, int dir, int s) {
  if (s < 256) { int t = dir ? 255 - s : s; return NL + b * 256 + t; }
  int t = s - 256;
  if (dir) t = 8191 - t;
  return b * 8192 + t;
}

template <bool GLA>
DI void scan_item(const Params& p, const int wid, int layer, int item, char* lds) {
  constexpr int CT = 16;
  constexpr int V = GLA ? 128 : 64;
  constexpr int NJ = V / 32;
  constexpr int BV = V / 16;
  float* a_s = (float*)lds;
  float* c_s = a_s + CT * 64;
  float* w_s = c_s + CT * 64;
  float* b_s = w_s + CT * 64;
  float* x_s = b_s + CT * V;
  float* op = x_s + (GLA ? 0 : CT * V);
  float* wg_s = op + CT * 4 * V;
  const int tid = tid_fresh(p, wid), lane = tid & 63, wave = tid >> 6;
  int head, dir, b;
  if (GLA) { head = item & 3; dir = (item >> 2) & 1; b = item >> 3; } else { head = item & 7; dir = (item >> 3) & 1; b = item >> 4; }
  const bf16* xbc = (const bf16*)(p.ws + OFF_XBC2);
  const bf16* gq = (const bf16*)(p.ws + OFF_GQ);
  const bf16* gk = (const bf16*)(p.ws + OFF_GK);
  const bf16* gv = (const bf16*)(p.ws + OFF_GV);
  const float* dtlr = (const float*)(p.ws + OFF_DTLR);
  bf16* yout = (bf16*)(p.ws + (GLA ? (dir ? OFF_YGB : OFF_YGF) : (dir ? OFF_YSB : OFF_YSF)));
  const int ocol = head * V;
  float Aneg = 0.f, Dsk = 0.f, dtb = 0.f;
  if (!GLA) {
    Aneg = -expf(p.a_log[layer * 16 + dir * 8 + head]);
    Dsk = p.ssm_d[layer * 16 + dir * 8 + head];
    dtb = p.dt_bias[layer * 16 + dir * 8 + head];
  } else {
    const float* wg = p.gla_w_gate + ((size_t)(layer * 2 + dir) * 16) * 256 + head * 64;
    for (int idx = tid; idx < 16 * 64; idx += 256) wg_s[idx] = wg[(idx >> 6) * 256 + (idx & 63)];
    if (tid < 64) wg_s[1024 + tid] = p.gla_b_gate[(layer * 2 + dir) * 256 + head * 64 + tid];
  }
  const int st = tid >> 4, sk4 = (tid & 15) * 4, sv = (tid & 15) * BV;
  const int vq = lane & 31, kg = wave * 2 + (lane >> 5);
  float S[8][NJ];
#pragma unroll
  for (int i = 0; i < 8; ++i)
#pragma unroll
    for (int j = 0; j < NJ; ++j) S[i][j] = 0.f;

  uint2 ra, rc; uint4 rbv; float rdt = 0.f; float4 rlr0, rlr1, rlr2, rlr3;
  rlr0 = rlr1 = rlr2 = rlr3 = make_float4(0.f, 0.f, 0.f, 0.f);
  rbv = make_uint4(0, 0, 0, 0);
#define SCAN_PREFETCH(chunk_)                                                                   \
  {                                                                                             \
    const int row_ = scan_row(b, dir, (chunk_) * CT + st);                                      \
    if (GLA) {                                                                                  \
      ra = *(const uint2*)(gk + (size_t)row_ * 256 + head * 64 + sk4);                          \
      rc = *(const uint2*)(gq + (size_t)row_ * 256 + head * 64 + sk4);                          \
      rbv = *(const uint4*)(gv + (size_t)row_ * 512 + head * 128 + sv);                         \
      const float* lr_ = dtlr + (size_t)row_ * 48 + 16 + dir * 16;                              \
      rlr0 = *(const float4*)(lr_); rlr1 = *(const float4*)(lr_ + 4);                           \
      rlr2 = *(const float4*)(lr_ + 8); rlr3 = *(const float4*)(lr_ + 12);                      \
    } else {                                                                                    \
      const int g_ = head >> 2;                                                                 \
      ra = *(const uint2*)(xbc + (size_t)row_ * 768 + 512 + g_ * 64 + sk4);                     \
      rc = *(const uint2*)(xbc + (size_t)row_ * 768 + 640 + g_ * 64 + sk4);                     \
      const uint2 t_ = *(const uint2*)(xbc + (size_t)row_ * 768 + head * 64 + sv);              \
      rbv.x = t_.x; rbv.y = t_.y;                                                               \
      rdt = dtlr[(size_t)row_ * 48 + dir * 8 + head];                                           \
    }                                                                                           \
  }
  SCAN_PREFETCH(0);
  constexpr int NCH = KEYS / CT;
  for (int chunk = 0; chunk < NCH; ++chunk) {
    {
      const float cscale = GLA ? 0.125f : 1.f;
      *(float4*)(a_s + st * 64 + sk4) = make_float4(blo(ra.x), bhi(ra.x), blo(ra.y), bhi(ra.y));
      *(float4*)(c_s + st * 64 + sk4) = make_float4(blo(rc.x) * cscale, bhi(rc.x) * cscale, blo(rc.y) * cscale, bhi(rc.y) * cscale);
      if (GLA) {
        *(float4*)(b_s + st * V + sv) = make_float4(blo(rbv.x), bhi(rbv.x), blo(rbv.y), bhi(rbv.y));
        *(float4*)(b_s + st * V + sv + 4) = make_float4(blo(rbv.z), bhi(rbv.z), blo(rbv.w), bhi(rbv.w));
        float4 zb = *(const float4*)(wg_s + 1024 + sk4);
        float z0 = zb.x, z1 = zb.y, z2 = zb.z, z3 = zb.w;
#define GROW(r_, lv_)                                                  \
  {                                                                    \
    const float4 w0_ = *(const float4*)(wg_s + (r_) * 64 + sk4);       \
    z0 = fmaf((lv_), w0_.x, z0); z1 = fmaf((lv_), w0_.y, z1); z2 = fmaf((lv_), w0_.z, z2); z3 = fmaf((lv_), w0_.w, z3); \
  }
        GROW(0, rlr0.x) GROW(1, rlr0.y) GROW(2, rlr0.z) GROW(3, rlr0.w)
        GROW(4, rlr1.x) GROW(5, rlr1.y) GROW(6, rlr1.z) GROW(7, rlr1.w)
        GROW(8, rlr2.x) GROW(9, rlr2.y) GROW(10, rlr2.z) GROW(11, rlr2.w)
        GROW(12, rlr3.x) GROW(13, rlr3.y) GROW(14, rlr3.z) GROW(15, rlr3.w)
#define LSIG16(zz) expf(((zz) >= 0.f ? -log1pf(expf(-(zz))) : (zz) - log1pf(expf(zz))) * (1.f / 16.f))
        *(float4*)(w_s + st * 64 + sk4) = make_float4(LSIG16(z0), LSIG16(z1), LSIG16(z2), LSIG16(z3));
      } else {
        float zz = rdt + dtb;
        float dt = zz > 20.f ? zz : log1pf(expf(zz));
        float4 xv = make_float4(blo(rbv.x), bhi(rbv.x), blo(rbv.y), bhi(rbv.y));
        *(float4*)(b_s + st * V + sv) = make_float4(xv.x * dt, xv.y * dt, xv.z * dt, xv.w * dt);
        *(float4*)(x_s + st * V + sv) = xv;
        if ((tid & 15) == 0) w_s[st] = expf(dt * Aneg);
      }
    }
    __syncthreads();
    if (chunk + 1 < NCH) SCAN_PREFETCH(chunk + 1);
#pragma unroll 4
    for (int tt = 0; tt < CT; ++tt) {
      const float4 a0 = *(const float4*)(a_s + tt * 64 + kg * 8), a1 = *(const float4*)(a_s + tt * 64 + kg * 8 + 4);
      const float4 c0 = *(const float4*)(c_s + tt * 64 + kg * 8), c1 = *(const float4*)(c_s + tt * 64 + kg * 8 + 4);
      const float av[8] = {a0.x, a0.y, a0.z, a0.w, a1.x, a1.y, a1.z, a1.w};
      const float cv[8] = {c0.x, c0.y, c0.z, c0.w, c1.x, c1.y, c1.z, c1.w};
      float wv[8];
      if (GLA) {
        const float4 w0 = *(const float4*)(w_s + tt * 64 + kg * 8), w1 = *(const float4*)(w_s + tt * 64 + kg * 8 + 4);
        wv[0] = w0.x; wv[1] = w0.y; wv[2] = w0.z; wv[3] = w0.w; wv[4] = w1.x; wv[5] = w1.y; wv[6] = w1.z; wv[7] = w1.w;
      } else {
        const float w = w_s[tt];
#pragma unroll
        for (int i = 0; i < 8; ++i) wv[i] = w;
      }
      float bv[NJ], o[NJ];
#pragma unroll
      for (int j = 0; j < NJ; ++j) { bv[j] = b_s[tt * V + vq + 32 * j]; o[j] = 0.f; }
#pragma unroll
      for (int i = 0; i < 8; ++i)
#pragma unroll
        for (int j = 0; j < NJ; ++j) {
          S[i][j] = fmaf(wv[i], S[i][j], av[i] * bv[j]);
          o[j] = fmaf(cv[i], S[i][j], o[j]);
        }
#pragma unroll
      for (int j = 0; j < NJ; ++j) {
        o[j] += __shfl_xor(o[j], 32);
        if (lane < 32) op[(tt * 4 + wave) * V + vq + 32 * j] = o[j];
      }
    }
    __syncthreads();
    {
      const int row = scan_row(b, dir, chunk * CT + st);
#pragma unroll
      for (int q = 0; q < BV / 4; ++q) {
        const int vc = sv + 4 * q;
        float4 o0 = *(const float4*)(op + (st * 4 + 0) * V + vc), o1 = *(const float4*)(op + (st * 4 + 1) * V + vc);
        float4 o2 = *(const float4*)(op + (st * 4 + 2) * V + vc), o3 = *(const float4*)(op + (st * 4 + 3) * V + vc);
        float r0 = o0.x + o1.x + o2.x + o3.x, r1 = o0.y + o1.y + o2.y + o3.y, r2 = o0.z + o1.z + o2.z + o3.z, r3 = o0.w + o1.w + o2.w + o3.w;
        if (!GLA) {
          float4 xv = *(const float4*)(x_s + st * V + vc);
          r0 = fmaf(Dsk, xv.x, r0); r1 = fmaf(Dsk, xv.y, r1); r2 = fmaf(Dsk, xv.z, r2); r3 = fmaf(Dsk, xv.w, r3);
        }
        uint2 pk; pk.x = pack2(r0, r1); pk.y = pack2(r2, r3);
        *(uint2*)(yout + (size_t)row * 512 + ocol + vc) = pk;
      }
    }
  }
  __syncthreads();
#undef SCAN_PREFETCH
#undef GROW
#undef LSIG16
}

DI bf16x8 pack8(const f32x16& x, int s) {
  uint32_t p0 = pack2(x[8 * s], x[8 * s + 1]), p1 = pack2(x[8 * s + 2], x[8 * s + 3]);
  uint32_t p2 = pack2(x[8 * s + 4], x[8 * s + 5]), p3 = pack2(x[8 * s + 6], x[8 * s + 7]);
  uint4 u = make_uint4(p0, p1, p2, p3);
  return __builtin_bit_cast(bf16x8, u);
}

template <bool GLA>
DI void cscan_item(const Params& p, const int wid, int layer, int item, char* lds) {
  constexpr int RS = 72;
  bf16* Qm = (bf16*)lds;
  bf16* Km = Qm + 64 * RS;
  bf16* KeT = Km + 64 * RS;
  bf16* bT = KeT + 64 * RS;
  bf16* ST = bT + 64 * RS;
  char* R = (char*)(ST + 64 * RS);
  float* Gf = (float*)R;
  bf16* Cm = (bf16*)R;
  float* Gs = (float*)(R + 64 * RS * 2);
  float* tot = (float*)(R + 16384);
  float* lr_s = tot + 256;
  const int tid = tid_fresh(p, wid), lane = tid & 63, wave = tid >> 6, l31 = lane & 31, lh = lane >> 5;
  const int nt = wave & 1, vh = wave >> 1;
  int head, dir, b, vhalf = 0;
  if (GLA) { vhalf = item & 1; head = (item >> 1) & 3; } else { head = item & 7; }
  dir = (item >> 3) & 1; b = item >> 4;
  const bf16* xbc = (const bf16*)(p.ws + OFF_XBC2);
  const bf16* gq = (const bf16*)(p.ws + OFF_GQ);
  const bf16* gk = (const bf16*)(p.ws + OFF_GK);
  const bf16* gv = (const bf16*)(p.ws + OFF_GV);
  const float* dtlr = (const float*)(p.ws + OFF_DTLR);
  bf16* yout = (bf16*)(p.ws + (GLA ? (dir ? OFF_YGB : OFF_YGF) : (dir ? OFF_YSB : OFF_YSF)));
  const int ocol = GLA ? head * 128 + vhalf * 64 : head * 64;
  float Aneg = 0.f, Dsk = 0.f, dtb = 0.f, bgk = 0.f;
  float wgk[16];
#pragma unroll
  for (int r = 0; r < 16; ++r) wgk[r] = 0.f;
  if (!GLA) {
    Aneg = -expf(p.a_log[layer * 16 + dir * 8 + head]);
    Dsk = p.ssm_d[layer * 16 + dir * 8 + head];
    dtb = p.dt_bias[layer * 16 + dir * 8 + head];
  } else {
    const float* wg = p.gla_w_gate + ((size_t)(layer * 2 + dir) * 16) * 256 + head * 64 + (tid & 63);
#pragma unroll
    for (int r = 0; r < 16; ++r) wgk[r] = wg[r * 256];
    bgk = p.gla_b_gate[(layer * 2 + dir) * 256 + head * 64 + (tid & 63)];
  }
  const int st = tid >> 2, k16 = (tid & 3) * 16;
  f32x16 Sacc;
#pragma unroll
  for (int i = 0; i < 16; ++i) Sacc[i] = 0.f;

  uint4 ra0, ra1, rc0, rc1, rb0, rb1; float4 rl;
#define CS_PREFETCH(chunk_)                                                                          \
  {                                                                                                  \
    const int row_ = scan_row(b, dir, (chunk_) * 64 + st);                                           \
    if (GLA) {                                                                                       \
      const uint4* ap_ = (const uint4*)(gk + (size_t)row_ * 256 + head * 64 + k16);                  \
      const uint4* cp_ = (const uint4*)(gq + (size_t)row_ * 256 + head * 64 + k16);                  \
      const uint4* bp_ = (const uint4*)(gv + (size_t)row_ * 512 + head * 128 + vhalf * 64 + k16);    \
      ra0 = ap_[0]; ra1 = ap_[1]; rc0 = cp_[0]; rc1 = cp_[1]; rb0 = bp_[0]; rb1 = bp_[1];            \
      rl = *(const float4*)(dtlr + (size_t)row_ * 48 + 16 + dir * 16 + (tid & 3) * 4);               \
    } else {                                                                                         \
      const int g_ = head >> 2;                                                                      \
      const uint4* ap_ = (const uint4*)(xbc + (size_t)row_ * 768 + 512 + g_ * 64 + k16);             \
      const uint4* cp_ = (const uint4*)(xbc + (size_t)row_ * 768 + 640 + g_ * 64 + k16);             \
      const uint4* bp_ = (const uint4*)(xbc + (size_t)row_ * 768 + head * 64 + k16);                 \
      ra0 = ap_[0]; ra1 = ap_[1]; rc0 = cp_[0]; rc1 = cp_[1]; rb0 = bp_[0]; rb1 = bp_[1];            \
      rl.x = dtlr[(size_t)row_ * 48 + dir * 8 + head]; rl.y = 0.f; rl.z = 0.f; rl.w = 0.f;           \
    }                                                                                                \
  }
  CS_PREFETCH(0);
#pragma unroll 1
  for (int chunk = 0; chunk < KEYS / 64; ++chunk) {
    float dt = 0.f;
    if (GLA) {
      *(float4*)(lr_s + st * 16 + (tid & 3) * 4) = rl;
      __syncthreads();
      float Gl[16];
      float run = 0.f;
#pragma unroll
      for (int i = 0; i < 16; ++i) {
        const float* lrp = lr_s + (wave * 16 + i) * 16;
        const float4 l0 = *(const float4*)(lrp), l1 = *(const float4*)(lrp + 4), l2 = *(const float4*)(lrp + 8), l3 = *(const float4*)(lrp + 12);
        float z = bgk;
        z = fmaf(l0.x, wgk[0], z); z = fmaf(l0.y, wgk[1], z); z = fmaf(l0.z, wgk[2], z); z = fmaf(l0.w, wgk[3], z);
        z = fmaf(l1.x, wgk[4], z); z = fmaf(l1.y, wgk[5], z); z = fmaf(l1.z, wgk[6], z); z = fmaf(l1.w, wgk[7], z);
        z = fmaf(l2.x, wgk[8], z); z = fmaf(l2.y, wgk[9], z); z = fmaf(l2.z, wgk[10], z); z = fmaf(l2.w, wgk[11], z);
        z = fmaf(l3.x, wgk[12], z); z = fmaf(l3.y, wgk[13], z); z = fmaf(l3.z, wgk[14], z); z = fmaf(l3.w, wgk[15], z);
        run -= (fmaxf(-z, 0.f) + __logf(1.f + __expf(-fabsf(z)))) * (1.f / 16.f);
        Gl[i] = run;
      }
      tot[wave * 64 + lane] = run;
      __syncthreads();
      float off = 0.f;
      if (wave > 0) off += tot[lane];
      if (wave > 1) off += tot[64 + lane];
      if (wave > 2) off += tot[128 + lane];
#pragma unroll
      for (int i = 0; i < 16; ++i) Gf[(wave * 16 + i) * 64 + lane] = Gl[i] + off;
    } else {
      const float zz = rl.x + dtb;
      dt = zz > 20.f ? zz : log1pf(expf(zz));
      if ((tid & 3) == 0) lr_s[st] = dt;
      __syncthreads();
      if (wave == 0) {
        float g = lr_s[lane] * Aneg;
#pragma unroll
        for (int o = 1; o < 64; o <<= 1) {
          const float v = __shfl_up(g, o);
          if (lane >= o) g += v;
        }
        Gs[lane] = g;
      }
    }
#pragma unroll
    for (int i = 0; i < 16; ++i)
      ST[(32 * (wave >> 1) + (i & 3) + 8 * (i >> 2) + 4 * lh) * RS + 32 * (wave & 1) + l31] = f2b(Sacc[i]);
    __syncthreads();
    {
      const uint32_t au[8] = {ra0.x, ra0.y, ra0.z, ra0.w, ra1.x, ra1.y, ra1.z, ra1.w};
      const uint32_t cu[8] = {rc0.x, rc0.y, rc0.z, rc0.w, rc1.x, rc1.y, rc1.z, rc1.w};
      const uint32_t bu[8] = {rb0.x, rb0.y, rb0.z, rb0.w, rb1.x, rb1.y, rb1.z, rb1.w};
      uint32_t qo[8], ko[8];
      if (GLA) {
#pragma unroll
        for (int q = 0; q < 4; ++q) {
          const float4 G4 = *(const float4*)(Gf + st * 64 + k16 + 4 * q);
          const float4 L4 = *(const float4*)(Gf + 63 * 64 + k16 + 4 * q);
          const float gg[4] = {G4.x, G4.y, G4.z, G4.w}, ll[4] = {L4.x, L4.y, L4.z, L4.w};
#pragma unroll
          for (int h2 = 0; h2 < 2; ++h2) {
            const int w = 2 * q + h2;
            const float a0 = blo(au[w]), a1 = bhi(au[w]), c0 = blo(cu[w]), c1 = bhi(cu[w]);
            const float g0 = gg[2 * h2], g1 = gg[2 * h2 + 1];
            qo[w] = pack2(c0 * 0.125f * __expf(g0), c1 * 0.125f * __expf(g1));
            ko[w] = pack2(a0 * __expf(-g0), a1 * __expf(-g1));
            KeT[(k16 + 2 * w) * RS + st] = f2b(a0 * __expf(ll[2 * h2] - g0));
            KeT[(k16 + 2 * w + 1) * RS + st] = f2b(a1 * __expf(ll[2 * h2 + 1] - g1));
            bT[(k16 + 2 * w) * RS + st] = (bf16)(bu[w] & 0xffffu);
            bT[(k16 + 2 * w + 1) * RS + st] = (bf16)(bu[w] >> 16);
          }
        }
      } else {
        const float Gt = Gs[st], GL = Gs[63];
        const float e1 = __expf(Gt), e3 = __expf(GL - Gt);
#pragma unroll
        for (int w = 0; w < 8; ++w) {
          const float a0 = blo(au[w]), a1 = bhi(au[w]), c0 = blo(cu[w]), c1 = bhi(cu[w]);
          qo[w] = pack2(c0 * e1, c1 * e1);
          ko[w] = au[w];
          KeT[(k16 + 2 * w) * RS + st] = f2b(a0 * e3);
          KeT[(k16 + 2 * w + 1) * RS + st] = f2b(a1 * e3);
          bT[(k16 + 2 * w) * RS + st] = f2b(blo(bu[w]) * dt);
          bT[(k16 + 2 * w + 1) * RS + st] = f2b(bhi(bu[w]) * dt);
        }
        *(uint4*)(Cm + st * RS + k16) = rc0;
        *(uint4*)(Cm + st * RS + k16 + 8) = rc1;
      }
      *(uint4*)(Qm + st * RS + k16) = make_uint4(qo[0], qo[1], qo[2], qo[3]);
      *(uint4*)(Qm + st * RS + k16 + 8) = make_uint4(qo[4], qo[5], qo[6], qo[7]);
      *(uint4*)(Km + st * RS + k16) = make_uint4(ko[0], ko[1], ko[2], ko[3]);
      *(uint4*)(Km + st * RS + k16 + 8) = make_uint4(ko[4], ko[5], ko[6], ko[7]);
    }
    __syncthreads();
    if (chunk + 1 < KEYS / 64) CS_PREFETCH(chunk + 1);
    const int trow = scan_row(b, dir, chunk * 64 + 32 * nt + l31);
    uint2 xr0 = make_uint2(0, 0), xr1 = xr0, xr2 = xr0, xr3 = xr0;
    if (!GLA) {
      const bf16* xp = xbc + (size_t)trow * 768 + head * 64 + 32 * vh + 4 * lh;
      xr0 = *(const uint2*)(xp); xr1 = *(const uint2*)(xp + 8); xr2 = *(const uint2*)(xp + 16); xr3 = *(const uint2*)(xp + 24);
    }
    f32x16 outv;
#pragma unroll
    for (int i = 0; i < 16; ++i) outv[i] = 0.f;
    const bf16* Qp = GLA ? Qm : Cm;
#pragma unroll
    for (int ms = 0; ms < 2; ++ms) {
      if (ms <= nt) {
        f32x16 at;
#pragma unroll
        for (int i = 0; i < 16; ++i) at[i] = 0.f;
#pragma unroll
        for (int ks = 0; ks < 4; ++ks) {
          const bf16x8 kf = *(const bf16x8*)(Km + (32 * ms + l31) * RS + ks * 16 + lh * 8);
          const bf16x8 qf = *(const bf16x8*)(Qp + (32 * nt + l31) * RS + ks * 16 + lh * 8);
          at = MFMA32(kf, qf, at);
        }
        if (!GLA) {
          const float gt = Gs[32 * nt + l31];
#pragma unroll
          for (int g4 = 0; g4 < 4; ++g4) {
            const float4 gs4 = *(const float4*)(Gs + 32 * ms + 8 * g4 + 4 * lh);
            const float gsv[4] = {gs4.x, gs4.y, gs4.z, gs4.w};
#pragma unroll
            for (int j = 0; j < 4; ++j) {
              const int sl = 8 * g4 + 4 * lh + j;
              const bool keep = (ms < nt) || (sl <= l31);
              at[4 * g4 + j] = keep ? at[4 * g4 + j] * __expf(gt - gsv[j]) : 0.f;
            }
          }
        } else if (ms == nt) {
#pragma unroll
          for (int i = 0; i < 16; ++i) {
            const int sl = (i & 3) + 8 * (i >> 2) + 4 * lh;
            at[i] = (sl <= l31) ? at[i] : 0.f;
          }
        }
#pragma unroll
        for (int s2 = 0; s2 < 2; ++s2) {
          const bf16x8 pf = pack8(at, s2);
          const bf16* vp = bT + (32 * vh + l31) * RS + 32 * ms + 16 * s2 + 4 * lh;
          const uint2 lo = *(const uint2*)vp, hi = *(const uint2*)(vp + 8);
          const uint4 u = make_uint4(lo.x, lo.y, hi.x, hi.y);
          outv = MFMA32(__builtin_bit_cast(bf16x8, u), pf, outv);
        }
      }
    }
#pragma unroll
    for (int ks = 0; ks < 4; ++ks) {
      const bf16x8 sf = *(const bf16x8*)(ST + (32 * vh + l31) * RS + ks * 16 + lh * 8);
      const bf16x8 qf = *(const bf16x8*)(Qm + (32 * nt + l31) * RS + ks * 16 + lh * 8);
      outv = MFMA32(sf, qf, outv);
    }
    {
      const float dec = GLA ? __expf(Gf[63 * 64 + 32 * (wave & 1) + l31]) : __expf(Gs[63]);
#pragma unroll
      for (int i = 0; i < 16; ++i) Sacc[i] *= dec;
#pragma unroll
      for (int ks = 0; ks < 4; ++ks) {
        const bf16x8 bf_ = *(const bf16x8*)(bT + (32 * (wave >> 1) + l31) * RS + ks * 16 + lh * 8);
        const bf16x8 kf = *(const bf16x8*)(KeT + (32 * (wave & 1) + l31) * RS + ks * 16 + lh * 8);
        Sacc = MFMA32(bf_, kf, Sacc);
      }
    }
    {
      bf16* yp = yout + (size_t)trow * 512 + ocol + 32 * vh + 4 * lh;
      const uint2 xr[4] = {xr0, xr1, xr2, xr3};
#pragma unroll
      for (int g4 = 0; g4 < 4; ++g4) {
        float r0 = outv[4 * g4], r1 = outv[4 * g4 + 1], r2 = outv[4 * g4 + 2], r3 = outv[4 * g4 + 3];
        if (!GLA) {
          r0 = fmaf(Dsk, blo(xr[g4].x), r0); r1 = fmaf(Dsk, bhi(xr[g4].x), r1);
          r2 = fmaf(Dsk, blo(xr[g4].y), r2); r3 = fmaf(Dsk, bhi(xr[g4].y), r3);
        }
        uint2 pk; pk.x = pack2(r0, r1); pk.y = pack2(r2, r3);
        *(uint2*)(yp + 8 * g4) = pk;
      }
    }
    __syncthreads();
  }
#undef CS_PREFETCH
}


DI void attn_item(const Params& p, const int wid, int layer, int b, int head, int qrow0, int nkeys, char* lds) {
  bf16* Ks = (bf16*)lds;
  bf16* Vs = Ks + 64 * 136;
  bf16* Qa = (bf16*)(p.ws + OFF_QA);
  const bf16* Ka = (const bf16*)(p.ws + OFF_KA);
  const bf16* Vt = (const bf16*)(p.ws + OFF_VT) + (size_t)(b * 4 + head) * 128 * KEYS;
  const int tid = tid_fresh(p, wid), lane = tid & 63, wave = tid >> 6, l31 = lane & 31, lh = lane >> 5;

  bf16* Qs = Vs + 128 * 68;
#pragma unroll
  for (int i = 0; i < 8; ++i) {
    const int ch = tid + 256 * i;
    *(uint4*)(Qs + (ch >> 4) * 136 + (ch & 15) * 8) = *(const uint4*)(Qa + (size_t)(qrow0 + (ch >> 4)) * 512 + head * 128 + (ch & 15) * 8);
  }
  const bf16* qsw = Qs + (wave * 32 + l31) * 136 + lh * 8;
  f32x16 O[2][4];
#pragma unroll
  for (int c = 0; c < 2; ++c)
#pragma unroll
    for (int vt = 0; vt < 4; ++vt)
#pragma unroll
      for (int i = 0; i < 16; ++i) O[c][vt][i] = 0.f;
  float mrun[2] = {-1e30f, -1e30f}, lrun[2] = {0.f, 0.f};

  const int lkey = tid >> 2, lkq = (tid & 3) * 32, lvr = tid >> 1, lvh = (tid & 1) * 32;
#define KROW(key) ((key) < 256 ? NL + b * 256 + (key) : b * 8192 + (key) - 256)
#define KVLOAD(k0_)                                                                                  \
  {                                                                                                  \
    const uint4* kp_ = (const uint4*)(Ka + (size_t)KROW((k0_) + lkey) * 512 + head * 128 + lkq);      \
    rk0 = kp_[0]; rk1 = kp_[1]; rk2 = kp_[2]; rk3 = kp_[3];                                          \
    const uint4* vp_ = (const uint4*)(Vt + (size_t)lvr * KEYS + (k0_) + lvh);                        \
    rv0 = vp_[0]; rv1 = vp_[1]; rv2 = vp_[2]; rv3 = vp_[3];                                          \
  }
#define VST2(dst_, val) { (dst_)[0] = make_uint2((val).x, (val).y); (dst_)[1] = make_uint2((val).z, (val).w); }
  uint4 rk0, rk1, rk2, rk3, rv0, rv1, rv2, rv3;
  KVLOAD(0);
#pragma unroll 1
  for (int k0 = 0; k0 < nkeys; k0 += 64) {
    {
      uint4* kd = (uint4*)(Ks + lkey * 136 + lkq);
      kd[0] = rk0; kd[1] = rk1; kd[2] = rk2; kd[3] = rk3;
      uint2* vd = (uint2*)(Vs + lvr * 68 + lvh);
      VST2(vd, rv0); VST2(vd + 2, rv1); VST2(vd + 4, rv2); VST2(vd + 6, rv3);
    }
    __syncthreads();
    if (k0 + 64 < nkeys) KVLOAD(k0 + 64);
#pragma unroll
    for (int c = 0; c < 2; ++c) {
#pragma unroll
      for (int mt = 0; mt < 2; ++mt) {
        f32x16 sv;
#pragma unroll
        for (int i = 0; i < 16; ++i) sv[i] = 0.f;
#pragma unroll
        for (int ks = 0; ks < 4; ++ks) {
          const bf16x8 qf = *(const bf16x8*)(qsw + c * 64 + ks * 16);
          const bf16x8 kf = *(const bf16x8*)(Ks + (mt * 32 + l31) * 136 + c * 64 + ks * 16 + lh * 8);
          sv = MFMA32(kf, qf, sv);
        }
        __builtin_amdgcn_sched_barrier(0);
        float mx = sv[0];
#pragma unroll
        for (int i = 1; i < 16; ++i) mx = fmaxf(mx, sv[i]);
        mx = fmaxf(mx, __shfl_xor(mx, 32));
        const float mnew = fmaxf(mrun[c], mx);
        if (__any(mnew > mrun[c])) {
          const float alpha = __builtin_amdgcn_exp2f(mrun[c] - mnew);
          mrun[c] = mnew;
          lrun[c] *= alpha;
#pragma unroll
          for (int vt = 0; vt < 4; ++vt)
#pragma unroll
            for (int i = 0; i < 16; ++i) O[c][vt][i] *= alpha;
        }
        float psum = 0.f;
#pragma unroll
        for (int i = 0; i < 16; ++i) {
          float pv = __builtin_amdgcn_exp2f(sv[i] - mrun[c]);
          sv[i] = pv;
          psum += pv;
        }
        lrun[c] += psum;
        __builtin_amdgcn_sched_barrier(0);
#pragma unroll
        for (int st = 0; st < 2; ++st) {
          const bf16x8 pf = pack8(sv, st);
#pragma unroll
          for (int vt = 0; vt < 4; ++vt) {
            const bf16* vp = Vs + (vt * 32 + l31) * 68 + mt * 32 + 16 * st + 4 * lh;
            uint2 lo = *(const uint2*)vp, hi = *(const uint2*)(vp + 8);
            uint4 u = make_uint4(lo.x, lo.y, hi.x, hi.y);
            O[c][vt] = MFMA32(__builtin_bit_cast(bf16x8, u), pf, O[c][vt]);
          }
          __builtin_amdgcn_sched_barrier(0);
        }
      }
    }
    __syncthreads();
  }
  const float lam = ((const float*)(p.ws + OFF_MISC))[layer];
  const float lam_init = layer == 0 ? 0.2f : 0.8f - 0.6f * 0.7408182206817179f;
  const float l1 = lrun[0] + __shfl_xor(lrun[0], 32);
  const float l2 = lrun[1] + __shfl_xor(lrun[1], 32);
  const float i1 = 1.f / l1, i2 = lam / l2;
  float ss = 0.f;
#pragma unroll
  for (int vt = 0; vt < 4; ++vt)
#pragma unroll
    for (int i = 0; i < 16; ++i) {
      float o = O[0][vt][i] * i1 - O[1][vt][i] * i2;
      O[0][vt][i] = o;
      ss += o * o;
    }
  ss += __shfl_xor(ss, 32);
  const float rstd = rsqrtf(ss * (1.f / 128.f) + EPS) * (1.f - lam_init);
  const float* nw = p.da_norm_w + layer * 128;
  bf16* orow = Qa + (size_t)(qrow0 + wave * 32 + l31) * 512 + head * 128;
#pragma unroll
  for (int vt = 0; vt < 4; ++vt)
#pragma unroll
    for (int g = 0; g < 4; ++g) {
      const int v0 = vt * 32 + 8 * g + 4 * lh;
      float4 w4 = *(const float4*)(nw + v0);
      uint2 pk;
      pk.x = pack2(O[0][vt][4 * g] * rstd * w4.x, O[0][vt][4 * g + 1] * rstd * w4.y);
      pk.y = pack2(O[0][vt][4 * g + 2] * rstd * w4.z, O[0][vt][4 * g + 3] * rstd * w4.w);
      *(uint2*)(orow + v0) = pk;
    }
}

DI void phase_mixers(const Params& p, const int wid, int layer, char* lds) {
  __shared__ int s_item;
  const int x = blockIdx.x & 7;
  unsigned* counter = (unsigned*)(p.ws + OFF_MISC + 64) + layer * 8 + x;
  const int total = layer == 0 ? 32 + 256 + 8 : 32 + 256;
  for (;;) {
    if (tid_fresh(p, wid) == 0) s_item = (int)atomicAdd(counter, 1u);
    __syncthreads();
    const int li = s_item;
    __syncthreads();
    if (li >= total) break;
    if (li < 32) {
      const int sid = li * 8 + x;
      if (sid < 128) cscan_item<true>(p, wid, layer, sid, lds);
      else cscan_item<false>(p, wid, layer, sid - 128, lds);
    } else if (li < 288) {
      const int a = li - 32;
      const int bh = x + 8 * (a >> 6), qb = a & 63;
      attn_item(p, wid, layer, bh >> 2, bh & 3, (bh >> 2) * 8192 + qb * 128, KEYS, lds);
    } else {
      const int c = x * 8 + (li - 288);
      const int bh = c >> 1, qb = c & 1;
      attn_item(p, wid, layer, bh >> 2, bh & 3, NL + (bh >> 2) * 256 + qb * 128, 256, lds);
    }
  }
}

DI void phase_z(const Params& p, const int wid, int layer, int M, char* lds) {
  const bf16* h = (const bf16*)(p.ws + OFF_H);
  const bf16* W2 = (const bf16*)(p.ws + OFF_W + (size_t)layer * LW + SZ_W1);
  bf16* Z = (bf16*)(p.ws + OFF_Z);
  const int tidf = tid_fresh(p, wid); const int lane = tidf & 63, wave = tidf >> 6, wm = wave >> 1, wn = wave & 1, l31 = lane & 31, lh = lane >> 5;
  constexpr int NTN = N2 / 128;
  int mt_, nt_;
  for (int it = 0; xcd_tile(it, M / 256, NTN, 12, mt_, nt_); ++it) {
    const int m0 = mt_ * 256, n0 = nt_ * 128;
    f32x16 acc[4][2];
    zero_acc<4, 2>(acc);
    gemm_main256(h + (size_t)m0 * 1024, 1024, W2 + (size_t)n0 * 1024, 1024, 1024, acc, lds, tidf);
#pragma unroll
    for (int tm = 0; tm < 4; ++tm)
#pragma unroll
      for (int tn = 0; tn < 2; ++tn) {
        const int col = n0 + wn * 64 + tn * 32 + l31;
        const int rowb = m0 + wm * 128 + tm * 32 + 4 * lh;
#pragma unroll
        for (int i = 0; i < 16; ++i) {
          const int row = rowb + (i & 3) + 8 * (i >> 2);
          Z[(size_t)row * 1536 + col] = f2b(acc[tm][tn][i]);
        }
      }
  }
}

DI void phase_post(const Params& p, const int wid, int layer, int M) {
  const int tidf = tid_fresh(p, wid); const int lane = tidf & 63, wave = tidf >> 6;
  bf16* Z = (bf16*)(p.ws + OFF_Z);
  const bf16* oda = (const bf16*)(p.ws + OFF_QA);
  const bf16* ysf = (const bf16*)(p.ws + OFF_YSF);
  const bf16* ysb = (const bf16*)(p.ws + OFF_YSB);
  const bf16* ygf = (const bf16*)(p.ws + OFF_YGF);
  const bf16* ygb = (const bf16*)(p.ws + OFF_YGB);
  const float* snw = p.ssm_norm_w + layer * 512;
  const float* gnw = p.gla_norm_w + layer * 128;
  const int c0 = lane * 8;
  for (int row = blockIdx.x * 4 + wave; row < M; row += gridDim.x * 4) {
    bf16* zr = Z + (size_t)row * 1536;
    {
      uint4 o = *(const uint4*)(oda + (size_t)row * 512 + c0);
      uint4 z = *(const uint4*)(zr + c0);
      const uint32_t ou[4] = {o.x, o.y, o.z, o.w}, zu[4] = {z.x, z.y, z.z, z.w};
      uint32_t r[4];
#pragma unroll
      for (int q = 0; q < 4; ++q) r[q] = pack2(blo(ou[q]) * siluf(blo(zu[q])), bhi(ou[q]) * siluf(bhi(zu[q])));
      *(uint4*)(zr + c0) = make_uint4(r[0], r[1], r[2], r[3]);
    }
    {
      uint4 yf = *(const uint4*)(ysf + (size_t)row * 512 + c0), yb = *(const uint4*)(ysb + (size_t)row * 512 + c0);
      uint4 z = *(const uint4*)(zr + 512 + c0);
      const uint32_t fu[4] = {yf.x, yf.y, yf.z, yf.w}, bu[4] = {yb.x, yb.y, yb.z, yb.w}, zu[4] = {z.x, z.y, z.z, z.w};
      float y[8];
      float ss = 0.f;
#pragma unroll
      for (int q = 0; q < 4; ++q) {
        y[2 * q] = (blo(fu[q]) + blo(bu[q])) * siluf(blo(zu[q]));
        y[2 * q + 1] = (bhi(fu[q]) + bhi(bu[q])) * siluf(bhi(zu[q]));
        ss += y[2 * q] * y[2 * q] + y[2 * q + 1] * y[2 * q + 1];
      }
#pragma unroll
      for (int m = 16; m >= 1; m >>= 1) ss += __shfl_xor(ss, m);
      const float rstd = rsqrtf(ss * (1.f / 256.f) + EPS);
      float4 w0 = *(const float4*)(snw + c0), w1 = *(const float4*)(snw + c0 + 4);
      uint32_t r[4];
      r[0] = pack2(y[0] * rstd * w0.x, y[1] * rstd * w0.y); r[1] = pack2(y[2] * rstd * w0.z, y[3] * rstd * w0.w);
      r[2] = pack2(y[4] * rstd * w1.x, y[5] * rstd * w1.y); r[3] = pack2(y[6] * rstd * w1.z, y[7] * rstd * w1.w);
      *(uint4*)(zr + 512 + c0) = make_uint4(r[0], r[1], r[2], r[3]);
    }
    {
      uint4 yf = *(const uint4*)(ygf + (size_t)row * 512 + c0), yb = *(const uint4*)(ygb + (size_t)row * 512 + c0);
      uint4 z = *(const uint4*)(zr + 1024 + c0);
      const uint32_t fu[4] = {yf.x, yf.y, yf.z, yf.w}, bu[4] = {yb.x, yb.y, yb.z, yb.w}, zu[4] = {z.x, z.y, z.z, z.w};
      float y[8];
      float ss = 0.f;
#pragma unroll
      for (int q = 0; q < 4; ++q) {
        y[2 * q] = blo(fu[q]) + blo(bu[q]);
        y[2 * q + 1] = bhi(fu[q]) + bhi(bu[q]);
        ss += y[2 * q] * y[2 * q] + y[2 * q + 1] * y[2 * q + 1];
      }
#pragma unroll
      for (int m = 8; m >= 1; m >>= 1) ss += __shfl_xor(ss, m);
      const float rstd = rsqrtf(ss * (1.f / 128.f) + EPS);
      const int cw = c0 & 127;
      float4 w0 = *(const float4*)(gnw + cw), w1 = *(const float4*)(gnw + cw + 4);
      uint32_t r[4];
      r[0] = pack2(y[0] * rstd * w0.x * siluf(blo(zu[0])), y[1] * rstd * w0.y * siluf(bhi(zu[0])));
      r[1] = pack2(y[2] * rstd * w0.z * siluf(blo(zu[1])), y[3] * rstd * w0.w * siluf(bhi(zu[1])));
      r[2] = pack2(y[4] * rstd * w1.x * siluf(blo(zu[2])), y[5] * rstd * w1.y * siluf(bhi(zu[2])));
      r[3] = pack2(y[6] * rstd * w1.z * siluf(blo(zu[3])), y[7] * rstd * w1.w * siluf(bhi(zu[3])));
      *(uint4*)(zr + 1024 + c0) = make_uint4(r[0], r[1], r[2], r[3]);
    }
  }
}

DI void phase_merge(const Params& p, const int wid, int layer, int M, char* lds) {
  const bf16* h = (const bf16*)(p.ws + OFF_H);
  const bf16* osg = (const bf16*)(p.ws + OFF_Z);
  const char* wb = p.ws + OFF_W + (size_t)layer * LW;
  const bf16* W3 = (const bf16*)(wb + SZ_W1 + SZ_W2);
  const bf16* Wout = (const bf16*)(wb + SZ_W1 + SZ_W2 + SZ_W3);
  bf16* U = (bf16*)(p.ws + OFF_U);
  const int tidf = tid_fresh(p, wid); const int lane = tidf & 63, wave = tidf >> 6, wm = wave >> 1, wn = wave & 1, l31 = lane & 31, lh = lane >> 5;
  constexpr int NTN = 1024 / 128;
  int mt_, nt_;
  for (int it = 0; xcd_tile(it, M / 128, NTN, 8, mt_, nt_); ++it) {
    const int m0 = mt_ * 128, n0 = nt_ * 128;
    f32x16 u[2][2];
    zero_acc<2, 2>(u);
#pragma unroll 1
    for (int br = 0; br < 3; ++br) {
      uint32_t* sgl = (uint32_t*)(lds + 36864) + tidf;
      {
        f32x16 g[2][2];
        zero_acc<2, 2>(g);
        gemm_main128(h + (size_t)m0 * 1024, 1024, W3 + (size_t)(br * 1024 + n0) * 1024, 1024, 1024, g, lds, tidf);
#pragma unroll
        for (int tm = 0; tm < 2; ++tm)
#pragma unroll
          for (int tn = 0; tn < 2; ++tn)
#pragma unroll
            for (int q = 0; q < 8; ++q) sgl[((tm * 2 + tn) * 8 + q) * 256] = pack2(sigmf(g[tm][tn][2 * q]), sigmf(g[tm][tn][2 * q + 1]));
      }
      f32x16 t[2][2];
      zero_acc<2, 2>(t);
      gemm_main128(osg + (size_t)m0 * 1536 + br * 512, 1536, Wout + (size_t)br * 1024 * 512 + (size_t)n0 * 512, 512, 512, t, lds, tidf);
#pragma unroll
      for (int tm = 0; tm < 2; ++tm)
#pragma unroll
        for (int tn = 0; tn < 2; ++tn)
#pragma unroll
          for (int q = 0; q < 8; ++q) {
            const uint32_t sgv = sgl[((tm * 2 + tn) * 8 + q) * 256];
            u[tm][tn][2 * q] = fmaf(blo(sgv), t[tm][tn][2 * q], u[tm][tn][2 * q]);
            u[tm][tn][2 * q + 1] = fmaf(bhi(sgv), t[tm][tn][2 * q + 1], u[tm][tn][2 * q + 1]);
          }
    }
#pragma unroll
    for (int tm = 0; tm < 2; ++tm)
#pragma unroll
      for (int tn = 0; tn < 2; ++tn) {
        const int col = n0 + wn * 64 + tn * 32 + l31;
        const int rowb = m0 + wm * 64 + tm * 32 + 4 * lh;
#pragma unroll
        for (int i = 0; i < 16; ++i) {
          const int row = rowb + (i & 3) + 8 * (i >> 2);
          U[(size_t)row * 1024 + col] = f2b(u[tm][tn][i]);
        }
      }
  }
}

DI void phase_out(const Params& p, const int wid, int layer, int M, const float* xl, const float* xc, float* ol, float* oc, char* lds) {
  const bf16* U = (const bf16*)(p.ws + OFF_U);
  const bf16* Wo = (const bf16*)(p.ws + OFF_W + (size_t)layer * LW + SZ_W1 + SZ_W2 + SZ_W3 + 3 * SZ_WOUT);
  const float* modv = (const float*)(p.ws + OFF_MOD) + (size_t)layer * 9 * 3072;
  const int tidf = tid_fresh(p, wid); const int lane = tidf & 63, wave = tidf >> 6, wm = wave >> 1, wn = wave & 1, l31 = lane & 31, lh = lane >> 5;
  constexpr int NTN = 1024 / 128;
  int mt_, nt_;
  for (int it = 0; xcd_tile(it, M / 256, NTN, 8, mt_, nt_); ++it) {
    const int m0 = mt_ * 256, n0 = nt_ * 128;
    f32x16 acc[4][2];
    zero_acc<4, 2>(acc);
    gemm_main256(U + (size_t)m0 * 1024, 1024, Wo + (size_t)n0 * 1024, 1024, 1024, acc, lds, tidf);
    const bool lat = m0 < NL;
    const int j = lat ? (m0 >> 13) : 8;
    const float* gate = modv + j * 3072 + 2048;
    const float* src = lat ? xl + (size_t)m0 * 1024 : xc + (size_t)(m0 - NL) * 1024;
    float* dst = lat ? ol + (size_t)m0 * 1024 : oc + (size_t)(m0 - NL) * 1024;
    uint32_t eoff = (uint32_t)((wm * 128 + 4 * lh) * 1024 + n0 + wn * 64 + l31);
    asm volatile("" : "+v"(eoff));
    const float* sp = src + eoff;
    float* dp = dst + eoff;
    const float* gp = gate + n0 + wn * 64 + l31;
#pragma unroll
    for (int tm = 0; tm < 4; ++tm)
#pragma unroll
      for (int tn = 0; tn < 2; ++tn) {
        const float gt = gp[tn * 32];
#pragma unroll
        for (int i = 0; i < 16; ++i) {
          const int off = (tm * 32 + (i & 3) + 8 * (i >> 2)) * 1024 + tn * 32;
          dp[off] = sp[off] + gt * acc[tm][tn][i];
        }
        __builtin_amdgcn_sched_barrier(0);
      }
  }
}

DI void phase_final(const Params& p, const int wid) {
  const int tidf = tid_fresh(p, wid); const int lane = tidf & 63, wave = tidf >> 6;
  const int stride = gridDim.x * 4;
  for (int row0 = blockIdx.x * 4 + wave; row0 < NL; row0 += 2 * stride) {
    float4 v[2][4];
    float ss[2] = {0.f, 0.f};
#pragma unroll
    for (int r = 0; r < 2; ++r) {
      int row = row0 + r * stride;
      if (row >= NL) row = row0;
      const float* src = p.out + (size_t)row * 1024;
#pragma unroll
      for (int i = 0; i < 4; ++i) v[r][i] = *(const float4*)(src + (i * 64 + lane) * 4);
    }
#pragma unroll
    for (int r = 0; r < 2; ++r) {
#pragma unroll
      for (int i = 0; i < 4; ++i) ss[r] += v[r][i].x * v[r][i].x + v[r][i].y * v[r][i].y + v[r][i].z * v[r][i].z + v[r][i].w * v[r][i].w;
      ss[r] = wave_sum(ss[r]);
    }
#pragma unroll
    for (int r = 0; r < 2; ++r) {
      const int row = row0 + r * stride;
      if (row < NL) {
        float* dst = p.out + (size_t)row * 1024;
        const float rstd = rsqrtf(ss[r] * (1.f / 1024.f) + EPS);
#pragma unroll
        for (int i = 0; i < 4; ++i) {
          const int c = (i * 64 + lane) * 4;
          float4 w4 = *(const float4*)(p.final_norm_w + c);
          *(float4*)(dst + c) = make_float4(v[r][i].x * rstd * w4.x, v[r][i].y * rstd * w4.y, v[r][i].z * rstd * w4.z, v[r][i].w * rstd * w4.w);
        }
      }
    }
  }
}

__global__ void __launch_bounds__(256, 2) hybrid_trunk_mega(Params p) {
  cg::grid_group grid = cg::this_grid();
  const int wid = __builtin_amdgcn_readfirstlane((int)(threadIdx.x >> 6));
  __shared__ __attribute__((aligned(16))) char lds[LDS_BYTES];
  phase0(p, wid, lds);
  grid.sync();
  float* ctx1 = (float*)(p.ws + OFF_CTX1);
#pragma unroll 1
  for (int layer = 0; layer < 2; ++layer) {
    const float* xl = layer == 0 ? p.x : p.out;
    const float* xc = layer == 0 ? p.ctx : ctx1;
    const int M = layer == 0 ? NT : NL;
    phase_h(p, wid, layer, xl, xc, NT);
    grid.sync();
    phase_p1(p, wid, layer, NT, lds);
    grid.sync();
#ifdef DUP_GEMM
    phase_p1(p, wid, layer, NT, lds);
    grid.sync();
#endif
    phase_conv(p, wid, layer);
    grid.sync();
#ifdef PROBE_SCAN
    for (int it = blockIdx.x; it < 192; it += gridDim.x) { if (it < 64) scan_item<true>(p, wid, layer, it, lds); else scan_item<false>(p, wid, layer, it - 64, lds); }
    grid.sync();
#endif
    phase_mixers(p, wid, layer, lds);
    grid.sync();
    phase_z(p, wid, layer, M, lds);
    grid.sync();
#ifdef DUP_GEMM
    phase_z(p, wid, layer, M, lds);
    grid.sync();
#endif
    phase_post(p, wid, layer, M);
    grid.sync();
    phase_merge(p, wid, layer, M, lds);
    grid.sync();
#ifdef DUP_GEMM
    phase_merge(p, wid, layer, M, lds);
    grid.sync();
#endif
    phase_out(p, wid, layer, M, xl, xc, p.out, ctx1, lds);
    grid.sync();
  }
  phase_final(p, wid);
}

extern "C" void kernel_launch(void* const* d_in, const int* in_sizes, int n_in, void* d_out, int out_size, void* d_ws,
                              size_t ws_size, hipStream_t stream) {
  (void)in_sizes; (void)n_in; (void)out_size;
  static int grid_blocks = 0;
  if (!grid_blocks) {
    int dev = 0, cus = 0, per_cu = 0;
    hipGetDevice(&dev);
    hipDeviceGetAttribute(&cus, hipDeviceAttributeMultiprocessorCount, dev);
    hipOccupancyMaxActiveBlocksPerMultiprocessor(&per_cu, hybrid_trunk_mega, 256, 0);
    (void)per_cu;
    grid_blocks = cus * 2;
  }
  if (ws_size < WS_TOTAL) { fprintf(stderr, "workspace too small: %zu < %zu\n", ws_size, (size_t)WS_TOTAL); return; }
  Params p{};
  const float** f = (const float**)&p;
  for (int i = 0; i < 24; ++i) f[i] = (const float*)d_in[i];
  p.wid = 0; p.pad_ = 0;
  p.out = (float*)d_out;
  p.ws = (char*)d_ws;
  void* args[] = {&p};
  hipError_t e = hipLaunchCooperativeKernel((const void*)hybrid_trunk_mega, dim3(grid_blocks), dim3(256), args, 0, stream);
  if (e != hipSuccess && (grid_blocks & 15) == 0) {
    (void)hipGetLastError();
    grid_blocks >>= 1;
    e = hipLaunchCooperativeKernel((const void*)hybrid_trunk_mega, dim3(grid_blocks), dim3(256), args, 0, stream);
  }
  if (e != hipSuccess) fprintf(stderr, "cooperative launch failed: %s (grid %d)\n", hipGetErrorString(e), grid_blocks);
}
```

```cpp
#include <hip/hip_runtime.h>
#include <hip/hip_cooperative_groups.h>
#include <stdint.h>
#include <stdio.h>
namespace cg = cooperative_groups;

typedef unsigned short bf16;
using bf16x8 = __attribute__((ext_vector_type(8))) short;
using f32x16 = __attribute__((ext_vector_type(16))) float;
using u32x8 = __attribute__((ext_vector_type(8))) unsigned int;
#define DI __device__ __forceinline__
#define MFMA32(a, b, c) __builtin_amdgcn_mfma_f32_32x32x16_bf16((a), (b), (c), 0, 0, 0)

typedef __bf16 hbf16x2 __attribute__((ext_vector_type(2)));
typedef float f32x2 __attribute__((ext_vector_type(2)));
DI uint32_t pack2(float a, float b) { f32x2 v = {a, b}; return __builtin_bit_cast(uint32_t, __builtin_convertvector(v, hbf16x2)); }
DI bf16 f2b(float x) { return (bf16)(pack2(x, x) & 0xffffu); }
DI float blo(uint32_t u) { return __uint_as_float(u << 16); }
DI float bhi(uint32_t u) { return __uint_as_float(u & 0xffff0000u); }
DI float siluf(float x) { return x / (1.f + __expf(-x)); }
DI float sigmf(float x) { return 1.f / (1.f + __expf(-x)); }

constexpr int NB = 8, SEQ = 8192, CTX = 256, DM = 1024;
constexpr int NL = NB * SEQ;
constexpr int NC = NB * CTX;
constexpr int NT = NL + NC;
constexpr int KEYS = CTX + SEQ;
constexpr int INW = 7984;
constexpr int N1 = 3456, N2 = 1536, N3 = 3072;
constexpr float EPS = 1e-6f;
constexpr float QSCALE = 0.125f * 1.4426950408889634f;

constexpr size_t al256(size_t x) { return (x + 255) & ~(size_t)255; }
constexpr size_t SZ_W1 = (size_t)N1 * 1024 * 2, SZ_W2 = (size_t)N2 * 1024 * 2, SZ_W3 = (size_t)N3 * 1024 * 2;
constexpr size_t SZ_WOUT = (size_t)1024 * 512 * 2, SZ_WO = (size_t)1024 * 1024 * 2;
constexpr size_t LW = SZ_W1 + SZ_W2 + SZ_W3 + 3 * SZ_WOUT + SZ_WO;
constexpr size_t OFF_W = 0;
constexpr size_t OFF_MOD = OFF_W + 2 * LW;
constexpr size_t OFF_ROPE = OFF_MOD + al256((size_t)2 * 9 * 3072 * 4);
constexpr size_t OFF_MISC = OFF_ROPE + (size_t)128 * 16 * 2 * 4;
constexpr size_t OFF_H = OFF_MISC + 256;
constexpr size_t OFF_QA = OFF_H + (size_t)NT * 1024 * 2;
constexpr size_t OFF_KA = OFF_QA + (size_t)NT * 512 * 2;
constexpr size_t OFF_VT = OFF_KA + (size_t)NT * 512 * 2;
constexpr size_t OFF_XBC = OFF_VT + (size_t)NT * 512 * 2;
constexpr size_t OFF_XBC2 = OFF_XBC + (size_t)NT * 768 * 2;
constexpr size_t OFF_GQ = OFF_XBC2 + (size_t)NT * 768 * 2;
constexpr size_t OFF_GK = OFF_GQ + (size_t)NT * 256 * 2;
constexpr size_t OFF_GV = OFF_GK + (size_t)NT * 256 * 2;
constexpr size_t OFF_DTLR = OFF_GV + (size_t)NT * 512 * 2;
constexpr size_t OFF_YSF = OFF_DTLR + (size_t)NT * 48 * 4;
constexpr size_t OFF_YSB = OFF_YSF + (size_t)NT * 512 * 2;
constexpr size_t OFF_YGF = OFF_YSB + (size_t)NT * 512 * 2;
constexpr size_t OFF_YGB = OFF_YGF + (size_t)NT * 512 * 2;
constexpr size_t OFF_CTX1 = OFF_YGB + (size_t)NT * 512 * 2;
constexpr size_t WS_TOTAL = OFF_CTX1 + (size_t)NC * 1024 * 4;
constexpr size_t OFF_Z = OFF_KA;
constexpr size_t OFF_U = OFF_GQ;
static_assert(WS_TOTAL <= ((size_t)1 << 30), "workspace too large");
static_assert((size_t)NT * 1536 * 2 <= OFF_XBC2 - OFF_KA, "Z overlay");
static_assert((size_t)NT * 1024 * 2 <= OFF_DTLR - OFF_GQ, "U overlay");

struct Params {
  const float *x, *c, *ctx, *c_ctx, *w_mod, *b_mod, *norm_w, *w_in, *da_lambda, *da_norm_w, *w_out_da;
  const float *conv_w, *conv_b, *dt_bias, *a_log, *ssm_d, *ssm_norm_w, *w_out_ssm;
  const float *gla_w_gate, *gla_b_gate, *gla_norm_w, *w_out_gla, *w_o, *final_norm_w;
  float* out;
  char* ws;
  int wid, pad_;
};
DI int tid_fresh(const Params& p, const int wid) {
  int t = wid * 64 + (int)__builtin_amdgcn_mbcnt_hi(~0u, __builtin_amdgcn_mbcnt_lo(~0u, 0u));
  asm volatile("" : "+v"(t));
  return t;
}

constexpr int LDS_BYTES = 70 * 1024;

DI int map_w1(int n) {
  if (n < 1536) return n;
  if (n < 2048) return 2048 + (n - 1536);
  if (n < 2304) return 3072 + (n - 2048);
  if (n < 3328) return 3344 + (n - 2304);
  if (n < 3344) return 3328 + (n - 3328);
  if (n < 3376) return 4880 + (n - 3344);
  return -1;
}
DI int map_w2(int n) {
  if (n < 512) return 1536 + n;
  if (n < 1024) return 2560 + (n - 512);
  return 4368 + (n - 1024);
}

DI void tr_tile(const Params& p, const int wid, const float* __restrict__ src, int ldsrc, bf16* __restrict__ dst, int K, int n0, int k0, int mapk, float* tile) {
  const int tid = tid_fresh(p, wid), tx = tid & 63, ty = tid >> 6;
  const int n = n0 + tx;
  int col = n;
  if (mapk == 1) col = map_w1(n); else if (mapk == 2) col = map_w2(n); else if (mapk == 3) col = 4912 + n;
#pragma unroll
  for (int i = 0; i < 16; ++i) {
    int kk = ty + 4 * i;
    tile[kk * 65 + tx] = (col >= 0) ? src[(size_t)(k0 + kk) * ldsrc + col] : 0.f;
  }
  __syncthreads();
#pragma unroll
  for (int i = 0; i < 16; ++i) {
    int nn = ty + 4 * i;
    dst[(size_t)(n0 + nn) * K + k0 + tx] = f2b(tile[tx * 65 + nn]);
  }
  __syncthreads();
}

constexpr int TR_PER_LAYER = 864 + 384 + 768 + 384 + 256;
constexpr int P0_ITEMS = 2 * TR_PER_LAYER + 96 + 1;

DI void phase0(const Params& p, const int wid, char* lds) {
  const int tid = tid_fresh(p, wid);
  float* fl = (float*)lds;
  for (int item = blockIdx.x; item < P0_ITEMS; item += gridDim.x) {
    if (item < 2 * TR_PER_LAYER) {
      const int layer = item / TR_PER_LAYER;
      int j = item % TR_PER_LAYER;
      char* wb = p.ws + OFF_W + (size_t)layer * LW;
      const float* win = p.w_in + (size_t)layer * 1024 * INW;
      if (j < 864) {
        tr_tile(p, wid, win, INW, (bf16*)wb, 1024, (j >> 4) * 64, (j & 15) * 64, 1, fl);
      } else if (j < 1248) {
        j -= 864;
        tr_tile(p, wid, win, INW, (bf16*)(wb + SZ_W1), 1024, (j >> 4) * 64, (j & 15) * 64, 2, fl);
      } else if (j < 2016) {
        j -= 1248;
        tr_tile(p, wid, win, INW, (bf16*)(wb + SZ_W1 + SZ_W2), 1024, (j >> 4) * 64, (j & 15) * 64, 3, fl);
      } else if (j < 2400) {
        j -= 2016;
        const int br = j >> 7, r = j & 127;
        const float* src = (br == 0 ? p.w_out_da : br == 1 ? p.w_out_ssm : p.w_out_gla) + (size_t)layer * 512 * 1024;
        tr_tile(p, wid, src, 1024, (bf16*)(wb + SZ_W1 + SZ_W2 + SZ_W3 + (size_t)br * SZ_WOUT), 512, (r >> 3) * 64, (r & 7) * 64, 0, fl);
      } else {
        j -= 2400;
        tr_tile(p, wid, p.w_o + (size_t)layer * 1024 * 1024, 1024, (bf16*)(wb + SZ_W1 + SZ_W2 + SZ_W3 + 3 * SZ_WOUT), 1024,
                (j >> 4) * 64, (j & 15) * 64, 0, fl);
      }
    } else if (item < 2 * TR_PER_LAYER + 96) {
      const int m = item - 2 * TR_PER_LAYER;
      const int layer = m / 48, nc = (m % 48) * 64;
      float* sc = fl;
      float* red = fl + 9 * 1024;
      for (int idx = tid; idx < 9 * 1024; idx += 256) {
        int j = idx >> 10, k = idx & 1023;
        float v = j < 8 ? p.c[j * 1024 + k] : p.c_ctx[k];
        sc[idx] = v / (1.f + expf(-v));
      }
      __syncthreads();
      const int tx = tid & 63, q = tid >> 6;
      float acc[9];
#pragma unroll
      for (int j = 0; j < 9; ++j) acc[j] = 0.f;
      const float* wm = p.w_mod + (size_t)layer * 1024 * 3072 + nc + tx;
#pragma unroll 4
      for (int k = q * 256; k < q * 256 + 256; ++k) {
        float wv = wm[(size_t)k * 3072];
#pragma unroll
        for (int j = 0; j < 9; ++j) acc[j] = fmaf(sc[j * 1024 + k], wv, acc[j]);
      }
#pragma unroll
      for (int j = 0; j < 9; ++j) red[(q * 9 + j) * 64 + tx] = acc[j];
      __syncthreads();
      float* modv = (float*)(p.ws + OFF_MOD);
      for (int idx = tid; idx < 9 * 64; idx += 256) {
        int j = idx >> 6, t = idx & 63;
        float s = red[(0 * 9 + j) * 64 + t] + red[(1 * 9 + j) * 64 + t] + red[(2 * 9 + j) * 64 + t] + red[(3 * 9 + j) * 64 + t];
        modv[(size_t)(layer * 9 + j) * 3072 + nc + t] = s + p.b_mod[layer * 3072 + nc + t];
      }
      __syncthreads();
    } else {
      float* rope = (float*)(p.ws + OFF_ROPE);
      for (int idx = tid; idx < 2048; idx += 256) {
        int pos = idx >> 4, f = idx & 15;
        float inv = (float)exp(-(double)f / 16.0 * 9.210340371976184);
        float angf = (float)pos * inv;
        double a = (double)angf;
        double r = a - 6.283185307179586477 * rint(a * 0.15915494309189533577);
        double r2 = r * r;
        double ts = r, ss = r, tc = 1.0, cs = 1.0;
#pragma unroll 1
        for (int n = 1; n <= 12; ++n) {
          tc *= -r2 / (double)((2 * n - 1) * (2 * n));
          cs += tc;
          ts *= -r2 / (double)((2 * n) * (2 * n + 1));
          ss += ts;
        }
        rope[idx * 2] = (float)cs;
        rope[idx * 2 + 1] = (float)ss;
      }
      float* misc = (float*)(p.ws + OFF_MISC);
      if (tid < 2) {
        const float* lm = p.da_lambda + tid * 4 * 64;
        float s1 = 0.f, s2 = 0.f;
        for (int i = 0; i < 64; ++i) { s1 += lm[i] * lm[64 + i]; s2 += lm[128 + i] * lm[192 + i]; }
        float lam_init = 0.8f - 0.6f * expf(-0.3f * (float)tid);
        misc[tid] = expf(s1) - expf(s2) + lam_init;
      }
      if (tid < 16) ((unsigned*)(p.ws + OFF_MISC + 64))[tid] = 0u;
    }
  }
}

DI float wave_sum(float v) {
#pragma unroll
  for (int m = 32; m >= 1; m >>= 1) v += __shfl_xor(v, m);
  return v;
}

DI void phase_h(const Params& p, const int wid, int layer, const float* xl, const float* xc, int M) {
  const int tidf = tid_fresh(p, wid); const int lane = tidf & 63, wave = tidf >> 6;
  bf16* h = (bf16*)(p.ws + OFF_H);
  const float* modv = (const float*)(p.ws + OFF_MOD) + (size_t)layer * 9 * 3072;
  const float* nw = p.norm_w + layer * 1024;
  const int stride = gridDim.x * 4;
  for (int row0 = blockIdx.x * 4 + wave; row0 < M; row0 += 2 * stride) {
    float4 v[2][4];
    float ss[2] = {0.f, 0.f};
#pragma unroll
    for (int r = 0; r < 2; ++r) {
      int row = row0 + r * stride;
      if (row >= M) row = row0;
      const float* src = row < NL ? xl + (size_t)row * 1024 : xc + (size_t)(row - NL) * 1024;
#pragma unroll
      for (int i = 0; i < 4; ++i) v[r][i] = *(const float4*)(src + (i * 64 + lane) * 4);
    }
#pragma unroll
    for (int r = 0; r < 2; ++r) {
#pragma unroll
      for (int i = 0; i < 4; ++i) ss[r] += v[r][i].x * v[r][i].x + v[r][i].y * v[r][i].y + v[r][i].z * v[r][i].z + v[r][i].w * v[r][i].w;
      ss[r] = wave_sum(ss[r]);
    }
#pragma unroll
    for (int r = 0; r < 2; ++r) {
      const int row = row0 + r * stride;
      if (row < M) {
        const int j = row < NL ? (row >> 13) : 8;
        const float* shift = modv + j * 3072;
        const float* scale = shift + 1024;
        const float rstd = rsqrtf(ss[r] * (1.f / 1024.f) + EPS);
#pragma unroll
        for (int i = 0; i < 4; ++i) {
          const int c = (i * 64 + lane) * 4;
          float4 w4 = *(const float4*)(nw + c), sc4 = *(const float4*)(scale + c), sh4 = *(const float4*)(shift + c);
          float o0 = v[r][i].x * rstd * w4.x * (1.f + sc4.x) + sh4.x;
          float o1 = v[r][i].y * rstd * w4.y * (1.f + sc4.y) + sh4.y;
          float o2 = v[r][i].z * rstd * w4.z * (1.f + sc4.z) + sh4.z;
          float o3 = v[r][i].w * rstd * w4.w * (1.f + sc4.w) + sh4.w;
          uint2 pk; pk.x = pack2(o0, o1); pk.y = pack2(o2, o3);
          *(uint2*)(h + (size_t)row * 1024 + c) = pk;
        }
      }
    }
  }
}

DI void gemm_main128(const bf16* __restrict__ A, int lda, const bf16* __restrict__ Bt, int ldb, int K,
                     f32x16 (&acc)[2][2], char* lds, const int tid) {
  bf16* As = (bf16*)lds;
  bf16* Bs = As + 128 * 72;
  const int lane = tid & 63, wave = tid >> 6, wm = wave >> 1, wn = wave & 1;
  const int l31 = lane & 31, lh = lane >> 5;
  const uint32_t aoff = (uint32_t)(((tid >> 3) * lda + (tid & 7) * 8) * 2);
  const uint32_t boff = (uint32_t)(((tid >> 3) * ldb + (tid & 7) * 8) * 2);
  const uint32_t soff = (uint32_t)(((tid >> 3) * 72 + (tid & 7) * 8) * 2);
  const char* Ab = (const char*)A;
  const char* Bb = (const char*)Bt;
  char* Asb = (char*)As;
  char* Bsb = (char*)Bs;
  const size_t astep = (size_t)32 * lda * 2, bstep = (size_t)32 * ldb * 2;
  uint4 ra0, ra1, ra2, ra3, rb0, rb1, rb2, rb3;
#define ALD(i, kb) (*(const uint4*)(Ab + ((size_t)(i) * astep + (kb)) + aoff))
#define BLD(i, kb) (*(const uint4*)(Bb + ((size_t)(i) * bstep + (kb)) + boff))
#define LDALL(kb)                                                          \
  ra0 = ALD(0, kb); ra1 = ALD(1, kb); ra2 = ALD(2, kb); ra3 = ALD(3, kb);  \
  rb0 = BLD(0, kb); rb1 = BLD(1, kb); rb2 = BLD(2, kb); rb3 = BLD(3, kb);
#define SST(base, i, val) (*(uint4*)((base) + (i) * (32 * 72 * 2) + soff) = (val))
  LDALL((size_t)0)
#pragma unroll 1
  for (int k0 = 0; k0 < K; k0 += 64) {
    SST(Asb, 0, ra0); SST(Asb, 1, ra1); SST(Asb, 2, ra2); SST(Asb, 3, ra3);
    SST(Bsb, 0, rb0); SST(Bsb, 1, rb1); SST(Bsb, 2, rb2); SST(Bsb, 3, rb3);
    __syncthreads();
    if (k0 + 64 < K) {
      const size_t kb = (size_t)(k0 + 64) * 2;
      LDALL(kb)
    }
    {
      const bf16* ap = As + (wm * 64 + l31) * 72 + lh * 8;
      const bf16* bp = Bs + (wn * 64 + l31) * 72 + lh * 8;
#define LDA_(tm, ks) (*(const bf16x8*)(ap + (tm) * 32 * 72 + (ks) * 16))
#define LDB_(tn, ks) (*(const bf16x8*)(bp + (tn) * 32 * 72 + (ks) * 16))
#define STEP(B0_, B1_, N0_, N1_, ks, more)                                              \
  if (more) { N0_ = LDB_(0, (ks) + 1); N1_ = LDB_(1, (ks) + 1); }                       \
  acc[0][0] = MFMA32(a0, B0_, acc[0][0]); acc[0][1] = MFMA32(a0, B1_, acc[0][1]);       \
  if (more) a0 = LDA_(0, (ks) + 1);                                                     \
  acc[1][0] = MFMA32(a1, B0_, acc[1][0]); acc[1][1] = MFMA32(a1, B1_, acc[1][1]);       \
  if (more) a1 = LDA_(1, (ks) + 1);                                                     \
  __builtin_amdgcn_sched_barrier(0);
      bf16x8 a0 = LDA_(0, 0), a1 = LDA_(1, 0);
      bf16x8 p0 = LDB_(0, 0), p1 = LDB_(1, 0), q0, q1;
      __builtin_amdgcn_sched_barrier(0);
      STEP(p0, p1, q0, q1, 0, true)
      STEP(q0, q1, p0, p1, 1, true)
      STEP(p0, p1, q0, q1, 2, true)
      STEP(q0, q1, p0, p1, 3, false)
#undef LDA_
#undef LDB_
#undef STEP
    }
    __syncthreads();
  }
#undef LDALL
#undef ALD
#undef BLD
#undef SST
}

template <int TM, int WN>
DI void zero_acc(f32x16 (&acc)[TM][WN]) {
#pragma unroll
  for (int a = 0; a < TM; ++a)
#pragma unroll
    for (int b = 0; b < WN; ++b)
#pragma unroll
      for (int i = 0; i < 16; ++i) acc[a][b][i] = 0.f;
}

DI void gemm_main256(const bf16* __restrict__ A, int lda, const bf16* __restrict__ Bt, int ldb, int K,
                     f32x16 (&acc)[4][2], char* lds, const int tid) {
  bf16* As = (bf16*)lds;
  bf16* Bs = As + 256 * 72;
  const int lane = tid & 63, wave = tid >> 6, wm = wave >> 1, wn = wave & 1;
  const int l31 = lane & 31, lh = lane >> 5;
  const uint32_t aoff = (uint32_t)(((tid >> 3) * lda + (tid & 7) * 8) * 2);
  const uint32_t boff = (uint32_t)(((tid >> 3) * ldb + (tid & 7) * 8) * 2);
  const uint32_t soff = (uint32_t)(((tid >> 3) * 72 + (tid & 7) * 8) * 2);
  const char* Ab = (const char*)A;
  const char* Bb = (const char*)Bt;
  char* Asb = (char*)As;
  char* Bsb = (char*)Bs;
  const size_t astep = (size_t)32 * lda * 2, bstep = (size_t)32 * ldb * 2;
  uint4 ra0, ra1, ra2, ra3, ra4, ra5, ra6, ra7, rb0, rb1, rb2, rb3;
#define ALD(i, kb) (*(const uint4*)(Ab + ((size_t)(i) * astep + (kb)) + aoff))
#define BLD(i, kb) (*(const uint4*)(Bb + ((size_t)(i) * bstep + (kb)) + boff))
#define LDALL(kb)                                                                      \
  ra0 = ALD(0, kb); ra1 = ALD(1, kb); ra2 = ALD(2, kb); ra3 = ALD(3, kb);              \
  ra4 = ALD(4, kb); ra5 = ALD(5, kb); ra6 = ALD(6, kb); ra7 = ALD(7, kb);              \
  rb0 = BLD(0, kb); rb1 = BLD(1, kb); rb2 = BLD(2, kb); rb3 = BLD(3, kb);
#define SST(base, i, val) (*(uint4*)((base) + (i) * (32 * 72 * 2) + soff) = (val))
  LDALL((size_t)0)
#pragma unroll 1
  for (int k0 = 0; k0 < K; k0 += 64) {
    SST(Asb, 0, ra0); SST(Asb, 1, ra1); SST(Asb, 2, ra2); SST(Asb, 3, ra3);
    SST(Asb, 4, ra4); SST(Asb, 5, ra5); SST(Asb, 6, ra6); SST(Asb, 7, ra7);
    SST(Bsb, 0, rb0); SST(Bsb, 1, rb1); SST(Bsb, 2, rb2); SST(Bsb, 3, rb3);
    __syncthreads();
    if (k0 + 64 < K) {
      const size_t kb = (size_t)(k0 + 64) * 2;
      LDALL(kb)
    }
    {
      const bf16* ap = As + (wm * 128 + l31) * 72 + lh * 8;
      const bf16* bp = Bs + (wn * 64 + l31) * 72 + lh * 8;
#define LDA_(tm, ks) (*(const bf16x8*)(ap + (tm) * 32 * 72 + (ks) * 16))
#define LDB_(tn, ks) (*(const bf16x8*)(bp + (tn) * 32 * 72 + (ks) * 16))
#define STEP(B0_, B1_, N0_, N1_, ks, more)                                              \
  if (more) { N0_ = LDB_(0, (ks) + 1); N1_ = LDB_(1, (ks) + 1); }                       \
  acc[0][0] = MFMA32(a0, B0_, acc[0][0]); acc[0][1] = MFMA32(a0, B1_, acc[0][1]);       \
  if (more) a0 = LDA_(0, (ks) + 1);                                                     \
  acc[1][0] = MFMA32(a1, B0_, acc[1][0]); acc[1][1] = MFMA32(a1, B1_, acc[1][1]);       \
  if (more) a1 = LDA_(1, (ks) + 1);                                                     \
  acc[2][0] = MFMA32(a2, B0_, acc[2][0]); acc[2][1] = MFMA32(a2, B1_, acc[2][1]);       \
  if (more) a2 = LDA_(2, (ks) + 1);                                                     \
  acc[3][0] = MFMA32(a3, B0_, acc[3][0]); acc[3][1] = MFMA32(a3, B1_, acc[3][1]);       \
  if (more) a3 = LDA_(3, (ks) + 1);                                                     \
  __builtin_amdgcn_sched_barrier(0);
      bf16x8 a0 = LDA_(0, 0), a1 = LDA_(1, 0), a2 = LDA_(2, 0), a3 = LDA_(3, 0);
      bf16x8 p0 = LDB_(0, 0), p1 = LDB_(1, 0), q0, q1;
      __builtin_amdgcn_sched_barrier(0);
      STEP(p0, p1, q0, q1, 0, true)
      STEP(q0, q1, p0, p1, 1, true)
      STEP(p0, p1, q0, q1, 2, true)
      STEP(q0, q1, p0, p1, 3, false)
#undef LDA_
#undef LDB_
#undef STEP
    }
    __syncthreads();
  }
#undef LDALL
#undef ALD
#undef BLD
#undef SST
}

DI bool xcd_tile(int it, int MT, int NTN, int PN, int& mt, int& nt) {
  const int x = blockIdx.x & 7, slot = blockIdx.x >> 3, nslots = gridDim.x >> 3;
  const int MTx = MT >> 3;
  const int lt = slot + it * nslots;
  if (lt >= MTx * NTN) return false;
  const int per_panel = MTx * PN;
  const int pn = lt / per_panel, r = lt - pn * per_panel;
  mt = x * MTx + r / PN;
  nt = pn * PN + r % PN;
  return true;
}

DI void phase_p1(const Params& p, const int wid, int layer, int M, char* lds) {
  const bf16* h = (const bf16*)(p.ws + OFF_H);
  const bf16* W1 = (const bf16*)(p.ws + OFF_W + (size_t)layer * LW);
  const float2* rope = (const float2*)(p.ws + OFF_ROPE);
  bf16* Qa = (bf16*)(p.ws + OFF_QA);
  bf16* Ka = (bf16*)(p.ws + OFF_KA);
  bf16* Vt = (bf16*)(p.ws + OFF_VT);
  bf16* xbc = (bf16*)(p.ws + OFF_XBC);
  bf16* gq = (bf16*)(p.ws + OFF_GQ);
  bf16* gk = (bf16*)(p.ws + OFF_GK);
  bf16* gv = (bf16*)(p.ws + OFF_GV);
  float* dtlr = (float*)(p.ws + OFF_DTLR);
  const int tidf = tid_fresh(p, wid); const int lane = tidf & 63, wave = tidf >> 6, wm = wave >> 1, wn = wave & 1, l31 = lane & 31, lh = lane >> 5;
  constexpr int NTN = N1 / 128;
  int mt_, nt_;
  for (int it = 0; xcd_tile(it, M / 256, NTN, 9, mt_, nt_); ++it) {
    const int m0 = mt_ * 256, n0 = nt_ * 128;
    f32x16 acc[4][2];
    zero_acc<4, 2>(acc);
    gemm_main256(h + (size_t)m0 * 1024, 1024, W1 + (size_t)n0 * 1024, 1024, 1024, acc, lds, tidf);
    const bool lat = m0 < NL;
#pragma unroll
    for (int tm = 0; tm < 4; ++tm)
#pragma unroll
      for (int tn = 0; tn < 2; ++tn) {
        const int col = n0 + wn * 64 + tn * 32 + l31;
        const int rowb = m0 + wm * 128 + tm * 32 + 4 * lh;
        if (n0 < 1024) {
          const int d = col & 63, axis = d >> 5, half = (d >> 4) & 1, f = d & 15;
          bf16* dst = n0 < 512 ? Qa : Ka;
#pragma unroll
          for (int i = 0; i < 16; ++i) {
            const int row = rowb + (i & 3) + 8 * (i >> 2);
            float v = acc[tm][tn][i];
            float partner = __shfl_xor(v, 16);
            if (lat) {
              const int t = row & 8191;
              const int pos = axis ? (t & 63) : (t >> 6);
              float2 cs = rope[pos * 16 + f];
              v = v * cs.x + (half ? partner : -partner) * cs.y;
            }
            if (n0 < 512) v *= QSCALE;
            dst[(size_t)row * 512 + (col & 511)] = f2b(v);
          }
        } else if (n0 < 1536) {
          const int hd = (col - 1024) >> 7, vv = (col - 1024) & 127;
#pragma unroll
          for (int g = 0; g < 4; ++g) {
            const int row0 = rowb + 8 * g;
            int b, key;
            if (lat) { b = row0 >> 13; key = 256 + (row0 & 8191); } else { b = (row0 - NL) >> 8; key = (row0 - NL) & 255; }
            uint2 pk;
            pk.x = pack2(acc[tm][tn][4 * g], acc[tm][tn][4 * g + 1]);
            pk.y = pack2(acc[tm][tn][4 * g + 2], acc[tm][tn][4 * g + 3]);
            *(uint2*)(Vt + ((size_t)((b * 4 + hd) * 128 + vv)) * KEYS + key) = pk;
          }
        } else if (n0 < 3328) {
          bf16* dst; int ld, cc;
          if (n0 < 2304) { dst = xbc; ld = 768; cc = col - 1536; }
          else if (n0 < 2560) { dst = gq; ld = 256; cc = col - 2304; }
          else if (n0 < 2816) { dst = gk; ld = 256; cc = col - 2560; }
          else { dst = gv; ld = 512; cc = col - 2816; }
#pragma unroll
          for (int i = 0; i < 16; ++i) {
            const int row = rowb + (i & 3) + 8 * (i >> 2);
            dst[(size_t)row * ld + cc] = f2b(acc[tm][tn][i]);
          }
        } else {
          const int cc = col - 3328;
          if (cc < 48) {
#pragma unroll
            for (int i = 0; i < 16; ++i) {
              const int row = rowb + (i & 3) + 8 * (i >> 2);
              dtlr[(size_t)row * 48 + cc] = acc[tm][tn][i];
            }
          }
        }
      }
  }
}

DI void phase_conv(const Params& p, const int wid, int layer) {
  const bf16* xin = (const bf16*)(p.ws + OFF_XBC);
  bf16* xo = (bf16*)(p.ws + OFF_XBC2);
  const float* cw = p.conv_w + layer * 3 * 768;
  const float* cb = p.conv_b + layer * 768;
  const int total = NT * 96;
  for (int idx = blockIdx.x * 256 + tid_fresh(p, wid); idx < total; idx += gridDim.x * 256) {
    const int row = idx / 96, c0 = (idx % 96) * 8;
    int t, L;
    if (row < NL) { t = row & 8191; L = 8192; } else { t = (row - NL) & 255; L = 256; }
    uint4 cur = *(const uint4*)(xin + (size_t)row * 768 + c0);
    uint4 prv = make_uint4(0, 0, 0, 0), nxt = make_uint4(0, 0, 0, 0);
    if (t > 0) prv = *(const uint4*)(xin + (size_t)(row - 1) * 768 + c0);
    if (t < L - 1) nxt = *(const uint4*)(xin + (size_t)(row + 1) * 768 + c0);
    const uint32_t cu[4] = {cur.x, cur.y, cur.z, cur.w}, pu[4] = {prv.x, prv.y, prv.z, prv.w}, nu[4] = {nxt.x, nxt.y, nxt.z, nxt.w};
    uint32_t ou[4];
#pragma unroll
    for (int q = 0; q < 4; ++q) {
      const int c = c0 + 2 * q;
      float a0 = cw[c] * blo(pu[q]) + cw[768 + c] * blo(cu[q]) + cw[1536 + c] * blo(nu[q]) + cb[c];
      float a1 = cw[c + 1] * bhi(pu[q]) + cw[768 + c + 1] * bhi(cu[q]) + cw[1536 + c + 1] * bhi(nu[q]) + cb[c + 1];
      ou[q] = pack2(siluf(a0), siluf(a1));
    }
    *(uint4*)(xo + (size_t)row * 768 + c0) = make_uint4(ou[0], ou[1], ou[2], ou[3]);
  }
}

DI int scan_row(int b, int dir, int s) {
  if (s < 256) { int t = dir ? 255 - s : s; return NL + b * 256 + t; }
  int t = s - 256;
  if (dir) t = 8191 - t;
  return b * 8192 + t;
}

template <bool GLA>
DI void scan_item(const Params& p, const int wid, int layer, int item, char* lds) {
  constexpr int CT = 16;
  constexpr int V = GLA ? 128 : 64;
  constexpr int NJ = V / 32;
  constexpr int BV = V / 16;
  float* a_s = (float*)lds;
  float* c_s = a_s + CT * 64;
  float* w_s = c_s + CT * 64;
  float* b_s = w_s + CT * 64;
  float* x_s = b_s + CT * V;
  float* op = x_s + (GLA ? 0 : CT * V);
  float* wg_s = op + CT * 4 * V;
  const int tid = tid_fresh(p, wid), lane = tid & 63, wave = tid >> 6;
  int head, dir, b;
  if (GLA) { head = item & 3; dir = (item >> 2) & 1; b = item >> 3; } else { head = item & 7; dir = (item >> 3) & 1; b = item >> 4; }
  const bf16* xbc = (const bf16*)(p.ws + OFF_XBC2);
  const bf16* gq = (const bf16*)(p.ws + OFF_GQ);
  const bf16* gk = (const bf16*)(p.ws + OFF_GK);
  const bf16* gv = (const bf16*)(p.ws + OFF_GV);
  const float* dtlr = (const float*)(p.ws + OFF_DTLR);
  bf16* yout = (bf16*)(p.ws + (GLA ? (dir ? OFF_YGB : OFF_YGF) : (dir ? OFF_YSB : OFF_YSF)));
  const int ocol = head * V;
  float Aneg = 0.f, Dsk = 0.f, dtb = 0.f;
  if (!GLA) {
    Aneg = -expf(p.a_log[layer * 16 + dir * 8 + head]);
    Dsk = p.ssm_d[layer * 16 + dir * 8 + head];
    dtb = p.dt_bias[layer * 16 + dir * 8 + head];
  } else {
    const float* wg = p.gla_w_gate + ((size_t)(layer * 2 + dir) * 16) * 256 + head * 64;
    for (int idx = tid; idx < 16 * 64; idx += 256) wg_s[idx] = wg[(idx >> 6) * 256 + (idx & 63)];
    if (tid < 64) wg_s[1024 + tid] = p.gla_b_gate[(layer * 2 + dir) * 256 + head * 64 + tid];
  }
  const int st = tid >> 4, sk4 = (tid & 15) * 4, sv = (tid & 15) * BV;
  const int vq = lane & 31, kg = wave * 2 + (lane >> 5);
  float S[8][NJ];
#pragma unroll
  for (int i = 0; i < 8; ++i)
#pragma unroll
    for (int j = 0; j < NJ; ++j) S[i][j] = 0.f;

  uint2 ra, rc; uint4 rbv; float rdt = 0.f; float4 rlr0, rlr1, rlr2, rlr3;
  rlr0 = rlr1 = rlr2 = rlr3 = make_float4(0.f, 0.f, 0.f, 0.f);
  rbv = make_uint4(0, 0, 0, 0);
#define SCAN_PREFETCH(chunk_)                                                                   \
  {                                                                                             \
    const int row_ = scan_row(b, dir, (chunk_) * CT + st);                                      \
    if (GLA) {                                                                                  \
      ra = *(const uint2*)(gk + (size_t)row_ * 256 + head * 64 + sk4);                          \
      rc = *(const uint2*)(gq + (size_t)row_ * 256 + head * 64 + sk4);                          \
      rbv = *(const uint4*)(gv + (size_t)row_ * 512 + head * 128 + sv);                         \
      const float* lr_ = dtlr + (size_t)row_ * 48 + 16 + dir * 16;                              \
      rlr0 = *(const float4*)(lr_); rlr1 = *(const float4*)(lr_ + 4);                           \
      rlr2 = *(const float4*)(lr_ + 8); rlr3 = *(const float4*)(lr_ + 12);                      \
    } else {                                                                                    \
      const int g_ = head >> 2;                                                                 \
      ra = *(const uint2*)(xbc + (size_t)row_ * 768 + 512 + g_ * 64 + sk4);                     \
      rc = *(const uint2*)(xbc + (size_t)row_ * 768 + 640 + g_ * 64 + sk4);                     \
      const uint2 t_ = *(const uint2*)(xbc + (size_t)row_ * 768 + head * 64 + sv);              \
      rbv.x = t_.x; rbv.y = t_.y;                                                               \
      rdt = dtlr[(size_t)row_ * 48 + dir * 8 + head];                                           \
    }                                                                                           \
  }
  SCAN_PREFETCH(0);
  constexpr int NCH = KEYS / CT;
  for (int chunk = 0; chunk < NCH; ++chunk) {
    {
      const float cscale = GLA ? 0.125f : 1.f;
      *(float4*)(a_s + st * 64 + sk4) = make_float4(blo(ra.x), bhi(ra.x), blo(ra.y), bhi(ra.y));
      *(float4*)(c_s + st * 64 + sk4) = make_float4(blo(rc.x) * cscale, bhi(rc.x) * cscale, blo(rc.y) * cscale, bhi(rc.y) * cscale);
      if (GLA) {
        *(float4*)(b_s + st * V + sv) = make_float4(blo(rbv.x), bhi(rbv.x), blo(rbv.y), bhi(rbv.y));
        *(float4*)(b_s + st * V + sv + 4) = make_float4(blo(rbv.z), bhi(rbv.z), blo(rbv.w), bhi(rbv.w));
        float4 zb = *(const float4*)(wg_s + 1024 + sk4);
        float z0 = zb.x, z1 = zb.y, z2 = zb.z, z3 = zb.w;
#define GROW(r_, lv_)                                                  \
  {                                                                    \
    const float4 w0_ = *(const float4*)(wg_s + (r_) * 64 + sk4);       \
    z0 = fmaf((lv_), w0_.x, z0); z1 = fmaf((lv_), w0_.y, z1); z2 = fmaf((lv_), w0_.z, z2); z3 = fmaf((lv_), w0_.w, z3); \
  }
        GROW(0, rlr0.x) GROW(1, rlr0.y) GROW(2, rlr0.z) GROW(3, rlr0.w)
        GROW(4, rlr1.x) GROW(5, rlr1.y) GROW(6, rlr1.z) GROW(7, rlr1.w)
        GROW(8, rlr2.x) GROW(9, rlr2.y) GROW(10, rlr2.z) GROW(11, rlr2.w)
        GROW(12, rlr3.x) GROW(13, rlr3.y) GROW(14, rlr3.z) GROW(15, rlr3.w)
#define LSIG16(zz) expf(((zz) >= 0.f ? -log1pf(expf(-(zz))) : (zz) - log1pf(expf(zz))) * (1.f / 16.f))
        *(float4*)(w_s + st * 64 + sk4) = make_float4(LSIG16(z0), LSIG16(z1), LSIG16(z2), LSIG16(z3));
      } else {
        float zz = rdt + dtb;
        float dt = zz > 20.f ? zz : log1pf(expf(zz));
        float4 xv = make_float4(blo(rbv.x), bhi(rbv.x), blo(rbv.y), bhi(rbv.y));
        *(float4*)(b_s + st * V + sv) = make_float4(xv.x * dt, xv.y * dt, xv.z * dt, xv.w * dt);
        *(float4*)(x_s + st * V + sv) = xv;
        if ((tid & 15) == 0) w_s[st] = expf(dt * Aneg);
      }
    }
    __syncthreads();
    if (chunk + 1 < NCH) SCAN_PREFETCH(chunk + 1);
#pragma unroll 4
    for (int tt = 0; tt < CT; ++tt) {
      const float4 a0 = *(const float4*)(a_s + tt * 64 + kg * 8), a1 = *(const float4*)(a_s + tt * 64 + kg * 8 + 4);
      const float4 c0 = *(const float4*)(c_s + tt * 64 + kg * 8), c1 = *(const float4*)(c_s + tt * 64 + kg * 8 + 4);
      const float av[8] = {a0.x, a0.y, a0.z, a0.w, a1.x, a1.y, a1.z, a1.w};
      const float cv[8] = {c0.x, c0.y, c0.z, c0.w, c1.x, c1.y, c1.z, c1.w};
      float wv[8];
      if (GLA) {
        const float4 w0 = *(const float4*)(w_s + tt * 64 + kg * 8), w1 = *(const float4*)(w_s + tt * 64 + kg * 8 + 4);
        wv[0] = w0.x; wv[1] = w0.y; wv[2] = w0.z; wv[3] = w0.w; wv[4] = w1.x; wv[5] = w1.y; wv[6] = w1.z; wv[7] = w1.w;
      } else {
        const float w = w_s[tt];
#pragma unroll
        for (int i = 0; i < 8; ++i) wv[i] = w;
      }
      float bv[NJ], o[NJ];
#pragma unroll
      for (int j = 0; j < NJ; ++j) { bv[j] = b_s[tt * V + vq + 32 * j]; o[j] = 0.f; }
#pragma unroll
      for (int i = 0; i < 8; ++i)
#pragma unroll
        for (int j = 0; j < NJ; ++j) {
          S[i][j] = fmaf(wv[i], S[i][j], av[i] * bv[j]);
          o[j] = fmaf(cv[i], S[i][j], o[j]);
        }
#pragma unroll
      for (int j = 0; j < NJ; ++j) {
        o[j] += __shfl_xor(o[j], 32);
        if (lane < 32) op[(tt * 4 + wave) * V + vq + 32 * j] = o[j];
      }
    }
    __syncthreads();
    {
      const int row = scan_row(b, dir, chunk * CT + st);
#pragma unroll
      for (int q = 0; q < BV / 4; ++q) {
        const int vc = sv + 4 * q;
        float4 o0 = *(const float4*)(op + (st * 4 + 0) * V + vc), o1 = *(const float4*)(op + (st * 4 + 1) * V + vc);
        float4 o2 = *(const float4*)(op + (st * 4 + 2) * V + vc), o3 = *(const float4*)(op + (st * 4 + 3) * V + vc);
        float r0 = o0.x + o1.x + o2.x + o3.x, r1 = o0.y + o1.y + o2.y + o3.y, r2 = o0.z + o1.z + o2.z + o3.z, r3 = o0.w + o1.w + o2.w + o3.w;
        if (!GLA) {
          float4 xv = *(const float4*)(x_s + st * V + vc);
          r0 = fmaf(Dsk, xv.x, r0); r1 = fmaf(Dsk, xv.y, r1); r2 = fmaf(Dsk, xv.z, r2); r3 = fmaf(Dsk, xv.w, r3);
        }
        uint2 pk; pk.x = pack2(r0, r1); pk.y = pack2(r2, r3);
        *(uint2*)(yout + (size_t)row * 512 + ocol + vc) = pk;
      }
    }
  }
  __syncthreads();
#undef SCAN_PREFETCH
#undef GROW
#undef LSIG16
}

DI bf16x8 pack8(const f32x16& x, int s) {
  uint32_t p0 = pack2(x[8 * s], x[8 * s + 1]), p1 = pack2(x[8 * s + 2], x[8 * s + 3]);
  uint32_t p2 = pack2(x[8 * s + 4], x[8 * s + 5]), p3 = pack2(x[8 * s + 6], x[8 * s + 7]);
  uint4 u = make_uint4(p0, p1, p2, p3);
  return __builtin_bit_cast(bf16x8, u);
}

template <bool GLA>
DI void cscan_item(const Params& p, const int wid, int layer, int item, char* lds) {
  constexpr int RS = 72;
  bf16* Qm = (bf16*)lds;
  bf16* Km = Qm + 64 * RS;
  bf16* KeT = Km + 64 * RS;
  bf16* bT = KeT + 64 * RS;
  bf16* ST = bT + 64 * RS;
  char* R = (char*)(ST + 64 * RS);
  float* Gf = (float*)R;
  bf16* Cm = (bf16*)R;
  float* Gs = (float*)(R + 64 * RS * 2);
  float* tot = (float*)(R + 16384);
  float* lr_s = tot + 256;
  const int tid = tid_fresh(p, wid), lane = tid & 63, wave = tid >> 6, l31 = lane & 31, lh = lane >> 5;
  const int nt = wave & 1, vh = wave >> 1;
  int head, dir, b, vhalf = 0;
  if (GLA) { vhalf = item & 1; head = (item >> 1) & 3; } else { head = item & 7; }
  dir = (item >> 3) & 1; b = item >> 4;
  const bf16* xbc = (const bf16*)(p.ws + OFF_XBC2);
  const bf16* gq = (const bf16*)(p.ws + OFF_GQ);
  const bf16* gk = (const bf16*)(p.ws + OFF_GK);
  const bf16* gv = (const bf16*)(p.ws + OFF_GV);
  const float* dtlr = (const float*)(p.ws + OFF_DTLR);
  bf16* yout = (bf16*)(p.ws + (GLA ? (dir ? OFF_YGB : OFF_YGF) : (dir ? OFF_YSB : OFF_YSF)));
  const int ocol = GLA ? head * 128 + vhalf * 64 : head * 64;
  float Aneg = 0.f, Dsk = 0.f, dtb = 0.f, bgk = 0.f;
  float wgk[16];
#pragma unroll
  for (int r = 0; r < 16; ++r) wgk[r] = 0.f;
  if (!GLA) {
    Aneg = -expf(p.a_log[layer * 16 + dir * 8 + head]);
    Dsk = p.ssm_d[layer * 16 + dir * 8 + head];
    dtb = p.dt_bias[layer * 16 + dir * 8 + head];
  } else {
    const float* wg = p.gla_w_gate + ((size_t)(layer * 2 + dir) * 16) * 256 + head * 64 + (tid & 63);
#pragma unroll
    for (int r = 0; r < 16; ++r) wgk[r] = wg[r * 256];
    bgk = p.gla_b_gate[(layer * 2 + dir) * 256 + head * 64 + (tid & 63)];
  }
  const int st = tid >> 2, k16 = (tid & 3) * 16;
  f32x16 Sacc;
#pragma unroll
  for (int i = 0; i < 16; ++i) Sacc[i] = 0.f;

  uint4 ra0, ra1, rc0, rc1, rb0, rb1; float4 rl;
#define CS_PREFETCH(chunk_)                                                                          \
  {                                                                                                  \
    const int row_ = scan_row(b, dir, (chunk_) * 64 + st);                                           \
    if (GLA) {                                                                                       \
      const uint4* ap_ = (const uint4*)(gk + (size_t)row_ * 256 + head * 64 + k16);                  \
      const uint4* cp_ = (const uint4*)(gq + (size_t)row_ * 256 + head * 64 + k16);                  \
      const uint4* bp_ = (const uint4*)(gv + (size_t)row_ * 512 + head * 128 + vhalf * 64 + k16);    \
      ra0 = ap_[0]; ra1 = ap_[1]; rc0 = cp_[0]; rc1 = cp_[1]; rb0 = bp_[0]; rb1 = bp_[1];            \
      rl = *(const float4*)(dtlr + (size_t)row_ * 48 + 16 + dir * 16 + (tid & 3) * 4);               \
    } else {                                                                                         \
      const int g_ = head >> 2;                                                                      \
      const uint4* ap_ = (const uint4*)(xbc + (size_t)row_ * 768 + 512 + g_ * 64 + k16);             \
      const uint4* cp_ = (const uint4*)(xbc + (size_t)row_ * 768 + 640 + g_ * 64 + k16);             \
      const uint4* bp_ = (const uint4*)(xbc + (size_t)row_ * 768 + head * 64 + k16);                 \
      ra0 = ap_[0]; ra1 = ap_[1]; rc0 = cp_[0]; rc1 = cp_[1]; rb0 = bp_[0]; rb1 = bp_[1];            \
      rl.x = dtlr[(size_t)row_ * 48 + dir * 8 + head]; rl.y = 0.f; rl.z = 0.f; rl.w = 0.f;           \
    }                                                                                                \
  }
  CS_PREFETCH(0);
#pragma unroll 1
  for (int chunk = 0; chunk < KEYS / 64; ++chunk) {
    float dt = 0.f;
    if (GLA) {
      *(float4*)(lr_s + st * 16 + (tid & 3) * 4) = rl;
      __syncthreads();
      float Gl[16];
      float run = 0.f;
#pragma unroll
      for (int i = 0; i < 16; ++i) {
        const float* lrp = lr_s + (wave * 16 + i) * 16;
        const float4 l0 = *(const float4*)(lrp), l1 = *(const float4*)(lrp + 4), l2 = *(const float4*)(lrp + 8), l3 = *(const float4*)(lrp + 12);
        float z = bgk;
        z = fmaf(l0.x, wgk[0], z); z = fmaf(l0.y, wgk[1], z); z = fmaf(l0.z, wgk[2], z); z = fmaf(l0.w, wgk[3], z);
        z = fmaf(l1.x, wgk[4], z); z = fmaf(l1.y, wgk[5], z); z = fmaf(l1.z, wgk[6], z); z = fmaf(l1.w, wgk[7], z);
        z = fmaf(l2.x, wgk[8], z); z = fmaf(l2.y, wgk[9], z); z = fmaf(l2.z, wgk[10], z); z = fmaf(l2.w, wgk[11], z);
        z = fmaf(l3.x, wgk[12], z); z = fmaf(l3.y, wgk[13], z); z = fmaf(l3.z, wgk[14], z); z = fmaf(l3.w, wgk[15], z);
        run -= (fmaxf(-z, 0.f) + __logf(1.f + __expf(-fabsf(z)))) * (1.f / 16.f);
        Gl[i] = run;
      }
      tot[wave * 64 + lane] = run;
      __syncthreads();
      float off = 0.f;
      if (wave > 0) off += tot[lane];
      if (wave > 1) off += tot[64 + lane];
      if (wave > 2) off += tot[128 + lane];
#pragma unroll
      for (int i = 0; i < 16; ++i) Gf[(wave * 16 + i) * 64 + lane] = Gl[i] + off;
    } else {
      const float zz = rl.x + dtb;
      dt = zz > 20.f ? zz : log1pf(expf(zz));
      if ((tid & 3) == 0) lr_s[st] = dt;
      __syncthreads();
      if (wave == 0) {
        float g = lr_s[lane] * Aneg;
#pragma unroll
        for (int o = 1; o < 64; o <<= 1) {
          const float v = __shfl_up(g, o);
          if (lane >= o) g += v;
        }
        Gs[lane] = g;
      }
    }
#pragma unroll
    for (int i = 0; i < 16; ++i)
      ST[(32 * (wave >> 1) + (i & 3) + 8 * (i >> 2) + 4 * lh) * RS + 32 * (wave & 1) + l31] = f2b(Sacc[i]);
    __syncthreads();
    {
      const uint32_t au[8] = {ra0.x, ra0.y, ra0.z, ra0.w, ra1.x, ra1.y, ra1.z, ra1.w};
      const uint32_t cu[8] = {rc0.x, rc0.y, rc0.z, rc0.w, rc1.x, rc1.y, rc1.z, rc1.w};
      const uint32_t bu[8] = {rb0.x, rb0.y, rb0.z, rb0.w, rb1.x, rb1.y, rb1.z, rb1.w};
      uint32_t qo[8], ko[8];
      if (GLA) {
#pragma unroll
        for (int q = 0; q < 4; ++q) {
          const float4 G4 = *(const float4*)(Gf + st * 64 + k16 + 4 * q);
          const float4 L4 = *(const float4*)(Gf + 63 * 64 + k16 + 4 * q);
          const float gg[4] = {G4.x, G4.y, G4.z, G4.w}, ll[4] = {L4.x, L4.y, L4.z, L4.w};
#pragma unroll
          for (int h2 = 0; h2 < 2; ++h2) {
            const int w = 2 * q + h2;
            const float a0 = blo(au[w]), a1 = bhi(au[w]), c0 = blo(cu[w]), c1 = bhi(cu[w]);
            const float g0 = gg[2 * h2], g1 = gg[2 * h2 + 1];
            qo[w] = pack2(c0 * 0.125f * __expf(g0), c1 * 0.125f * __expf(g1));
            ko[w] = pack2(a0 * __expf(-g0), a1 * __expf(-g1));
            KeT[(k16 + 2 * w) * RS + st] = f2b(a0 * __expf(ll[2 * h2] - g0));
            KeT[(k16 + 2 * w + 1) * RS + st] = f2b(a1 * __expf(ll[2 * h2 + 1] - g1));
            bT[(k16 + 2 * w) * RS + st] = (bf16)(bu[w] & 0xffffu);
            bT[(k16 + 2 * w + 1) * RS + st] = (bf16)(bu[w] >> 16);
          }
        }
      } else {
        const float Gt = Gs[st], GL = Gs[63];
        const float e1 = __expf(Gt), e3 = __expf(GL - Gt);
#pragma unroll
        for (int w = 0; w < 8; ++w) {
          const float a0 = blo(au[w]), a1 = bhi(au[w]), c0 = blo(cu[w]), c1 = bhi(cu[w]);
          qo[w] = pack2(c0 * e1, c1 * e1);
          ko[w] = au[w];
          KeT[(k16 + 2 * w) * RS + st] = f2b(a0 * e3);
          KeT[(k16 + 2 * w + 1) * RS + st] = f2b(a1 * e3);
          bT[(k16 + 2 * w) * RS + st] = f2b(blo(bu[w]) * dt);
          bT[(k16 + 2 * w + 1) * RS + st] = f2b(bhi(bu[w]) * dt);
        }
        *(uint4*)(Cm + st * RS + k16) = rc0;
        *(uint4*)(Cm + st * RS + k16 + 8) = rc1;
      }
      *(uint4*)(Qm + st * RS + k16) = make_uint4(qo[0], qo[1], qo[2], qo[3]);
      *(uint4*)(Qm + st * RS + k16 + 8) = make_uint4(qo[4], qo[5], qo[6], qo[7]);
      *(uint4*)(Km + st * RS + k16) = make_uint4(ko[0], ko[1], ko[2], ko[3]);
      *(uint4*)(Km + st * RS + k16 + 8) = make_uint4(ko[4], ko[5], ko[6], ko[7]);
    }
    __syncthreads();
    if (chunk + 1 < KEYS / 64) CS_PREFETCH(chunk + 1);
    const int trow = scan_row(b, dir, chunk * 64 + 32 * nt + l31);
    uint2 xr0 = make_uint2(0, 0), xr1 = xr0, xr2 = xr0, xr3 = xr0;
    if (!GLA) {
      const bf16* xp = xbc + (size_t)trow * 768 + head * 64 + 32 * vh + 4 * lh;
      xr0 = *(const uint2*)(xp); xr1 = *(const uint2*)(xp + 8); xr2 = *(const uint2*)(xp + 16); xr3 = *(const uint2*)(xp + 24);
    }
    f32x16 outv;
#pragma unroll
    for (int i = 0; i < 16; ++i) outv[i] = 0.f;
    const bf16* Qp = GLA ? Qm : Cm;
#pragma unroll
    for (int ms = 0; ms < 2; ++ms) {
      if (ms <= nt) {
        f32x16 at;
#pragma unroll
        for (int i = 0; i < 16; ++i) at[i] = 0.f;
#pragma unroll
        for (int ks = 0; ks < 4; ++ks) {
          const bf16x8 kf = *(const bf16x8*)(Km + (32 * ms + l31) * RS + ks * 16 + lh * 8);
          const bf16x8 qf = *(const bf16x8*)(Qp + (32 * nt + l31) * RS + ks * 16 + lh * 8);
          at = MFMA32(kf, qf, at);
        }
        if (!GLA) {
          const float gt = Gs[32 * nt + l31];
#pragma unroll
          for (int g4 = 0; g4 < 4; ++g4) {
            const float4 gs4 = *(const float4*)(Gs + 32 * ms + 8 * g4 + 4 * lh);
            const float gsv[4] = {gs4.x, gs4.y, gs4.z, gs4.w};
#pragma unroll
            for (int j = 0; j < 4; ++j) {
              const int sl = 8 * g4 + 4 * lh + j;
              const bool keep = (ms < nt) || (sl <= l31);
              at[4 * g4 + j] = keep ? at[4 * g4 + j] * __expf(gt - gsv[j]) : 0.f;
            }
          }
        } else if (ms == nt) {
#pragma unroll
          for (int i = 0; i < 16; ++i) {
            const int sl = (i & 3) + 8 * (i >> 2) + 4 * lh;
            at[i] = (sl <= l31) ? at[i] : 0.f;
          }
        }
#pragma unroll
        for (int s2 = 0; s2 < 2; ++s2) {
          const bf16x8 pf = pack8(at, s2);
          const bf16* vp = bT + (32 * vh + l31) * RS + 32 * ms + 16 * s2 + 4 * lh;
          const uint2 lo = *(const uint2*)vp, hi = *(const uint2*)(vp + 8);
          const uint4 u = make_uint4(lo.x, lo.y, hi.x, hi.y);
          outv = MFMA32(__builtin_bit_cast(bf16x8, u), pf, outv);
        }
      }
    }
#pragma unroll
    for (int ks = 0; ks < 4; ++ks) {
      const bf16x8 sf = *(const bf16x8*)(ST + (32 * vh + l31) * RS + ks * 16 + lh * 8);
      const bf16x8 qf = *(const bf16x8*)(Qm + (32 * nt + l31) * RS + ks * 16 + lh * 8);
      outv = MFMA32(sf, qf, outv);
    }
    {
      const float dec = GLA ? __expf(Gf[63 * 64 + 32 * (wave & 1) + l31]) : __expf(Gs[63]);
#pragma unroll
      for (int i = 0; i < 16; ++i) Sacc[i] *= dec;
#pragma unroll
      for (int ks = 0; ks < 4; ++ks) {
        const bf16x8 bf_ = *(const bf16x8*)(bT + (32 * (wave >> 1) + l31) * RS + ks * 16 + lh * 8);
        const bf16x8 kf = *(const bf16x8*)(KeT + (32 * (wave & 1) + l31) * RS + ks * 16 + lh * 8);
        Sacc = MFMA32(bf_, kf, Sacc);
      }
    }
    {
      bf16* yp = yout + (size_t)trow * 512 + ocol + 32 * vh + 4 * lh;
      const uint2 xr[4] = {xr0, xr1, xr2, xr3};
#pragma unroll
      for (int g4 = 0; g4 < 4; ++g4) {
        float r0 = outv[4 * g4], r1 = outv[4 * g4 + 1], r2 = outv[4 * g4 + 2], r3 = outv[4 * g4 + 3];
        if (!GLA) {
          r0 = fmaf(Dsk, blo(xr[g4].x), r0); r1 = fmaf(Dsk, bhi(xr[g4].x), r1);
          r2 = fmaf(Dsk, blo(xr[g4].y), r2); r3 = fmaf(Dsk, bhi(xr[g4].y), r3);
        }
        uint2 pk; pk.x = pack2(r0, r1); pk.y = pack2(r2, r3);
        *(uint2*)(yp + 8 * g4) = pk;
      }
    }
    __syncthreads();
  }
#undef CS_PREFETCH
}


DI void attn_item(const Params& p, const int wid, int layer, int b, int head, int qrow0, int nkeys, char* lds) {
  bf16* Ks = (bf16*)lds;
  bf16* Vs = Ks + 64 * 136;
  bf16* Qa = (bf16*)(p.ws + OFF_QA);
  const bf16* Ka = (const bf16*)(p.ws + OFF_KA);
  const bf16* Vt = (const bf16*)(p.ws + OFF_VT) + (size_t)(b * 4 + head) * 128 * KEYS;
  const int tid = tid_fresh(p, wid), lane = tid & 63, wave = tid >> 6, l31 = lane & 31, lh = lane >> 5;

  bf16* Qs = Vs + 128 * 68;
#pragma unroll
  for (int i = 0; i < 8; ++i) {
    const int ch = tid + 256 * i;
    *(uint4*)(Qs + (ch >> 4) * 136 + (ch & 15) * 8) = *(const uint4*)(Qa + (size_t)(qrow0 + (ch >> 4)) * 512 + head * 128 + (ch & 15) * 8);
  }
  const bf16* qsw = Qs + (wave * 32 + l31) * 136 + lh * 8;
  f32x16 O[2][4];
#pragma unroll
  for (int c = 0; c < 2; ++c)
#pragma unroll
    for (int vt = 0; vt < 4; ++vt)
#pragma unroll
      for (int i = 0; i < 16; ++i) O[c][vt][i] = 0.f;
  float mrun[2] = {-1e30f, -1e30f}, lrun[2] = {0.f, 0.f};

  const int lkey = tid >> 2, lkq = (tid & 3) * 32, lvr = tid >> 1, lvh = (tid & 1) * 32;
#define KROW(key) ((key) < 256 ? NL + b * 256 + (key) : b * 8192 + (key) - 256)
#define KVLOAD(k0_)                                                                                  \
  {                                                                                                  \
    const uint4* kp_ = (const uint4*)(Ka + (size_t)KROW((k0_) + lkey) * 512 + head * 128 + lkq);      \
    rk0 = kp_[0]; rk1 = kp_[1]; rk2 = kp_[2]; rk3 = kp_[3];                                          \
    const uint4* vp_ = (const uint4*)(Vt + (size_t)lvr * KEYS + (k0_) + lvh);                        \
    rv0 = vp_[0]; rv1 = vp_[1]; rv2 = vp_[2]; rv3 = vp_[3];                                          \
  }
#define VST2(dst_, val) { (dst_)[0] = make_uint2((val).x, (val).y); (dst_)[1] = make_uint2((val).z, (val).w); }
  uint4 rk0, rk1, rk2, rk3, rv0, rv1, rv2, rv3;
  KVLOAD(0);
#pragma unroll 1
  for (int k0 = 0; k0 < nkeys; k0 += 64) {
    {
      uint4* kd = (uint4*)(Ks + lkey * 136 + lkq);
      kd[0] = rk0; kd[1] = rk1; kd[2] = rk2; kd[3] = rk3;
      uint2* vd = (uint2*)(Vs + lvr * 68 + lvh);
      VST2(vd, rv0); VST2(vd + 2, rv1); VST2(vd + 4, rv2); VST2(vd + 6, rv3);
    }
    __syncthreads();
    if (k0 + 64 < nkeys) KVLOAD(k0 + 64);
#pragma unroll
    for (int c = 0; c < 2; ++c) {
#pragma unroll
      for (int mt = 0; mt < 2; ++mt) {
        f32x16 sv;
#pragma unroll
        for (int i = 0; i < 16; ++i) sv[i] = 0.f;
#pragma unroll
        for (int ks = 0; ks < 4; ++ks) {
          const bf16x8 qf = *(const bf16x8*)(qsw + c * 64 + ks * 16);
          const bf16x8 kf = *(const bf16x8*)(Ks + (mt * 32 + l31) * 136 + c * 64 + ks * 16 + lh * 8);
          sv = MFMA32(kf, qf, sv);
        }
        __builtin_amdgcn_sched_barrier(0);
        const bf16* vpb = Vs + l31 * 68 + mt * 32 + 4 * lh;
#define VLD_(vt, st) ({ const bf16* vp_ = vpb + (vt) * 32 * 68 + 16 * (st); const uint2 lo_ = *(const uint2*)vp_, hi_ = *(const uint2*)(vp_ + 8); \
                        __builtin_bit_cast(bf16x8, make_uint4(lo_.x, lo_.y, hi_.x, hi_.y)); })
        bf16x8 v0, v1, v2, v3;
        float mx = sv[0];
#pragma unroll
        for (int i = 1; i < 16; ++i) mx = fmaxf(mx, sv[i]);
        mx = fmaxf(mx, __shfl_xor(mx, 32));
        const float mnew = fmaxf(mrun[c], mx);
        if (__any(mnew > mrun[c])) {
          const float alpha = __builtin_amdgcn_exp2f(mrun[c] - mnew);
          mrun[c] = mnew;
          lrun[c] *= alpha;
#pragma unroll
          for (int vt = 0; vt < 4; ++vt)
#pragma unroll
            for (int i = 0; i < 16; ++i) O[c][vt][i] *= alpha;
        }
        float psum = 0.f;
#pragma unroll
        for (int i = 0; i < 16; ++i) {
          float pv = __builtin_amdgcn_exp2f(sv[i] - mrun[c]);
          sv[i] = pv;
          psum += pv;
        }
        lrun[c] += psum;
        v0 = VLD_(0, 0); v1 = VLD_(1, 0); v2 = VLD_(2, 0); v3 = VLD_(3, 0);
        __builtin_amdgcn_sched_barrier(0);
        {
          const bf16x8 pf = pack8(sv, 0);
          O[c][0] = MFMA32(v0, pf, O[c][0]); O[c][1] = MFMA32(v1, pf, O[c][1]);
          O[c][2] = MFMA32(v2, pf, O[c][2]); O[c][3] = MFMA32(v3, pf, O[c][3]);
          v0 = VLD_(0, 1); v1 = VLD_(1, 1); v2 = VLD_(2, 1); v3 = VLD_(3, 1);
        }
        __builtin_amdgcn_sched_barrier(0);
        {
          const bf16x8 pf = pack8(sv, 1);
          O[c][0] = MFMA32(v0, pf, O[c][0]); O[c][1] = MFMA32(v1, pf, O[c][1]);
          O[c][2] = MFMA32(v2, pf, O[c][2]); O[c][3] = MFMA32(v3, pf, O[c][3]);
        }
        __builtin_amdgcn_sched_barrier(0);
#undef VLD_
      }
    }
    __syncthreads();
  }
  const float lam = ((const float*)(p.ws + OFF_MISC))[layer];
  const float lam_init = layer == 0 ? 0.2f : 0.8f - 0.6f * 0.7408182206817179f;
  const float l1 = lrun[0] + __shfl_xor(lrun[0], 32);
  const float l2 = lrun[1] + __shfl_xor(lrun[1], 32);
  const float i1 = 1.f / l1, i2 = lam / l2;
  float ss = 0.f;
#pragma unroll
  for (int vt = 0; vt < 4; ++vt)
#pragma unroll
    for (int i = 0; i < 16; ++i) {
      float o = O[0][vt][i] * i1 - O[1][vt][i] * i2;
      O[0][vt][i] = o;
      ss += o * o;
    }
  ss += __shfl_xor(ss, 32);
  const float rstd = rsqrtf(ss * (1.f / 128.f) + EPS) * (1.f - lam_init);
  const float* nw = p.da_norm_w + layer * 128;
  bf16* orow = Qa + (size_t)(qrow0 + wave * 32 + l31) * 512 + head * 128;
#pragma unroll
  for (int vt = 0; vt < 4; ++vt)
#pragma unroll
    for (int g = 0; g < 4; ++g) {
      const int v0 = vt * 32 + 8 * g + 4 * lh;
      float4 w4 = *(const float4*)(nw + v0);
      uint2 pk;
      pk.x = pack2(O[0][vt][4 * g] * rstd * w4.x, O[0][vt][4 * g + 1] * rstd * w4.y);
      pk.y = pack2(O[0][vt][4 * g + 2] * rstd * w4.z, O[0][vt][4 * g + 3] * rstd * w4.w);
      *(uint2*)(orow + v0) = pk;
    }
}

DI void phase_mixers(const Params& p, const int wid, int layer, char* lds) {
  __shared__ int s_item;
  const int x = blockIdx.x & 7;
  unsigned* counter = (unsigned*)(p.ws + OFF_MISC + 64) + layer * 8 + x;
  const int total = layer == 0 ? 32 + 256 + 8 : 32 + 256;
  for (;;) {
    if (tid_fresh(p, wid) == 0) s_item = (int)atomicAdd(counter, 1u);
    __syncthreads();
    const int li = s_item;
    __syncthreads();
    if (li >= total) break;
    if (li < 32) {
      const int sid = li * 8 + x;
      if (sid < 128) cscan_item<true>(p, wid, layer, sid, lds);
      else cscan_item<false>(p, wid, layer, sid - 128, lds);
    } else if (li < 288) {
      const int a = li - 32;
      const int bh = x + 8 * (a >> 6), qb = a & 63;
      attn_item(p, wid, layer, bh >> 2, bh & 3, (bh >> 2) * 8192 + qb * 128, KEYS, lds);
    } else {
      const int c = x * 8 + (li - 288);
      const int bh = c >> 1, qb = c & 1;
      attn_item(p, wid, layer, bh >> 2, bh & 3, NL + (bh >> 2) * 256 + qb * 128, 256, lds);
    }
  }
}

DI void phase_z(const Params& p, const int wid, int layer, int M, char* lds) {
  const bf16* h = (const bf16*)(p.ws + OFF_H);
  const bf16* W2 = (const bf16*)(p.ws + OFF_W + (size_t)layer * LW + SZ_W1);
  bf16* Z = (bf16*)(p.ws + OFF_Z);
  const int tidf = tid_fresh(p, wid); const int lane = tidf & 63, wave = tidf >> 6, wm = wave >> 1, wn = wave & 1, l31 = lane & 31, lh = lane >> 5;
  constexpr int NTN = N2 / 128;
  int mt_, nt_;
  for (int it = 0; xcd_tile(it, M / 256, NTN, 12, mt_, nt_); ++it) {
    const int m0 = mt_ * 256, n0 = nt_ * 128;
    f32x16 acc[4][2];
    zero_acc<4, 2>(acc);
    gemm_main256(h + (size_t)m0 * 1024, 1024, W2 + (size_t)n0 * 1024, 1024, 1024, acc, lds, tidf);
#pragma unroll
    for (int tm = 0; tm < 4; ++tm)
#pragma unroll
      for (int tn = 0; tn < 2; ++tn) {
        const int col = n0 + wn * 64 + tn * 32 + l31;
        const int rowb = m0 + wm * 128 + tm * 32 + 4 * lh;
#pragma unroll
        for (int i = 0; i < 16; ++i) {
          const int row = rowb + (i & 3) + 8 * (i >> 2);
          Z[(size_t)row * 1536 + col] = f2b(acc[tm][tn][i]);
        }
      }
  }
}

DI void phase_post(const Params& p, const int wid, int layer, int M) {
  const int tidf = tid_fresh(p, wid); const int lane = tidf & 63, wave = tidf >> 6;
  bf16* Z = (bf16*)(p.ws + OFF_Z);
  const bf16* oda = (const bf16*)(p.ws + OFF_QA);
  const bf16* ysf = (const bf16*)(p.ws + OFF_YSF);
  const bf16* ysb = (const bf16*)(p.ws + OFF_YSB);
  const bf16* ygf = (const bf16*)(p.ws + OFF_YGF);
  const bf16* ygb = (const bf16*)(p.ws + OFF_YGB);
  const float* snw = p.ssm_norm_w + layer * 512;
  const float* gnw = p.gla_norm_w + layer * 128;
  const int c0 = lane * 8;
  for (int row = blockIdx.x * 4 + wave; row < M; row += gridDim.x * 4) {
    bf16* zr = Z + (size_t)row * 1536;
    {
      uint4 o = *(const uint4*)(oda + (size_t)row * 512 + c0);
      uint4 z = *(const uint4*)(zr + c0);
      const uint32_t ou[4] = {o.x, o.y, o.z, o.w}, zu[4] = {z.x, z.y, z.z, z.w};
      uint32_t r[4];
#pragma unroll
      for (int q = 0; q < 4; ++q) r[q] = pack2(blo(ou[q]) * siluf(blo(zu[q])), bhi(ou[q]) * siluf(bhi(zu[q])));
      *(uint4*)(zr + c0) = make_uint4(r[0], r[1], r[2], r[3]);
    }
    {
      uint4 yf = *(const uint4*)(ysf + (size_t)row * 512 + c0), yb = *(const uint4*)(ysb + (size_t)row * 512 + c0);
      uint4 z = *(const uint4*)(zr + 512 + c0);
      const uint32_t fu[4] = {yf.x, yf.y, yf.z, yf.w}, bu[4] = {yb.x, yb.y, yb.z, yb.w}, zu[4] = {z.x, z.y, z.z, z.w};
      float y[8];
      float ss = 0.f;
#pragma unroll
      for (int q = 0; q < 4; ++q) {
        y[2 * q] = (blo(fu[q]) + blo(bu[q])) * siluf(blo(zu[q]));
        y[2 * q + 1] = (bhi(fu[q]) + bhi(bu[q])) * siluf(bhi(zu[q]));
        ss += y[2 * q] * y[2 * q] + y[2 * q + 1] * y[2 * q + 1];
      }
#pragma unroll
      for (int m = 16; m >= 1; m >>= 1) ss += __shfl_xor(ss, m);
      const float rstd = rsqrtf(ss * (1.f / 256.f) + EPS);
      float4 w0 = *(const float4*)(snw + c0), w1 = *(const float4*)(snw + c0 + 4);
      uint32_t r[4];
      r[0] = pack2(y[0] * rstd * w0.x, y[1] * rstd * w0.y); r[1] = pack2(y[2] * rstd * w0.z, y[3] * rstd * w0.w);
      r[2] = pack2(y[4] * rstd * w1.x, y[5] * rstd * w1.y); r[3] = pack2(y[6] * rstd * w1.z, y[7] * rstd * w1.w);
      *(uint4*)(zr + 512 + c0) = make_uint4(r[0], r[1], r[2], r[3]);
    }
    {
      uint4 yf = *(const uint4*)(ygf + (size_t)row * 512 + c0), yb = *(const uint4*)(ygb + (size_t)row * 512 + c0);
      uint4 z = *(const uint4*)(zr + 1024 + c0);
      const uint32_t fu[4] = {yf.x, yf.y, yf.z, yf.w}, bu[4] = {yb.x, yb.y, yb.z, yb.w}, zu[4] = {z.x, z.y, z.z, z.w};
      float y[8];
      float ss = 0.f;
#pragma unroll
      for (int q = 0; q < 4; ++q) {
        y[2 * q] = blo(fu[q]) + blo(bu[q]);
        y[2 * q + 1] = bhi(fu[q]) + bhi(bu[q]);
        ss += y[2 * q] * y[2 * q] + y[2 * q + 1] * y[2 * q + 1];
      }
#pragma unroll
      for (int m = 8; m >= 1; m >>= 1) ss += __shfl_xor(ss, m);
      const float rstd = rsqrtf(ss * (1.f / 128.f) + EPS);
      const int cw = c0 & 127;
      float4 w0 = *(const float4*)(gnw + cw), w1 = *(const float4*)(gnw + cw + 4);
      uint32_t r[4];
      r[0] = pack2(y[0] * rstd * w0.x * siluf(blo(zu[0])), y[1] * rstd * w0.y * siluf(bhi(zu[0])));
      r[1] = pack2(y[2] * rstd * w0.z * siluf(blo(zu[1])), y[3] * rstd * w0.w * siluf(bhi(zu[1])));
      r[2] = pack2(y[4] * rstd * w1.x * siluf(blo(zu[2])), y[5] * rstd * w1.y * siluf(bhi(zu[2])));
      r[3] = pack2(y[6] * rstd * w1.z * siluf(blo(zu[3])), y[7] * rstd * w1.w * siluf(bhi(zu[3])));
      *(uint4*)(zr + 1024 + c0) = make_uint4(r[0], r[1], r[2], r[3]);
    }
  }
}

DI void phase_merge(const Params& p, const int wid, int layer, int M, char* lds) {
  const bf16* h = (const bf16*)(p.ws + OFF_H);
  const bf16* osg = (const bf16*)(p.ws + OFF_Z);
  const char* wb = p.ws + OFF_W + (size_t)layer * LW;
  const bf16* W3 = (const bf16*)(wb + SZ_W1 + SZ_W2);
  const bf16* Wout = (const bf16*)(wb + SZ_W1 + SZ_W2 + SZ_W3);
  bf16* U = (bf16*)(p.ws + OFF_U);
  const int tidf = tid_fresh(p, wid); const int lane = tidf & 63, wave = tidf >> 6, wm = wave >> 1, wn = wave & 1, l31 = lane & 31, lh = lane >> 5;
  constexpr int NTN = 1024 / 128;
  int mt_, nt_;
  for (int it = 0; xcd_tile(it, M / 128, NTN, 8, mt_, nt_); ++it) {
    const int m0 = mt_ * 128, n0 = nt_ * 128;
    f32x16 u[2][2];
    zero_acc<2, 2>(u);
#pragma unroll 1
    for (int br = 0; br < 3; ++br) {
      uint32_t* sgl = (uint32_t*)(lds + 36864) + tidf;
      {
        f32x16 g[2][2];
        zero_acc<2, 2>(g);
        gemm_main128(h + (size_t)m0 * 1024, 1024, W3 + (size_t)(br * 1024 + n0) * 1024, 1024, 1024, g, lds, tidf);
#pragma unroll
        for (int tm = 0; tm < 2; ++tm)
#pragma unroll
          for (int tn = 0; tn < 2; ++tn)
#pragma unroll
            for (int q = 0; q < 8; ++q) sgl[((tm * 2 + tn) * 8 + q) * 256] = pack2(sigmf(g[tm][tn][2 * q]), sigmf(g[tm][tn][2 * q + 1]));
      }
      f32x16 t[2][2];
      zero_acc<2, 2>(t);
      gemm_main128(osg + (size_t)m0 * 1536 + br * 512, 1536, Wout + (size_t)br * 1024 * 512 + (size_t)n0 * 512, 512, 512, t, lds, tidf);
#pragma unroll
      for (int tm = 0; tm < 2; ++tm)
#pragma unroll
        for (int tn = 0; tn < 2; ++tn)
#pragma unroll
          for (int q = 0; q < 8; ++q) {
            const uint32_t sgv = sgl[((tm * 2 + tn) * 8 + q) * 256];
            u[tm][tn][2 * q] = fmaf(blo(sgv), t[tm][tn][2 * q], u[tm][tn][2 * q]);
            u[tm][tn][2 * q + 1] = fmaf(bhi(sgv), t[tm][tn][2 * q + 1], u[tm][tn][2 * q + 1]);
          }
    }
#pragma unroll
    for (int tm = 0; tm < 2; ++tm)
#pragma unroll
      for (int tn = 0; tn < 2; ++tn) {
        const int col = n0 + wn * 64 + tn * 32 + l31;
        const int rowb = m0 + wm * 64 + tm * 32 + 4 * lh;
#pragma unroll
        for (int i = 0; i < 16; ++i) {
          const int row = rowb + (i & 3) + 8 * (i >> 2);
          U[(size_t)row * 1024 + col] = f2b(u[tm][tn][i]);
        }
      }
  }
}

DI void phase_out(const Params& p, const int wid, int layer, int M, const float* xl, const float* xc, float* ol, float* oc, char* lds) {
  const bf16* U = (const bf16*)(p.ws + OFF_U);
  const bf16* Wo = (const bf16*)(p.ws + OFF_W + (size_t)layer * LW + SZ_W1 + SZ_W2 + SZ_W3 + 3 * SZ_WOUT);
  const float* modv = (const float*)(p.ws + OFF_MOD) + (size_t)layer * 9 * 3072;
  const int tidf = tid_fresh(p, wid); const int lane = tidf & 63, wave = tidf >> 6, wm = wave >> 1, wn = wave & 1, l31 = lane & 31, lh = lane >> 5;
  constexpr int NTN = 1024 / 128;
  int mt_, nt_;
  for (int it = 0; xcd_tile(it, M / 256, NTN, 8, mt_, nt_); ++it) {
    const int m0 = mt_ * 256, n0 = nt_ * 128;
    f32x16 acc[4][2];
    zero_acc<4, 2>(acc);
    gemm_main256(U + (size_t)m0 * 1024, 1024, Wo + (size_t)n0 * 1024, 1024, 1024, acc, lds, tidf);
    const bool lat = m0 < NL;
    const int j = lat ? (m0 >> 13) : 8;
    const float* gate = modv + j * 3072 + 2048;
    const float* src = lat ? xl + (size_t)m0 * 1024 : xc + (size_t)(m0 - NL) * 1024;
    float* dst = lat ? ol + (size_t)m0 * 1024 : oc + (size_t)(m0 - NL) * 1024;
    uint32_t eoff = (uint32_t)((wm * 128 + 4 * lh) * 1024 + n0 + wn * 64 + l31);
    asm volatile("" : "+v"(eoff));
    const float* sp = src + eoff;
    float* dp = dst + eoff;
    const float* gp = gate + n0 + wn * 64 + l31;
#pragma unroll
    for (int tm = 0; tm < 4; ++tm)
#pragma unroll
      for (int tn = 0; tn < 2; ++tn) {
        const float gt = gp[tn * 32];
#pragma unroll
        for (int i = 0; i < 16; ++i) {
          const int off = (tm * 32 + (i & 3) + 8 * (i >> 2)) * 1024 + tn * 32;
          dp[off] = sp[off] + gt * acc[tm][tn][i];
        }
        __builtin_amdgcn_sched_barrier(0);
      }
  }
}

DI void phase_final(const Params& p, const int wid) {
  const int tidf = tid_fresh(p, wid); const int lane = tidf & 63, wave = tidf >> 6;
  const int stride = gridDim.x * 4;
  for (int row0 = blockIdx.x * 4 + wave; row0 < NL; row0 += 2 * stride) {
    float4 v[2][4];
    float ss[2] = {0.f, 0.f};
#pragma unroll
    for (int r = 0; r < 2; ++r) {
      int row = row0 + r * stride;
      if (row >= NL) row = row0;
      const float* src = p.out + (size_t)row * 1024;
#pragma unroll
      for (int i = 0; i < 4; ++i) v[r][i] = *(const float4*)(src + (i * 64 + lane) * 4);
    }
#pragma unroll
    for (int r = 0; r < 2; ++r) {
#pragma unroll
      for (int i = 0; i < 4; ++i) ss[r] += v[r][i].x * v[r][i].x + v[r][i].y * v[r][i].y + v[r][i].z * v[r][i].z + v[r][i].w * v[r][i].w;
      ss[r] = wave_sum(ss[r]);
    }
#pragma unroll
    for (int r = 0; r < 2; ++r) {
      const int row = row0 + r * stride;
      if (row < NL) {
        float* dst = p.out + (size_t)row * 1024;
        const float rstd = rsqrtf(ss[r] * (1.f / 1024.f) + EPS);
#pragma unroll
        for (int i = 0; i < 4; ++i) {
          const int c = (i * 64 + lane) * 4;
          float4 w4 = *(const float4*)(p.final_norm_w + c);
          *(float4*)(dst + c) = make_float4(v[r][i].x * rstd * w4.x, v[r][i].y * rstd * w4.y, v[r][i].z * rstd * w4.z, v[r][i].w * rstd * w4.w);
        }
      }
    }
  }
}

__global__ void __launch_bounds__(256, 2) hybrid_trunk_mega(Params p) {
  cg::grid_group grid = cg::this_grid();
  const int wid = __builtin_amdgcn_readfirstlane((int)(threadIdx.x >> 6));
  __shared__ __attribute__((aligned(16))) char lds[LDS_BYTES];
  phase0(p, wid, lds);
  grid.sync();
  float* ctx1 = (float*)(p.ws + OFF_CTX1);
#pragma unroll 1
  for (int layer = 0; layer < 2; ++layer) {
    const float* xl = layer == 0 ? p.x : p.out;
    const float* xc = layer == 0 ? p.ctx : ctx1;
    const int M = layer == 0 ? NT : NL;
    phase_h(p, wid, layer, xl, xc, NT);
    grid.sync();
    phase_p1(p, wid, layer, NT, lds);
    grid.sync();
#ifdef DUP_GEMM
    phase_p1(p, wid, layer, NT, lds);
    grid.sync();
#endif
    phase_conv(p, wid, layer);
    grid.sync();
#ifdef PROBE_SCAN
    for (int it = blockIdx.x; it < 192; it += gridDim.x) { if (it < 64) scan_item<true>(p, wid, layer, it, lds); else scan_item<false>(p, wid, layer, it - 64, lds); }
    grid.sync();
#endif
    phase_mixers(p, wid, layer, lds);
    grid.sync();
    phase_z(p, wid, layer, M, lds);
    grid.sync();
#ifdef DUP_GEMM
    phase_z(p, wid, layer, M, lds);
    grid.sync();
#endif
    phase_post(p, wid, layer, M);
    grid.sync();
    phase_merge(p, wid, layer, M, lds);
    grid.sync();
#ifdef DUP_GEMM
    phase_merge(p, wid, layer, M, lds);
    grid.sync();
#endif
    phase_out(p, wid, layer, M, xl, xc, p.out, ctx1, lds);
    grid.sync();
  }
  phase_final(p, wid);
}

extern "C" void kernel_launch(void* const* d_in, const int* in_sizes, int n_in, void* d_out, int out_size, void* d_ws,
                              size_t ws_size, hipStream_t stream) {
  (void)in_sizes; (void)n_in; (void)out_size;
  static int grid_blocks = 0;
  if (!grid_blocks) {
    int dev = 0, cus = 0, per_cu = 0;
    hipGetDevice(&dev);
    hipDeviceGetAttribute(&cus, hipDeviceAttributeMultiprocessorCount, dev);
    hipOccupancyMaxActiveBlocksPerMultiprocessor(&per_cu, hybrid_trunk_mega, 256, 0);
    (void)per_cu;
    grid_blocks = cus * 2;
  }
  if (ws_size < WS_TOTAL) { fprintf(stderr, "workspace too small: %zu < %zu\n", ws_size, (size_t)WS_TOTAL); return; }
  Params p{};
  const float** f = (const float**)&p;
  for (int i = 0; i < 24; ++i) f[i] = (const float*)d_in[i];
  p.wid = 0; p.pad_ = 0;
  p.out = (float*)d_out;
  p.ws = (char*)d_ws;
  void* args[] = {&p};
  hipError_t e = hipLaunchCooperativeKernel((const void*)hybrid_trunk_mega, dim3(grid_blocks), dim3(256), args, 0, stream);
  if (e != hipSuccess && (grid_blocks & 15) == 0) {
    (void)hipGetLastError();
    grid_blocks >>= 1;
    e = hipLaunchCooperativeKernel((const void*)hybrid_trunk_mega, dim3(grid_blocks), dim3(256), args, 0, stream);
  }
  if (e != hipSuccess) fprintf(stderr, "cooperative launch failed: %s (grid %d)\n", hipGetErrorString(e), grid_blocks);
}
```

```cpp
#include <hip/hip_runtime.h>
#include <hip/hip_cooperative_groups.h>
#include <stdint.h>
#include <stdio.h>
namespace cg = cooperative_groups;

typedef unsigned short bf16;
using bf16x8 = __attribute__((ext_vector_type(8))) short;
using f32x16 = __attribute__((ext_vector_type(16))) float;
using u32x8 = __attribute__((ext_vector_type(8))) unsigned int;
#define DI __device__ __forceinline__
#define MFMA32(a, b, c) __builtin_amdgcn_mfma_f32_32x32x16_bf16((a), (b), (c), 0, 0, 0)

typedef __bf16 hbf16x2 __attribute__((ext_vector_type(2)));
typedef float f32x2 __attribute__((ext_vector_type(2)));
DI uint32_t pack2(float a, float b) { f32x2 v = {a, b}; return __builtin_bit_cast(uint32_t, __builtin_convertvector(v, hbf16x2)); }
DI bf16 f2b(float x) { return (bf16)(pack2(x, x) & 0xffffu); }
DI float blo(uint32_t u) { return __uint_as_float(u << 16); }
DI float bhi(uint32_t u) { return __uint_as_float(u & 0xffff0000u); }
DI float max3f(float a, float b, float c) { float r; asm("v_max3_f32 %0, %1, %2, %3" : "=v"(r) : "v"(a), "v"(b), "v"(c)); return r; }
DI float xhalf_max(float x) {
  const unsigned u = __float_as_uint(x);
  const auto r = __builtin_amdgcn_permlane32_swap(u, u, false, false);
  float m; asm("v_max_f32 %0, %1, %2" : "=v"(m) : "v"(__uint_as_float(r[0])), "v"(__uint_as_float(r[1]))); return m;
}
DI float siluf(float x) { return x / (1.f + __expf(-x)); }
DI float sigmf(float x) { return 1.f / (1.f + __expf(-x)); }

constexpr int NB = 8, SEQ = 8192, CTX = 256, DM = 1024;
constexpr int NL = NB * SEQ;
constexpr int NC = NB * CTX;
constexpr int NT = NL + NC;
constexpr int KEYS = CTX + SEQ;
constexpr int INW = 7984;
constexpr int N1 = 3456, N2 = 1536, N3 = 3072;
constexpr float EPS = 1e-6f;
constexpr float QSCALE = 0.125f * 1.4426950408889634f;

constexpr size_t al256(size_t x) { return (x + 255) & ~(size_t)255; }
constexpr size_t SZ_W1 = (size_t)N1 * 1024 * 2, SZ_W2 = (size_t)N2 * 1024 * 2, SZ_W3 = (size_t)N3 * 1024 * 2;
constexpr size_t SZ_WOUT = (size_t)1024 * 512 * 2, SZ_WO = (size_t)1024 * 1024 * 2;
constexpr size_t LW = SZ_W1 + SZ_W2 + SZ_W3 + 3 * SZ_WOUT + SZ_WO;
constexpr size_t OFF_W = 0;
constexpr size_t OFF_MOD = OFF_W + 2 * LW;
constexpr size_t OFF_ROPE = OFF_MOD + al256((size_t)2 * 9 * 3072 * 4);
constexpr size_t OFF_MISC = OFF_ROPE + (size_t)128 * 16 * 2 * 4;
constexpr size_t OFF_H = OFF_MISC + 256;
constexpr size_t OFF_QA = OFF_H + (size_t)NT * 1024 * 2;
constexpr size_t OFF_KA = OFF_QA + (size_t)NT * 512 * 2;
constexpr size_t OFF_VT = OFF_KA + (size_t)NT * 512 * 2;
constexpr size_t OFF_XBC = OFF_VT + (size_t)NT * 512 * 2;
constexpr size_t OFF_XBC2 = OFF_XBC + (size_t)NT * 768 * 2;
constexpr size_t OFF_GQ = OFF_XBC2 + (size_t)NT * 768 * 2;
constexpr size_t OFF_GK = OFF_GQ + (size_t)NT * 256 * 2;
constexpr size_t OFF_GV = OFF_GK + (size_t)NT * 256 * 2;
constexpr size_t OFF_DTLR = OFF_GV + (size_t)NT * 512 * 2;
constexpr size_t OFF_YSF = OFF_DTLR + (size_t)NT * 48 * 4;
constexpr size_t OFF_YSB = OFF_YSF + (size_t)NT * 512 * 2;
constexpr size_t OFF_YGF = OFF_YSB + (size_t)NT * 512 * 2;
constexpr size_t OFF_YGB = OFF_YGF + (size_t)NT * 512 * 2;
constexpr size_t OFF_CTX1 = OFF_YGB + (size_t)NT * 512 * 2;
constexpr size_t WS_TOTAL = OFF_CTX1 + (size_t)NC * 1024 * 4;
constexpr size_t OFF_Z = OFF_KA;
constexpr size_t OFF_U = OFF_GQ;
static_assert(WS_TOTAL <= ((size_t)1 << 30), "workspace too large");
static_assert((size_t)NT * 1536 * 2 <= OFF_XBC2 - OFF_KA, "Z overlay");
static_assert((size_t)NT * 1024 * 2 <= OFF_DTLR - OFF_GQ, "U overlay");

struct Params {
  const float *x, *c, *ctx, *c_ctx, *w_mod, *b_mod, *norm_w, *w_in, *da_lambda, *da_norm_w, *w_out_da;
  const float *conv_w, *conv_b, *dt_bias, *a_log, *ssm_d, *ssm_norm_w, *w_out_ssm;
  const float *gla_w_gate, *gla_b_gate, *gla_norm_w, *w_out_gla, *w_o, *final_norm_w;
  float* out;
  char* ws;
  int wid, pad_;
};
DI int tid_fresh(const Params& p, const int wid) {
  int t = wid * 64 + (int)__builtin_amdgcn_mbcnt_hi(~0u, __builtin_amdgcn_mbcnt_lo(~0u, 0u));
  asm volatile("" : "+v"(t));
  return t;
}

constexpr int LDS_BYTES = 70 * 1024;

DI int map_w1(int n) {
  if (n < 1536) return n;
  if (n < 2048) return 2048 + (n - 1536);
  if (n < 2304) return 3072 + (n - 2048);
  if (n < 3328) return 3344 + (n - 2304);
  if (n < 3344) return 3328 + (n - 3328);
  if (n < 3376) return 4880 + (n - 3344);
  return -1;
}
DI int map_w2(int n) {
  if (n < 512) return 1536 + n;
  if (n < 1024) return 2560 + (n - 512);
  return 4368 + (n - 1024);
}

DI void tr_tile(const Params& p, const int wid, const float* __restrict__ src, int ldsrc, bf16* __restrict__ dst, int K, int n0, int k0, int mapk, float* tile) {
  const int tid = tid_fresh(p, wid), tx = tid & 63, ty = tid >> 6;
  const int n = n0 + tx;
  int col = n;
  if (mapk == 1) col = map_w1(n); else if (mapk == 2) col = map_w2(n); else if (mapk == 3) col = 4912 + n;
#pragma unroll
  for (int i = 0; i < 16; ++i) {
    int kk = ty + 4 * i;
    tile[kk * 65 + tx] = (col >= 0) ? src[(size_t)(k0 + kk) * ldsrc + col] : 0.f;
  }
  __syncthreads();
#pragma unroll
  for (int i = 0; i < 16; ++i) {
    int nn = ty + 4 * i;
    dst[(size_t)(n0 + nn) * K + k0 + tx] = f2b(tile[tx * 65 + nn]);
  }
  __syncthreads();
}

constexpr int TR_PER_LAYER = 864 + 384 + 768 + 384 + 256;
constexpr int P0_ITEMS = 2 * TR_PER_LAYER + 96 + 1;

DI void phase0(const Params& p, const int wid, char* lds) {
  const int tid = tid_fresh(p, wid);
  float* fl = (float*)lds;
  for (int item = blockIdx.x; item < P0_ITEMS; item += gridDim.x) {
    if (item < 2 * TR_PER_LAYER) {
      const int layer = item / TR_PER_LAYER;
      int j = item % TR_PER_LAYER;
      char* wb = p.ws + OFF_W + (size_t)layer * LW;
      const float* win = p.w_in + (size_t)layer * 1024 * INW;
      if (j < 864) {
        tr_tile(p, wid, win, INW, (bf16*)wb, 1024, (j >> 4) * 64, (j & 15) * 64, 1, fl);
      } else if (j < 1248) {
        j -= 864;
        tr_tile(p, wid, win, INW, (bf16*)(wb + SZ_W1), 1024, (j >> 4) * 64, (j & 15) * 64, 2, fl);
      } else if (j < 2016) {
        j -= 1248;
        tr_tile(p, wid, win, INW, (bf16*)(wb + SZ_W1 + SZ_W2), 1024, (j >> 4) * 64, (j & 15) * 64, 3, fl);
      } else if (j < 2400) {
        j -= 2016;
        const int br = j >> 7, r = j & 127;
        const float* src = (br == 0 ? p.w_out_da : br == 1 ? p.w_out_ssm : p.w_out_gla) + (size_t)layer * 512 * 1024;
        tr_tile(p, wid, src, 1024, (bf16*)(wb + SZ_W1 + SZ_W2 + SZ_W3 + (size_t)br * SZ_WOUT), 512, (r >> 3) * 64, (r & 7) * 64, 0, fl);
      } else {
        j -= 2400;
        tr_tile(p, wid, p.w_o + (size_t)layer * 1024 * 1024, 1024, (bf16*)(wb + SZ_W1 + SZ_W2 + SZ_W3 + 3 * SZ_WOUT), 1024,
                (j >> 4) * 64, (j & 15) * 64, 0, fl);
      }
    } else if (item < 2 * TR_PER_LAYER + 96) {
      const int m = item - 2 * TR_PER_LAYER;
      const int layer = m / 48, nc = (m % 48) * 64;
      float* sc = fl;
      float* red = fl + 9 * 1024;
      for (int idx = tid; idx < 9 * 1024; idx += 256) {
        int j = idx >> 10, k = idx & 1023;
        float v = j < 8 ? p.c[j * 1024 + k] : p.c_ctx[k];
        sc[idx] = v / (1.f + expf(-v));
      }
      __syncthreads();
      const int tx = tid & 63, q = tid >> 6;
      float acc[9];
#pragma unroll
      for (int j = 0; j < 9; ++j) acc[j] = 0.f;
      const float* wm = p.w_mod + (size_t)layer * 1024 * 3072 + nc + tx;
#pragma unroll 4
      for (int k = q * 256; k < q * 256 + 256; ++k) {
        float wv = wm[(size_t)k * 3072];
#pragma unroll
        for (int j = 0; j < 9; ++j) acc[j] = fmaf(sc[j * 1024 + k], wv, acc[j]);
      }
#pragma unroll
      for (int j = 0; j < 9; ++j) red[(q * 9 + j) * 64 + tx] = acc[j];
      __syncthreads();
      float* modv = (float*)(p.ws + OFF_MOD);
      for (int idx = tid; idx < 9 * 64; idx += 256) {
        int j = idx >> 6, t = idx & 63;
        float s = red[(0 * 9 + j) * 64 + t] + red[(1 * 9 + j) * 64 + t] + red[(2 * 9 + j) * 64 + t] + red[(3 * 9 + j) * 64 + t];
        modv[(size_t)(layer * 9 + j) * 3072 + nc + t] = s + p.b_mod[layer * 3072 + nc + t];
      }
      __syncthreads();
    } else {
      float* rope = (float*)(p.ws + OFF_ROPE);
      for (int idx = tid; idx < 2048; idx += 256) {
        int pos = idx >> 4, f = idx & 15;
        float inv = (float)exp(-(double)f / 16.0 * 9.210340371976184);
        float angf = (float)pos * inv;
        double a = (double)angf;
        double r = a - 6.283185307179586477 * rint(a * 0.15915494309189533577);
        double r2 = r * r;
        double ts = r, ss = r, tc = 1.0, cs = 1.0;
#pragma unroll 1
        for (int n = 1; n <= 12; ++n) {
          tc *= -r2 / (double)((2 * n - 1) * (2 * n));
          cs += tc;
          ts *= -r2 / (double)((2 * n) * (2 * n + 1));
          ss += ts;
        }
        rope[idx * 2] = (float)cs;
        rope[idx * 2 + 1] = (float)ss;
      }
      float* misc = (float*)(p.ws + OFF_MISC);
      if (tid < 2) {
        const float* lm = p.da_lambda + tid * 4 * 64;
        float s1 = 0.f, s2 = 0.f;
        for (int i = 0; i < 64; ++i) { s1 += lm[i] * lm[64 + i]; s2 += lm[128 + i] * lm[192 + i]; }
        float lam_init = 0.8f - 0.6f * expf(-0.3f * (float)tid);
        misc[tid] = expf(s1) - expf(s2) + lam_init;
      }
      if (tid < 16) ((unsigned*)(p.ws + OFF_MISC + 64))[tid] = 0u;
    }
  }
}

DI float wave_sum(float v) {
#pragma unroll
  for (int m = 32; m >= 1; m >>= 1) v += __shfl_xor(v, m);
  return v;
}

DI void phase_h(const Params& p, const int wid, int layer, const float* xl, const float* xc, int M) {
  const int tidf = tid_fresh(p, wid); const int lane = tidf & 63, wave = tidf >> 6;
  bf16* h = (bf16*)(p.ws + OFF_H);
  const float* modv = (const float*)(p.ws + OFF_MOD) + (size_t)layer * 9 * 3072;
  const float* nw = p.norm_w + layer * 1024;
  const int stride = gridDim.x * 4;
  for (int row0 = blockIdx.x * 4 + wave; row0 < M; row0 += 2 * stride) {
    float4 v[2][4];
    float ss[2] = {0.f, 0.f};
#pragma unroll
    for (int r = 0; r < 2; ++r) {
      int row = row0 + r * stride;
      if (row >= M) row = row0;
      const float* src = row < NL ? xl + (size_t)row * 1024 : xc + (size_t)(row - NL) * 1024;
#pragma unroll
      for (int i = 0; i < 4; ++i) v[r][i] = *(const float4*)(src + (i * 64 + lane) * 4);
    }
#pragma unroll
    for (int r = 0; r < 2; ++r) {
#pragma unroll
      for (int i = 0; i < 4; ++i) ss[r] += v[r][i].x * v[r][i].x + v[r][i].y * v[r][i].y + v[r][i].z * v[r][i].z + v[r][i].w * v[r][i].w;
      ss[r] = wave_sum(ss[r]);
    }
#pragma unroll
    for (int r = 0; r < 2; ++r) {
      const int row = row0 + r * stride;
      if (row < M) {
        const int j = row < NL ? (row >> 13) : 8;
        const float* shift = modv + j * 3072;
        const float* scale = shift + 1024;
        const float rstd = rsqrtf(ss[r] * (1.f / 1024.f) + EPS);
#pragma unroll
        for (int i = 0; i < 4; ++i) {
          const int c = (i * 64 + lane) * 4;
          float4 w4 = *(const float4*)(nw + c), sc4 = *(const float4*)(scale + c), sh4 = *(const float4*)(shift + c);
          float o0 = v[r][i].x * rstd * w4.x * (1.f + sc4.x) + sh4.x;
          float o1 = v[r][i].y * rstd * w4.y * (1.f + sc4.y) + sh4.y;
          float o2 = v[r][i].z * rstd * w4.z * (1.f + sc4.z) + sh4.z;
          float o3 = v[r][i].w * rstd * w4.w * (1.f + sc4.w) + sh4.w;
          uint2 pk; pk.x = pack2(o0, o1); pk.y = pack2(o2, o3);
          *(uint2*)(h + (size_t)row * 1024 + c) = pk;
        }
      }
    }
  }
}

DI void gemm_main128(const bf16* __restrict__ A, int lda, const bf16* __restrict__ Bt, int ldb, int K,
                     f32x16 (&acc)[2][2], char* lds, const int tid) {
  bf16* As = (bf16*)lds;
  bf16* Bs = As + 128 * 72;
  const int lane = tid & 63, wave = tid >> 6, wm = wave >> 1, wn = wave & 1;
  const int l31 = lane & 31, lh = lane >> 5;
  const uint32_t aoff = (uint32_t)(((tid >> 3) * lda + (tid & 7) * 8) * 2);
  const uint32_t boff = (uint32_t)(((tid >> 3) * ldb + (tid & 7) * 8) * 2);
  const uint32_t soff = (uint32_t)(((tid >> 3) * 72 + (tid & 7) * 8) * 2);
  const char* Ab = (const char*)A;
  const char* Bb = (const char*)Bt;
  char* Asb = (char*)As;
  char* Bsb = (char*)Bs;
  const size_t astep = (size_t)32 * lda * 2, bstep = (size_t)32 * ldb * 2;
  uint4 ra0, ra1, ra2, ra3, rb0, rb1, rb2, rb3;
#define ALD(i, kb) (*(const uint4*)(Ab + ((size_t)(i) * astep + (kb)) + aoff))
#define BLD(i, kb) (*(const uint4*)(Bb + ((size_t)(i) * bstep + (kb)) + boff))
#define LDALL(kb)                                                          \
  ra0 = ALD(0, kb); ra1 = ALD(1, kb); ra2 = ALD(2, kb); ra3 = ALD(3, kb);  \
  rb0 = BLD(0, kb); rb1 = BLD(1, kb); rb2 = BLD(2, kb); rb3 = BLD(3, kb);
#define SST(base, i, val) (*(uint4*)((base) + (i) * (32 * 72 * 2) + soff) = (val))
  LDALL((size_t)0)
#pragma unroll 1
  for (int k0 = 0; k0 < K; k0 += 64) {
    SST(Asb, 0, ra0); SST(Asb, 1, ra1); SST(Asb, 2, ra2); SST(Asb, 3, ra3);
    SST(Bsb, 0, rb0); SST(Bsb, 1, rb1); SST(Bsb, 2, rb2); SST(Bsb, 3, rb3);
    __syncthreads();
    if (k0 + 64 < K) {
      const size_t kb = (size_t)(k0 + 64) * 2;
      LDALL(kb)
    }
    {
      const bf16* ap = As + (wm * 64 + l31) * 72 + lh * 8;
      const bf16* bp = Bs + (wn * 64 + l31) * 72 + lh * 8;
#define LDA_(tm, ks) (*(const bf16x8*)(ap + (tm) * 32 * 72 + (ks) * 16))
#define LDB_(tn, ks) (*(const bf16x8*)(bp + (tn) * 32 * 72 + (ks) * 16))
#define STEP(B0_, B1_, N0_, N1_, ks, more)                                              \
  if (more) { N0_ = LDB_(0, (ks) + 1); N1_ = LDB_(1, (ks) + 1); }                       \
  acc[0][0] = MFMA32(a0, B0_, acc[0][0]); acc[0][1] = MFMA32(a0, B1_, acc[0][1]);       \
  if (more) a0 = LDA_(0, (ks) + 1);                                                     \
  acc[1][0] = MFMA32(a1, B0_, acc[1][0]); acc[1][1] = MFMA32(a1, B1_, acc[1][1]);       \
  if (more) a1 = LDA_(1, (ks) + 1);                                                     \
  __builtin_amdgcn_sched_barrier(0);
      bf16x8 a0 = LDA_(0, 0), a1 = LDA_(1, 0);
      bf16x8 p0 = LDB_(0, 0), p1 = LDB_(1, 0), q0, q1;
      __builtin_amdgcn_sched_barrier(0);
      STEP(p0, p1, q0, q1, 0, true)
      STEP(q0, q1, p0, p1, 1, true)
      STEP(p0, p1, q0, q1, 2, true)
      STEP(q0, q1, p0, p1, 3, false)
#undef LDA_
#undef LDB_
#undef STEP
    }
    __syncthreads();
  }
#undef LDALL
#undef ALD
#undef BLD
#undef SST
}

template <int TM, int WN>
DI void zero_acc(f32x16 (&acc)[TM][WN]) {
#pragma unroll
  for (int a = 0; a < TM; ++a)
#pragma unroll
    for (int b = 0; b < WN; ++b)
#pragma unroll
      for (int i = 0; i < 16; ++i) acc[a][b][i] = 0.f;
}

DI void gemm_main256(const bf16* __restrict__ A, int lda, const bf16* __restrict__ Bt, int ldb, int K,
                     f32x16 (&acc)[4][2], char* lds, const int tid) {
  bf16* As = (bf16*)lds;
  bf16* Bs = As + 256 * 72;
  const int lane = tid & 63, wave = tid >> 6, wm = wave >> 1, wn = wave & 1;
  const int l31 = lane & 31, lh = lane >> 5;
  const uint32_t aoff = (uint32_t)(((tid >> 3) * lda + (tid & 7) * 8) * 2);
  const uint32_t boff = (uint32_t)(((tid >> 3) * ldb + (tid & 7) * 8) * 2);
  const uint32_t soff = (uint32_t)(((tid >> 3) * 72 + (tid & 7) * 8) * 2);
  const char* Ab = (const char*)A;
  const char* Bb = (const char*)Bt;
  char* Asb = (char*)As;
  char* Bsb = (char*)Bs;
  const size_t astep = (size_t)32 * lda * 2, bstep = (size_t)32 * ldb * 2;
  uint4 ra0, ra1, ra2, ra3, ra4, ra5, ra6, ra7, rb0, rb1, rb2, rb3;
#define ALD(i, kb) (*(const uint4*)(Ab + ((size_t)(i) * astep + (kb)) + aoff))
#define BLD(i, kb) (*(const uint4*)(Bb + ((size_t)(i) * bstep + (kb)) + boff))
#define LDALL(kb)                                                                      \
  ra0 = ALD(0, kb); ra1 = ALD(1, kb); ra2 = ALD(2, kb); ra3 = ALD(3, kb);              \
  ra4 = ALD(4, kb); ra5 = ALD(5, kb); ra6 = ALD(6, kb); ra7 = ALD(7, kb);              \
  rb0 = BLD(0, kb); rb1 = BLD(1, kb); rb2 = BLD(2, kb); rb3 = BLD(3, kb);
#define SST(base, i, val) (*(uint4*)((base) + (i) * (32 * 72 * 2) + soff) = (val))
  LDALL((size_t)0)
#pragma unroll 1
  for (int k0 = 0; k0 < K; k0 += 64) {
    SST(Asb, 0, ra0); SST(Asb, 1, ra1); SST(Asb, 2, ra2); SST(Asb, 3, ra3);
    SST(Asb, 4, ra4); SST(Asb, 5, ra5); SST(Asb, 6, ra6); SST(Asb, 7, ra7);
    SST(Bsb, 0, rb0); SST(Bsb, 1, rb1); SST(Bsb, 2, rb2); SST(Bsb, 3, rb3);
    __syncthreads();
    if (k0 + 64 < K) {
      const size_t kb = (size_t)(k0 + 64) * 2;
      LDALL(kb)
    }
    {
      const bf16* ap = As + (wm * 128 + l31) * 72 + lh * 8;
      const bf16* bp = Bs + (wn * 64 + l31) * 72 + lh * 8;
#define LDA_(tm, ks) (*(const bf16x8*)(ap + (tm) * 32 * 72 + (ks) * 16))
#define LDB_(tn, ks) (*(const bf16x8*)(bp + (tn) * 32 * 72 + (ks) * 16))
#define STEP(B0_, B1_, N0_, N1_, ks, more)                                              \
  if (more) { N0_ = LDB_(0, (ks) + 1); N1_ = LDB_(1, (ks) + 1); }                       \
  acc[0][0] = MFMA32(a0, B0_, acc[0][0]); acc[0][1] = MFMA32(a0, B1_, acc[0][1]);       \
  if (more) a0 = LDA_(0, (ks) + 1);                                                     \
  acc[1][0] = MFMA32(a1, B0_, acc[1][0]); acc[1][1] = MFMA32(a1, B1_, acc[1][1]);       \
  if (more) a1 = LDA_(1, (ks) + 1);                                                     \
  acc[2][0] = MFMA32(a2, B0_, acc[2][0]); acc[2][1] = MFMA32(a2, B1_, acc[2][1]);       \
  if (more) a2 = LDA_(2, (ks) + 1);                                                     \
  acc[3][0] = MFMA32(a3, B0_, acc[3][0]); acc[3][1] = MFMA32(a3, B1_, acc[3][1]);       \
  if (more) a3 = LDA_(3, (ks) + 1);                                                     \
  __builtin_amdgcn_sched_barrier(0);
      bf16x8 a0 = LDA_(0, 0), a1 = LDA_(1, 0), a2 = LDA_(2, 0), a3 = LDA_(3, 0);
      bf16x8 p0 = LDB_(0, 0), p1 = LDB_(1, 0), q0, q1;
      __builtin_amdgcn_sched_barrier(0);
      STEP(p0, p1, q0, q1, 0, true)
      STEP(q0, q1, p0, p1, 1, true)
      STEP(p0, p1, q0, q1, 2, true)
      STEP(q0, q1, p0, p1, 3, false)
#undef LDA_
#undef LDB_
#undef STEP
    }
    __syncthreads();
  }
#undef LDALL
#undef ALD
#undef BLD
#undef SST
}

DI bool xcd_tile(int it, int MT, int NTN, int PN, int& mt, int& nt) {
  const int x = blockIdx.x & 7, slot = blockIdx.x >> 3, nslots = gridDim.x >> 3;
  const int MTx = MT >> 3;
  const int lt = slot + it * nslots;
  if (lt >= MTx * NTN) return false;
  const int per_panel = MTx * PN;
  const int pn = lt / per_panel, r = lt - pn * per_panel;
  mt = x * MTx + r / PN;
  nt = pn * PN + r % PN;
  return true;
}

DI void phase_p1(const Params& p, const int wid, int layer, int M, char* lds) {
  const bf16* h = (const bf16*)(p.ws + OFF_H);
  const bf16* W1 = (const bf16*)(p.ws + OFF_W + (size_t)layer * LW);
  const float2* rope = (const float2*)(p.ws + OFF_ROPE);
  bf16* Qa = (bf16*)(p.ws + OFF_QA);
  bf16* Ka = (bf16*)(p.ws + OFF_KA);
  bf16* Vt = (bf16*)(p.ws + OFF_VT);
  bf16* xbc = (bf16*)(p.ws + OFF_XBC);
  bf16* gq = (bf16*)(p.ws + OFF_GQ);
  bf16* gk = (bf16*)(p.ws + OFF_GK);
  bf16* gv = (bf16*)(p.ws + OFF_GV);
  float* dtlr = (float*)(p.ws + OFF_DTLR);
  const int tidf = tid_fresh(p, wid); const int lane = tidf & 63, wave = tidf >> 6, wm = wave >> 1, wn = wave & 1, l31 = lane & 31, lh = lane >> 5;
  constexpr int NTN = N1 / 128;
  int mt_, nt_;
  for (int it = 0; xcd_tile(it, M / 256, NTN, 9, mt_, nt_); ++it) {
    const int m0 = mt_ * 256, n0 = nt_ * 128;
    f32x16 acc[4][2];
    zero_acc<4, 2>(acc);
    gemm_main256(h + (size_t)m0 * 1024, 1024, W1 + (size_t)n0 * 1024, 1024, 1024, acc, lds, tidf);
    const bool lat = m0 < NL;
#pragma unroll
    for (int tm = 0; tm < 4; ++tm)
#pragma unroll
      for (int tn = 0; tn < 2; ++tn) {
        const int col = n0 + wn * 64 + tn * 32 + l31;
        const int rowb = m0 + wm * 128 + tm * 32 + 4 * lh;
        if (n0 < 1024) {
          const int d = col & 63, axis = d >> 5, half = (d >> 4) & 1, f = d & 15;
          bf16* dst = n0 < 512 ? Qa : Ka;
#pragma unroll
          for (int i = 0; i < 16; ++i) {
            const int row = rowb + (i & 3) + 8 * (i >> 2);
            float v = acc[tm][tn][i];
            float partner = __shfl_xor(v, 16);
            if (lat) {
              const int t = row & 8191;
              const int pos = axis ? (t & 63) : (t >> 6);
              float2 cs = rope[pos * 16 + f];
              v = v * cs.x + (half ? partner : -partner) * cs.y;
            }
            if (n0 < 512) v *= QSCALE;
            dst[(size_t)row * 512 + (col & 511)] = f2b(v);
          }
        } else if (n0 < 1536) {
          const int hd = (col - 1024) >> 7, vv = (col - 1024) & 127;
#pragma unroll
          for (int g = 0; g < 4; ++g) {
            const int row0 = rowb + 8 * g;
            int b, key;
            if (lat) { b = row0 >> 13; key = 256 + (row0 & 8191); } else { b = (row0 - NL) >> 8; key = (row0 - NL) & 255; }
            uint2 pk;
            pk.x = pack2(acc[tm][tn][4 * g], acc[tm][tn][4 * g + 1]);
            pk.y = pack2(acc[tm][tn][4 * g + 2], acc[tm][tn][4 * g + 3]);
            *(uint2*)(Vt + ((size_t)((b * 4 + hd) * 128 + vv)) * KEYS + key) = pk;
          }
        } else if (n0 < 3328) {
          bf16* dst; int ld, cc;
          if (n0 < 2304) { dst = xbc; ld = 768; cc = col - 1536; }
          else if (n0 < 2560) { dst = gq; ld = 256; cc = col - 2304; }
          else if (n0 < 2816) { dst = gk; ld = 256; cc = col - 2560; }
          else { dst = gv; ld = 512; cc = col - 2816; }
#pragma unroll
          for (int i = 0; i < 16; ++i) {
            const int row = rowb + (i & 3) + 8 * (i >> 2);
            dst[(size_t)row * ld + cc] = f2b(acc[tm][tn][i]);
          }
        } else {
          const int cc = col - 3328;
          if (cc < 48) {
#pragma unroll
            for (int i = 0; i < 16; ++i) {
              const int row = rowb + (i & 3) + 8 * (i >> 2);
              dtlr[(size_t)row * 48 + cc] = acc[tm][tn][i];
            }
          }
        }
      }
  }
}

DI void phase_conv(const Params& p, const int wid, int layer) {
  const bf16* xin = (const bf16*)(p.ws + OFF_XBC);
  bf16* xo = (bf16*)(p.ws + OFF_XBC2);
  const float* cw = p.conv_w + layer * 3 * 768;
  const float* cb = p.conv_b + layer * 768;
  const int total = NT * 96;
  for (int idx = blockIdx.x * 256 + tid_fresh(p, wid); idx < total; idx += gridDim.x * 256) {
    const int row = idx / 96, c0 = (idx % 96) * 8;
    int t, L;
    if (row < NL) { t = row & 8191; L = 8192; } else { t = (row - NL) & 255; L = 256; }
    uint4 cur = *(const uint4*)(xin + (size_t)row * 768 + c0);
    uint4 prv = make_uint4(0, 0, 0, 0), nxt = make_uint4(0, 0, 0, 0);
    if (t > 0) prv = *(const uint4*)(xin + (size_t)(row - 1) * 768 + c0);
    if (t < L - 1) nxt = *(const uint4*)(xin + (size_t)(row + 1) * 768 + c0);
    const uint32_t cu[4] = {cur.x, cur.y, cur.z, cur.w}, pu[4] = {prv.x, prv.y, prv.z, prv.w}, nu[4] = {nxt.x, nxt.y, nxt.z, nxt.w};
    uint32_t ou[4];
#pragma unroll
    for (int q = 0; q < 4; ++q) {
      const int c = c0 + 2 * q;
      float a0 = cw[c] * blo(pu[q]) + cw[768 + c] * blo(cu[q]) + cw[1536 + c] * blo(nu[q]) + cb[c];
      float a1 = cw[c + 1] * bhi(pu[q]) + cw[768 + c + 1] * bhi(cu[q]) + cw[1536 + c + 1] * bhi(nu[q]) + cb[c + 1];
      ou[q] = pack2(siluf(a0), siluf(a1));
    }
    *(uint4*)(xo + (size_t)row * 768 + c0) = make_uint4(ou[0], ou[1], ou[2], ou[3]);
  }
}

DI int scan_row(int b, int dir, int s) {
  if (s < 256) { int t = dir ? 255 - s : s; return NL + b * 256 + t; }
  int t = s - 256;
  if (dir) t = 8191 - t;
  return b * 8192 + t;
}

template <bool GLA>
DI void scan_item(const Params& p, const int wid, int layer, int item, char* lds) {
  constexpr int CT = 16;
  constexpr int V = GLA ? 128 : 64;
  constexpr int NJ = V / 32;
  constexpr int BV = V / 16;
  float* a_s = (float*)lds;
  float* c_s = a_s + CT * 64;
  float* w_s = c_s + CT * 64;
  float* b_s = w_s + CT * 64;
  float* x_s = b_s + CT * V;
  float* op = x_s + (GLA ? 0 : CT * V);
  float* wg_s = op + CT * 4 * V;
  const int tid = tid_fresh(p, wid), lane = tid & 63, wave = tid >> 6;
  int head, dir, b;
  if (GLA) { head = item & 3; dir = (item >> 2) & 1; b = item >> 3; } else { head = item & 7; dir = (item >> 3) & 1; b = item >> 4; }
  const bf16* xbc = (const bf16*)(p.ws + OFF_XBC2);
  const bf16* gq = (const bf16*)(p.ws + OFF_GQ);
  const bf16* gk = (const bf16*)(p.ws + OFF_GK);
  const bf16* gv = (const bf16*)(p.ws + OFF_GV);
  const float* dtlr = (const float*)(p.ws + OFF_DTLR);
  bf16* yout = (bf16*)(p.ws + (GLA ? (dir ? OFF_YGB : OFF_YGF) : (dir ? OFF_YSB : OFF_YSF)));
  const int ocol = head * V;
  float Aneg = 0.f, Dsk = 0.f, dtb = 0.f;
  if (!GLA) {
    Aneg = -expf(p.a_log[layer * 16 + dir * 8 + head]);
    Dsk = p.ssm_d[layer * 16 + dir * 8 + head];
    dtb = p.dt_bias[layer * 16 + dir * 8 + head];
  } else {
    const float* wg = p.gla_w_gate + ((size_t)(layer * 2 + dir) * 16) * 256 + head * 64;
    for (int idx = tid; idx < 16 * 64; idx += 256) wg_s[idx] = wg[(idx >> 6) * 256 + (idx & 63)];
    if (tid < 64) wg_s[1024 + tid] = p.gla_b_gate[(layer * 2 + dir) * 256 + head * 64 + tid];
  }
  const int st = tid >> 4, sk4 = (tid & 15) * 4, sv = (tid & 15) * BV;
  const int vq = lane & 31, kg = wave * 2 + (lane >> 5);
  float S[8][NJ];
#pragma unroll
  for (int i = 0; i < 8; ++i)
#pragma unroll
    for (int j = 0; j < NJ; ++j) S[i][j] = 0.f;

  uint2 ra, rc; uint4 rbv; float rdt = 0.f; float4 rlr0, rlr1, rlr2, rlr3;
  rlr0 = rlr1 = rlr2 = rlr3 = make_float4(0.f, 0.f, 0.f, 0.f);
  rbv = make_uint4(0, 0, 0, 0);
#define SCAN_PREFETCH(chunk_)                                                                   \
  {                                                                                             \
    const int row_ = scan_row(b, dir, (chunk_) * CT + st);                                      \
    if (GLA) {                                                                                  \
      ra = *(const uint2*)(gk + (size_t)row_ * 256 + head * 64 + sk4);                          \
      rc = *(const uint2*)(gq + (size_t)row_ * 256 + head * 64 + sk4);                          \
      rbv = *(const uint4*)(gv + (size_t)row_ * 512 + head * 128 + sv);                         \
      const float* lr_ = dtlr + (size_t)row_ * 48 + 16 + dir * 16;                              \
      rlr0 = *(const float4*)(lr_); rlr1 = *(const float4*)(lr_ + 4);                           \
      rlr2 = *(const float4*)(lr_ + 8); rlr3 = *(const float4*)(lr_ + 12);                      \
    } else {                                                                                    \
      const int g_ = head >> 2;                                                                 \
      ra = *(const uint2*)(xbc + (size_t)row_ * 768 + 512 + g_ * 64 + sk4);                     \
      rc = *(const uint2*)(xbc + (size_t)row_ * 768 + 640 + g_ * 64 + sk4);                     \
      const uint2 t_ = *(const uint2*)(xbc + (size_t)row_ * 768 + head * 64 + sv);              \
      rbv.x = t_.x; rbv.y = t_.y;                                                               \
      rdt = dtlr[(size_t)row_ * 48 + dir * 8 + head];                                           \
    }                                                                                           \
  }
  SCAN_PREFETCH(0);
  constexpr int NCH = KEYS / CT;
  for (int chunk = 0; chunk < NCH; ++chunk) {
    {
      const float cscale = GLA ? 0.125f : 1.f;
      *(float4*)(a_s + st * 64 + sk4) = make_float4(blo(ra.x), bhi(ra.x), blo(ra.y), bhi(ra.y));
      *(float4*)(c_s + st * 64 + sk4) = make_float4(blo(rc.x) * cscale, bhi(rc.x) * cscale, blo(rc.y) * cscale, bhi(rc.y) * cscale);
      if (GLA) {
        *(float4*)(b_s + st * V + sv) = make_float4(blo(rbv.x), bhi(rbv.x), blo(rbv.y), bhi(rbv.y));
        *(float4*)(b_s + st * V + sv + 4) = make_float4(blo(rbv.z), bhi(rbv.z), blo(rbv.w), bhi(rbv.w));
        float4 zb = *(const float4*)(wg_s + 1024 + sk4);
        float z0 = zb.x, z1 = zb.y, z2 = zb.z, z3 = zb.w;
#define GROW(r_, lv_)                                                  \
  {                                                                    \
    const float4 w0_ = *(const float4*)(wg_s + (r_) * 64 + sk4);       \
    z0 = fmaf((lv_), w0_.x, z0); z1 = fmaf((lv_), w0_.y, z1); z2 = fmaf((lv_), w0_.z, z2); z3 = fmaf((lv_), w0_.w, z3); \
  }
        GROW(0, rlr0.x) GROW(1, rlr0.y) GROW(2, rlr0.z) GROW(3, rlr0.w)
        GROW(4, rlr1.x) GROW(5, rlr1.y) GROW(6, rlr1.z) GROW(7, rlr1.w)
        GROW(8, rlr2.x) GROW(9, rlr2.y) GROW(10, rlr2.z) GROW(11, rlr2.w)
        GROW(12, rlr3.x) GROW(13, rlr3.y) GROW(14, rlr3.z) GROW(15, rlr3.w)
#define LSIG16(zz) expf(((zz) >= 0.f ? -log1pf(expf(-(zz))) : (zz) - log1pf(expf(zz))) * (1.f / 16.f))
        *(float4*)(w_s + st * 64 + sk4) = make_float4(LSIG16(z0), LSIG16(z1), LSIG16(z2), LSIG16(z3));
      } else {
        float zz = rdt + dtb;
        float dt = zz > 20.f ? zz : log1pf(expf(zz));
        float4 xv = make_float4(blo(rbv.x), bhi(rbv.x), blo(rbv.y), bhi(rbv.y));
        *(float4*)(b_s + st * V + sv) = make_float4(xv.x * dt, xv.y * dt, xv.z * dt, xv.w * dt);
        *(float4*)(x_s + st * V + sv) = xv;
        if ((tid & 15) == 0) w_s[st] = expf(dt * Aneg);
      }
    }
    __syncthreads();
    if (chunk + 1 < NCH) SCAN_PREFETCH(chunk + 1);
#pragma unroll 4
    for (int tt = 0; tt < CT; ++tt) {
      const float4 a0 = *(const float4*)(a_s + tt * 64 + kg * 8), a1 = *(const float4*)(a_s + tt * 64 + kg * 8 + 4);
      const float4 c0 = *(const float4*)(c_s + tt * 64 + kg * 8), c1 = *(const float4*)(c_s + tt * 64 + kg * 8 + 4);
      const float av[8] = {a0.x, a0.y, a0.z, a0.w, a1.x, a1.y, a1.z, a1.w};
      const float cv[8] = {c0.x, c0.y, c0.z, c0.w, c1.x, c1.y, c1.z, c1.w};
      float wv[8];
      if (GLA) {
        const float4 w0 = *(const float4*)(w_s + tt * 64 + kg * 8), w1 = *(const float4*)(w_s + tt * 64 + kg * 8 + 4);
        wv[0] = w0.x; wv[1] = w0.y; wv[2] = w0.z; wv[3] = w0.w; wv[4] = w1.x; wv[5] = w1.y; wv[6] = w1.z; wv[7] = w1.w;
      } else {
        const float w = w_s[tt];
#pragma unroll
        for (int i = 0; i < 8; ++i) wv[i] = w;
      }
      float bv[NJ], o[NJ];
#pragma unroll
      for (int j = 0; j < NJ; ++j) { bv[j] = b_s[tt * V + vq + 32 * j]; o[j] = 0.f; }
#pragma unroll
      for (int i = 0; i < 8; ++i)
#pragma unroll
        for (int j = 0; j < NJ; ++j) {
          S[i][j] = fmaf(wv[i], S[i][j], av[i] * bv[j]);
          o[j] = fmaf(cv[i], S[i][j], o[j]);
        }
#pragma unroll
      for (int j = 0; j < NJ; ++j) {
        o[j] += __shfl_xor(o[j], 32);
        if (lane < 32) op[(tt * 4 + wave) * V + vq + 32 * j] = o[j];
      }
    }
    __syncthreads();
    {
      const int row = scan_row(b, dir, chunk * CT + st);
#pragma unroll
      for (int q = 0; q < BV / 4; ++q) {
        const int vc = sv + 4 * q;
        float4 o0 = *(const float4*)(op + (st * 4 + 0) * V + vc), o1 = *(const float4*)(op + (st * 4 + 1) * V + vc);
        float4 o2 = *(const float4*)(op + (st * 4 + 2) * V + vc), o3 = *(const float4*)(op + (st * 4 + 3) * V + vc);
        float r0 = o0.x + o1.x + o2.x + o3.x, r1 = o0.y + o1.y + o2.y + o3.y, r2 = o0.z + o1.z + o2.z + o3.z, r3 = o0.w + o1.w + o2.w + o3.w;
        if (!GLA) {
          float4 xv = *(const float4*)(x_s + st * V + vc);
          r0 = fmaf(Dsk, xv.x, r0); r1 = fmaf(Dsk, xv.y, r1); r2 = fmaf(Dsk, xv.z, r2); r3 = fmaf(Dsk, xv.w, r3);
        }
        uint2 pk; pk.x = pack2(r0, r1); pk.y = pack2(r2, r3);
        *(uint2*)(yout + (size_t)row * 512 + ocol + vc) = pk;
      }
    }
  }
  __syncthreads();
#undef SCAN_PREFETCH
#undef GROW
#undef LSIG16
}

DI bf16x8 pack8(const f32x16& x, int s) {
  uint32_t p0 = pack2(x[8 * s], x[8 * s + 1]), p1 = pack2(x[8 * s + 2], x[8 * s + 3]);
  uint32_t p2 = pack2(x[8 * s + 4], x[8 * s + 5]), p3 = pack2(x[8 * s + 6], x[8 * s + 7]);
  uint4 u = make_uint4(p0, p1, p2, p3);
  return __builtin_bit_cast(bf16x8, u);
}

template <bool GLA>
DI void cscan_item(const Params& p, const int wid, int layer, int item, char* lds) {
  constexpr int RS = 72;
  bf16* Qm = (bf16*)lds;
  bf16* Km = Qm + 64 * RS;
  bf16* KeT = Km + 64 * RS;
  bf16* bT = KeT + 64 * RS;
  bf16* ST = bT + 64 * RS;
  char* R = (char*)(ST + 64 * RS);
  float* Gf = (float*)R;
  bf16* Cm = (bf16*)R;
  float* Gs = (float*)(R + 64 * RS * 2);
  float* tot = (float*)(R + 16384);
  float* lr_s = tot + 256;
  const int tid = tid_fresh(p, wid), lane = tid & 63, wave = tid >> 6, l31 = lane & 31, lh = lane >> 5;
  const int nt = wave & 1, vh = wave >> 1;
  int head, dir, b, vhalf = 0;
  if (GLA) { vhalf = item & 1; head = (item >> 1) & 3; } else { head = item & 7; }
  dir = (item >> 3) & 1; b = item >> 4;
  const bf16* xbc = (const bf16*)(p.ws + OFF_XBC2);
  const bf16* gq = (const bf16*)(p.ws + OFF_GQ);
  const bf16* gk = (const bf16*)(p.ws + OFF_GK);
  const bf16* gv = (const bf16*)(p.ws + OFF_GV);
  const float* dtlr = (const float*)(p.ws + OFF_DTLR);
  bf16* yout = (bf16*)(p.ws + (GLA ? (dir ? OFF_YGB : OFF_YGF) : (dir ? OFF_YSB : OFF_YSF)));
  const int ocol = GLA ? head * 128 + vhalf * 64 : head * 64;
  float Aneg = 0.f, Dsk = 0.f, dtb = 0.f, bgk = 0.f;
  float wgk[16];
#pragma unroll
  for (int r = 0; r < 16; ++r) wgk[r] = 0.f;
  if (!GLA) {
    Aneg = -expf(p.a_log[layer * 16 + dir * 8 + head]);
    Dsk = p.ssm_d[layer * 16 + dir * 8 + head];
    dtb = p.dt_bias[layer * 16 + dir * 8 + head];
  } else {
    const float* wg = p.gla_w_gate + ((size_t)(layer * 2 + dir) * 16) * 256 + head * 64 + (tid & 63);
#pragma unroll
    for (int r = 0; r < 16; ++r) wgk[r] = wg[r * 256];
    bgk = p.gla_b_gate[(layer * 2 + dir) * 256 + head * 64 + (tid & 63)];
  }
  const int st = tid >> 2, k16 = (tid & 3) * 16;
  f32x16 Sacc;
#pragma unroll
  for (int i = 0; i < 16; ++i) Sacc[i] = 0.f;

  uint4 ra0, ra1, rc0, rc1, rb0, rb1; float4 rl;
#define CS_PREFETCH(chunk_)                                                                          \
  {                                                                                                  \
    const int row_ = scan_row(b, dir, (chunk_) * 64 + st);                                           \
    if (GLA) {                                                                                       \
      const uint4* ap_ = (const uint4*)(gk + (size_t)row_ * 256 + head * 64 + k16);                  \
      const uint4* cp_ = (const uint4*)(gq + (size_t)row_ * 256 + head * 64 + k16);                  \
      const uint4* bp_ = (const uint4*)(gv + (size_t)row_ * 512 + head * 128 + vhalf * 64 + k16);    \
      ra0 = ap_[0]; ra1 = ap_[1]; rc0 = cp_[0]; rc1 = cp_[1]; rb0 = bp_[0]; rb1 = bp_[1];            \
      rl = *(const float4*)(dtlr + (size_t)row_ * 48 + 16 + dir * 16 + (tid & 3) * 4);               \
    } else {                                                                                         \
      const int g_ = head >> 2;                                                                      \
      const uint4* ap_ = (const uint4*)(xbc + (size_t)row_ * 768 + 512 + g_ * 64 + k16);             \
      const uint4* cp_ = (const uint4*)(xbc + (size_t)row_ * 768 + 640 + g_ * 64 + k16);             \
      const uint4* bp_ = (const uint4*)(xbc + (size_t)row_ * 768 + head * 64 + k16);                 \
      ra0 = ap_[0]; ra1 = ap_[1]; rc0 = cp_[0]; rc1 = cp_[1]; rb0 = bp_[0]; rb1 = bp_[1];            \
      rl.x = dtlr[(size_t)row_ * 48 + dir * 8 + head]; rl.y = 0.f; rl.z = 0.f; rl.w = 0.f;           \
    }                                                                                                \
  }
  CS_PREFETCH(0);
#pragma unroll 1
  for (int chunk = 0; chunk < KEYS / 64; ++chunk) {
    float dt = 0.f;
    if (GLA) {
      *(float4*)(lr_s + st * 16 + (tid & 3) * 4) = rl;
      __syncthreads();
      float Gl[16];
      float run = 0.f;
#pragma unroll
      for (int i = 0; i < 16; ++i) {
        const float* lrp = lr_s + (wave * 16 + i) * 16;
        const float4 l0 = *(const float4*)(lrp), l1 = *(const float4*)(lrp + 4), l2 = *(const float4*)(lrp + 8), l3 = *(const float4*)(lrp + 12);
        float z = bgk;
        z = fmaf(l0.x, wgk[0], z); z = fmaf(l0.y, wgk[1], z); z = fmaf(l0.z, wgk[2], z); z = fmaf(l0.w, wgk[3], z);
        z = fmaf(l1.x, wgk[4], z); z = fmaf(l1.y, wgk[5], z); z = fmaf(l1.z, wgk[6], z); z = fmaf(l1.w, wgk[7], z);
        z = fmaf(l2.x, wgk[8], z); z = fmaf(l2.y, wgk[9], z); z = fmaf(l2.z, wgk[10], z); z = fmaf(l2.w, wgk[11], z);
        z = fmaf(l3.x, wgk[12], z); z = fmaf(l3.y, wgk[13], z); z = fmaf(l3.z, wgk[14], z); z = fmaf(l3.w, wgk[15], z);
        run -= (fmaxf(-z, 0.f) + __logf(1.f + __expf(-fabsf(z)))) * (1.f / 16.f);
        Gl[i] = run;
      }
      tot[wave * 64 + lane] = run;
      __syncthreads();
      float off = 0.f;
      if (wave > 0) off += tot[lane];
      if (wave > 1) off += tot[64 + lane];
      if (wave > 2) off += tot[128 + lane];
#pragma unroll
      for (int i = 0; i < 16; ++i) Gf[(wave * 16 + i) * 64 + lane] = Gl[i] + off;
    } else {
      const float zz = rl.x + dtb;
      dt = zz > 20.f ? zz : log1pf(expf(zz));
      if ((tid & 3) == 0) lr_s[st] = dt;
      __syncthreads();
      if (wave == 0) {
        float g = lr_s[lane] * Aneg;
#pragma unroll
        for (int o = 1; o < 64; o <<= 1) {
          const float v = __shfl_up(g, o);
          if (lane >= o) g += v;
        }
        Gs[lane] = g;
      }
    }
#pragma unroll
    for (int i = 0; i < 16; ++i)
      ST[(32 * (wave >> 1) + (i & 3) + 8 * (i >> 2) + 4 * lh) * RS + 32 * (wave & 1) + l31] = f2b(Sacc[i]);
    __syncthreads();
    {
      const uint32_t au[8] = {ra0.x, ra0.y, ra0.z, ra0.w, ra1.x, ra1.y, ra1.z, ra1.w};
      const uint32_t cu[8] = {rc0.x, rc0.y, rc0.z, rc0.w, rc1.x, rc1.y, rc1.z, rc1.w};
      const uint32_t bu[8] = {rb0.x, rb0.y, rb0.z, rb0.w, rb1.x, rb1.y, rb1.z, rb1.w};
      uint32_t qo[8], ko[8];
      if (GLA) {
#pragma unroll
        for (int q = 0; q < 4; ++q) {
          const float4 G4 = *(const float4*)(Gf + st * 64 + k16 + 4 * q);
          const float4 L4 = *(const float4*)(Gf + 63 * 64 + k16 + 4 * q);
          const float gg[4] = {G4.x, G4.y, G4.z, G4.w}, ll[4] = {L4.x, L4.y, L4.z, L4.w};
#pragma unroll
          for (int h2 = 0; h2 < 2; ++h2) {
            const int w = 2 * q + h2;
            const float a0 = blo(au[w]), a1 = bhi(au[w]), c0 = blo(cu[w]), c1 = bhi(cu[w]);
            const float g0 = gg[2 * h2], g1 = gg[2 * h2 + 1];
            qo[w] = pack2(c0 * 0.125f * __expf(g0), c1 * 0.125f * __expf(g1));
            ko[w] = pack2(a0 * __expf(-g0), a1 * __expf(-g1));
            KeT[(k16 + 2 * w) * RS + st] = f2b(a0 * __expf(ll[2 * h2] - g0));
            KeT[(k16 + 2 * w + 1) * RS + st] = f2b(a1 * __expf(ll[2 * h2 + 1] - g1));
            bT[(k16 + 2 * w) * RS + st] = (bf16)(bu[w] & 0xffffu);
            bT[(k16 + 2 * w + 1) * RS + st] = (bf16)(bu[w] >> 16);
          }
        }
      } else {
        const float Gt = Gs[st], GL = Gs[63];
        const float e1 = __expf(Gt), e3 = __expf(GL - Gt);
#pragma unroll
        for (int w = 0; w < 8; ++w) {
          const float a0 = blo(au[w]), a1 = bhi(au[w]), c0 = blo(cu[w]), c1 = bhi(cu[w]);
          qo[w] = pack2(c0 * e1, c1 * e1);
          ko[w] = au[w];
          KeT[(k16 + 2 * w) * RS + st] = f2b(a0 * e3);
          KeT[(k16 + 2 * w + 1) * RS + st] = f2b(a1 * e3);
          bT[(k16 + 2 * w) * RS + st] = f2b(blo(bu[w]) * dt);
          bT[(k16 + 2 * w + 1) * RS + st] = f2b(bhi(bu[w]) * dt);
        }
        *(uint4*)(Cm + st * RS + k16) = rc0;
        *(uint4*)(Cm + st * RS + k16 + 8) = rc1;
      }
      *(uint4*)(Qm + st * RS + k16) = make_uint4(qo[0], qo[1], qo[2], qo[3]);
      *(uint4*)(Qm + st * RS + k16 + 8) = make_uint4(qo[4], qo[5], qo[6], qo[7]);
      *(uint4*)(Km + st * RS + k16) = make_uint4(ko[0], ko[1], ko[2], ko[3]);
      *(uint4*)(Km + st * RS + k16 + 8) = make_uint4(ko[4], ko[5], ko[6], ko[7]);
    }
    __syncthreads();
    if (chunk + 1 < KEYS / 64) CS_PREFETCH(chunk + 1);
    const int trow = scan_row(b, dir, chunk * 64 + 32 * nt + l31);
    uint2 xr0 = make_uint2(0, 0), xr1 = xr0, xr2 = xr0, xr3 = xr0;
    if (!GLA) {
      const bf16* xp = xbc + (size_t)trow * 768 + head * 64 + 32 * vh + 4 * lh;
      xr0 = *(const uint2*)(xp); xr1 = *(const uint2*)(xp + 8); xr2 = *(const uint2*)(xp + 16); xr3 = *(const uint2*)(xp + 24);
    }
    f32x16 outv;
#pragma unroll
    for (int i = 0; i < 16; ++i) outv[i] = 0.f;
    const bf16* Qp = GLA ? Qm : Cm;
#pragma unroll
    for (int ms = 0; ms < 2; ++ms) {
      if (ms <= nt) {
        f32x16 at;
#pragma unroll
        for (int i = 0; i < 16; ++i) at[i] = 0.f;
#pragma unroll
        for (int ks = 0; ks < 4; ++ks) {
          const bf16x8 kf = *(const bf16x8*)(Km + (32 * ms + l31) * RS + ks * 16 + lh * 8);
          const bf16x8 qf = *(const bf16x8*)(Qp + (32 * nt + l31) * RS + ks * 16 + lh * 8);
          at = MFMA32(kf, qf, at);
        }
        if (!GLA) {
          const float gt = Gs[32 * nt + l31];
#pragma unroll
          for (int g4 = 0; g4 < 4; ++g4) {
            const float4 gs4 = *(const float4*)(Gs + 32 * ms + 8 * g4 + 4 * lh);
            const float gsv[4] = {gs4.x, gs4.y, gs4.z, gs4.w};
#pragma unroll
            for (int j = 0; j < 4; ++j) {
              const int sl = 8 * g4 + 4 * lh + j;
              const bool keep = (ms < nt) || (sl <= l31);
              at[4 * g4 + j] = keep ? at[4 * g4 + j] * __expf(gt - gsv[j]) : 0.f;
            }
          }
        } else if (ms == nt) {
#pragma unroll
          for (int i = 0; i < 16; ++i) {
            const int sl = (i & 3) + 8 * (i >> 2) + 4 * lh;
            at[i] = (sl <= l31) ? at[i] : 0.f;
          }
        }
#pragma unroll
        for (int s2 = 0; s2 < 2; ++s2) {
          const bf16x8 pf = pack8(at, s2);
          const bf16* vp = bT + (32 * vh + l31) * RS + 32 * ms + 16 * s2 + 4 * lh;
          const uint2 lo = *(const uint2*)vp, hi = *(const uint2*)(vp + 8);
          const uint4 u = make_uint4(lo.x, lo.y, hi.x, hi.y);
          outv = MFMA32(__builtin_bit_cast(bf16x8, u), pf, outv);
        }
      }
    }
#pragma unroll
    for (int ks = 0; ks < 4; ++ks) {
      const bf16x8 sf = *(const bf16x8*)(ST + (32 * vh + l31) * RS + ks * 16 + lh * 8);
      const bf16x8 qf = *(const bf16x8*)(Qm + (32 * nt + l31) * RS + ks * 16 + lh * 8);
      outv = MFMA32(sf, qf, outv);
    }
    {
      const float dec = GLA ? __expf(Gf[63 * 64 + 32 * (wave & 1) + l31]) : __expf(Gs[63]);
#pragma unroll
      for (int i = 0; i < 16; ++i) Sacc[i] *= dec;
#pragma unroll
      for (int ks = 0; ks < 4; ++ks) {
        const bf16x8 bf_ = *(const bf16x8*)(bT + (32 * (wave >> 1) + l31) * RS + ks * 16 + lh * 8);
        const bf16x8 kf = *(const bf16x8*)(KeT + (32 * (wave & 1) + l31) * RS + ks * 16 + lh * 8);
        Sacc = MFMA32(bf_, kf, Sacc);
      }
    }
    {
      bf16* yp = yout + (size_t)trow * 512 + ocol + 32 * vh + 4 * lh;
      const uint2 xr[4] = {xr0, xr1, xr2, xr3};
#pragma unroll
      for (int g4 = 0; g4 < 4; ++g4) {
        float r0 = outv[4 * g4], r1 = outv[4 * g4 + 1], r2 = outv[4 * g4 + 2], r3 = outv[4 * g4 + 3];
        if (!GLA) {
          r0 = fmaf(Dsk, blo(xr[g4].x), r0); r1 = fmaf(Dsk, bhi(xr[g4].x), r1);
          r2 = fmaf(Dsk, blo(xr[g4].y), r2); r3 = fmaf(Dsk, bhi(xr[g4].y), r3);
        }
        uint2 pk; pk.x = pack2(r0, r1); pk.y = pack2(r2, r3);
        *(uint2*)(yp + 8 * g4) = pk;
      }
    }
    __syncthreads();
  }
#undef CS_PREFETCH
}


DI void attn_item(const Params& p, const int wid, int layer, int b, int head, int qrow0, int nkeys, char* lds) {
  bf16* Ks = (bf16*)lds;
  bf16* Vs = Ks + 64 * 136;
  bf16* Qa = (bf16*)(p.ws + OFF_QA);
  const bf16* Ka = (const bf16*)(p.ws + OFF_KA);
  const bf16* Vt = (const bf16*)(p.ws + OFF_VT) + (size_t)(b * 4 + head) * 128 * KEYS;
  const int tid = tid_fresh(p, wid), lane = tid & 63, wave = tid >> 6, l31 = lane & 31, lh = lane >> 5;

  bf16* Qs = Vs + 128 * 68;
#pragma unroll
  for (int i = 0; i < 8; ++i) {
    const int ch = tid + 256 * i;
    *(uint4*)(Qs + (ch >> 4) * 136 + (ch & 15) * 8) = *(const uint4*)(Qa + (size_t)(qrow0 + (ch >> 4)) * 512 + head * 128 + (ch & 15) * 8);
  }
  const bf16* qsw = Qs + (wave * 32 + l31) * 136 + lh * 8;
  f32x16 O[2][4];
#pragma unroll
  for (int c = 0; c < 2; ++c)
#pragma unroll
    for (int vt = 0; vt < 4; ++vt)
#pragma unroll
      for (int i = 0; i < 16; ++i) O[c][vt][i] = 0.f;
  float mrun[2] = {-1e30f, -1e30f}, lrun[2] = {0.f, 0.f};

  const int lkey = tid >> 2, lkq = (tid & 3) * 32, lvr = tid >> 1, lvh = (tid & 1) * 32;
#define KROW(key) ((key) < 256 ? NL + b * 256 + (key) : b * 8192 + (key) - 256)
#define KVLOAD(k0_)                                                                                  \
  {                                                                                                  \
    const uint4* kp_ = (const uint4*)(Ka + (size_t)KROW((k0_) + lkey) * 512 + head * 128 + lkq);      \
    rk0 = kp_[0]; rk1 = kp_[1]; rk2 = kp_[2]; rk3 = kp_[3];                                          \
    const uint4* vp_ = (const uint4*)(Vt + (size_t)lvr * KEYS + (k0_) + lvh);                        \
    rv0 = vp_[0]; rv1 = vp_[1]; rv2 = vp_[2]; rv3 = vp_[3];                                          \
  }
#define VST2(dst_, val) { (dst_)[0] = make_uint2((val).x, (val).y); (dst_)[1] = make_uint2((val).z, (val).w); }
  uint4 rk0, rk1, rk2, rk3, rv0, rv1, rv2, rv3;
  KVLOAD(0);
#pragma unroll 1
  for (int k0 = 0; k0 < nkeys; k0 += 64) {
    {
      uint4* kd = (uint4*)(Ks + lkey * 136 + lkq);
      kd[0] = rk0; kd[1] = rk1; kd[2] = rk2; kd[3] = rk3;
      uint2* vd = (uint2*)(Vs + lvr * 68 + lvh);
      VST2(vd, rv0); VST2(vd + 2, rv1); VST2(vd + 4, rv2); VST2(vd + 6, rv3);
    }
    __syncthreads();
    if (k0 + 64 < nkeys) KVLOAD(k0 + 64);
#pragma unroll
    for (int c = 0; c < 2; ++c) {
#pragma unroll
      for (int mt = 0; mt < 2; ++mt) {
        f32x16 sv;
#pragma unroll
        for (int i = 0; i < 16; ++i) sv[i] = 0.f;
#pragma unroll
        for (int ks = 0; ks < 4; ++ks) {
          const bf16x8 qf = *(const bf16x8*)(qsw + c * 64 + ks * 16);
          const bf16x8 kf = *(const bf16x8*)(Ks + (mt * 32 + l31) * 136 + c * 64 + ks * 16 + lh * 8);
          sv = MFMA32(kf, qf, sv);
        }
        __builtin_amdgcn_sched_barrier(0);
        const bf16* vpb = Vs + l31 * 68 + mt * 32 + 4 * lh;
#define VLD_(vt, st) ({ const bf16* vp_ = vpb + (vt) * 32 * 68 + 16 * (st); const uint2 lo_ = *(const uint2*)vp_, hi_ = *(const uint2*)(vp_ + 8); \
                        __builtin_bit_cast(bf16x8, make_uint4(lo_.x, lo_.y, hi_.x, hi_.y)); })
        bf16x8 v0, v1, v2, v3;
        float mx = fmaxf(sv[0], sv[1]);
#pragma unroll
        for (int i = 2; i < 16; i += 2) mx = max3f(mx, sv[i], sv[i + 1]);
        mx = xhalf_max(mx);
        if (__any(mx - mrun[c] > 8.0f)) {
          const float mnew = fmaxf(mrun[c], mx);
          const float alpha = __builtin_amdgcn_exp2f(mrun[c] - mnew);
          mrun[c] = mnew;
          lrun[c] *= alpha;
#pragma unroll
          for (int vt = 0; vt < 4; ++vt)
#pragma unroll
            for (int i = 0; i < 16; ++i) O[c][vt][i] *= alpha;
        }
        float psum = 0.f;
#pragma unroll
        for (int i = 0; i < 16; ++i) {
          float pv = __builtin_amdgcn_exp2f(sv[i] - mrun[c]);
          sv[i] = pv;
          psum += pv;
        }
        lrun[c] += psum;
        v0 = VLD_(0, 0); v1 = VLD_(1, 0); v2 = VLD_(2, 0); v3 = VLD_(3, 0);
        __builtin_amdgcn_sched_barrier(0);
        {
          const bf16x8 pf = pack8(sv, 0);
          O[c][0] = MFMA32(v0, pf, O[c][0]); O[c][1] = MFMA32(v1, pf, O[c][1]);
          O[c][2] = MFMA32(v2, pf, O[c][2]); O[c][3] = MFMA32(v3, pf, O[c][3]);
          v0 = VLD_(0, 1); v1 = VLD_(1, 1); v2 = VLD_(2, 1); v3 = VLD_(3, 1);
        }
        __builtin_amdgcn_sched_barrier(0);
        {
          const bf16x8 pf = pack8(sv, 1);
          O[c][0] = MFMA32(v0, pf, O[c][0]); O[c][1] = MFMA32(v1, pf, O[c][1]);
          O[c][2] = MFMA32(v2, pf, O[c][2]); O[c][3] = MFMA32(v3, pf, O[c][3]);
        }
        __builtin_amdgcn_sched_barrier(0);
#undef VLD_
      }
    }
    __syncthreads();
  }
  const float lam = ((const float*)(p.ws + OFF_MISC))[layer];
  const float lam_init = layer == 0 ? 0.2f : 0.8f - 0.6f * 0.7408182206817179f;
  const float l1 = lrun[0] + __shfl_xor(lrun[0], 32);
  const float l2 = lrun[1] + __shfl_xor(lrun[1], 32);
  const float i1 = 1.f / l1, i2 = lam / l2;
  float ss = 0.f;
#pragma unroll
  for (int vt = 0; vt < 4; ++vt)
#pragma unroll
    for (int i = 0; i < 16; ++i) {
      float o = O[0][vt][i] * i1 - O[1][vt][i] * i2;
      O[0][vt][i] = o;
      ss += o * o;
    }
  ss += __shfl_xor(ss, 32);
  const float rstd = rsqrtf(ss * (1.f / 128.f) + EPS) * (1.f - lam_init);
  const float* nw = p.da_norm_w + layer * 128;
  bf16* orow = Qa + (size_t)(qrow0 + wave * 32 + l31) * 512 + head * 128;
#pragma unroll
  for (int vt = 0; vt < 4; ++vt)
#pragma unroll
    for (int g = 0; g < 4; ++g) {
      const int v0 = vt * 32 + 8 * g + 4 * lh;
      float4 w4 = *(const float4*)(nw + v0);
      uint2 pk;
      pk.x = pack2(O[0][vt][4 * g] * rstd * w4.x, O[0][vt][4 * g + 1] * rstd * w4.y);
      pk.y = pack2(O[0][vt][4 * g + 2] * rstd * w4.z, O[0][vt][4 * g + 3] * rstd * w4.w);
      *(uint2*)(orow + v0) = pk;
    }
}

DI void phase_mixers(const Params& p, const int wid, int layer, char* lds) {
  __shared__ int s_item;
  const int x = blockIdx.x & 7;
  unsigned* counter = (unsigned*)(p.ws + OFF_MISC + 64) + layer * 8 + x;
  const int total = layer == 0 ? 32 + 256 + 8 : 32 + 256;
  for (;;) {
    if (tid_fresh(p, wid) == 0) s_item = (int)atomicAdd(counter, 1u);
    __syncthreads();
    const int li = s_item;
    __syncthreads();
    if (li >= total) break;
    if (li < 32) {
      const int sid = li * 8 + x;
      if (sid < 128) cscan_item<true>(p, wid, layer, sid, lds);
      else cscan_item<false>(p, wid, layer, sid - 128, lds);
    } else if (li < 288) {
      const int a = li - 32;
      const int bh = x + 8 * (a >> 6), qb = a & 63;
      attn_item(p, wid, layer, bh >> 2, bh & 3, (bh >> 2) * 8192 + qb * 128, KEYS, lds);
    } else {
      const int c = x * 8 + (li - 288);
      const int bh = c >> 1, qb = c & 1;
      attn_item(p, wid, layer, bh >> 2, bh & 3, NL + (bh >> 2) * 256 + qb * 128, 256, lds);
    }
  }
}

DI void phase_z(const Params& p, const int wid, int layer, int M, char* lds) {
  const bf16* h = (const bf16*)(p.ws + OFF_H);
  const bf16* W2 = (const bf16*)(p.ws + OFF_W + (size_t)layer * LW + SZ_W1);
  bf16* Z = (bf16*)(p.ws + OFF_Z);
  const int tidf = tid_fresh(p, wid); const int lane = tidf & 63, wave = tidf >> 6, wm = wave >> 1, wn = wave & 1, l31 = lane & 31, lh = lane >> 5;
  constexpr int NTN = N2 / 128;
  int mt_, nt_;
  for (int it = 0; xcd_tile(it, M / 256, NTN, 12, mt_, nt_); ++it) {
    const int m0 = mt_ * 256, n0 = nt_ * 128;
    f32x16 acc[4][2];
    zero_acc<4, 2>(acc);
    gemm_main256(h + (size_t)m0 * 1024, 1024, W2 + (size_t)n0 * 1024, 1024, 1024, acc, lds, tidf);
#pragma unroll
    for (int tm = 0; tm < 4; ++tm)
#pragma unroll
      for (int tn = 0; tn < 2; ++tn) {
        const int col = n0 + wn * 64 + tn * 32 + l31;
        const int rowb = m0 + wm * 128 + tm * 32 + 4 * lh;
#pragma unroll
        for (int i = 0; i < 16; ++i) {
          const int row = rowb + (i & 3) + 8 * (i >> 2);
          Z[(size_t)row * 1536 + col] = f2b(acc[tm][tn][i]);
        }
      }
  }
}

DI void phase_post(const Params& p, const int wid, int layer, int M) {
  const int tidf = tid_fresh(p, wid); const int lane = tidf & 63, wave = tidf >> 6;
  bf16* Z = (bf16*)(p.ws + OFF_Z);
  const bf16* oda = (const bf16*)(p.ws + OFF_QA);
  const bf16* ysf = (const bf16*)(p.ws + OFF_YSF);
  const bf16* ysb = (const bf16*)(p.ws + OFF_YSB);
  const bf16* ygf = (const bf16*)(p.ws + OFF_YGF);
  const bf16* ygb = (const bf16*)(p.ws + OFF_YGB);
  const float* snw = p.ssm_norm_w + layer * 512;
  const float* gnw = p.gla_norm_w + layer * 128;
  const int c0 = lane * 8;
  for (int row = blockIdx.x * 4 + wave; row < M; row += gridDim.x * 4) {
    bf16* zr = Z + (size_t)row * 1536;
    {
      uint4 o = *(const uint4*)(oda + (size_t)row * 512 + c0);
      uint4 z = *(const uint4*)(zr + c0);
      const uint32_t ou[4] = {o.x, o.y, o.z, o.w}, zu[4] = {z.x, z.y, z.z, z.w};
      uint32_t r[4];
#pragma unroll
      for (int q = 0; q < 4; ++q) r[q] = pack2(blo(ou[q]) * siluf(blo(zu[q])), bhi(ou[q]) * siluf(bhi(zu[q])));
      *(uint4*)(zr + c0) = make_uint4(r[0], r[1], r[2], r[3]);
    }
    {
      uint4 yf = *(const uint4*)(ysf + (size_t)row * 512 + c0), yb = *(const uint4*)(ysb + (size_t)row * 512 + c0);
      uint4 z = *(const uint4*)(zr + 512 + c0);
      const uint32_t fu[4] = {yf.x, yf.y, yf.z, yf.w}, bu[4] = {yb.x, yb.y, yb.z, yb.w}, zu[4] = {z.x, z.y, z.z, z.w};
      float y[8];
      float ss = 0.f;
#pragma unroll
      for (int q = 0; q < 4; ++q) {
        y[2 * q] = (blo(fu[q]) + blo(bu[q])) * siluf(blo(zu[q]));
        y[2 * q + 1] = (bhi(fu[q]) + bhi(bu[q])) * siluf(bhi(zu[q]));
        ss += y[2 * q] * y[2 * q] + y[2 * q + 1] * y[2 * q + 1];
      }
#pragma unroll
      for (int m = 16; m >= 1; m >>= 1) ss += __shfl_xor(ss, m);
      const float rstd = rsqrtf(ss * (1.f / 256.f) + EPS);
      float4 w0 = *(const float4*)(snw + c0), w1 = *(const float4*)(snw + c0 + 4);
      uint32_t r[4];
      r[0] = pack2(y[0] * rstd * w0.x, y[1] * rstd * w0.y); r[1] = pack2(y[2] * rstd * w0.z, y[3] * rstd * w0.w);
      r[2] = pack2(y[4] * rstd * w1.x, y[5] * rstd * w1.y); r[3] = pack2(y[6] * rstd * w1.z, y[7] * rstd * w1.w);
      *(uint4*)(zr + 512 + c0) = make_uint4(r[0], r[1], r[2], r[3]);
    }
    {
      uint4 yf = *(const uint4*)(ygf + (size_t)row * 512 + c0), yb = *(const uint4*)(ygb + (size_t)row * 512 + c0);
      uint4 z = *(const uint4*)(zr + 1024 + c0);
      const uint32_t fu[4] = {yf.x, yf.y, yf.z, yf.w}, bu[4] = {yb.x, yb.y, yb.z, yb.w}, zu[4] = {z.x, z.y, z.z, z.w};
      float y[8];
      float ss = 0.f;
#pragma unroll
      for (int q = 0; q < 4; ++q) {
        y[2 * q] = blo(fu[q]) + blo(bu[q]);
        y[2 * q + 1] = bhi(fu[q]) + bhi(bu[q]);
        ss += y[2 * q] * y[2 * q] + y[2 * q + 1] * y[2 * q + 1];
      }
#pragma unroll
      for (int m = 8; m >= 1; m >>= 1) ss += __shfl_xor(ss, m);
      const float rstd = rsqrtf(ss * (1.f / 128.f) + EPS);
      const int cw = c0 & 127;
      float4 w0 = *(const float4*)(gnw + cw), w1 = *(const float4*)(gnw + cw + 4);
      uint32_t r[4];
      r[0] = pack2(y[0] * rstd * w0.x * siluf(blo(zu[0])), y[1] * rstd * w0.y * siluf(bhi(zu[0])));
      r[1] = pack2(y[2] * rstd * w0.z * siluf(blo(zu[1])), y[3] * rstd * w0.w * siluf(bhi(zu[1])));
      r[2] = pack2(y[4] * rstd * w1.x * siluf(blo(zu[2])), y[5] * rstd * w1.y * siluf(bhi(zu[2])));
      r[3] = pack2(y[6] * rstd * w1.z * siluf(blo(zu[3])), y[7] * rstd * w1.w * siluf(bhi(zu[3])));
      *(uint4*)(zr + 1024 + c0) = make_uint4(r[0], r[1], r[2], r[3]);
    }
  }
}

DI void phase_merge(const Params& p, const int wid, int layer, int M, char* lds) {
  const bf16* h = (const bf16*)(p.ws + OFF_H);
  const bf16* osg = (const bf16*)(p.ws + OFF_Z);
  const char* wb = p.ws + OFF_W + (size_t)layer * LW;
  const bf16* W3 = (const bf16*)(wb + SZ_W1 + SZ_W2);
  const bf16* Wout = (const bf16*)(wb + SZ_W1 + SZ_W2 + SZ_W3);
  bf16* U = (bf16*)(p.ws + OFF_U);
  const int tidf = tid_fresh(p, wid); const int lane = tidf & 63, wave = tidf >> 6, wm = wave >> 1, wn = wave & 1, l31 = lane & 31, lh = lane >> 5;
  constexpr int NTN = 1024 / 128;
  int mt_, nt_;
  for (int it = 0; xcd_tile(it, M / 128, NTN, 8, mt_, nt_); ++it) {
    const int m0 = mt_ * 128, n0 = nt_ * 128;
    f32x16 u[2][2];
    zero_acc<2, 2>(u);
#pragma unroll 1
    for (int br = 0; br < 3; ++br) {
      uint32_t* sgl = (uint32_t*)(lds + 36864) + tidf;
      {
        f32x16 g[2][2];
        zero_acc<2, 2>(g);
        gemm_main128(h + (size_t)m0 * 1024, 1024, W3 + (size_t)(br * 1024 + n0) * 1024, 1024, 1024, g, lds, tidf);
#pragma unroll
        for (int tm = 0; tm < 2; ++tm)
#pragma unroll
          for (int tn = 0; tn < 2; ++tn)
#pragma unroll
            for (int q = 0; q < 8; ++q) sgl[((tm * 2 + tn) * 8 + q) * 256] = pack2(sigmf(g[tm][tn][2 * q]), sigmf(g[tm][tn][2 * q + 1]));
      }
      f32x16 t[2][2];
      zero_acc<2, 2>(t);
      gemm_main128(osg + (size_t)m0 * 1536 + br * 512, 1536, Wout + (size_t)br * 1024 * 512 + (size_t)n0 * 512, 512, 512, t, lds, tidf);
#pragma unroll
      for (int tm = 0; tm < 2; ++tm)
#pragma unroll
        for (int tn = 0; tn < 2; ++tn)
#pragma unroll
          for (int q = 0; q < 8; ++q) {
            const uint32_t sgv = sgl[((tm * 2 + tn) * 8 + q) * 256];
            u[tm][tn][2 * q] = fmaf(blo(sgv), t[tm][tn][2 * q], u[tm][tn][2 * q]);
            u[tm][tn][2 * q + 1] = fmaf(bhi(sgv), t[tm][tn][2 * q + 1], u[tm][tn][2 * q + 1]);
          }
    }
#pragma unroll
    for (int tm = 0; tm < 2; ++tm)
#pragma unroll
      for (int tn = 0; tn < 2; ++tn) {
        const int col = n0 + wn * 64 + tn * 32 + l31;
        const int rowb = m0 + wm * 64 + tm * 32 + 4 * lh;
#pragma unroll
        for (int i = 0; i < 16; ++i) {
          const int row = rowb + (i & 3) + 8 * (i >> 2);
          U[(size_t)row * 1024 + col] = f2b(u[tm][tn][i]);
        }
      }
  }
}

DI void phase_out(const Params& p, const int wid, int layer, int M, const float* xl, const float* xc, float* ol, float* oc, char* lds) {
  const bf16* U = (const bf16*)(p.ws + OFF_U);
  const bf16* Wo = (const bf16*)(p.ws + OFF_W + (size_t)layer * LW + SZ_W1 + SZ_W2 + SZ_W3 + 3 * SZ_WOUT);
  const float* modv = (const float*)(p.ws + OFF_MOD) + (size_t)layer * 9 * 3072;
  const int tidf = tid_fresh(p, wid); const int lane = tidf & 63, wave = tidf >> 6, wm = wave >> 1, wn = wave & 1, l31 = lane & 31, lh = lane >> 5;
  constexpr int NTN = 1024 / 128;
  int mt_, nt_;
  for (int it = 0; xcd_tile(it, M / 256, NTN, 8, mt_, nt_); ++it) {
    const int m0 = mt_ * 256, n0 = nt_ * 128;
    f32x16 acc[4][2];
    zero_acc<4, 2>(acc);
    gemm_main256(U + (size_t)m0 * 1024, 1024, Wo + (size_t)n0 * 1024, 1024, 1024, acc, lds, tidf);
    const bool lat = m0 < NL;
    const int j = lat ? (m0 >> 13) : 8;
    const float* gate = modv + j * 3072 + 2048;
    const float* src = lat ? xl + (size_t)m0 * 1024 : xc + (size_t)(m0 - NL) * 1024;
    float* dst = lat ? ol + (size_t)m0 * 1024 : oc + (size_t)(m0 - NL) * 1024;
    uint32_t eoff = (uint32_t)((wm * 128 + 4 * lh) * 1024 + n0 + wn * 64 + l31);
    asm volatile("" : "+v"(eoff));
    const float* sp = src + eoff;
    float* dp = dst + eoff;
    const float* gp = gate + n0 + wn * 64 + l31;
#pragma unroll
    for (int tm = 0; tm < 4; ++tm)
#pragma unroll
      for (int tn = 0; tn < 2; ++tn) {
        const float gt = gp[tn * 32];
#pragma unroll
        for (int i = 0; i < 16; ++i) {
          const int off = (tm * 32 + (i & 3) + 8 * (i >> 2)) * 1024 + tn * 32;
          dp[off] = sp[off] + gt * acc[tm][tn][i];
        }
        __builtin_amdgcn_sched_barrier(0);
      }
  }
}

DI void phase_final(const Params& p, const int wid) {
  const int tidf = tid_fresh(p, wid); const int lane = tidf & 63, wave = tidf >> 6;
  const int stride = gridDim.x * 4;
  for (int row0 = blockIdx.x * 4 + wave; row0 < NL; row0 += 2 * stride) {
    float4 v[2][4];
    float ss[2] = {0.f, 0.f};
#pragma unroll
    for (int r = 0; r < 2; ++r) {
      int row = row0 + r * stride;
      if (row >= NL) row = row0;
      const float* src = p.out + (size_t)row * 1024;
#pragma unroll
      for (int i = 0; i < 4; ++i) v[r][i] = *(const float4*)(src + (i * 64 + lane) * 4);
    }
#pragma unroll
    for (int r = 0; r < 2; ++r) {
#pragma unroll
      for (int i = 0; i < 4; ++i) ss[r] += v[r][i].x * v[r][i].x + v[r][i].y * v[r][i].y + v[r][i].z * v[r][i].z + v[r][i].w * v[r][i].w;
      ss[r] = wave_sum(ss[r]);
    }
#pragma unroll
    for (int r = 0; r < 2; ++r) {
      const int row = row0 + r * stride;
      if (row < NL) {
        float* dst = p.out + (size_t)row * 1024;
        const float rstd = rsqrtf(ss[r] * (1.f / 1024.f) + EPS);
#pragma unroll
        for (int i = 0; i < 4; ++i) {
          const int c = (i * 64 + lane) * 4;
          float4 w4 = *(const float4*)(p.final_norm_w + c);
          *(float4*)(dst + c) = make_float4(v[r][i].x * rstd * w4.x, v[r][i].y * rstd * w4.y, v[r][i].z * rstd * w4.z, v[r][i].w * rstd * w4.w);
        }
      }
    }
  }
}

__global__ void __launch_bounds__(256, 2) hybrid_trunk_mega(Params p) {
  cg::grid_group grid = cg::this_grid();
  const int wid = __builtin_amdgcn_readfirstlane((int)(threadIdx.x >> 6));
  __shared__ __attribute__((aligned(16))) char lds[LDS_BYTES];
  phase0(p, wid, lds);
  grid.sync();
  float* ctx1 = (float*)(p.ws + OFF_CTX1);
#pragma unroll 1
  for (int layer = 0; layer < 2; ++layer) {
    const float* xl = layer == 0 ? p.x : p.out;
    const float* xc = layer == 0 ? p.ctx : ctx1;
    const int M = layer == 0 ? NT : NL;
    phase_h(p, wid, layer, xl, xc, NT);
    grid.sync();
    phase_p1(p, wid, layer, NT, lds);
    grid.sync();
#ifdef DUP_GEMM
    phase_p1(p, wid, layer, NT, lds);
    grid.sync();
#endif
    phase_conv(p, wid, layer);
    grid.sync();
#ifdef PROBE_SCAN
    for (int it = blockIdx.x; it < 192; it += gridDim.x) { if (it < 64) scan_item<true>(p, wid, layer, it, lds); else scan_item<false>(p, wid, layer, it - 64, lds); }
    grid.sync();
#endif
    phase_mixers(p, wid, layer, lds);
    grid.sync();
    phase_z(p, wid, layer, M, lds);
    grid.sync();
#ifdef DUP_GEMM
    phase_z(p, wid, layer, M, lds);
    grid.sync();
#endif
    phase_post(p, wid, layer, M);
    grid.sync();
    phase_merge(p, wid, layer, M, lds);
    grid.sync();
#ifdef DUP_GEMM
    phase_merge(p, wid, layer, M, lds);
    grid.sync();
#endif
    phase_out(p, wid, layer, M, xl, xc, p.out, ctx1, lds);
    grid.sync();
  }
  phase_final(p, wid);
}

extern "C" void kernel_launch(void* const* d_in, const int* in_sizes, int n_in, void* d_out, int out_size, void* d_ws,
                              size_t ws_size, hipStream_t stream) {
  (void)in_sizes; (void)n_in; (void)out_size;
  static int grid_blocks = 0;
  if (!grid_blocks) {
    int dev = 0, cus = 0, per_cu = 0;
    hipGetDevice(&dev);
    hipDeviceGetAttribute(&cus, hipDeviceAttributeMultiprocessorCount, dev);
    hipOccupancyMaxActiveBlocksPerMultiprocessor(&per_cu, hybrid_trunk_mega, 256, 0);
    (void)per_cu;
    grid_blocks = cus * 2;
  }
  if (ws_size < WS_TOTAL) { fprintf(stderr, "workspace too small: %zu < %zu\n", ws_size, (size_t)WS_TOTAL); return; }
  Params p{};
  const float** f = (const float**)&p;
  for (int i = 0; i < 24; ++i) f[i] = (const float*)d_in[i];
  p.wid = 0; p.pad_ = 0;
  p.out = (float*)d_out;
  p.ws = (char*)d_ws;
  void* args[] = {&p};
  hipError_t e = hipLaunchCooperativeKernel((const void*)hybrid_trunk_mega, dim3(grid_blocks), dim3(256), args, 0, stream);
  if (e != hipSuccess && (grid_blocks & 15) == 0) {
    (void)hipGetLastError();
    grid_blocks >>= 1;
    e = hipLaunchCooperativeKernel((const void*)hybrid_trunk_mega, dim3(grid_blocks), dim3(256), args, 0, stream);
  }
  if (e != hipSuccess) fprintf(stderr, "cooperative launch failed: %s (grid %d)\n", hipGetErrorString(e), grid_blocks);
}
```

```cpp
#include <hip/hip_runtime.h>
#include <hip/hip_cooperative_groups.h>
#include <stdint.h>
#include <stdio.h>
namespace cg = cooperative_groups;

typedef unsigned short bf16;
using bf16x8 = __attribute__((ext_vector_type(8))) short;
using f32x16 = __attribute__((ext_vector_type(16))) float;
using u32x8 = __attribute__((ext_vector_type(8))) unsigned int;
#define DI __device__ __forceinline__
#define MFMA32(a, b, c) __builtin_amdgcn_mfma_f32_32x32x16_bf16((a), (b), (c), 0, 0, 0)

typedef __bf16 hbf16x2 __attribute__((ext_vector_type(2)));
typedef float f32x2 __attribute__((ext_vector_type(2)));
DI uint32_t pack2(float a, float b) { f32x2 v = {a, b}; return __builtin_bit_cast(uint32_t, __builtin_convertvector(v, hbf16x2)); }
DI bf16 f2b(float x) { return (bf16)(pack2(x, x) & 0xffffu); }
DI float blo(uint32_t u) { return __uint_as_float(u << 16); }
DI float bhi(uint32_t u) { return __uint_as_float(u & 0xffff0000u); }
DI float max3f(float a, float b, float c) { float r; asm("v_max3_f32 %0, %1, %2, %3" : "=v"(r) : "v"(a), "v"(b), "v"(c)); return r; }
DI float xhalf_max(float x) {
  const unsigned u = __float_as_uint(x);
  const auto r = __builtin_amdgcn_permlane32_swap(u, u, false, false);
  float m; asm("v_max_f32 %0, %1, %2" : "=v"(m) : "v"(__uint_as_float(r[0])), "v"(__uint_as_float(r[1]))); return m;
}
DI float siluf(float x) { return x / (1.f + __expf(-x)); }
DI float sigmf(float x) { return 1.f / (1.f + __expf(-x)); }

constexpr int NB = 8, SEQ = 8192, CTX = 256, DM = 1024;
constexpr int NL = NB * SEQ;
constexpr int NC = NB * CTX;
constexpr int NT = NL + NC;
constexpr int KEYS = CTX + SEQ;
constexpr int INW = 7984;
constexpr int N1 = 3456, N2 = 1536, N3 = 3072;
constexpr float EPS = 1e-6f;
constexpr float QSCALE = 0.125f * 1.4426950408889634f;

constexpr size_t al256(size_t x) { return (x + 255) & ~(size_t)255; }
constexpr size_t SZ_W1 = (size_t)N1 * 1024 * 2, SZ_W2 = (size_t)N2 * 1024 * 2, SZ_W3 = (size_t)N3 * 1024 * 2;
constexpr size_t SZ_WOUT = (size_t)1024 * 512 * 2, SZ_WO = (size_t)1024 * 1024 * 2;
constexpr size_t LW = SZ_W1 + SZ_W2 + SZ_W3 + 3 * SZ_WOUT + SZ_WO;
constexpr size_t OFF_W = 0;
constexpr size_t OFF_MOD = OFF_W + 2 * LW;
constexpr size_t OFF_ROPE = OFF_MOD + al256((size_t)2 * 9 * 3072 * 4);
constexpr size_t OFF_MISC = OFF_ROPE + (size_t)128 * 16 * 2 * 4;
constexpr size_t OFF_H = OFF_MISC + 256;
constexpr size_t OFF_QA = OFF_H + (size_t)NT * 1024 * 2;
constexpr size_t OFF_KA = OFF_QA + (size_t)NT * 512 * 2;
constexpr size_t OFF_VT = OFF_KA + (size_t)NT * 512 * 2;
constexpr size_t OFF_XBC = OFF_VT + (size_t)NT * 512 * 2;
constexpr size_t OFF_XBC2 = OFF_XBC + (size_t)NT * 768 * 2;
constexpr size_t OFF_GQ = OFF_XBC2 + (size_t)NT * 768 * 2;
constexpr size_t OFF_GK = OFF_GQ + (size_t)NT * 256 * 2;
constexpr size_t OFF_GV = OFF_GK + (size_t)NT * 256 * 2;
constexpr size_t OFF_DTLR = OFF_GV + (size_t)NT * 512 * 2;
constexpr size_t OFF_YSF = OFF_DTLR + (size_t)NT * 48 * 4;
constexpr size_t OFF_YSB = OFF_YSF + (size_t)NT * 512 * 2;
constexpr size_t OFF_YGF = OFF_YSB + (size_t)NT * 512 * 2;
constexpr size_t OFF_YGB = OFF_YGF + (size_t)NT * 512 * 2;
constexpr size_t OFF_CTX1 = OFF_YGB + (size_t)NT * 512 * 2;
constexpr size_t OFF_BAR = OFF_CTX1 + (size_t)NC * 1024 * 4;
constexpr size_t WS_TOTAL = OFF_BAR + 16384;
constexpr size_t OFF_Z = OFF_KA;
constexpr size_t OFF_U = OFF_GQ;
static_assert(WS_TOTAL <= ((size_t)1 << 30), "workspace too large");
static_assert((size_t)NT * 1536 * 2 <= OFF_XBC2 - OFF_KA, "Z overlay");
static_assert((size_t)NT * 1024 * 2 <= OFF_DTLR - OFF_GQ, "U overlay");

struct Params {
  const float *x, *c, *ctx, *c_ctx, *w_mod, *b_mod, *norm_w, *w_in, *da_lambda, *da_norm_w, *w_out_da;
  const float *conv_w, *conv_b, *dt_bias, *a_log, *ssm_d, *ssm_norm_w, *w_out_ssm;
  const float *gla_w_gate, *gla_b_gate, *gla_norm_w, *w_out_gla, *w_o, *final_norm_w;
  float* out;
  char* ws;
  int wid, pad_;
};
DI int tid_fresh(const Params& p, const int wid) {
  int t = wid * 64 + (int)__builtin_amdgcn_mbcnt_hi(~0u, __builtin_amdgcn_mbcnt_lo(~0u, 0u));
  asm volatile("" : "+v"(t));
  return t;
}

constexpr int LDS_BYTES = 70 * 1024;

DI int map_w1(int n) {
  if (n < 1536) return n;
  if (n < 2048) return 2048 + (n - 1536);
  if (n < 2304) return 3072 + (n - 2048);
  if (n < 3328) return 3344 + (n - 2304);
  if (n < 3344) return 3328 + (n - 3328);
  if (n < 3376) return 4880 + (n - 3344);
  return -1;
}
DI int map_w2(int n) {
  if (n < 512) return 1536 + n;
  if (n < 1024) return 2560 + (n - 512);
  return 4368 + (n - 1024);
}

DI void tr_tile(const Params& p, const int wid, const float* __restrict__ src, int ldsrc, bf16* __restrict__ dst, int K, int n0, int k0, int mapk, float* tile) {
  const int tid = tid_fresh(p, wid), tx = tid & 63, ty = tid >> 6;
  const int n = n0 + tx;
  int col = n;
  if (mapk == 1) col = map_w1(n); else if (mapk == 2) col = map_w2(n); else if (mapk == 3) col = 4912 + n;
#pragma unroll
  for (int i = 0; i < 16; ++i) {
    int kk = ty + 4 * i;
    tile[kk * 65 + tx] = (col >= 0) ? src[(size_t)(k0 + kk) * ldsrc + col] : 0.f;
  }
  __syncthreads();
#pragma unroll
  for (int i = 0; i < 16; ++i) {
    int nn = ty + 4 * i;
    dst[(size_t)(n0 + nn) * K + k0 + tx] = f2b(tile[tx * 65 + nn]);
  }
  __syncthreads();
}

#define XB_TMO      128
#define XB_XCNT(j)  (256  + 64 * (j))
#define XB_XSUB(j)  (1280 + 64 * (j))
#define XB_XGEN(j)  (2304 + 64 * (j))
#define XB_TOP      3328
#define XB_TOPGEN   3392
#define XCD_BAR_WORDS 3456
#define XB_SPIN_CAP (1u << 18)
#define LAS __attribute__((address_space(3)))
DI unsigned xb_ld(unsigned* q) { return __hip_atomic_load(q, __ATOMIC_RELAXED, __HIP_MEMORY_SCOPE_AGENT); }
DI unsigned xb_add(unsigned* q, unsigned v) { return __hip_atomic_fetch_add(q, v, __ATOMIC_RELAXED, __HIP_MEMORY_SCOPE_AGENT); }
DI unsigned xb_xcc_id() { return (unsigned)__builtin_amdgcn_s_getreg((3 << 11) | 20) & 0xFu; }
#define XB_SPIN(cond, bar) do { unsigned _sp = 0; while (cond) { __builtin_amdgcn_s_sleep(1); \
    if ((++_sp & 255u) == 0u) { if (xb_ld(&(bar)[XB_TMO])) break; if (_sp > XB_SPIN_CAP) { atomicAdd(&(bar)[XB_TMO], 1u); break; } } } } while (0)
struct XcdBarrier { unsigned* bar; unsigned x; volatile LAS unsigned* st; };
DI XcdBarrier xcd_barrier_post(unsigned* bar, volatile LAS unsigned* st, bool t0) {
  XcdBarrier b; b.bar = bar; b.x = xb_xcc_id(); b.st = st;
  if (t0) (void)xb_add(&bar[XB_XCNT(b.x)], 1u);
  return b;
}
DI void xcd_barrier_complete(unsigned* bar, unsigned x, unsigned& nloc, unsigned& nx) {
  const unsigned G = gridDim.x * gridDim.y * gridDim.z;
  unsigned sum, cnt, mine, sp = 0u;
  for (;;) {
    sum = 0u; cnt = 0u; mine = 0u;
#pragma unroll
    for (unsigned j = 0; j < 16; ++j) { const unsigned c = xb_ld(&bar[XB_XCNT(j)]); sum += c; cnt += (c > 0u) ? 1u : 0u; mine = (j == x) ? c : mine; }
    if (sum == G) break;
    __builtin_amdgcn_s_sleep(1);
    if ((++sp & 255u) == 0u) { if (xb_ld(&bar[XB_TMO])) break; if (sp > XB_SPIN_CAP) { atomicAdd(&bar[XB_TMO], 1u); break; } }
  }
  nloc = mine > 0u ? mine : 1u; nx = cnt > 0u ? cnt : 1u;
}
DI void xcd_barrier(const Params& p, const int wid, volatile LAS unsigned* st) {
  asm volatile("s_waitcnt vmcnt(0)" ::: "memory");
  __syncthreads();
  if (tid_fresh(p, wid) == 0) {
    unsigned* bar = (unsigned*)(p.ws + OFF_BAR);
    const unsigned x = xb_xcc_id();
    __builtin_amdgcn_s_waitcnt(0);
    unsigned nloc = st[0], nx = st[1];
    if (nloc == 0u) { xcd_barrier_complete(bar, x, nloc, nx); st[0] = nloc; st[1] = nx; }
    const unsigned old = xb_add(&bar[XB_XSUB(x)], 1u);
    const unsigned gen = old / nloc;
    if (old + 1u == (gen + 1u) * nloc) {
      __builtin_amdgcn_fence(__ATOMIC_RELEASE, "agent");
      asm volatile("s_waitcnt vmcnt(0)" ::: "memory");
      const unsigned og = xb_add(&bar[XB_TOP], 1u);
      const unsigned tg = og / nx;
      if (og + 1u == (tg + 1u) * nx) xb_add(&bar[XB_TOPGEN], 1u);
      else XB_SPIN(xb_ld(&bar[XB_TOPGEN]) == tg, bar);
      __builtin_amdgcn_fence(__ATOMIC_ACQUIRE, "agent");
      xb_add(&bar[XB_XGEN(x)], 1u);
      asm volatile("s_waitcnt vmcnt(0)" ::: "memory");
    } else {
      XB_SPIN(xb_ld(&bar[XB_XGEN(x)]) == gen, bar);
      __builtin_amdgcn_fence(__ATOMIC_ACQUIRE, "agent");
      asm volatile("s_waitcnt vmcnt(0)" ::: "memory");
    }
  }
  __syncthreads();
}

constexpr int TR_PER_LAYER = 864 + 384 + 768 + 384 + 256;
constexpr int P0_ITEMS = 2 * TR_PER_LAYER + 96 + 1;

DI void phase0(const Params& p, const int wid, char* lds) {
  const int tid = tid_fresh(p, wid);
  float* fl = (float*)lds;
  if (blockIdx.x == 0) for (int i = tid; i < XCD_BAR_WORDS; i += 256) ((unsigned*)(p.ws + OFF_BAR))[i] = 0u;
  for (int item = blockIdx.x; item < P0_ITEMS; item += gridDim.x) {
    if (item < 2 * TR_PER_LAYER) {
      const int layer = item / TR_PER_LAYER;
      int j = item % TR_PER_LAYER;
      char* wb = p.ws + OFF_W + (size_t)layer * LW;
      const float* win = p.w_in + (size_t)layer * 1024 * INW;
      if (j < 864) {
        tr_tile(p, wid, win, INW, (bf16*)wb, 1024, (j >> 4) * 64, (j & 15) * 64, 1, fl);
      } else if (j < 1248) {
        j -= 864;
        tr_tile(p, wid, win, INW, (bf16*)(wb + SZ_W1), 1024, (j >> 4) * 64, (j & 15) * 64, 2, fl);
      } else if (j < 2016) {
        j -= 1248;
        tr_tile(p, wid, win, INW, (bf16*)(wb + SZ_W1 + SZ_W2), 1024, (j >> 4) * 64, (j & 15) * 64, 3, fl);
      } else if (j < 2400) {
        j -= 2016;
        const int br = j >> 7, r = j & 127;
        const float* src = (br == 0 ? p.w_out_da : br == 1 ? p.w_out_ssm : p.w_out_gla) + (size_t)layer * 512 * 1024;
        tr_tile(p, wid, src, 1024, (bf16*)(wb + SZ_W1 + SZ_W2 + SZ_W3 + (size_t)br * SZ_WOUT), 512, (r >> 3) * 64, (r & 7) * 64, 0, fl);
      } else {
        j -= 2400;
        tr_tile(p, wid, p.w_o + (size_t)layer * 1024 * 1024, 1024, (bf16*)(wb + SZ_W1 + SZ_W2 + SZ_W3 + 3 * SZ_WOUT), 1024,
                (j >> 4) * 64, (j & 15) * 64, 0, fl);
      }
    } else if (item < 2 * TR_PER_LAYER + 96) {
      const int m = item - 2 * TR_PER_LAYER;
      const int layer = m / 48, nc = (m % 48) * 64;
      float* sc = fl;
      float* red = fl + 9 * 1024;
      for (int idx = tid; idx < 9 * 1024; idx += 256) {
        int j = idx >> 10, k = idx & 1023;
        float v = j < 8 ? p.c[j * 1024 + k] : p.c_ctx[k];
        sc[idx] = v / (1.f + expf(-v));
      }
      __syncthreads();
      const int tx = tid & 63, q = tid >> 6;
      float acc[9];
#pragma unroll
      for (int j = 0; j < 9; ++j) acc[j] = 0.f;
      const float* wm = p.w_mod + (size_t)layer * 1024 * 3072 + nc + tx;
#pragma unroll 4
      for (int k = q * 256; k < q * 256 + 256; ++k) {
        float wv = wm[(size_t)k * 3072];
#pragma unroll
        for (int j = 0; j < 9; ++j) acc[j] = fmaf(sc[j * 1024 + k], wv, acc[j]);
      }
#pragma unroll
      for (int j = 0; j < 9; ++j) red[(q * 9 + j) * 64 + tx] = acc[j];
      __syncthreads();
      float* modv = (float*)(p.ws + OFF_MOD);
      for (int idx = tid; idx < 9 * 64; idx += 256) {
        int j = idx >> 6, t = idx & 63;
        float s = red[(0 * 9 + j) * 64 + t] + red[(1 * 9 + j) * 64 + t] + red[(2 * 9 + j) * 64 + t] + red[(3 * 9 + j) * 64 + t];
        modv[(size_t)(layer * 9 + j) * 3072 + nc + t] = s + p.b_mod[layer * 3072 + nc + t];
      }
      __syncthreads();
    } else {
      float* rope = (float*)(p.ws + OFF_ROPE);
      for (int idx = tid; idx < 2048; idx += 256) {
        int pos = idx >> 4, f = idx & 15;
        float inv = (float)exp(-(double)f / 16.0 * 9.210340371976184);
        float angf = (float)pos * inv;
        double a = (double)angf;
        double r = a - 6.283185307179586477 * rint(a * 0.15915494309189533577);
        double r2 = r * r;
        double ts = r, ss = r, tc = 1.0, cs = 1.0;
#pragma unroll 1
        for (int n = 1; n <= 12; ++n) {
          tc *= -r2 / (double)((2 * n - 1) * (2 * n));
          cs += tc;
          ts *= -r2 / (double)((2 * n) * (2 * n + 1));
          ss += ts;
        }
        rope[idx * 2] = (float)cs;
        rope[idx * 2 + 1] = (float)ss;
      }
      float* misc = (float*)(p.ws + OFF_MISC);
      if (tid < 2) {
        const float* lm = p.da_lambda + tid * 4 * 64;
        float s1 = 0.f, s2 = 0.f;
        for (int i = 0; i < 64; ++i) { s1 += lm[i] * lm[64 + i]; s2 += lm[128 + i] * lm[192 + i]; }
        float lam_init = 0.8f - 0.6f * expf(-0.3f * (float)tid);
        misc[tid] = expf(s1) - expf(s2) + lam_init;
      }
      if (tid < 16) ((unsigned*)(p.ws + OFF_MISC + 64))[tid] = 0u;
    }
  }
}

DI float wave_sum(float v) {
#pragma unroll
  for (int m = 32; m >= 1; m >>= 1) v += __shfl_xor(v, m);
  return v;
}

DI void phase_h(const Params& p, const int wid, int layer, const float* xl, const float* xc, int M) {
  const int tidf = tid_fresh(p, wid); const int lane = tidf & 63, wave = tidf >> 6;
  bf16* h = (bf16*)(p.ws + OFF_H);
  const float* modv = (const float*)(p.ws + OFF_MOD) + (size_t)layer * 9 * 3072;
  const float* nw = p.norm_w + layer * 1024;
  const int stride = gridDim.x * 4;
  for (int row0 = blockIdx.x * 4 + wave; row0 < M; row0 += 2 * stride) {
    float4 v[2][4];
    float ss[2] = {0.f, 0.f};
#pragma unroll
    for (int r = 0; r < 2; ++r) {
      int row = row0 + r * stride;
      if (row >= M) row = row0;
      const float* src = row < NL ? xl + (size_t)row * 1024 : xc + (size_t)(row - NL) * 1024;
#pragma unroll
      for (int i = 0; i < 4; ++i) v[r][i] = *(const float4*)(src + (i * 64 + lane) * 4);
    }
#pragma unroll
    for (int r = 0; r < 2; ++r) {
#pragma unroll
      for (int i = 0; i < 4; ++i) ss[r] += v[r][i].x * v[r][i].x + v[r][i].y * v[r][i].y + v[r][i].z * v[r][i].z + v[r][i].w * v[r][i].w;
      ss[r] = wave_sum(ss[r]);
    }
#pragma unroll
    for (int r = 0; r < 2; ++r) {
      const int row = row0 + r * stride;
      if (row < M) {
        const int j = row < NL ? (row >> 13) : 8;
        const float* shift = modv + j * 3072;
        const float* scale = shift + 1024;
        const float rstd = rsqrtf(ss[r] * (1.f / 1024.f) + EPS);
#pragma unroll
        for (int i = 0; i < 4; ++i) {
          const int c = (i * 64 + lane) * 4;
          float4 w4 = *(const float4*)(nw + c), sc4 = *(const float4*)(scale + c), sh4 = *(const float4*)(shift + c);
          float o0 = v[r][i].x * rstd * w4.x * (1.f + sc4.x) + sh4.x;
          float o1 = v[r][i].y * rstd * w4.y * (1.f + sc4.y) + sh4.y;
          float o2 = v[r][i].z * rstd * w4.z * (1.f + sc4.z) + sh4.z;
          float o3 = v[r][i].w * rstd * w4.w * (1.f + sc4.w) + sh4.w;
          uint2 pk; pk.x = pack2(o0, o1); pk.y = pack2(o2, o3);
          *(uint2*)(h + (size_t)row * 1024 + c) = pk;
        }
      }
    }
  }
}

DI void gemm_main128(const bf16* __restrict__ A, int lda, const bf16* __restrict__ Bt, int ldb, int K,
                     f32x16 (&acc)[2][2], char* lds, const int tid) {
  bf16* As = (bf16*)lds;
  bf16* Bs = As + 128 * 72;
  const int lane = tid & 63, wave = tid >> 6, wm = wave >> 1, wn = wave & 1;
  const int l31 = lane & 31, lh = lane >> 5;
  const uint32_t aoff = (uint32_t)(((tid >> 3) * lda + (tid & 7) * 8) * 2);
  const uint32_t boff = (uint32_t)(((tid >> 3) * ldb + (tid & 7) * 8) * 2);
  const uint32_t soff = (uint32_t)(((tid >> 3) * 72 + (tid & 7) * 8) * 2);
  const char* Ab = (const char*)A;
  const char* Bb = (const char*)Bt;
  char* Asb = (char*)As;
  char* Bsb = (char*)Bs;
  const size_t astep = (size_t)32 * lda * 2, bstep = (size_t)32 * ldb * 2;
  uint4 ra0, ra1, ra2, ra3, rb0, rb1, rb2, rb3;
#define ALD(i, kb) (*(const uint4*)(Ab + ((size_t)(i) * astep + (kb)) + aoff))
#define BLD(i, kb) (*(const uint4*)(Bb + ((size_t)(i) * bstep + (kb)) + boff))
#define LDALL(kb)                                                          \
  ra0 = ALD(0, kb); ra1 = ALD(1, kb); ra2 = ALD(2, kb); ra3 = ALD(3, kb);  \
  rb0 = BLD(0, kb); rb1 = BLD(1, kb); rb2 = BLD(2, kb); rb3 = BLD(3, kb);
#define SST(base, i, val) (*(uint4*)((base) + (i) * (32 * 72 * 2) + soff) = (val))
  LDALL((size_t)0)
#pragma unroll 1
  for (int k0 = 0; k0 < K; k0 += 64) {
    SST(Asb, 0, ra0); SST(Asb, 1, ra1); SST(Asb, 2, ra2); SST(Asb, 3, ra3);
    SST(Bsb, 0, rb0); SST(Bsb, 1, rb1); SST(Bsb, 2, rb2); SST(Bsb, 3, rb3);
    __syncthreads();
    if (k0 + 64 < K) {
      const size_t kb = (size_t)(k0 + 64) * 2;
      LDALL(kb)
    }
    {
      const bf16* ap = As + (wm * 64 + l31) * 72 + lh * 8;
      const bf16* bp = Bs + (wn * 64 + l31) * 72 + lh * 8;
#define LDA_(tm, ks) (*(const bf16x8*)(ap + (tm) * 32 * 72 + (ks) * 16))
#define LDB_(tn, ks) (*(const bf16x8*)(bp + (tn) * 32 * 72 + (ks) * 16))
#define STEP(B0_, B1_, N0_, N1_, ks, more)                                              \
  if (more) { N0_ = LDB_(0, (ks) + 1); N1_ = LDB_(1, (ks) + 1); }                       \
  acc[0][0] = MFMA32(a0, B0_, acc[0][0]); acc[0][1] = MFMA32(a0, B1_, acc[0][1]);       \
  if (more) a0 = LDA_(0, (ks) + 1);                                                     \
  acc[1][0] = MFMA32(a1, B0_, acc[1][0]); acc[1][1] = MFMA32(a1, B1_, acc[1][1]);       \
  if (more) a1 = LDA_(1, (ks) + 1);                                                     \
  __builtin_amdgcn_sched_barrier(0);
      bf16x8 a0 = LDA_(0, 0), a1 = LDA_(1, 0);
      bf16x8 p0 = LDB_(0, 0), p1 = LDB_(1, 0), q0, q1;
      __builtin_amdgcn_sched_barrier(0);
      STEP(p0, p1, q0, q1, 0, true)
      STEP(q0, q1, p0, p1, 1, true)
      STEP(p0, p1, q0, q1, 2, true)
      STEP(q0, q1, p0, p1, 3, false)
#undef LDA_
#undef LDB_
#undef STEP
    }
    __syncthreads();
  }
#undef LDALL
#undef ALD
#undef BLD
#undef SST
}

template <int TM, int WN>
DI void zero_acc(f32x16 (&acc)[TM][WN]) {
#pragma unroll
  for (int a = 0; a < TM; ++a)
#pragma unroll
    for (int b = 0; b < WN; ++b)
#pragma unroll
      for (int i = 0; i < 16; ++i) acc[a][b][i] = 0.f;
}

DI void gemm_main256(const bf16* __restrict__ A, int lda, const bf16* __restrict__ Bt, int ldb, int K,
                     f32x16 (&acc)[4][2], char* lds, const int tid) {
  bf16* As = (bf16*)lds;
  bf16* Bs = As + 256 * 72;
  const int lane = tid & 63, wave = tid >> 6, wm = wave >> 1, wn = wave & 1;
  const int l31 = lane & 31, lh = lane >> 5;
  const uint32_t aoff = (uint32_t)(((tid >> 3) * lda + (tid & 7) * 8) * 2);
  const uint32_t boff = (uint32_t)(((tid >> 3) * ldb + (tid & 7) * 8) * 2);
  const uint32_t soff = (uint32_t)(((tid >> 3) * 72 + (tid & 7) * 8) * 2);
  const char* Ab = (const char*)A;
  const char* Bb = (const char*)Bt;
  char* Asb = (char*)As;
  char* Bsb = (char*)Bs;
  const size_t astep = (size_t)32 * lda * 2, bstep = (size_t)32 * ldb * 2;
  uint4 ra0, ra1, ra2, ra3, ra4, ra5, ra6, ra7, rb0, rb1, rb2, rb3;
#define ALD(i, kb) (*(const uint4*)(Ab + ((size_t)(i) * astep + (kb)) + aoff))
#define BLD(i, kb) (*(const uint4*)(Bb + ((size_t)(i) * bstep + (kb)) + boff))
#define LDALL(kb)                                                                      \
  ra0 = ALD(0, kb); ra1 = ALD(1, kb); ra2 = ALD(2, kb); ra3 = ALD(3, kb);              \
  ra4 = ALD(4, kb); ra5 = ALD(5, kb); ra6 = ALD(6, kb); ra7 = ALD(7, kb);              \
  rb0 = BLD(0, kb); rb1 = BLD(1, kb); rb2 = BLD(2, kb); rb3 = BLD(3, kb);
#define SST(base, i, val) (*(uint4*)((base) + (i) * (32 * 72 * 2) + soff) = (val))
  LDALL((size_t)0)
#pragma unroll 1
  for (int k0 = 0; k0 < K; k0 += 64) {
    SST(Asb, 0, ra0); SST(Asb, 1, ra1); SST(Asb, 2, ra2); SST(Asb, 3, ra3);
    SST(Asb, 4, ra4); SST(Asb, 5, ra5); SST(Asb, 6, ra6); SST(Asb, 7, ra7);
    SST(Bsb, 0, rb0); SST(Bsb, 1, rb1); SST(Bsb, 2, rb2); SST(Bsb, 3, rb3);
    __syncthreads();
    if (k0 + 64 < K) {
      const size_t kb = (size_t)(k0 + 64) * 2;
      LDALL(kb)
    }
    {
      const bf16* ap = As + (wm * 128 + l31) * 72 + lh * 8;
      const bf16* bp = Bs + (wn * 64 + l31) * 72 + lh * 8;
#define LDA_(tm, ks) (*(const bf16x8*)(ap + (tm) * 32 * 72 + (ks) * 16))
#define LDB_(tn, ks) (*(const bf16x8*)(bp + (tn) * 32 * 72 + (ks) * 16))
#define STEP(B0_, B1_, N0_, N1_, ks, more)                                              \
  if (more) { N0_ = LDB_(0, (ks) + 1); N1_ = LDB_(1, (ks) + 1); }                       \
  acc[0][0] = MFMA32(a0, B0_, acc[0][0]); acc[0][1] = MFMA32(a0, B1_, acc[0][1]);       \
  if (more) a0 = LDA_(0, (ks) + 1);                                                     \
  acc[1][0] = MFMA32(a1, B0_, acc[1][0]); acc[1][1] = MFMA32(a1, B1_, acc[1][1]);       \
  if (more) a1 = LDA_(1, (ks) + 1);                                                     \
  acc[2][0] = MFMA32(a2, B0_, acc[2][0]); acc[2][1] = MFMA32(a2, B1_, acc[2][1]);       \
  if (more) a2 = LDA_(2, (ks) + 1);                                                     \
  acc[3][0] = MFMA32(a3, B0_, acc[3][0]); acc[3][1] = MFMA32(a3, B1_, acc[3][1]);       \
  if (more) a3 = LDA_(3, (ks) + 1);                                                     \
  __builtin_amdgcn_sched_barrier(0);
      bf16x8 a0 = LDA_(0, 0), a1 = LDA_(1, 0), a2 = LDA_(2, 0), a3 = LDA_(3, 0);
      bf16x8 p0 = LDB_(0, 0), p1 = LDB_(1, 0), q0, q1;
      __builtin_amdgcn_sched_barrier(0);
      STEP(p0, p1, q0, q1, 0, true)
      STEP(q0, q1, p0, p1, 1, true)
      STEP(p0, p1, q0, q1, 2, true)
      STEP(q0, q1, p0, p1, 3, false)
#undef LDA_
#undef LDB_
#undef STEP
    }
    __syncthreads();
  }
#undef LDALL
#undef ALD
#undef BLD
#undef SST
}

DI bool xcd_tile(int it, int MT, int NTN, int PN, int& mt, int& nt) {
  const int x = blockIdx.x & 7, slot = blockIdx.x >> 3, nslots = gridDim.x >> 3;
  const int MTx = MT >> 3;
  const int lt = slot + it * nslots;
  if (lt >= MTx * NTN) return false;
  const int per_panel = MTx * PN;
  const int pn = lt / per_panel, r = lt - pn * per_panel;
  mt = x * MTx + r / PN;
  nt = pn * PN + r % PN;
  return true;
}

DI void phase_p1(const Params& p, const int wid, int layer, int M, char* lds) {
  const bf16* h = (const bf16*)(p.ws + OFF_H);
  const bf16* W1 = (const bf16*)(p.ws + OFF_W + (size_t)layer * LW);
  const float2* rope = (const float2*)(p.ws + OFF_ROPE);
  bf16* Qa = (bf16*)(p.ws + OFF_QA);
  bf16* Ka = (bf16*)(p.ws + OFF_KA);
  bf16* Vt = (bf16*)(p.ws + OFF_VT);
  bf16* xbc = (bf16*)(p.ws + OFF_XBC);
  bf16* gq = (bf16*)(p.ws + OFF_GQ);
  bf16* gk = (bf16*)(p.ws + OFF_GK);
  bf16* gv = (bf16*)(p.ws + OFF_GV);
  float* dtlr = (float*)(p.ws + OFF_DTLR);
  const int tidf = tid_fresh(p, wid); const int lane = tidf & 63, wave = tidf >> 6, wm = wave >> 1, wn = wave & 1, l31 = lane & 31, lh = lane >> 5;
  constexpr int NTN = N1 / 128;
  int mt_, nt_;
  for (int it = 0; xcd_tile(it, M / 256, NTN, 9, mt_, nt_); ++it) {
    const int m0 = mt_ * 256, n0 = nt_ * 128;
    f32x16 acc[4][2];
    zero_acc<4, 2>(acc);
    gemm_main256(h + (size_t)m0 * 1024, 1024, W1 + (size_t)n0 * 1024, 1024, 1024, acc, lds, tidf);
    const bool lat = m0 < NL;
#pragma unroll
    for (int tm = 0; tm < 4; ++tm)
#pragma unroll
      for (int tn = 0; tn < 2; ++tn) {
        const int col = n0 + wn * 64 + tn * 32 + l31;
        const int rowb = m0 + wm * 128 + tm * 32 + 4 * lh;
        if (n0 < 1024) {
          const int d = col & 63, axis = d >> 5, half = (d >> 4) & 1, f = d & 15;
          bf16* dst = n0 < 512 ? Qa : Ka;
#pragma unroll
          for (int i = 0; i < 16; ++i) {
            const int row = rowb + (i & 3) + 8 * (i >> 2);
            float v = acc[tm][tn][i];
            float partner = __shfl_xor(v, 16);
            if (lat) {
              const int t = row & 8191;
              const int pos = axis ? (t & 63) : (t >> 6);
              float2 cs = rope[pos * 16 + f];
              v = v * cs.x + (half ? partner : -partner) * cs.y;
            }
            if (n0 < 512) v *= QSCALE;
            dst[(size_t)row * 512 + (col & 511)] = f2b(v);
          }
        } else if (n0 < 1536) {
          const int hd = (col - 1024) >> 7, vv = (col - 1024) & 127;
#pragma unroll
          for (int g = 0; g < 4; ++g) {
            const int row0 = rowb + 8 * g;
            int b, key;
            if (lat) { b = row0 >> 13; key = 256 + (row0 & 8191); } else { b = (row0 - NL) >> 8; key = (row0 - NL) & 255; }
            uint2 pk;
            pk.x = pack2(acc[tm][tn][4 * g], acc[tm][tn][4 * g + 1]);
            pk.y = pack2(acc[tm][tn][4 * g + 2], acc[tm][tn][4 * g + 3]);
            *(uint2*)(Vt + ((size_t)((b * 4 + hd) * 128 + vv)) * KEYS + key) = pk;
          }
        } else if (n0 < 3328) {
          bf16* dst; int ld, cc;
          if (n0 < 2304) { dst = xbc; ld = 768; cc = col - 1536; }
          else if (n0 < 2560) { dst = gq; ld = 256; cc = col - 2304; }
          else if (n0 < 2816) { dst = gk; ld = 256; cc = col - 2560; }
          else { dst = gv; ld = 512; cc = col - 2816; }
#pragma unroll
          for (int i = 0; i < 16; ++i) {
            const int row = rowb + (i & 3) + 8 * (i >> 2);
            dst[(size_t)row * ld + cc] = f2b(acc[tm][tn][i]);
          }
        } else {
          const int cc = col - 3328;
          if (cc < 48) {
#pragma unroll
            for (int i = 0; i < 16; ++i) {
              const int row = rowb + (i & 3) + 8 * (i >> 2);
              dtlr[(size_t)row * 48 + cc] = acc[tm][tn][i];
            }
          }
        }
      }
  }
}

DI void phase_conv(const Params& p, const int wid, int layer) {
  const bf16* xin = (const bf16*)(p.ws + OFF_XBC);
  bf16* xo = (bf16*)(p.ws + OFF_XBC2);
  const float* cw = p.conv_w + layer * 3 * 768;
  const float* cb = p.conv_b + layer * 768;
  const int total = NT * 96;
  for (int idx = blockIdx.x * 256 + tid_fresh(p, wid); idx < total; idx += gridDim.x * 256) {
    const int row = idx / 96, c0 = (idx % 96) * 8;
    int t, L;
    if (row < NL) { t = row & 8191; L = 8192; } else { t = (row - NL) & 255; L = 256; }
    uint4 cur = *(const uint4*)(xin + (size_t)row * 768 + c0);
    uint4 prv = make_uint4(0, 0, 0, 0), nxt = make_uint4(0, 0, 0, 0);
    if (t > 0) prv = *(const uint4*)(xin + (size_t)(row - 1) * 768 + c0);
    if (t < L - 1) nxt = *(const uint4*)(xin + (size_t)(row + 1) * 768 + c0);
    const uint32_t cu[4] = {cur.x, cur.y, cur.z, cur.w}, pu[4] = {prv.x, prv.y, prv.z, prv.w}, nu[4] = {nxt.x, nxt.y, nxt.z, nxt.w};
    uint32_t ou[4];
#pragma unroll
    for (int q = 0; q < 4; ++q) {
      const int c = c0 + 2 * q;
      float a0 = cw[c] * blo(pu[q]) + cw[768 + c] * blo(cu[q]) + cw[1536 + c] * blo(nu[q]) + cb[c];
      float a1 = cw[c + 1] * bhi(pu[q]) + cw[768 + c + 1] * bhi(cu[q]) + cw[1536 + c + 1] * bhi(nu[q]) + cb[c + 1];
      ou[q] = pack2(siluf(a0), siluf(a1));
    }
    *(uint4*)(xo + (size_t)row * 768 + c0) = make_uint4(ou[0], ou[1], ou[2], ou[3]);
  }
}

DI int scan_row(int b, int dir, int s) {
  if (s < 256) { int t = dir ? 255 - s : s; return NL + b * 256 + t; }
  int t = s - 256;
  if (dir) t = 8191 - t;
  return b * 8192 + t;
}

template <bool GLA>
DI void scan_item(const Params& p, const int wid, int layer, int item, char* lds) {
  constexpr int CT = 16;
  constexpr int V = GLA ? 128 : 64;
  constexpr int NJ = V / 32;
  constexpr int BV = V / 16;
  float* a_s = (float*)lds;
  float* c_s = a_s + CT * 64;
  float* w_s = c_s + CT * 64;
  float* b_s = w_s + CT * 64;
  float* x_s = b_s + CT * V;
  float* op = x_s + (GLA ? 0 : CT * V);
  float* wg_s = op + CT * 4 * V;
  const int tid = tid_fresh(p, wid), lane = tid & 63, wave = tid >> 6;
  int head, dir, b;
  if (GLA) { head = item & 3; dir = (item >> 2) & 1; b = item >> 3; } else { head = item & 7; dir = (item >> 3) & 1; b = item >> 4; }
  const bf16* xbc = (const bf16*)(p.ws + OFF_XBC2);
  const bf16* gq = (const bf16*)(p.ws + OFF_GQ);
  const bf16* gk = (const bf16*)(p.ws + OFF_GK);
  const bf16* gv = (const bf16*)(p.ws + OFF_GV);
  const float* dtlr = (const float*)(p.ws + OFF_DTLR);
  bf16* yout = (bf16*)(p.ws + (GLA ? (dir ? OFF_YGB : OFF_YGF) : (dir ? OFF_YSB : OFF_YSF)));
  const int ocol = head * V;
  float Aneg = 0.f, Dsk = 0.f, dtb = 0.f;
  if (!GLA) {
    Aneg = -expf(p.a_log[layer * 16 + dir * 8 + head]);
    Dsk = p.ssm_d[layer * 16 + dir * 8 + head];
    dtb = p.dt_bias[layer * 16 + dir * 8 + head];
  } else {
    const float* wg = p.gla_w_gate + ((size_t)(layer * 2 + dir) * 16) * 256 + head * 64;
    for (int idx = tid; idx < 16 * 64; idx += 256) wg_s[idx] = wg[(idx >> 6) * 256 + (idx & 63)];
    if (tid < 64) wg_s[1024 + tid] = p.gla_b_gate[(layer * 2 + dir) * 256 + head * 64 + tid];
  }
  const int st = tid >> 4, sk4 = (tid & 15) * 4, sv = (tid & 15) * BV;
  const int vq = lane & 31, kg = wave * 2 + (lane >> 5);
  float S[8][NJ];
#pragma unroll
  for (int i = 0; i < 8; ++i)
#pragma unroll
    for (int j = 0; j < NJ; ++j) S[i][j] = 0.f;

  uint2 ra, rc; uint4 rbv; float rdt = 0.f; float4 rlr0, rlr1, rlr2, rlr3;
  rlr0 = rlr1 = rlr2 = rlr3 = make_float4(0.f, 0.f, 0.f, 0.f);
  rbv = make_uint4(0, 0, 0, 0);
#define SCAN_PREFETCH(chunk_)                                                                   \
  {                                                                                             \
    const int row_ = scan_row(b, dir, (chunk_) * CT + st);                                      \
    if (GLA) {                                                                                  \
      ra = *(const uint2*)(gk + (size_t)row_ * 256 + head * 64 + sk4);                          \
      rc = *(const uint2*)(gq + (size_t)row_ * 256 + head * 64 + sk4);                          \
      rbv = *(const uint4*)(gv + (size_t)row_ * 512 + head * 128 + sv);                         \
      const float* lr_ = dtlr + (size_t)row_ * 48 + 16 + dir * 16;                              \
      rlr0 = *(const float4*)(lr_); rlr1 = *(const float4*)(lr_ + 4);                           \
      rlr2 = *(const float4*)(lr_ + 8); rlr3 = *(const float4*)(lr_ + 12);                      \
    } else {                                                                                    \
      const int g_ = head >> 2;                                                                 \
      ra = *(const uint2*)(xbc + (size_t)row_ * 768 + 512 + g_ * 64 + sk4);                     \
      rc = *(const uint2*)(xbc + (size_t)row_ * 768 + 640 + g_ * 64 + sk4);                     \
      const uint2 t_ = *(const uint2*)(xbc + (size_t)row_ * 768 + head * 64 + sv);              \
      rbv.x = t_.x; rbv.y = t_.y;                                                               \
      rdt = dtlr[(size_t)row_ * 48 + dir * 8 + head];                                           \
    }                                                                                           \
  }
  SCAN_PREFETCH(0);
  constexpr int NCH = KEYS / CT;
  for (int chunk = 0; chunk < NCH; ++chunk) {
    {
      const float cscale = GLA ? 0.125f : 1.f;
      *(float4*)(a_s + st * 64 + sk4) = make_float4(blo(ra.x), bhi(ra.x), blo(ra.y), bhi(ra.y));
      *(float4*)(c_s + st * 64 + sk4) = make_float4(blo(rc.x) * cscale, bhi(rc.x) * cscale, blo(rc.y) * cscale, bhi(rc.y) * cscale);
      if (GLA) {
        *(float4*)(b_s + st * V + sv) = make_float4(blo(rbv.x), bhi(rbv.x), blo(rbv.y), bhi(rbv.y));
        *(float4*)(b_s + st * V + sv + 4) = make_float4(blo(rbv.z), bhi(rbv.z), blo(rbv.w), bhi(rbv.w));
        float4 zb = *(const float4*)(wg_s + 1024 + sk4);
        float z0 = zb.x, z1 = zb.y, z2 = zb.z, z3 = zb.w;
#define GROW(r_, lv_)                                                  \
  {                                                                    \
    const float4 w0_ = *(const float4*)(wg_s + (r_) * 64 + sk4);       \
    z0 = fmaf((lv_), w0_.x, z0); z1 = fmaf((lv_), w0_.y, z1); z2 = fmaf((lv_), w0_.z, z2); z3 = fmaf((lv_), w0_.w, z3); \
  }
        GROW(0, rlr0.x) GROW(1, rlr0.y) GROW(2, rlr0.z) GROW(3, rlr0.w)
        GROW(4, rlr1.x) GROW(5, rlr1.y) GROW(6, rlr1.z) GROW(7, rlr1.w)
        GROW(8, rlr2.x) GROW(9, rlr2.y) GROW(10, rlr2.z) GROW(11, rlr2.w)
        GROW(12, rlr3.x) GROW(13, rlr3.y) GROW(14, rlr3.z) GROW(15, rlr3.w)
#define LSIG16(zz) expf(((zz) >= 0.f ? -log1pf(expf(-(zz))) : (zz) - log1pf(expf(zz))) * (1.f / 16.f))
        *(float4*)(w_s + st * 64 + sk4) = make_float4(LSIG16(z0), LSIG16(z1), LSIG16(z2), LSIG16(z3));
      } else {
        float zz = rdt + dtb;
        float dt = zz > 20.f ? zz : log1pf(expf(zz));
        float4 xv = make_float4(blo(rbv.x), bhi(rbv.x), blo(rbv.y), bhi(rbv.y));
        *(float4*)(b_s + st * V + sv) = make_float4(xv.x * dt, xv.y * dt, xv.z * dt, xv.w * dt);
        *(float4*)(x_s + st * V + sv) = xv;
        if ((tid & 15) == 0) w_s[st] = expf(dt * Aneg);
      }
    }
    __syncthreads();
    if (chunk + 1 < NCH) SCAN_PREFETCH(chunk + 1);
#pragma unroll 4
    for (int tt = 0; tt < CT; ++tt) {
      const float4 a0 = *(const float4*)(a_s + tt * 64 + kg * 8), a1 = *(const float4*)(a_s + tt * 64 + kg * 8 + 4);
      const float4 c0 = *(const float4*)(c_s + tt * 64 + kg * 8), c1 = *(const float4*)(c_s + tt * 64 + kg * 8 + 4);
      const float av[8] = {a0.x, a0.y, a0.z, a0.w, a1.x, a1.y, a1.z, a1.w};
      const float cv[8] = {c0.x, c0.y, c0.z, c0.w, c1.x, c1.y, c1.z, c1.w};
      float wv[8];
      if (GLA) {
        const float4 w0 = *(const float4*)(w_s + tt * 64 + kg * 8), w1 = *(const float4*)(w_s + tt * 64 + kg * 8 + 4);
        wv[0] = w0.x; wv[1] = w0.y; wv[2] = w0.z; wv[3] = w0.w; wv[4] = w1.x; wv[5] = w1.y; wv[6] = w1.z; wv[7] = w1.w;
      } else {
        const float w = w_s[tt];
#pragma unroll
        for (int i = 0; i < 8; ++i) wv[i] = w;
      }
      float bv[NJ], o[NJ];
#pragma unroll
      for (int j = 0; j < NJ; ++j) { bv[j] = b_s[tt * V + vq + 32 * j]; o[j] = 0.f; }
#pragma unroll
      for (int i = 0; i < 8; ++i)
#pragma unroll
        for (int j = 0; j < NJ; ++j) {
          S[i][j] = fmaf(wv[i], S[i][j], av[i] * bv[j]);
          o[j] = fmaf(cv[i], S[i][j], o[j]);
        }
#pragma unroll
      for (int j = 0; j < NJ; ++j) {
        o[j] += __shfl_xor(o[j], 32);
        if (lane < 32) op[(tt * 4 + wave) * V + vq + 32 * j] = o[j];
      }
    }
    __syncthreads();
    {
      const int row = scan_row(b, dir, chunk * CT + st);
#pragma unroll
      for (int q = 0; q < BV / 4; ++q) {
        const int vc = sv + 4 * q;
        float4 o0 = *(const float4*)(op + (st * 4 + 0) * V + vc), o1 = *(const float4*)(op + (st * 4 + 1) * V + vc);
        float4 o2 = *(const float4*)(op + (st * 4 + 2) * V + vc), o3 = *(const float4*)(op + (st * 4 + 3) * V + vc);
        float r0 = o0.x + o1.x + o2.x + o3.x, r1 = o0.y + o1.y + o2.y + o3.y, r2 = o0.z + o1.z + o2.z + o3.z, r3 = o0.w + o1.w + o2.w + o3.w;
        if (!GLA) {
          float4 xv = *(const float4*)(x_s + st * V + vc);
          r0 = fmaf(Dsk, xv.x, r0); r1 = fmaf(Dsk, xv.y, r1); r2 = fmaf(Dsk, xv.z, r2); r3 = fmaf(Dsk, xv.w, r3);
        }
        uint2 pk; pk.x = pack2(r0, r1); pk.y = pack2(r2, r3);
        *(uint2*)(yout + (size_t)row * 512 + ocol + vc) = pk;
      }
    }
  }
  __syncthreads();
#undef SCAN_PREFETCH
#undef GROW
#undef LSIG16
}

DI bf16x8 pack8(const f32x16& x, int s) {
  uint32_t p0 = pack2(x[8 * s], x[8 * s + 1]), p1 = pack2(x[8 * s + 2], x[8 * s + 3]);
  uint32_t p2 = pack2(x[8 * s + 4], x[8 * s + 5]), p3 = pack2(x[8 * s + 6], x[8 * s + 7]);
  uint4 u = make_uint4(p0, p1, p2, p3);
  return __builtin_bit_cast(bf16x8, u);
}

template <bool GLA>
DI void cscan_item(const Params& p, const int wid, int layer, int item, char* lds) {
  constexpr int RS = 72;
  bf16* Qm = (bf16*)lds;
  bf16* Km = Qm + 64 * RS;
  bf16* KeT = Km + 64 * RS;
  bf16* bT = KeT + 64 * RS;
  bf16* ST = bT + 64 * RS;
  char* R = (char*)(ST + 64 * RS);
  float* Gf = (float*)R;
  bf16* Cm = (bf16*)R;
  float* Gs = (float*)(R + 64 * RS * 2);
  float* tot = (float*)(R + 16384);
  float* lr_s = tot + 256;
  const int tid = tid_fresh(p, wid), lane = tid & 63, wave = tid >> 6, l31 = lane & 31, lh = lane >> 5;
  const int nt = wave & 1, vh = wave >> 1;
  int head, dir, b, vhalf = 0;
  if (GLA) { vhalf = item & 1; head = (item >> 1) & 3; } else { head = item & 7; }
  dir = (item >> 3) & 1; b = item >> 4;
  const bf16* xbc = (const bf16*)(p.ws + OFF_XBC2);
  const bf16* gq = (const bf16*)(p.ws + OFF_GQ);
  const bf16* gk = (const bf16*)(p.ws + OFF_GK);
  const bf16* gv = (const bf16*)(p.ws + OFF_GV);
  const float* dtlr = (const float*)(p.ws + OFF_DTLR);
  bf16* yout = (bf16*)(p.ws + (GLA ? (dir ? OFF_YGB : OFF_YGF) : (dir ? OFF_YSB : OFF_YSF)));
  const int ocol = GLA ? head * 128 + vhalf * 64 : head * 64;
  float Aneg = 0.f, Dsk = 0.f, dtb = 0.f, bgk = 0.f;
  float wgk[16];
#pragma unroll
  for (int r = 0; r < 16; ++r) wgk[r] = 0.f;
  if (!GLA) {
    Aneg = -expf(p.a_log[layer * 16 + dir * 8 + head]);
    Dsk = p.ssm_d[layer * 16 + dir * 8 + head];
    dtb = p.dt_bias[layer * 16 + dir * 8 + head];
  } else {
    const float* wg = p.gla_w_gate + ((size_t)(layer * 2 + dir) * 16) * 256 + head * 64 + (tid & 63);
#pragma unroll
    for (int r = 0; r < 16; ++r) wgk[r] = wg[r * 256];
    bgk = p.gla_b_gate[(layer * 2 + dir) * 256 + head * 64 + (tid & 63)];
  }
  const int st = tid >> 2, k16 = (tid & 3) * 16;
  f32x16 Sacc;
#pragma unroll
  for (int i = 0; i < 16; ++i) Sacc[i] = 0.f;

  uint4 ra0, ra1, rc0, rc1, rb0, rb1; float4 rl;
#define CS_PREFETCH(chunk_)                                                                          \
  {                                                                                                  \
    const int row_ = scan_row(b, dir, (chunk_) * 64 + st);                                           \
    if (GLA) {                                                                                       \
      const uint4* ap_ = (const uint4*)(gk + (size_t)row_ * 256 + head * 64 + k16);                  \
      const uint4* cp_ = (const uint4*)(gq + (size_t)row_ * 256 + head * 64 + k16);                  \
      const uint4* bp_ = (const uint4*)(gv + (size_t)row_ * 512 + head * 128 + vhalf * 64 + k16);    \
      ra0 = ap_[0]; ra1 = ap_[1]; rc0 = cp_[0]; rc1 = cp_[1]; rb0 = bp_[0]; rb1 = bp_[1];            \
      rl = *(const float4*)(dtlr + (size_t)row_ * 48 + 16 + dir * 16 + (tid & 3) * 4);               \
    } else {                                                                                         \
      const int g_ = head >> 2;                                                                      \
      const uint4* ap_ = (const uint4*)(xbc + (size_t)row_ * 768 + 512 + g_ * 64 + k16);             \
      const uint4* cp_ = (const uint4*)(xbc + (size_t)row_ * 768 + 640 + g_ * 64 + k16);             \
      const uint4* bp_ = (const uint4*)(xbc + (size_t)row_ * 768 + head * 64 + k16);                 \
      ra0 = ap_[0]; ra1 = ap_[1]; rc0 = cp_[0]; rc1 = cp_[1]; rb0 = bp_[0]; rb1 = bp_[1];            \
      rl.x = dtlr[(size_t)row_ * 48 + dir * 8 + head]; rl.y = 0.f; rl.z = 0.f; rl.w = 0.f;           \
    }                                                                                                \
  }
  CS_PREFETCH(0);
#pragma unroll 1
  for (int chunk = 0; chunk < KEYS / 64; ++chunk) {
    float dt = 0.f;
    if (GLA) {
      *(float4*)(lr_s + st * 16 + (tid & 3) * 4) = rl;
      __syncthreads();
      float Gl[16];
      float run = 0.f;
#pragma unroll
      for (int i = 0; i < 16; ++i) {
        const float* lrp = lr_s + (wave * 16 + i) * 16;
        const float4 l0 = *(const float4*)(lrp), l1 = *(const float4*)(lrp + 4), l2 = *(const float4*)(lrp + 8), l3 = *(const float4*)(lrp + 12);
        float z = bgk;
        z = fmaf(l0.x, wgk[0], z); z = fmaf(l0.y, wgk[1], z); z = fmaf(l0.z, wgk[2], z); z = fmaf(l0.w, wgk[3], z);
        z = fmaf(l1.x, wgk[4], z); z = fmaf(l1.y, wgk[5], z); z = fmaf(l1.z, wgk[6], z); z = fmaf(l1.w, wgk[7], z);
        z = fmaf(l2.x, wgk[8], z); z = fmaf(l2.y, wgk[9], z); z = fmaf(l2.z, wgk[10], z); z = fmaf(l2.w, wgk[11], z);
        z = fmaf(l3.x, wgk[12], z); z = fmaf(l3.y, wgk[13], z); z = fmaf(l3.z, wgk[14], z); z = fmaf(l3.w, wgk[15], z);
        run -= (fmaxf(-z, 0.f) + __logf(1.f + __expf(-fabsf(z)))) * (1.f / 16.f);
        Gl[i] = run;
      }
      tot[wave * 64 + lane] = run;
      __syncthreads();
      float off = 0.f;
      if (wave > 0) off += tot[lane];
      if (wave > 1) off += tot[64 + lane];
      if (wave > 2) off += tot[128 + lane];
#pragma unroll
      for (int i = 0; i < 16; ++i) Gf[(wave * 16 + i) * 64 + lane] = Gl[i] + off;
    } else {
      const float zz = rl.x + dtb;
      dt = zz > 20.f ? zz : log1pf(expf(zz));
      if ((tid & 3) == 0) lr_s[st] = dt;
      __syncthreads();
      if (wave == 0) {
        float g = lr_s[lane] * Aneg;
#pragma unroll
        for (int o = 1; o < 64; o <<= 1) {
          const float v = __shfl_up(g, o);
          if (lane >= o) g += v;
        }
        Gs[lane] = g;
      }
    }
#pragma unroll
    for (int i = 0; i < 16; ++i)
      ST[(32 * (wave >> 1) + (i & 3) + 8 * (i >> 2) + 4 * lh) * RS + 32 * (wave & 1) + l31] = f2b(Sacc[i]);
    __syncthreads();
    {
      const uint32_t au[8] = {ra0.x, ra0.y, ra0.z, ra0.w, ra1.x, ra1.y, ra1.z, ra1.w};
      const uint32_t cu[8] = {rc0.x, rc0.y, rc0.z, rc0.w, rc1.x, rc1.y, rc1.z, rc1.w};
      const uint32_t bu[8] = {rb0.x, rb0.y, rb0.z, rb0.w, rb1.x, rb1.y, rb1.z, rb1.w};
      uint32_t qo[8], ko[8];
      if (GLA) {
#pragma unroll
        for (int q = 0; q < 4; ++q) {
          const float4 G4 = *(const float4*)(Gf + st * 64 + k16 + 4 * q);
          const float4 L4 = *(const float4*)(Gf + 63 * 64 + k16 + 4 * q);
          const float gg[4] = {G4.x, G4.y, G4.z, G4.w}, ll[4] = {L4.x, L4.y, L4.z, L4.w};
#pragma unroll
          for (int h2 = 0; h2 < 2; ++h2) {
            const int w = 2 * q + h2;
            const float a0 = blo(au[w]), a1 = bhi(au[w]), c0 = blo(cu[w]), c1 = bhi(cu[w]);
            const float g0 = gg[2 * h2], g1 = gg[2 * h2 + 1];
            qo[w] = pack2(c0 * 0.125f * __expf(g0), c1 * 0.125f * __expf(g1));
            ko[w] = pack2(a0 * __expf(-g0), a1 * __expf(-g1));
            KeT[(k16 + 2 * w) * RS + st] = f2b(a0 * __expf(ll[2 * h2] - g0));
            KeT[(k16 + 2 * w + 1) * RS + st] = f2b(a1 * __expf(ll[2 * h2 + 1] - g1));
            bT[(k16 + 2 * w) * RS + st] = (bf16)(bu[w] & 0xffffu);
            bT[(k16 + 2 * w + 1) * RS + st] = (bf16)(bu[w] >> 16);
          }
        }
      } else {
        const float Gt = Gs[st], GL = Gs[63];
        const float e1 = __expf(Gt), e3 = __expf(GL - Gt);
#pragma unroll
        for (int w = 0; w < 8; ++w) {
          const float a0 = blo(au[w]), a1 = bhi(au[w]), c0 = blo(cu[w]), c1 = bhi(cu[w]);
          qo[w] = pack2(c0 * e1, c1 * e1);
          ko[w] = au[w];
          KeT[(k16 + 2 * w) * RS + st] = f2b(a0 * e3);
          KeT[(k16 + 2 * w + 1) * RS + st] = f2b(a1 * e3);
          bT[(k16 + 2 * w) * RS + st] = f2b(blo(bu[w]) * dt);
          bT[(k16 + 2 * w + 1) * RS + st] = f2b(bhi(bu[w]) * dt);
        }
        *(uint4*)(Cm + st * RS + k16) = rc0;
        *(uint4*)(Cm + st * RS + k16 + 8) = rc1;
      }
      *(uint4*)(Qm + st * RS + k16) = make_uint4(qo[0], qo[1], qo[2], qo[3]);
      *(uint4*)(Qm + st * RS + k16 + 8) = make_uint4(qo[4], qo[5], qo[6], qo[7]);
      *(uint4*)(Km + st * RS + k16) = make_uint4(ko[0], ko[1], ko[2], ko[3]);
      *(uint4*)(Km + st * RS + k16 + 8) = make_uint4(ko[4], ko[5], ko[6], ko[7]);
    }
    __syncthreads();
    if (chunk + 1 < KEYS / 64) CS_PREFETCH(chunk + 1);
    const int trow = scan_row(b, dir, chunk * 64 + 32 * nt + l31);
    uint2 xr0 = make_uint2(0, 0), xr1 = xr0, xr2 = xr0, xr3 = xr0;
    if (!GLA) {
      const bf16* xp = xbc + (size_t)trow * 768 + head * 64 + 32 * vh + 4 * lh;
      xr0 = *(const uint2*)(xp); xr1 = *(const uint2*)(xp + 8); xr2 = *(const uint2*)(xp + 16); xr3 = *(const uint2*)(xp + 24);
    }
    f32x16 outv;
#pragma unroll
    for (int i = 0; i < 16; ++i) outv[i] = 0.f;
    const bf16* Qp = GLA ? Qm : Cm;
#pragma unroll
    for (int ms = 0; ms < 2; ++ms) {
      if (ms <= nt) {
        f32x16 at;
#pragma unroll
        for (int i = 0; i < 16; ++i) at[i] = 0.f;
#pragma unroll
        for (int ks = 0; ks < 4; ++ks) {
          const bf16x8 kf = *(const bf16x8*)(Km + (32 * ms + l31) * RS + ks * 16 + lh * 8);
          const bf16x8 qf = *(const bf16x8*)(Qp + (32 * nt + l31) * RS + ks * 16 + lh * 8);
          at = MFMA32(kf, qf, at);
        }
        if (!GLA) {
          const float gt = Gs[32 * nt + l31];
#pragma unroll
          for (int g4 = 0; g4 < 4; ++g4) {
            const float4 gs4 = *(const float4*)(Gs + 32 * ms + 8 * g4 + 4 * lh);
            const float gsv[4] = {gs4.x, gs4.y, gs4.z, gs4.w};
#pragma unroll
            for (int j = 0; j < 4; ++j) {
              const int sl = 8 * g4 + 4 * lh + j;
              const bool keep = (ms < nt) || (sl <= l31);
              at[4 * g4 + j] = keep ? at[4 * g4 + j] * __expf(gt - gsv[j]) : 0.f;
            }
          }
        } else if (ms == nt) {
#pragma unroll
          for (int i = 0; i < 16; ++i) {
            const int sl = (i & 3) + 8 * (i >> 2) + 4 * lh;
            at[i] = (sl <= l31) ? at[i] : 0.f;
          }
        }
#pragma unroll
        for (int s2 = 0; s2 < 2; ++s2) {
          const bf16x8 pf = pack8(at, s2);
          const bf16* vp = bT + (32 * vh + l31) * RS + 32 * ms + 16 * s2 + 4 * lh;
          const uint2 lo = *(const uint2*)vp, hi = *(const uint2*)(vp + 8);
          const uint4 u = make_uint4(lo.x, lo.y, hi.x, hi.y);
          outv = MFMA32(__builtin_bit_cast(bf16x8, u), pf, outv);
        }
      }
    }
#pragma unroll
    for (int ks = 0; ks < 4; ++ks) {
      const bf16x8 sf = *(const bf16x8*)(ST + (32 * vh + l31) * RS + ks * 16 + lh * 8);
      const bf16x8 qf = *(const bf16x8*)(Qm + (32 * nt + l31) * RS + ks * 16 + lh * 8);
      outv = MFMA32(sf, qf, outv);
    }
    {
      const float dec = GLA ? __expf(Gf[63 * 64 + 32 * (wave & 1) + l31]) : __expf(Gs[63]);
#pragma unroll
      for (int i = 0; i < 16; ++i) Sacc[i] *= dec;
#pragma unroll
      for (int ks = 0; ks < 4; ++ks) {
        const bf16x8 bf_ = *(const bf16x8*)(bT + (32 * (wave >> 1) + l31) * RS + ks * 16 + lh * 8);
        const bf16x8 kf = *(const bf16x8*)(KeT + (32 * (wave & 1) + l31) * RS + ks * 16 + lh * 8);
        Sacc = MFMA32(bf_, kf, Sacc);
      }
    }
    {
      bf16* yp = yout + (size_t)trow * 512 + ocol + 32 * vh + 4 * lh;
      const uint2 xr[4] = {xr0, xr1, xr2, xr3};
#pragma unroll
      for (int g4 = 0; g4 < 4; ++g4) {
        float r0 = outv[4 * g4], r1 = outv[4 * g4 + 1], r2 = outv[4 * g4 + 2], r3 = outv[4 * g4 + 3];
        if (!GLA) {
          r0 = fmaf(Dsk, blo(xr[g4].x), r0); r1 = fmaf(Dsk, bhi(xr[g4].x), r1);
          r2 = fmaf(Dsk, blo(xr[g4].y), r2); r3 = fmaf(Dsk, bhi(xr[g4].y), r3);
        }
        uint2 pk; pk.x = pack2(r0, r1); pk.y = pack2(r2, r3);
        *(uint2*)(yp + 8 * g4) = pk;
      }
    }
    __syncthreads();
  }
#undef CS_PREFETCH
}


DI void attn_item(const Params& p, const int wid, int layer, int b, int head, int qrow0, int nkeys, char* lds) {
  bf16* Ks = (bf16*)lds;
  bf16* Vs = Ks + 64 * 136;
  bf16* Qa = (bf16*)(p.ws + OFF_QA);
  const bf16* Ka = (const bf16*)(p.ws + OFF_KA);
  const bf16* Vt = (const bf16*)(p.ws + OFF_VT) + (size_t)(b * 4 + head) * 128 * KEYS;
  const int tid = tid_fresh(p, wid), lane = tid & 63, wave = tid >> 6, l31 = lane & 31, lh = lane >> 5;

  bf16* Qs = Vs + 128 * 68;
#pragma unroll
  for (int i = 0; i < 8; ++i) {
    const int ch = tid + 256 * i;
    *(uint4*)(Qs + (ch >> 4) * 136 + (ch & 15) * 8) = *(const uint4*)(Qa + (size_t)(qrow0 + (ch >> 4)) * 512 + head * 128 + (ch & 15) * 8);
  }
  const bf16* qsw = Qs + (wave * 32 + l31) * 136 + lh * 8;
  f32x16 O[2][4];
#pragma unroll
  for (int c = 0; c < 2; ++c)
#pragma unroll
    for (int vt = 0; vt < 4; ++vt)
#pragma unroll
      for (int i = 0; i < 16; ++i) O[c][vt][i] = 0.f;
  float mrun[2] = {-1e30f, -1e30f}, lrun[2] = {0.f, 0.f};

  const int lkey = tid >> 2, lkq = (tid & 3) * 32, lvr = tid >> 1, lvh = (tid & 1) * 32;
#define KROW(key) ((key) < 256 ? NL + b * 256 + (key) : b * 8192 + (key) - 256)
#define KVLOAD(k0_)                                                                                  \
  {                                                                                                  \
    const uint4* kp_ = (const uint4*)(Ka + (size_t)KROW((k0_) + lkey) * 512 + head * 128 + lkq);      \
    rk0 = kp_[0]; rk1 = kp_[1]; rk2 = kp_[2]; rk3 = kp_[3];                                          \
    const uint4* vp_ = (const uint4*)(Vt + (size_t)lvr * KEYS + (k0_) + lvh);                        \
    rv0 = vp_[0]; rv1 = vp_[1]; rv2 = vp_[2]; rv3 = vp_[3];                                          \
  }
#define VST2(dst_, val) { (dst_)[0] = make_uint2((val).x, (val).y); (dst_)[1] = make_uint2((val).z, (val).w); }
  uint4 rk0, rk1, rk2, rk3, rv0, rv1, rv2, rv3;
  KVLOAD(0);
#pragma unroll 1
  for (int k0 = 0; k0 < nkeys; k0 += 64) {
    {
      uint4* kd = (uint4*)(Ks + lkey * 136 + lkq);
      kd[0] = rk0; kd[1] = rk1; kd[2] = rk2; kd[3] = rk3;
      uint2* vd = (uint2*)(Vs + lvr * 68 + lvh);
      VST2(vd, rv0); VST2(vd + 2, rv1); VST2(vd + 4, rv2); VST2(vd + 6, rv3);
    }
    __syncthreads();
    if (k0 + 64 < nkeys) KVLOAD(k0 + 64);
#pragma unroll
    for (int c = 0; c < 2; ++c) {
#pragma unroll
      for (int mt = 0; mt < 2; ++mt) {
        f32x16 sv;
#pragma unroll
        for (int i = 0; i < 16; ++i) sv[i] = 0.f;
#pragma unroll
        for (int ks = 0; ks < 4; ++ks) {
          const bf16x8 qf = *(const bf16x8*)(qsw + c * 64 + ks * 16);
          const bf16x8 kf = *(const bf16x8*)(Ks + (mt * 32 + l31) * 136 + c * 64 + ks * 16 + lh * 8);
          sv = MFMA32(kf, qf, sv);
        }
        __builtin_amdgcn_sched_barrier(0);
        const bf16* vpb = Vs + l31 * 68 + mt * 32 + 4 * lh;
#define VLD_(vt, st) ({ const bf16* vp_ = vpb + (vt) * 32 * 68 + 16 * (st); const uint2 lo_ = *(const uint2*)vp_, hi_ = *(const uint2*)(vp_ + 8); \
                        __builtin_bit_cast(bf16x8, make_uint4(lo_.x, lo_.y, hi_.x, hi_.y)); })
        bf16x8 v0, v1, v2, v3;
        float mx = fmaxf(sv[0], sv[1]);
#pragma unroll
        for (int i = 2; i < 16; i += 2) mx = max3f(mx, sv[i], sv[i + 1]);
        mx = xhalf_max(mx);
        if (__any(mx - mrun[c] > 8.0f)) {
          const float mnew = fmaxf(mrun[c], mx);
          const float alpha = __builtin_amdgcn_exp2f(mrun[c] - mnew);
          mrun[c] = mnew;
          lrun[c] *= alpha;
#pragma unroll
          for (int vt = 0; vt < 4; ++vt)
#pragma unroll
            for (int i = 0; i < 16; ++i) O[c][vt][i] *= alpha;
        }
        float psum = 0.f;
#pragma unroll
        for (int i = 0; i < 16; ++i) {
          float pv = __builtin_amdgcn_exp2f(sv[i] - mrun[c]);
          sv[i] = pv;
          psum += pv;
        }
        lrun[c] += psum;
        v0 = VLD_(0, 0); v1 = VLD_(1, 0); v2 = VLD_(2, 0); v3 = VLD_(3, 0);
        __builtin_amdgcn_sched_barrier(0);
        {
          const bf16x8 pf = pack8(sv, 0);
          O[c][0] = MFMA32(v0, pf, O[c][0]); O[c][1] = MFMA32(v1, pf, O[c][1]);
          O[c][2] = MFMA32(v2, pf, O[c][2]); O[c][3] = MFMA32(v3, pf, O[c][3]);
          v0 = VLD_(0, 1); v1 = VLD_(1, 1); v2 = VLD_(2, 1); v3 = VLD_(3, 1);
        }
        __builtin_amdgcn_sched_barrier(0);
        {
          const bf16x8 pf = pack8(sv, 1);
          O[c][0] = MFMA32(v0, pf, O[c][0]); O[c][1] = MFMA32(v1, pf, O[c][1]);
          O[c][2] = MFMA32(v2, pf, O[c][2]); O[c][3] = MFMA32(v3, pf, O[c][3]);
        }
        __builtin_amdgcn_sched_barrier(0);
#undef VLD_
      }
    }
    __syncthreads();
  }
  const float lam = ((const float*)(p.ws + OFF_MISC))[layer];
  const float lam_init = layer == 0 ? 0.2f : 0.8f - 0.6f * 0.7408182206817179f;
  const float l1 = lrun[0] + __shfl_xor(lrun[0], 32);
  const float l2 = lrun[1] + __shfl_xor(lrun[1], 32);
  const float i1 = 1.f / l1, i2 = lam / l2;
  float ss = 0.f;
#pragma unroll
  for (int vt = 0; vt < 4; ++vt)
#pragma unroll
    for (int i = 0; i < 16; ++i) {
      float o = O[0][vt][i] * i1 - O[1][vt][i] * i2;
      O[0][vt][i] = o;
      ss += o * o;
    }
  ss += __shfl_xor(ss, 32);
  const float rstd = rsqrtf(ss * (1.f / 128.f) + EPS) * (1.f - lam_init);
  const float* nw = p.da_norm_w + layer * 128;
  bf16* orow = Qa + (size_t)(qrow0 + wave * 32 + l31) * 512 + head * 128;
#pragma unroll
  for (int vt = 0; vt < 4; ++vt)
#pragma unroll
    for (int g = 0; g < 4; ++g) {
      const int v0 = vt * 32 + 8 * g + 4 * lh;
      float4 w4 = *(const float4*)(nw + v0);
      uint2 pk;
      pk.x = pack2(O[0][vt][4 * g] * rstd * w4.x, O[0][vt][4 * g + 1] * rstd * w4.y);
      pk.y = pack2(O[0][vt][4 * g + 2] * rstd * w4.z, O[0][vt][4 * g + 3] * rstd * w4.w);
      *(uint2*)(orow + v0) = pk;
    }
}

DI void phase_mixers(const Params& p, const int wid, int layer, char* lds) {
  __shared__ int s_item;
  const int x = blockIdx.x & 7;
  unsigned* counter = (unsigned*)(p.ws + OFF_MISC + 64) + layer * 8 + x;
  const int total = layer == 0 ? 32 + 256 + 8 : 32 + 256;
  for (;;) {
    if (tid_fresh(p, wid) == 0) s_item = (int)atomicAdd(counter, 1u);
    __syncthreads();
    const int li = s_item;
    __syncthreads();
    if (li >= total) break;
    if (li < 32) {
      const int sid = li * 8 + x;
      if (sid < 128) cscan_item<true>(p, wid, layer, sid, lds);
      else cscan_item<false>(p, wid, layer, sid - 128, lds);
    } else if (li < 288) {
      const int a = li - 32;
      const int bh = x + 8 * (a >> 6), qb = a & 63;
      attn_item(p, wid, layer, bh >> 2, bh & 3, (bh >> 2) * 8192 + qb * 128, KEYS, lds);
    } else {
      const int c = x * 8 + (li - 288);
      const int bh = c >> 1, qb = c & 1;
      attn_item(p, wid, layer, bh >> 2, bh & 3, NL + (bh >> 2) * 256 + qb * 128, 256, lds);
    }
  }
}

DI void phase_z(const Params& p, const int wid, int layer, int M, char* lds) {
  const bf16* h = (const bf16*)(p.ws + OFF_H);
  const bf16* W2 = (const bf16*)(p.ws + OFF_W + (size_t)layer * LW + SZ_W1);
  bf16* Z = (bf16*)(p.ws + OFF_Z);
  const int tidf = tid_fresh(p, wid); const int lane = tidf & 63, wave = tidf >> 6, wm = wave >> 1, wn = wave & 1, l31 = lane & 31, lh = lane >> 5;
  constexpr int NTN = N2 / 128;
  int mt_, nt_;
  for (int it = 0; xcd_tile(it, M / 256, NTN, 12, mt_, nt_); ++it) {
    const int m0 = mt_ * 256, n0 = nt_ * 128;
    f32x16 acc[4][2];
    zero_acc<4, 2>(acc);
    gemm_main256(h + (size_t)m0 * 1024, 1024, W2 + (size_t)n0 * 1024, 1024, 1024, acc, lds, tidf);
#pragma unroll
    for (int tm = 0; tm < 4; ++tm)
#pragma unroll
      for (int tn = 0; tn < 2; ++tn) {
        const int col = n0 + wn * 64 + tn * 32 + l31;
        const int rowb = m0 + wm * 128 + tm * 32 + 4 * lh;
#pragma unroll
        for (int i = 0; i < 16; ++i) {
          const int row = rowb + (i & 3) + 8 * (i >> 2);
          Z[(size_t)row * 1536 + col] = f2b(acc[tm][tn][i]);
        }
      }
  }
}

DI void phase_post(const Params& p, const int wid, int layer, int M) {
  const int tidf = tid_fresh(p, wid); const int lane = tidf & 63, wave = tidf >> 6;
  bf16* Z = (bf16*)(p.ws + OFF_Z);
  const bf16* oda = (const bf16*)(p.ws + OFF_QA);
  const bf16* ysf = (const bf16*)(p.ws + OFF_YSF);
  const bf16* ysb = (const bf16*)(p.ws + OFF_YSB);
  const bf16* ygf = (const bf16*)(p.ws + OFF_YGF);
  const bf16* ygb = (const bf16*)(p.ws + OFF_YGB);
  const float* snw = p.ssm_norm_w + layer * 512;
  const float* gnw = p.gla_norm_w + layer * 128;
  const int c0 = lane * 8;
  for (int row = blockIdx.x * 4 + wave; row < M; row += gridDim.x * 4) {
    bf16* zr = Z + (size_t)row * 1536;
    {
      uint4 o = *(const uint4*)(oda + (size_t)row * 512 + c0);
      uint4 z = *(const uint4*)(zr + c0);
      const uint32_t ou[4] = {o.x, o.y, o.z, o.w}, zu[4] = {z.x, z.y, z.z, z.w};
      uint32_t r[4];
#pragma unroll
      for (int q = 0; q < 4; ++q) r[q] = pack2(blo(ou[q]) * siluf(blo(zu[q])), bhi(ou[q]) * siluf(bhi(zu[q])));
      *(uint4*)(zr + c0) = make_uint4(r[0], r[1], r[2], r[3]);
    }
    {
      uint4 yf = *(const uint4*)(ysf + (size_t)row * 512 + c0), yb = *(const uint4*)(ysb + (size_t)row * 512 + c0);
      uint4 z = *(const uint4*)(zr + 512 + c0);
      const uint32_t fu[4] = {yf.x, yf.y, yf.z, yf.w}, bu[4] = {yb.x, yb.y, yb.z, yb.w}, zu[4] = {z.x, z.y, z.z, z.w};
      float y[8];
      float ss = 0.f;
#pragma unroll
      for (int q = 0; q < 4; ++q) {
        y[2 * q] = (blo(fu[q]) + blo(bu[q])) * siluf(blo(zu[q]));
        y[2 * q + 1] = (bhi(fu[q]) + bhi(bu[q])) * siluf(bhi(zu[q]));
        ss += y[2 * q] * y[2 * q] + y[2 * q + 1] * y[2 * q + 1];
      }
#pragma unroll
      for (int m = 16; m >= 1; m >>= 1) ss += __shfl_xor(ss, m);
      const float rstd = rsqrtf(ss * (1.f / 256.f) + EPS);
      float4 w0 = *(const float4*)(snw + c0), w1 = *(const float4*)(snw + c0 + 4);
      uint32_t r[4];
      r[0] = pack2(y[0] * rstd * w0.x, y[1] * rstd * w0.y); r[1] = pack2(y[2] * rstd * w0.z, y[3] * rstd * w0.w);
      r[2] = pack2(y[4] * rstd * w1.x, y[5] * rstd * w1.y); r[3] = pack2(y[6] * rstd * w1.z, y[7] * rstd * w1.w);
      *(uint4*)(zr + 512 + c0) = make_uint4(r[0], r[1], r[2], r[3]);
    }
    {
      uint4 yf = *(const uint4*)(ygf + (size_t)row * 512 + c0), yb = *(const uint4*)(ygb + (size_t)row * 512 + c0);
      uint4 z = *(const uint4*)(zr + 1024 + c0);
      const uint32_t fu[4] = {yf.x, yf.y, yf.z, yf.w}, bu[4] = {yb.x, yb.y, yb.z, yb.w}, zu[4] = {z.x, z.y, z.z, z.w};
      float y[8];
      float ss = 0.f;
#pragma unroll
      for (int q = 0; q < 4; ++q) {
        y[2 * q] = blo(fu[q]) + blo(bu[q]);
        y[2 * q + 1] = bhi(fu[q]) + bhi(bu[q]);
        ss += y[2 * q] * y[2 * q] + y[2 * q + 1] * y[2 * q + 1];
      }
#pragma unroll
      for (int m = 8; m >= 1; m >>= 1) ss += __shfl_xor(ss, m);
      const float rstd = rsqrtf(ss * (1.f / 128.f) + EPS);
      const int cw = c0 & 127;
      float4 w0 = *(const float4*)(gnw + cw), w1 = *(const float4*)(gnw + cw + 4);
      uint32_t r[4];
      r[0] = pack2(y[0] * rstd * w0.x * siluf(blo(zu[0])), y[1] * rstd * w0.y * siluf(bhi(zu[0])));
      r[1] = pack2(y[2] * rstd * w0.z * siluf(blo(zu[1])), y[3] * rstd * w0.w * siluf(bhi(zu[1])));
      r[2] = pack2(y[4] * rstd * w1.x * siluf(blo(zu[2])), y[5] * rstd * w1.y * siluf(bhi(zu[2])));
      r[3] = pack2(y[6] * rstd * w1.z * siluf(blo(zu[3])), y[7] * rstd * w1.w * siluf(bhi(zu[3])));
      *(uint4*)(zr + 1024 + c0) = make_uint4(r[0], r[1], r[2], r[3]);
    }
  }
}

DI void phase_merge(const Params& p, const int wid, int layer, int M, char* lds) {
  const bf16* h = (const bf16*)(p.ws + OFF_H);
  const bf16* osg = (const bf16*)(p.ws + OFF_Z);
  const char* wb = p.ws + OFF_W + (size_t)layer * LW;
  const bf16* W3 = (const bf16*)(wb + SZ_W1 + SZ_W2);
  const bf16* Wout = (const bf16*)(wb + SZ_W1 + SZ_W2 + SZ_W3);
  bf16* U = (bf16*)(p.ws + OFF_U);
  const int tidf = tid_fresh(p, wid); const int lane = tidf & 63, wave = tidf >> 6, wm = wave >> 1, wn = wave & 1, l31 = lane & 31, lh = lane >> 5;
  constexpr int NTN = 1024 / 128;
  int mt_, nt_;
  for (int it = 0; xcd_tile(it, M / 128, NTN, 8, mt_, nt_); ++it) {
    const int m0 = mt_ * 128, n0 = nt_ * 128;
    f32x16 u[2][2];
    zero_acc<2, 2>(u);
#pragma unroll 1
    for (int br = 0; br < 3; ++br) {
      uint32_t* sgl = (uint32_t*)(lds + 36864) + tidf;
      {
        f32x16 g[2][2];
        zero_acc<2, 2>(g);
        gemm_main128(h + (size_t)m0 * 1024, 1024, W3 + (size_t)(br * 1024 + n0) * 1024, 1024, 1024, g, lds, tidf);
#pragma unroll
        for (int tm = 0; tm < 2; ++tm)
#pragma unroll
          for (int tn = 0; tn < 2; ++tn)
#pragma unroll
            for (int q = 0; q < 8; ++q) sgl[((tm * 2 + tn) * 8 + q) * 256] = pack2(sigmf(g[tm][tn][2 * q]), sigmf(g[tm][tn][2 * q + 1]));
      }
      f32x16 t[2][2];
      zero_acc<2, 2>(t);
      gemm_main128(osg + (size_t)m0 * 1536 + br * 512, 1536, Wout + (size_t)br * 1024 * 512 + (size_t)n0 * 512, 512, 512, t, lds, tidf);
#pragma unroll
      for (int tm = 0; tm < 2; ++tm)
#pragma unroll
        for (int tn = 0; tn < 2; ++tn)
#pragma unroll
          for (int q = 0; q < 8; ++q) {
            const uint32_t sgv = sgl[((tm * 2 + tn) * 8 + q) * 256];
            u[tm][tn][2 * q] = fmaf(blo(sgv), t[tm][tn][2 * q], u[tm][tn][2 * q]);
            u[tm][tn][2 * q + 1] = fmaf(bhi(sgv), t[tm][tn][2 * q + 1], u[tm][tn][2 * q + 1]);
          }
    }
#pragma unroll
    for (int tm = 0; tm < 2; ++tm)
#pragma unroll
      for (int tn = 0; tn < 2; ++tn) {
        const int col = n0 + wn * 64 + tn * 32 + l31;
        const int rowb = m0 + wm * 64 + tm * 32 + 4 * lh;
#pragma unroll
        for (int i = 0; i < 16; ++i) {
          const int row = rowb + (i & 3) + 8 * (i >> 2);
          U[(size_t)row * 1024 + col] = f2b(u[tm][tn][i]);
        }
      }
  }
}

DI void phase_out(const Params& p, const int wid, int layer, int M, const float* xl, const float* xc, float* ol, float* oc, char* lds) {
  const bf16* U = (const bf16*)(p.ws + OFF_U);
  const bf16* Wo = (const bf16*)(p.ws + OFF_W + (size_t)layer * LW + SZ_W1 + SZ_W2 + SZ_W3 + 3 * SZ_WOUT);
  const float* modv = (const float*)(p.ws + OFF_MOD) + (size_t)layer * 9 * 3072;
  const int tidf = tid_fresh(p, wid); const int lane = tidf & 63, wave = tidf >> 6, wm = wave >> 1, wn = wave & 1, l31 = lane & 31, lh = lane >> 5;
  constexpr int NTN = 1024 / 128;
  int mt_, nt_;
  for (int it = 0; xcd_tile(it, M / 256, NTN, 8, mt_, nt_); ++it) {
    const int m0 = mt_ * 256, n0 = nt_ * 128;
    f32x16 acc[4][2];
    zero_acc<4, 2>(acc);
    gemm_main256(U + (size_t)m0 * 1024, 1024, Wo + (size_t)n0 * 1024, 1024, 1024, acc, lds, tidf);
    const bool lat = m0 < NL;
    const int j = lat ? (m0 >> 13) : 8;
    const float* gate = modv + j * 3072 + 2048;
    const float* src = lat ? xl + (size_t)m0 * 1024 : xc + (size_t)(m0 - NL) * 1024;
    float* dst = lat ? ol + (size_t)m0 * 1024 : oc + (size_t)(m0 - NL) * 1024;
    uint32_t eoff = (uint32_t)((wm * 128 + 4 * lh) * 1024 + n0 + wn * 64 + l31);
    asm volatile("" : "+v"(eoff));
    const float* sp = src + eoff;
    float* dp = dst + eoff;
    const float* gp = gate + n0 + wn * 64 + l31;
#pragma unroll
    for (int tm = 0; tm < 4; ++tm)
#pragma unroll
      for (int tn = 0; tn < 2; ++tn) {
        const float gt = gp[tn * 32];
#pragma unroll
        for (int i = 0; i < 16; ++i) {
          const int off = (tm * 32 + (i & 3) + 8 * (i >> 2)) * 1024 + tn * 32;
          dp[off] = sp[off] + gt * acc[tm][tn][i];
        }
        __builtin_amdgcn_sched_barrier(0);
      }
  }
}

DI void phase_final(const Params& p, const int wid) {
  const int tidf = tid_fresh(p, wid); const int lane = tidf & 63, wave = tidf >> 6;
  const int stride = gridDim.x * 4;
  for (int row0 = blockIdx.x * 4 + wave; row0 < NL; row0 += 2 * stride) {
    float4 v[2][4];
    float ss[2] = {0.f, 0.f};
#pragma unroll
    for (int r = 0; r < 2; ++r) {
      int row = row0 + r * stride;
      if (row >= NL) row = row0;
      const float* src = p.out + (size_t)row * 1024;
#pragma unroll
      for (int i = 0; i < 4; ++i) v[r][i] = *(const float4*)(src + (i * 64 + lane) * 4);
    }
#pragma unroll
    for (int r = 0; r < 2; ++r) {
#pragma unroll
      for (int i = 0; i < 4; ++i) ss[r] += v[r][i].x * v[r][i].x + v[r][i].y * v[r][i].y + v[r][i].z * v[r][i].z + v[r][i].w * v[r][i].w;
      ss[r] = wave_sum(ss[r]);
    }
#pragma unroll
    for (int r = 0; r < 2; ++r) {
      const int row = row0 + r * stride;
      if (row < NL) {
        float* dst = p.out + (size_t)row * 1024;
        const float rstd = rsqrtf(ss[r] * (1.f / 1024.f) + EPS);
#pragma unroll
        for (int i = 0; i < 4; ++i) {
          const int c = (i * 64 + lane) * 4;
          float4 w4 = *(const float4*)(p.final_norm_w + c);
          *(float4*)(dst + c) = make_float4(v[r][i].x * rstd * w4.x, v[r][i].y * rstd * w4.y, v[r][i].z * rstd * w4.z, v[r][i].w * rstd * w4.w);
        }
      }
    }
  }
}

__global__ void __launch_bounds__(256, 2) hybrid_trunk_mega(Params p) {
  cg::grid_group grid = cg::this_grid();
  const int wid = __builtin_amdgcn_readfirstlane((int)(threadIdx.x >> 6));
  __shared__ __attribute__((aligned(16))) char lds[LDS_BYTES];
  __shared__ uint4 xb_words;
  if (tid_fresh(p, wid) == 0) xb_words = make_uint4(0u, 0u, 0u, 0u);
  phase0(p, wid, lds);
  grid.sync();
  if (tid_fresh(p, wid) == 0) (void)xb_add(&((unsigned*)(p.ws + OFF_BAR))[XB_XCNT(xb_xcc_id())], 1u);
  float* ctx1 = (float*)(p.ws + OFF_CTX1);
#pragma unroll 1
  for (int layer = 0; layer < 2; ++layer) {
    const float* xl = layer == 0 ? p.x : p.out;
    const float* xc = layer == 0 ? p.ctx : ctx1;
    const int M = layer == 0 ? NT : NL;
    phase_h(p, wid, layer, xl, xc, NT);
    xcd_barrier(p, wid, (volatile LAS unsigned*)&xb_words);
    phase_p1(p, wid, layer, NT, lds);
    xcd_barrier(p, wid, (volatile LAS unsigned*)&xb_words);
#ifdef DUP_GEMM
    phase_p1(p, wid, layer, NT, lds);
    xcd_barrier(p, wid, (volatile LAS unsigned*)&xb_words);
#endif
    phase_conv(p, wid, layer);
    xcd_barrier(p, wid, (volatile LAS unsigned*)&xb_words);
#ifdef PROBE_SCAN
    for (int it = blockIdx.x; it < 192; it += gridDim.x) { if (it < 64) scan_item<true>(p, wid, layer, it, lds); else scan_item<false>(p, wid, layer, it - 64, lds); }
    xcd_barrier(p, wid, (volatile LAS unsigned*)&xb_words);
#endif
    phase_mixers(p, wid, layer, lds);
    xcd_barrier(p, wid, (volatile LAS unsigned*)&xb_words);
    phase_z(p, wid, layer, M, lds);
    xcd_barrier(p, wid, (volatile LAS unsigned*)&xb_words);
#ifdef DUP_GEMM
    phase_z(p, wid, layer, M, lds);
    xcd_barrier(p, wid, (volatile LAS unsigned*)&xb_words);
#endif
    phase_post(p, wid, layer, M);
    xcd_barrier(p, wid, (volatile LAS unsigned*)&xb_words);
    phase_merge(p, wid, layer, M, lds);
    xcd_barrier(p, wid, (volatile LAS unsigned*)&xb_words);
#ifdef DUP_GEMM
    phase_merge(p, wid, layer, M, lds);
    xcd_barrier(p, wid, (volatile LAS unsigned*)&xb_words);
#endif
    phase_out(p, wid, layer, M, xl, xc, p.out, ctx1, lds);
    xcd_barrier(p, wid, (volatile LAS unsigned*)&xb_words);
  }
  phase_final(p, wid);
}

extern "C" void kernel_launch(void* const* d_in, const int* in_sizes, int n_in, void* d_out, int out_size, void* d_ws,
                              size_t ws_size, hipStream_t stream) {
  (void)in_sizes; (void)n_in; (void)out_size;
  static int grid_blocks = 0;
  if (!grid_blocks) {
    int dev = 0, cus = 0, per_cu = 0;
    hipGetDevice(&dev);
    hipDeviceGetAttribute(&cus, hipDeviceAttributeMultiprocessorCount, dev);
    hipOccupancyMaxActiveBlocksPerMultiprocessor(&per_cu, hybrid_trunk_mega, 256, 0);
    (void)per_cu;
    grid_blocks = cus * 2;
  }
  if (ws_size < WS_TOTAL) { fprintf(stderr, "workspace too small: %zu < %zu\n", ws_size, (size_t)WS_TOTAL); return; }
  Params p{};
  const float** f = (const float**)&p;
  for (int i = 0; i < 24; ++i) f[i] = (const float*)d_in[i];
  p.wid = 0; p.pad_ = 0;
  p.out = (float*)d_out;
  p.ws = (char*)d_ws;
  void* args[] = {&p};
  hipError_t e = hipLaunchCooperativeKernel((const void*)hybrid_trunk_mega, dim3(grid_blocks), dim3(256), args, 0, stream);
  if (e != hipSuccess && (grid_blocks & 15) == 0) {
    (void)hipGetLastError();
    grid_blocks >>= 1;
    e = hipLaunchCooperativeKernel((const void*)hybrid_trunk_mega, dim3(grid_blocks), dim3(256), args, 0, stream);
  }
  if (e != hipSuccess) fprintf(stderr, "cooperative launch failed: %s (grid %d)\n", hipGetErrorString(e), grid_blocks);
}
```

```cpp
#include <hip/hip_runtime.h>
#include <hip/hip_cooperative_groups.h>
#include <stdint.h>
#include <stdio.h>
namespace cg = cooperative_groups;

typedef unsigned short bf16;
using bf16x8 = __attribute__((ext_vector_type(8))) short;
using f32x16 = __attribute__((ext_vector_type(16))) float;
using u32x8 = __attribute__((ext_vector_type(8))) unsigned int;
#define DI __device__ __forceinline__
#define MFMA32(a, b, c) __builtin_amdgcn_mfma_f32_32x32x16_bf16((a), (b), (c), 0, 0, 0)
#define MM(a_, b_, c_) (SWAP ? MFMA32((b_), (a_), (c_)) : MFMA32((a_), (b_), (c_)))

typedef __bf16 hbf16x2 __attribute__((ext_vector_type(2)));
typedef float f32x2 __attribute__((ext_vector_type(2)));
DI uint32_t pack2(float a, float b) { f32x2 v = {a, b}; return __builtin_bit_cast(uint32_t, __builtin_convertvector(v, hbf16x2)); }
DI bf16 f2b(float x) { return (bf16)(pack2(x, x) & 0xffffu); }
DI float blo(uint32_t u) { return __uint_as_float(u << 16); }
DI float bhi(uint32_t u) { return __uint_as_float(u & 0xffff0000u); }
DI float max3f(float a, float b, float c) { float r; asm("v_max3_f32 %0, %1, %2, %3" : "=v"(r) : "v"(a), "v"(b), "v"(c)); return r; }
DI float xhalf_max(float x) {
  const unsigned u = __float_as_uint(x);
  const auto r = __builtin_amdgcn_permlane32_swap(u, u, false, false);
  float m; asm("v_max_f32 %0, %1, %2" : "=v"(m) : "v"(__uint_as_float(r[0])), "v"(__uint_as_float(r[1]))); return m;
}
DI float siluf(float x) { return x / (1.f + __expf(-x)); }
DI float sigmf(float x) { return 1.f / (1.f + __expf(-x)); }

constexpr int NB = 8, SEQ = 8192, CTX = 256, DM = 1024;
constexpr int NL = NB * SEQ;
constexpr int NC = NB * CTX;
constexpr int NT = NL + NC;
constexpr int KEYS = CTX + SEQ;
constexpr int INW = 7984;
constexpr int N1 = 3456, N2 = 1536, N3 = 3072;
constexpr float EPS = 1e-6f;
constexpr float QSCALE = 0.125f * 1.4426950408889634f;

constexpr size_t al256(size_t x) { return (x + 255) & ~(size_t)255; }
constexpr size_t SZ_W1 = (size_t)N1 * 1024 * 2, SZ_W2 = (size_t)N2 * 1024 * 2, SZ_W3 = (size_t)N3 * 1024 * 2;
constexpr size_t SZ_WOUT = (size_t)1024 * 512 * 2, SZ_WO = (size_t)1024 * 1024 * 2;
constexpr size_t LW = SZ_W1 + SZ_W2 + SZ_W3 + 3 * SZ_WOUT + SZ_WO;
constexpr size_t OFF_W = 0;
constexpr size_t OFF_MOD = OFF_W + 2 * LW;
constexpr size_t OFF_ROPE = OFF_MOD + al256((size_t)2 * 9 * 3072 * 4);
constexpr size_t OFF_MISC = OFF_ROPE + (size_t)128 * 16 * 2 * 4;
constexpr size_t OFF_H = OFF_MISC + 256;
constexpr size_t OFF_QA = OFF_H + (size_t)NT * 1024 * 2;
constexpr size_t OFF_KA = OFF_QA + (size_t)NT * 512 * 2;
constexpr size_t OFF_VT = OFF_KA + (size_t)NT * 512 * 2;
constexpr size_t OFF_XBC = OFF_VT + (size_t)NT * 512 * 2;
constexpr size_t OFF_XBC2 = OFF_XBC + (size_t)NT * 768 * 2;
constexpr size_t OFF_GQ = OFF_XBC2 + (size_t)NT * 768 * 2;
constexpr size_t OFF_GK = OFF_GQ + (size_t)NT * 256 * 2;
constexpr size_t OFF_GV = OFF_GK + (size_t)NT * 256 * 2;
constexpr size_t OFF_DTLR = OFF_GV + (size_t)NT * 512 * 2;
constexpr size_t OFF_YSF = OFF_DTLR + (size_t)NT * 48 * 4;
constexpr size_t OFF_YSB = OFF_YSF + (size_t)NT * 512 * 2;
constexpr size_t OFF_YGF = OFF_YSB + (size_t)NT * 512 * 2;
constexpr size_t OFF_YGB = OFF_YGF + (size_t)NT * 512 * 2;
constexpr size_t OFF_CTX1 = OFF_YGB + (size_t)NT * 512 * 2;
constexpr size_t OFF_BAR = OFF_CTX1 + (size_t)NC * 1024 * 4;
constexpr size_t WS_TOTAL = OFF_BAR + 16384;
constexpr size_t OFF_Z = OFF_KA;
constexpr size_t OFF_U = OFF_GQ;
static_assert(WS_TOTAL <= ((size_t)1 << 30), "workspace too large");
static_assert((size_t)NT * 1536 * 2 <= OFF_XBC2 - OFF_KA, "Z overlay");
static_assert((size_t)NT * 1024 * 2 <= OFF_DTLR - OFF_GQ, "U overlay");

struct Params {
  const float *x, *c, *ctx, *c_ctx, *w_mod, *b_mod, *norm_w, *w_in, *da_lambda, *da_norm_w, *w_out_da;
  const float *conv_w, *conv_b, *dt_bias, *a_log, *ssm_d, *ssm_norm_w, *w_out_ssm;
  const float *gla_w_gate, *gla_b_gate, *gla_norm_w, *w_out_gla, *w_o, *final_norm_w;
  float* out;
  char* ws;
  int wid, pad_;
};
DI int tid_fresh(const Params& p, const int wid) {
  int t = wid * 64 + (int)__builtin_amdgcn_mbcnt_hi(~0u, __builtin_amdgcn_mbcnt_lo(~0u, 0u));
  asm volatile("" : "+v"(t));
  return t;
}

constexpr int LDS_BYTES = 70 * 1024;

DI int map_w1(int n) {
  if (n < 1536) return n;
  if (n < 2048) return 2048 + (n - 1536);
  if (n < 2304) return 3072 + (n - 2048);
  if (n < 3328) return 3344 + (n - 2304);
  if (n < 3344) return 3328 + (n - 3328);
  if (n < 3376) return 4880 + (n - 3344);
  return -1;
}
DI int map_w2(int n) {
  if (n < 512) return 1536 + n;
  if (n < 1024) return 2560 + (n - 512);
  return 4368 + (n - 1024);
}

DI void tr_tile(const Params& p, const int wid, const float* __restrict__ src, int ldsrc, bf16* __restrict__ dst, int K, int n0, int k0, int mapk, float* tile) {
  const int tid = tid_fresh(p, wid), tx = tid & 63, ty = tid >> 6;
  const int n = n0 + tx;
  int col = n;
  if (mapk == 1) col = map_w1(n); else if (mapk == 2) col = map_w2(n); else if (mapk == 3) col = 4912 + n;
#pragma unroll
  for (int i = 0; i < 16; ++i) {
    int kk = ty + 4 * i;
    tile[kk * 65 + tx] = (col >= 0) ? src[(size_t)(k0 + kk) * ldsrc + col] : 0.f;
  }
  __syncthreads();
#pragma unroll
  for (int i = 0; i < 16; ++i) {
    int nn = ty + 4 * i;
    dst[(size_t)(n0 + nn) * K + k0 + tx] = f2b(tile[tx * 65 + nn]);
  }
  __syncthreads();
}

#define XB_TMO      128
#define XB_XCNT(j)  (256  + 64 * (j))
#define XB_XSUB(j)  (1280 + 64 * (j))
#define XB_XGEN(j)  (2304 + 64 * (j))
#define XB_TOP      3328
#define XB_TOPGEN   3392
#define XCD_BAR_WORDS 3456
#define XB_SPIN_CAP (1u << 18)
#define LAS __attribute__((address_space(3)))
DI unsigned xb_ld(unsigned* q) { return __hip_atomic_load(q, __ATOMIC_RELAXED, __HIP_MEMORY_SCOPE_AGENT); }
DI unsigned xb_add(unsigned* q, unsigned v) { return __hip_atomic_fetch_add(q, v, __ATOMIC_RELAXED, __HIP_MEMORY_SCOPE_AGENT); }
DI unsigned xb_xcc_id() { return (unsigned)__builtin_amdgcn_s_getreg((3 << 11) | 20) & 0xFu; }
#define XB_SPIN(cond, bar) do { unsigned _sp = 0; while (cond) { __builtin_amdgcn_s_sleep(1); \
    if ((++_sp & 255u) == 0u) { if (xb_ld(&(bar)[XB_TMO])) break; if (_sp > XB_SPIN_CAP) { atomicAdd(&(bar)[XB_TMO], 1u); break; } } } } while (0)
struct XcdBarrier { unsigned* bar; unsigned x; volatile LAS unsigned* st; };
DI XcdBarrier xcd_barrier_post(unsigned* bar, volatile LAS unsigned* st, bool t0) {
  XcdBarrier b; b.bar = bar; b.x = xb_xcc_id(); b.st = st;
  if (t0) (void)xb_add(&bar[XB_XCNT(b.x)], 1u);
  return b;
}
DI void xcd_barrier_complete(unsigned* bar, unsigned x, unsigned& nloc, unsigned& nx) {
  const unsigned G = gridDim.x * gridDim.y * gridDim.z;
  unsigned sum, cnt, mine, sp = 0u;
  for (;;) {
    sum = 0u; cnt = 0u; mine = 0u;
#pragma unroll
    for (unsigned j = 0; j < 16; ++j) { const unsigned c = xb_ld(&bar[XB_XCNT(j)]); sum += c; cnt += (c > 0u) ? 1u : 0u; mine = (j == x) ? c : mine; }
    if (sum == G) break;
    __builtin_amdgcn_s_sleep(1);
    if ((++sp & 255u) == 0u) { if (xb_ld(&bar[XB_TMO])) break; if (sp > XB_SPIN_CAP) { atomicAdd(&bar[XB_TMO], 1u); break; } }
  }
  nloc = mine > 0u ? mine : 1u; nx = cnt > 0u ? cnt : 1u;
}
DI void xcd_barrier(const Params& p, const int wid, volatile LAS unsigned* st) {
  asm volatile("s_waitcnt vmcnt(0)" ::: "memory");
  __syncthreads();
  if (tid_fresh(p, wid) == 0) {
    unsigned* bar = (unsigned*)(p.ws + OFF_BAR);
    const unsigned x = xb_xcc_id();
    __builtin_amdgcn_s_waitcnt(0);
    unsigned nloc = st[0], nx = st[1];
    if (nloc == 0u) { xcd_barrier_complete(bar, x, nloc, nx); st[0] = nloc; st[1] = nx; }
    const unsigned old = xb_add(&bar[XB_XSUB(x)], 1u);
    const unsigned gen = old / nloc;
    if (old + 1u == (gen + 1u) * nloc) {
      __builtin_amdgcn_fence(__ATOMIC_RELEASE, "agent");
      asm volatile("s_waitcnt vmcnt(0)" ::: "memory");
      const unsigned og = xb_add(&bar[XB_TOP], 1u);
      const unsigned tg = og / nx;
      if (og + 1u == (tg + 1u) * nx) xb_add(&bar[XB_TOPGEN], 1u);
      else XB_SPIN(xb_ld(&bar[XB_TOPGEN]) == tg, bar);
      __builtin_amdgcn_fence(__ATOMIC_ACQUIRE, "agent");
      xb_add(&bar[XB_XGEN(x)], 1u);
      asm volatile("s_waitcnt vmcnt(0)" ::: "memory");
    } else {
      XB_SPIN(xb_ld(&bar[XB_XGEN(x)]) == gen, bar);
      __builtin_amdgcn_fence(__ATOMIC_ACQUIRE, "agent");
      asm volatile("s_waitcnt vmcnt(0)" ::: "memory");
    }
  }
  __syncthreads();
}

constexpr int TR_PER_LAYER = 864 + 384 + 768 + 384 + 256;
constexpr int P0_ITEMS = 2 * TR_PER_LAYER + 96 + 1;

DI void phase0(const Params& p, const int wid, char* lds) {
  const int tid = tid_fresh(p, wid);
  float* fl = (float*)lds;
  if (blockIdx.x == 0) for (int i = tid; i < XCD_BAR_WORDS; i += 256) ((unsigned*)(p.ws + OFF_BAR))[i] = 0u;
  for (int item = blockIdx.x; item < P0_ITEMS; item += gridDim.x) {
    if (item < 2 * TR_PER_LAYER) {
      const int layer = item / TR_PER_LAYER;
      int j = item % TR_PER_LAYER;
      char* wb = p.ws + OFF_W + (size_t)layer * LW;
      const float* win = p.w_in + (size_t)layer * 1024 * INW;
      if (j < 864) {
        tr_tile(p, wid, win, INW, (bf16*)wb, 1024, (j >> 4) * 64, (j & 15) * 64, 1, fl);
      } else if (j < 1248) {
        j -= 864;
        tr_tile(p, wid, win, INW, (bf16*)(wb + SZ_W1), 1024, (j >> 4) * 64, (j & 15) * 64, 2, fl);
      } else if (j < 2016) {
        j -= 1248;
        tr_tile(p, wid, win, INW, (bf16*)(wb + SZ_W1 + SZ_W2), 1024, (j >> 4) * 64, (j & 15) * 64, 3, fl);
      } else if (j < 2400) {
        j -= 2016;
        const int br = j >> 7, r = j & 127;
        const float* src = (br == 0 ? p.w_out_da : br == 1 ? p.w_out_ssm : p.w_out_gla) + (size_t)layer * 512 * 1024;
        tr_tile(p, wid, src, 1024, (bf16*)(wb + SZ_W1 + SZ_W2 + SZ_W3 + (size_t)br * SZ_WOUT), 512, (r >> 3) * 64, (r & 7) * 64, 0, fl);
      } else {
        j -= 2400;
        tr_tile(p, wid, p.w_o + (size_t)layer * 1024 * 1024, 1024, (bf16*)(wb + SZ_W1 + SZ_W2 + SZ_W3 + 3 * SZ_WOUT), 1024,
                (j >> 4) * 64, (j & 15) * 64, 0, fl);
      }
    } else if (item < 2 * TR_PER_LAYER + 96) {
      const int m = item - 2 * TR_PER_LAYER;
      const int layer = m / 48, nc = (m % 48) * 64;
      float* sc = fl;
      float* red = fl + 9 * 1024;
      for (int idx = tid; idx < 9 * 1024; idx += 256) {
        int j = idx >> 10, k = idx & 1023;
        float v = j < 8 ? p.c[j * 1024 + k] : p.c_ctx[k];
        sc[idx] = v / (1.f + expf(-v));
      }
      __syncthreads();
      const int tx = tid & 63, q = tid >> 6;
      float acc[9];
#pragma unroll
      for (int j = 0; j < 9; ++j) acc[j] = 0.f;
      const float* wm = p.w_mod + (size_t)layer * 1024 * 3072 + nc + tx;
#pragma unroll 4
      for (int k = q * 256; k < q * 256 + 256; ++k) {
        float wv = wm[(size_t)k * 3072];
#pragma unroll
        for (int j = 0; j < 9; ++j) acc[j] = fmaf(sc[j * 1024 + k], wv, acc[j]);
      }
#pragma unroll
      for (int j = 0; j < 9; ++j) red[(q * 9 + j) * 64 + tx] = acc[j];
      __syncthreads();
      float* modv = (float*)(p.ws + OFF_MOD);
      for (int idx = tid; idx < 9 * 64; idx += 256) {
        int j = idx >> 6, t = idx & 63;
        float s = red[(0 * 9 + j) * 64 + t] + red[(1 * 9 + j) * 64 + t] + red[(2 * 9 + j) * 64 + t] + red[(3 * 9 + j) * 64 + t];
        modv[(size_t)(layer * 9 + j) * 3072 + nc + t] = s + p.b_mod[layer * 3072 + nc + t];
      }
      __syncthreads();
    } else {
      float* rope = (float*)(p.ws + OFF_ROPE);
      for (int idx = tid; idx < 2048; idx += 256) {
        int pos = idx >> 4, f = idx & 15;
        float inv = (float)exp(-(double)f / 16.0 * 9.210340371976184);
        float angf = (float)pos * inv;
        double a = (double)angf;
        double r = a - 6.283185307179586477 * rint(a * 0.15915494309189533577);
        double r2 = r * r;
        double ts = r, ss = r, tc = 1.0, cs = 1.0;
#pragma unroll 1
        for (int n = 1; n <= 12; ++n) {
          tc *= -r2 / (double)((2 * n - 1) * (2 * n));
          cs += tc;
          ts *= -r2 / (double)((2 * n) * (2 * n + 1));
          ss += ts;
        }
        rope[idx * 2] = (float)cs;
        rope[idx * 2 + 1] = (float)ss;
      }
      float* misc = (float*)(p.ws + OFF_MISC);
      if (tid < 2) {
        const float* lm = p.da_lambda + tid * 4 * 64;
        float s1 = 0.f, s2 = 0.f;
        for (int i = 0; i < 64; ++i) { s1 += lm[i] * lm[64 + i]; s2 += lm[128 + i] * lm[192 + i]; }
        float lam_init = 0.8f - 0.6f * expf(-0.3f * (float)tid);
        misc[tid] = expf(s1) - expf(s2) + lam_init;
      }
      if (tid < 16) ((unsigned*)(p.ws + OFF_MISC + 64))[tid] = 0u;
    }
  }
}

DI float wave_sum(float v) {
#pragma unroll
  for (int m = 32; m >= 1; m >>= 1) v += __shfl_xor(v, m);
  return v;
}

DI void phase_h(const Params& p, const int wid, int layer, const float* xl, const float* xc, int M) {
  const int tidf = tid_fresh(p, wid); const int lane = tidf & 63, wave = tidf >> 6;
  bf16* h = (bf16*)(p.ws + OFF_H);
  const float* modv = (const float*)(p.ws + OFF_MOD) + (size_t)layer * 9 * 3072;
  const float* nw = p.norm_w + layer * 1024;
  const int stride = gridDim.x * 4;
  for (int row0 = blockIdx.x * 4 + wave; row0 < M; row0 += 2 * stride) {
    float4 v[2][4];
    float ss[2] = {0.f, 0.f};
#pragma unroll
    for (int r = 0; r < 2; ++r) {
      int row = row0 + r * stride;
      if (row >= M) row = row0;
      const float* src = row < NL ? xl + (size_t)row * 1024 : xc + (size_t)(row - NL) * 1024;
#pragma unroll
      for (int i = 0; i < 4; ++i) v[r][i] = *(const float4*)(src + (i * 64 + lane) * 4);
    }
#pragma unroll
    for (int r = 0; r < 2; ++r) {
#pragma unroll
      for (int i = 0; i < 4; ++i) ss[r] += v[r][i].x * v[r][i].x + v[r][i].y * v[r][i].y + v[r][i].z * v[r][i].z + v[r][i].w * v[r][i].w;
      ss[r] = wave_sum(ss[r]);
    }
#pragma unroll
    for (int r = 0; r < 2; ++r) {
      const int row = row0 + r * stride;
      if (row < M) {
        const int j = row < NL ? (row >> 13) : 8;
        const float* shift = modv + j * 3072;
        const float* scale = shift + 1024;
        const float rstd = rsqrtf(ss[r] * (1.f / 1024.f) + EPS);
#pragma unroll
        for (int i = 0; i < 4; ++i) {
          const int c = (i * 64 + lane) * 4;
          float4 w4 = *(const float4*)(nw + c), sc4 = *(const float4*)(scale + c), sh4 = *(const float4*)(shift + c);
          float o0 = v[r][i].x * rstd * w4.x * (1.f + sc4.x) + sh4.x;
          float o1 = v[r][i].y * rstd * w4.y * (1.f + sc4.y) + sh4.y;
          float o2 = v[r][i].z * rstd * w4.z * (1.f + sc4.z) + sh4.z;
          float o3 = v[r][i].w * rstd * w4.w * (1.f + sc4.w) + sh4.w;
          uint2 pk; pk.x = pack2(o0, o1); pk.y = pack2(o2, o3);
          *(uint2*)(h + (size_t)row * 1024 + c) = pk;
        }
      }
    }
  }
}

template <bool SWAP>
DI void gemm_main128(const bf16* __restrict__ A, int lda, const bf16* __restrict__ Bt, int ldb, int K,
                     f32x16 (&acc)[2][2], char* lds, const int tid) {
  bf16* As = (bf16*)lds;
  bf16* Bs = As + 128 * 72;
  const int lane = tid & 63, wave = tid >> 6, wm = wave >> 1, wn = wave & 1;
  const int l31 = lane & 31, lh = lane >> 5;
  const uint32_t aoff = (uint32_t)(((tid >> 3) * lda + (tid & 7) * 8) * 2);
  const uint32_t boff = (uint32_t)(((tid >> 3) * ldb + (tid & 7) * 8) * 2);
  const uint32_t soff = (uint32_t)(((tid >> 3) * 72 + (tid & 7) * 8) * 2);
  const char* Ab = (const char*)A;
  const char* Bb = (const char*)Bt;
  char* Asb = (char*)As;
  char* Bsb = (char*)Bs;
  const size_t astep = (size_t)32 * lda * 2, bstep = (size_t)32 * ldb * 2;
  uint4 ra0, ra1, ra2, ra3, rb0, rb1, rb2, rb3;
#define ALD(i, kb) (*(const uint4*)(Ab + ((size_t)(i) * astep + (kb)) + aoff))
#define BLD(i, kb) (*(const uint4*)(Bb + ((size_t)(i) * bstep + (kb)) + boff))
#define LDALL(kb)                                                          \
  ra0 = ALD(0, kb); ra1 = ALD(1, kb); ra2 = ALD(2, kb); ra3 = ALD(3, kb);  \
  rb0 = BLD(0, kb); rb1 = BLD(1, kb); rb2 = BLD(2, kb); rb3 = BLD(3, kb);
#define SST(base, i, val) (*(uint4*)((base) + (i) * (32 * 72 * 2) + soff) = (val))
  LDALL((size_t)0)
#pragma unroll 1
  for (int k0 = 0; k0 < K; k0 += 64) {
    SST(Asb, 0, ra0); SST(Asb, 1, ra1); SST(Asb, 2, ra2); SST(Asb, 3, ra3);
    SST(Bsb, 0, rb0); SST(Bsb, 1, rb1); SST(Bsb, 2, rb2); SST(Bsb, 3, rb3);
    __syncthreads();
    if (k0 + 64 < K) {
      const size_t kb = (size_t)(k0 + 64) * 2;
      LDALL(kb)
    }
    {
      const bf16* ap = As + (wm * 64 + l31) * 72 + lh * 8;
      const bf16* bp = Bs + (wn * 64 + l31) * 72 + lh * 8;
#define LDA_(tm, ks) (*(const bf16x8*)(ap + (tm) * 32 * 72 + (ks) * 16))
#define LDB_(tn, ks) (*(const bf16x8*)(bp + (tn) * 32 * 72 + (ks) * 16))
#define STEP(B0_, B1_, N0_, N1_, ks, more)                                              \
  if (more) { N0_ = LDB_(0, (ks) + 1); N1_ = LDB_(1, (ks) + 1); }                       \
  acc[0][0] = MM(a0, B0_, acc[0][0]); acc[0][1] = MM(a0, B1_, acc[0][1]);       \
  if (more) a0 = LDA_(0, (ks) + 1);                                                     \
  acc[1][0] = MM(a1, B0_, acc[1][0]); acc[1][1] = MM(a1, B1_, acc[1][1]);       \
  if (more) a1 = LDA_(1, (ks) + 1);                                                     \
  __builtin_amdgcn_sched_barrier(0);
      bf16x8 a0 = LDA_(0, 0), a1 = LDA_(1, 0);
      bf16x8 p0 = LDB_(0, 0), p1 = LDB_(1, 0), q0, q1;
      __builtin_amdgcn_sched_barrier(0);
      STEP(p0, p1, q0, q1, 0, true)
      STEP(q0, q1, p0, p1, 1, true)
      STEP(p0, p1, q0, q1, 2, true)
      STEP(q0, q1, p0, p1, 3, false)
#undef LDA_
#undef LDB_
#undef STEP
    }
    __syncthreads();
  }
#undef LDALL
#undef ALD
#undef BLD
#undef SST
}

template <int TM, int WN>
DI void zero_acc(f32x16 (&acc)[TM][WN]) {
#pragma unroll
  for (int a = 0; a < TM; ++a)
#pragma unroll
    for (int b = 0; b < WN; ++b)
#pragma unroll
      for (int i = 0; i < 16; ++i) acc[a][b][i] = 0.f;
}

template <bool SWAP>
DI void gemm_main256(const bf16* __restrict__ A, int lda, const bf16* __restrict__ Bt, int ldb, int K,
                     f32x16 (&acc)[4][2], char* lds, const int tid) {
  bf16* As = (bf16*)lds;
  bf16* Bs = As + 256 * 72;
  const int lane = tid & 63, wave = tid >> 6, wm = wave >> 1, wn = wave & 1;
  const int l31 = lane & 31, lh = lane >> 5;
  const uint32_t aoff = (uint32_t)(((tid >> 3) * lda + (tid & 7) * 8) * 2);
  const uint32_t boff = (uint32_t)(((tid >> 3) * ldb + (tid & 7) * 8) * 2);
  const uint32_t soff = (uint32_t)(((tid >> 3) * 72 + (tid & 7) * 8) * 2);
  const char* Ab = (const char*)A;
  const char* Bb = (const char*)Bt;
  char* Asb = (char*)As;
  char* Bsb = (char*)Bs;
  const size_t astep = (size_t)32 * lda * 2, bstep = (size_t)32 * ldb * 2;
  uint4 ra0, ra1, ra2, ra3, ra4, ra5, ra6, ra7, rb0, rb1, rb2, rb3;
#define ALD(i, kb) (*(const uint4*)(Ab + ((size_t)(i) * astep + (kb)) + aoff))
#define BLD(i, kb) (*(const uint4*)(Bb + ((size_t)(i) * bstep + (kb)) + boff))
#define LDALL(kb)                                                                      \
  ra0 = ALD(0, kb); ra1 = ALD(1, kb); ra2 = ALD(2, kb); ra3 = ALD(3, kb);              \
  ra4 = ALD(4, kb); ra5 = ALD(5, kb); ra6 = ALD(6, kb); ra7 = ALD(7, kb);              \
  rb0 = BLD(0, kb); rb1 = BLD(1, kb); rb2 = BLD(2, kb); rb3 = BLD(3, kb);
#define SST(base, i, val) (*(uint4*)((base) + (i) * (32 * 72 * 2) + soff) = (val))
  LDALL((size_t)0)
#pragma unroll 1
  for (int k0 = 0; k0 < K; k0 += 64) {
    SST(Asb, 0, ra0); SST(Asb, 1, ra1); SST(Asb, 2, ra2); SST(Asb, 3, ra3);
    SST(Asb, 4, ra4); SST(Asb, 5, ra5); SST(Asb, 6, ra6); SST(Asb, 7, ra7);
    SST(Bsb, 0, rb0); SST(Bsb, 1, rb1); SST(Bsb, 2, rb2); SST(Bsb, 3, rb3);
    __syncthreads();
    if (k0 + 64 < K) {
      const size_t kb = (size_t)(k0 + 64) * 2;
      LDALL(kb)
    }
    {
      const bf16* ap = As + (wm * 128 + l31) * 72 + lh * 8;
      const bf16* bp = Bs + (wn * 64 + l31) * 72 + lh * 8;
#define LDA_(tm, ks) (*(const bf16x8*)(ap + (tm) * 32 * 72 + (ks) * 16))
#define LDB_(tn, ks) (*(const bf16x8*)(bp + (tn) * 32 * 72 + (ks) * 16))
#define STEP(B0_, B1_, N0_, N1_, ks, more)                                              \
  if (more) { N0_ = LDB_(0, (ks) + 1); N1_ = LDB_(1, (ks) + 1); }                       \
  acc[0][0] = MM(a0, B0_, acc[0][0]); acc[0][1] = MM(a0, B1_, acc[0][1]);       \
  if (more) a0 = LDA_(0, (ks) + 1);                                                     \
  acc[1][0] = MM(a1, B0_, acc[1][0]); acc[1][1] = MM(a1, B1_, acc[1][1]);       \
  if (more) a1 = LDA_(1, (ks) + 1);                                                     \
  acc[2][0] = MM(a2, B0_, acc[2][0]); acc[2][1] = MM(a2, B1_, acc[2][1]);       \
  if (more) a2 = LDA_(2, (ks) + 1);                                                     \
  acc[3][0] = MM(a3, B0_, acc[3][0]); acc[3][1] = MM(a3, B1_, acc[3][1]);       \
  if (more) a3 = LDA_(3, (ks) + 1);                                                     \
  __builtin_amdgcn_sched_barrier(0);
      bf16x8 a0 = LDA_(0, 0), a1 = LDA_(1, 0), a2 = LDA_(2, 0), a3 = LDA_(3, 0);
      bf16x8 p0 = LDB_(0, 0), p1 = LDB_(1, 0), q0, q1;
      __builtin_amdgcn_sched_barrier(0);
      STEP(p0, p1, q0, q1, 0, true)
      STEP(q0, q1, p0, p1, 1, true)
      STEP(p0, p1, q0, q1, 2, true)
      STEP(q0, q1, p0, p1, 3, false)
#undef LDA_
#undef LDB_
#undef STEP
    }
    __syncthreads();
  }
#undef LDALL
#undef ALD
#undef BLD
#undef SST
}

DI void store_rows_bf16(bf16* __restrict__ rowp, const f32x16& a, int lh) {
#pragma unroll
  for (int k = 0; k < 4; k += 2) {
    uint32_t ax = pack2(a[4 * k], a[4 * k + 1]), ay = pack2(a[4 * k + 2], a[4 * k + 3]);
    uint32_t bx = pack2(a[4 * k + 4], a[4 * k + 5]), by = pack2(a[4 * k + 6], a[4 * k + 7]);
    const auto rx = __builtin_amdgcn_permlane32_swap(ax, bx, false, false);
    const auto ry = __builtin_amdgcn_permlane32_swap(ay, by, false, false);
    *(uint4*)(rowp + 8 * k + (lh ? 8 : 0)) = make_uint4(rx[0], ry[0], rx[1], ry[1]);
  }
}

DI bool xcd_tile(int it, int MT, int NTN, int PN, int& mt, int& nt) {
  const int x = blockIdx.x & 7, slot = blockIdx.x >> 3, nslots = gridDim.x >> 3;
  const int MTx = MT >> 3;
  const int lt = slot + it * nslots;
  if (lt >= MTx * NTN) return false;
  const int per_panel = MTx * PN;
  const int pn = lt / per_panel, r = lt - pn * per_panel;
  mt = x * MTx + r / PN;
  nt = pn * PN + r % PN;
  return true;
}

DI void phase_p1(const Params& p, const int wid, int layer, int M, char* lds) {
  const bf16* h = (const bf16*)(p.ws + OFF_H);
  const bf16* W1 = (const bf16*)(p.ws + OFF_W + (size_t)layer * LW);
  const float2* rope = (const float2*)(p.ws + OFF_ROPE);
  bf16* Qa = (bf16*)(p.ws + OFF_QA);
  bf16* Ka = (bf16*)(p.ws + OFF_KA);
  bf16* Vt = (bf16*)(p.ws + OFF_VT);
  bf16* xbc = (bf16*)(p.ws + OFF_XBC);
  bf16* gq = (bf16*)(p.ws + OFF_GQ);
  bf16* gk = (bf16*)(p.ws + OFF_GK);
  bf16* gv = (bf16*)(p.ws + OFF_GV);
  float* dtlr = (float*)(p.ws + OFF_DTLR);
  const int tidf = tid_fresh(p, wid); const int lane = tidf & 63, wave = tidf >> 6, wm = wave >> 1, wn = wave & 1, l31 = lane & 31, lh = lane >> 5;
  constexpr int NTN = N1 / 128;
  int mt_, nt_;
  for (int it = 0; xcd_tile(it, M / 256, NTN, 9, mt_, nt_); ++it) {
    const int m0 = mt_ * 256, n0 = nt_ * 128;
    f32x16 acc[4][2];
    zero_acc<4, 2>(acc);
    gemm_main256<false>(h + (size_t)m0 * 1024, 1024, W1 + (size_t)n0 * 1024, 1024, 1024, acc, lds, tidf);
    const bool lat = m0 < NL;
#pragma unroll
    for (int tm = 0; tm < 4; ++tm)
#pragma unroll
      for (int tn = 0; tn < 2; ++tn) {
        const int col = n0 + wn * 64 + tn * 32 + l31;
        const int rowb = m0 + wm * 128 + tm * 32 + 4 * lh;
        if (n0 < 1024) {
          const int d = col & 63, axis = d >> 5, half = (d >> 4) & 1, f = d & 15;
          bf16* dst = n0 < 512 ? Qa : Ka;
#pragma unroll
          for (int i = 0; i < 16; ++i) {
            const int row = rowb + (i & 3) + 8 * (i >> 2);
            float v = acc[tm][tn][i];
            float partner = __shfl_xor(v, 16);
            if (lat) {
              const int t = row & 8191;
              const int pos = axis ? (t & 63) : (t >> 6);
              float2 cs = rope[pos * 16 + f];
              v = v * cs.x + (half ? partner : -partner) * cs.y;
            }
            if (n0 < 512) v *= QSCALE;
            dst[(size_t)row * 512 + (col & 511)] = f2b(v);
          }
        } else if (n0 < 1536) {
          const int hd = (col - 1024) >> 7, vv = (col - 1024) & 127;
#pragma unroll
          for (int g = 0; g < 4; ++g) {
            const int row0 = rowb + 8 * g;
            int b, key;
            if (lat) { b = row0 >> 13; key = 256 + (row0 & 8191); } else { b = (row0 - NL) >> 8; key = (row0 - NL) & 255; }
            uint2 pk;
            pk.x = pack2(acc[tm][tn][4 * g], acc[tm][tn][4 * g + 1]);
            pk.y = pack2(acc[tm][tn][4 * g + 2], acc[tm][tn][4 * g + 3]);
            *(uint2*)(Vt + ((size_t)((b * 4 + hd) * 128 + vv)) * KEYS + key) = pk;
          }
        } else if (n0 < 3328) {
          bf16* dst; int ld, cc;
          if (n0 < 2304) { dst = xbc; ld = 768; cc = col - 1536; }
          else if (n0 < 2560) { dst = gq; ld = 256; cc = col - 2304; }
          else if (n0 < 2816) { dst = gk; ld = 256; cc = col - 2560; }
          else { dst = gv; ld = 512; cc = col - 2816; }
#pragma unroll
          for (int i = 0; i < 16; ++i) {
            const int row = rowb + (i & 3) + 8 * (i >> 2);
            dst[(size_t)row * ld + cc] = f2b(acc[tm][tn][i]);
          }
        } else {
          const int cc = col - 3328;
          if (cc < 48) {
#pragma unroll
            for (int i = 0; i < 16; ++i) {
              const int row = rowb + (i & 3) + 8 * (i >> 2);
              dtlr[(size_t)row * 48 + cc] = acc[tm][tn][i];
            }
          }
        }
      }
  }
}

DI void phase_conv(const Params& p, const int wid, int layer) {
  const bf16* xin = (const bf16*)(p.ws + OFF_XBC);
  bf16* xo = (bf16*)(p.ws + OFF_XBC2);
  const float* cw = p.conv_w + layer * 3 * 768;
  const float* cb = p.conv_b + layer * 768;
  const int total = NT * 96;
  for (int idx = blockIdx.x * 256 + tid_fresh(p, wid); idx < total; idx += gridDim.x * 256) {
    const int row = idx / 96, c0 = (idx % 96) * 8;
    int t, L;
    if (row < NL) { t = row & 8191; L = 8192; } else { t = (row - NL) & 255; L = 256; }
    uint4 cur = *(const uint4*)(xin + (size_t)row * 768 + c0);
    uint4 prv = make_uint4(0, 0, 0, 0), nxt = make_uint4(0, 0, 0, 0);
    if (t > 0) prv = *(const uint4*)(xin + (size_t)(row - 1) * 768 + c0);
    if (t < L - 1) nxt = *(const uint4*)(xin + (size_t)(row + 1) * 768 + c0);
    const uint32_t cu[4] = {cur.x, cur.y, cur.z, cur.w}, pu[4] = {prv.x, prv.y, prv.z, prv.w}, nu[4] = {nxt.x, nxt.y, nxt.z, nxt.w};
    uint32_t ou[4];
#pragma unroll
    for (int q = 0; q < 4; ++q) {
      const int c = c0 + 2 * q;
      float a0 = cw[c] * blo(pu[q]) + cw[768 + c] * blo(cu[q]) + cw[1536 + c] * blo(nu[q]) + cb[c];
      float a1 = cw[c + 1] * bhi(pu[q]) + cw[768 + c + 1] * bhi(cu[q]) + cw[1536 + c + 1] * bhi(nu[q]) + cb[c + 1];
      ou[q] = pack2(siluf(a0), siluf(a1));
    }
    *(uint4*)(xo + (size_t)row * 768 + c0) = make_uint4(ou[0], ou[1], ou[2], ou[3]);
  }
}

DI int scan_row(int b, int dir, int s) {
  if (s < 256) { int t = dir ? 255 - s : s; return NL + b * 256 + t; }
  int t = s - 256;
  if (dir) t = 8191 - t;
  return b * 8192 + t;
}

template <bool GLA>
DI void scan_item(const Params& p, const int wid, int layer, int item, char* lds) {
  constexpr int CT = 16;
  constexpr int V = GLA ? 128 : 64;
  constexpr int NJ = V / 32;
  constexpr int BV = V / 16;
  float* a_s = (float*)lds;
  float* c_s = a_s + CT * 64;
  float* w_s = c_s + CT * 64;
  float* b_s = w_s + CT * 64;
  float* x_s = b_s + CT * V;
  float* op = x_s + (GLA ? 0 : CT * V);
  float* wg_s = op + CT * 4 * V;
  const int tid = tid_fresh(p, wid), lane = tid & 63, wave = tid >> 6;
  int head, dir, b;
  if (GLA) { head = item & 3; dir = (item >> 2) & 1; b = item >> 3; } else { head = item & 7; dir = (item >> 3) & 1; b = item >> 4; }
  const bf16* xbc = (const bf16*)(p.ws + OFF_XBC2);
  const bf16* gq = (const bf16*)(p.ws + OFF_GQ);
  const bf16* gk = (const bf16*)(p.ws + OFF_GK);
  const bf16* gv = (const bf16*)(p.ws + OFF_GV);
  const float* dtlr = (const float*)(p.ws + OFF_DTLR);
  bf16* yout = (bf16*)(p.ws + (GLA ? (dir ? OFF_YGB : OFF_YGF) : (dir ? OFF_YSB : OFF_YSF)));
  const int ocol = head * V;
  float Aneg = 0.f, Dsk = 0.f, dtb = 0.f;
  if (!GLA) {
    Aneg = -expf(p.a_log[layer * 16 + dir * 8 + head]);
    Dsk = p.ssm_d[layer * 16 + dir * 8 + head];
    dtb = p.dt_bias[layer * 16 + dir * 8 + head];
  } else {
    const float* wg = p.gla_w_gate + ((size_t)(layer * 2 + dir) * 16) * 256 + head * 64;
    for (int idx = tid; idx < 16 * 64; idx += 256) wg_s[idx] = wg[(idx >> 6) * 256 + (idx & 63)];
    if (tid < 64) wg_s[1024 + tid] = p.gla_b_gate[(layer * 2 + dir) * 256 + head * 64 + tid];
  }
  const int st = tid >> 4, sk4 = (tid & 15) * 4, sv = (tid & 15) * BV;
  const int vq = lane & 31, kg = wave * 2 + (lane >> 5);
  float S[8][NJ];
#pragma unroll
  for (int i = 0; i < 8; ++i)
#pragma unroll
    for (int j = 0; j < NJ; ++j) S[i][j] = 0.f;

  uint2 ra, rc; uint4 rbv; float rdt = 0.f; float4 rlr0, rlr1, rlr2, rlr3;
  rlr0 = rlr1 = rlr2 = rlr3 = make_float4(0.f, 0.f, 0.f, 0.f);
  rbv = make_uint4(0, 0, 0, 0);
#define SCAN_PREFETCH(chunk_)                                                                   \
  {                                                                                             \
    const int row_ = scan_row(b, dir, (chunk_) * CT + st);                                      \
    if (GLA) {                                                                                  \
      ra = *(const uint2*)(gk + (size_t)row_ * 256 + head * 64 + sk4);                          \
      rc = *(const uint2*)(gq + (size_t)row_ * 256 + head * 64 + sk4);                          \
      rbv = *(const uint4*)(gv + (size_t)row_ * 512 + head * 128 + sv);                         \
      const float* lr_ = dtlr + (size_t)row_ * 48 + 16 + dir * 16;                              \
      rlr0 = *(const float4*)(lr_); rlr1 = *(const float4*)(lr_ + 4);                           \
      rlr2 = *(const float4*)(lr_ + 8); rlr3 = *(const float4*)(lr_ + 12);                      \
    } else {                                                                                    \
      const int g_ = head >> 2;                                                                 \
      ra = *(const uint2*)(xbc + (size_t)row_ * 768 + 512 + g_ * 64 + sk4);                     \
      rc = *(const uint2*)(xbc + (size_t)row_ * 768 + 640 + g_ * 64 + sk4);                     \
      const uint2 t_ = *(const uint2*)(xbc + (size_t)row_ * 768 + head * 64 + sv);              \
      rbv.x = t_.x; rbv.y = t_.y;                                                               \
      rdt = dtlr[(size_t)row_ * 48 + dir * 8 + head];                                           \
    }                                                                                           \
  }
  SCAN_PREFETCH(0);
  constexpr int NCH = KEYS / CT;
  for (int chunk = 0; chunk < NCH; ++chunk) {
    {
      const float cscale = GLA ? 0.125f : 1.f;
      *(float4*)(a_s + st * 64 + sk4) = make_float4(blo(ra.x), bhi(ra.x), blo(ra.y), bhi(ra.y));
      *(float4*)(c_s + st * 64 + sk4) = make_float4(blo(rc.x) * cscale, bhi(rc.x) * cscale, blo(rc.y) * cscale, bhi(rc.y) * cscale);
      if (GLA) {
        *(float4*)(b_s + st * V + sv) = make_float4(blo(rbv.x), bhi(rbv.x), blo(rbv.y), bhi(rbv.y));
        *(float4*)(b_s + st * V + sv + 4) = make_float4(blo(rbv.z), bhi(rbv.z), blo(rbv.w), bhi(rbv.w));
        float4 zb = *(const float4*)(wg_s + 1024 + sk4);
        float z0 = zb.x, z1 = zb.y, z2 = zb.z, z3 = zb.w;
#define GROW(r_, lv_)                                                  \
  {                                                                    \
    const float4 w0_ = *(const float4*)(wg_s + (r_) * 64 + sk4);       \
    z0 = fmaf((lv_), w0_.x, z0); z1 = fmaf((lv_), w0_.y, z1); z2 = fmaf((lv_), w0_.z, z2); z3 = fmaf((lv_), w0_.w, z3); \
  }
        GROW(0, rlr0.x) GROW(1, rlr0.y) GROW(2, rlr0.z) GROW(3, rlr0.w)
        GROW(4, rlr1.x) GROW(5, rlr1.y) GROW(6, rlr1.z) GROW(7, rlr1.w)
        GROW(8, rlr2.x) GROW(9, rlr2.y) GROW(10, rlr2.z) GROW(11, rlr2.w)
        GROW(12, rlr3.x) GROW(13, rlr3.y) GROW(14, rlr3.z) GROW(15, rlr3.w)
#define LSIG16(zz) expf(((zz) >= 0.f ? -log1pf(expf(-(zz))) : (zz) - log1pf(expf(zz))) * (1.f / 16.f))
        *(float4*)(w_s + st * 64 + sk4) = make_float4(LSIG16(z0), LSIG16(z1), LSIG16(z2), LSIG16(z3));
      } else {
        float zz = rdt + dtb;
        float dt = zz > 20.f ? zz : log1pf(expf(zz));
        float4 xv = make_float4(blo(rbv.x), bhi(rbv.x), blo(rbv.y), bhi(rbv.y));
        *(float4*)(b_s + st * V + sv) = make_float4(xv.x * dt, xv.y * dt, xv.z * dt, xv.w * dt);
        *(float4*)(x_s + st * V + sv) = xv;
        if ((tid & 15) == 0) w_s[st] = expf(dt * Aneg);
      }
    }
    __syncthreads();
    if (chunk + 1 < NCH) SCAN_PREFETCH(chunk + 1);
#pragma unroll 4
    for (int tt = 0; tt < CT; ++tt) {
      const float4 a0 = *(const float4*)(a_s + tt * 64 + kg * 8), a1 = *(const float4*)(a_s + tt * 64 + kg * 8 + 4);
      const float4 c0 = *(const float4*)(c_s + tt * 64 + kg * 8), c1 = *(const float4*)(c_s + tt * 64 + kg * 8 + 4);
      const float av[8] = {a0.x, a0.y, a0.z, a0.w, a1.x, a1.y, a1.z, a1.w};
      const float cv[8] = {c0.x, c0.y, c0.z, c0.w, c1.x, c1.y, c1.z, c1.w};
      float wv[8];
      if (GLA) {
        const float4 w0 = *(const float4*)(w_s + tt * 64 + kg * 8), w1 = *(const float4*)(w_s + tt * 64 + kg * 8 + 4);
        wv[0] = w0.x; wv[1] = w0.y; wv[2] = w0.z; wv[3] = w0.w; wv[4] = w1.x; wv[5] = w1.y; wv[6] = w1.z; wv[7] = w1.w;
      } else {
        const float w = w_s[tt];
#pragma unroll
        for (int i = 0; i < 8; ++i) wv[i] = w;
      }
      float bv[NJ], o[NJ];
#pragma unroll
      for (int j = 0; j < NJ; ++j) { bv[j] = b_s[tt * V + vq + 32 * j]; o[j] = 0.f; }
#pragma unroll
      for (int i = 0; i < 8; ++i)
#pragma unroll
        for (int j = 0; j < NJ; ++j) {
          S[i][j] = fmaf(wv[i], S[i][j], av[i] * bv[j]);
          o[j] = fmaf(cv[i], S[i][j], o[j]);
        }
#pragma unroll
      for (int j = 0; j < NJ; ++j) {
        o[j] += __shfl_xor(o[j], 32);
        if (lane < 32) op[(tt * 4 + wave) * V + vq + 32 * j] = o[j];
      }
    }
    __syncthreads();
    {
      const int row = scan_row(b, dir, chunk * CT + st);
#pragma unroll
      for (int q = 0; q < BV / 4; ++q) {
        const int vc = sv + 4 * q;
        float4 o0 = *(const float4*)(op + (st * 4 + 0) * V + vc), o1 = *(const float4*)(op + (st * 4 + 1) * V + vc);
        float4 o2 = *(const float4*)(op + (st * 4 + 2) * V + vc), o3 = *(const float4*)(op + (st * 4 + 3) * V + vc);
        float r0 = o0.x + o1.x + o2.x + o3.x, r1 = o0.y + o1.y + o2.y + o3.y, r2 = o0.z + o1.z + o2.z + o3.z, r3 = o0.w + o1.w + o2.w + o3.w;
        if (!GLA) {
          float4 xv = *(const float4*)(x_s + st * V + vc);
          r0 = fmaf(Dsk, xv.x, r0); r1 = fmaf(Dsk, xv.y, r1); r2 = fmaf(Dsk, xv.z, r2); r3 = fmaf(Dsk, xv.w, r3);
        }
        uint2 pk; pk.x = pack2(r0, r1); pk.y = pack2(r2, r3);
        *(uint2*)(yout + (size_t)row * 512 + ocol + vc) = pk;
      }
    }
  }
  __syncthreads();
#undef SCAN_PREFETCH
#undef GROW
#undef LSIG16
}

DI bf16x8 pack8(const f32x16& x, int s) {
  uint32_t p0 = pack2(x[8 * s], x[8 * s + 1]), p1 = pack2(x[8 * s + 2], x[8 * s + 3]);
  uint32_t p2 = pack2(x[8 * s + 4], x[8 * s + 5]), p3 = pack2(x[8 * s + 6], x[8 * s + 7]);
  uint4 u = make_uint4(p0, p1, p2, p3);
  return __builtin_bit_cast(bf16x8, u);
}

template <bool GLA>
DI void cscan_item(const Params& p, const int wid, int layer, int item, char* lds) {
  constexpr int RS = 72;
  bf16* Qm = (bf16*)lds;
  bf16* Km = Qm + 64 * RS;
  bf16* KeT = Km + 64 * RS;
  bf16* bT = KeT + 64 * RS;
  bf16* ST = bT + 64 * RS;
  char* R = (char*)(ST + 64 * RS);
  float* Gf = (float*)R;
  bf16* Cm = (bf16*)R;
  float* Gs = (float*)(R + 64 * RS * 2);
  float* tot = (float*)(R + 16384);
  float* lr_s = tot + 256;
  const int tid = tid_fresh(p, wid), lane = tid & 63, wave = tid >> 6, l31 = lane & 31, lh = lane >> 5;
  const int nt = wave & 1, vh = wave >> 1;
  int head, dir, b, vhalf = 0;
  if (GLA) { vhalf = item & 1; head = (item >> 1) & 3; } else { head = item & 7; }
  dir = (item >> 3) & 1; b = item >> 4;
  const bf16* xbc = (const bf16*)(p.ws + OFF_XBC2);
  const bf16* gq = (const bf16*)(p.ws + OFF_GQ);
  const bf16* gk = (const bf16*)(p.ws + OFF_GK);
  const bf16* gv = (const bf16*)(p.ws + OFF_GV);
  const float* dtlr = (const float*)(p.ws + OFF_DTLR);
  bf16* yout = (bf16*)(p.ws + (GLA ? (dir ? OFF_YGB : OFF_YGF) : (dir ? OFF_YSB : OFF_YSF)));
  const int ocol = GLA ? head * 128 + vhalf * 64 : head * 64;
  float Aneg = 0.f, Dsk = 0.f, dtb = 0.f, bgk = 0.f;
  float wgk[16];
#pragma unroll
  for (int r = 0; r < 16; ++r) wgk[r] = 0.f;
  if (!GLA) {
    Aneg = -expf(p.a_log[layer * 16 + dir * 8 + head]);
    Dsk = p.ssm_d[layer * 16 + dir * 8 + head];
    dtb = p.dt_bias[layer * 16 + dir * 8 + head];
  } else {
    const float* wg = p.gla_w_gate + ((size_t)(layer * 2 + dir) * 16) * 256 + head * 64 + (tid & 63);
#pragma unroll
    for (int r = 0; r < 16; ++r) wgk[r] = wg[r * 256];
    bgk = p.gla_b_gate[(layer * 2 + dir) * 256 + head * 64 + (tid & 63)];
  }
  const int st = tid >> 2, k16 = (tid & 3) * 16;
  f32x16 Sacc;
#pragma unroll
  for (int i = 0; i < 16; ++i) Sacc[i] = 0.f;

  uint4 ra0, ra1, rc0, rc1, rb0, rb1; float4 rl;
#define CS_PREFETCH(chunk_)                                                                          \
  {                                                                                                  \
    const int row_ = scan_row(b, dir, (chunk_) * 64 + st);                                           \
    if (GLA) {                                                                                       \
      const uint4* ap_ = (const uint4*)(gk + (size_t)row_ * 256 + head * 64 + k16);                  \
      const uint4* cp_ = (const uint4*)(gq + (size_t)row_ * 256 + head * 64 + k16);                  \
      const uint4* bp_ = (const uint4*)(gv + (size_t)row_ * 512 + head * 128 + vhalf * 64 + k16);    \
      ra0 = ap_[0]; ra1 = ap_[1]; rc0 = cp_[0]; rc1 = cp_[1]; rb0 = bp_[0]; rb1 = bp_[1];            \
      rl = *(const float4*)(dtlr + (size_t)row_ * 48 + 16 + dir * 16 + (tid & 3) * 4);               \
    } else {                                                                                         \
      const int g_ = head >> 2;                                                                      \
      const uint4* ap_ = (const uint4*)(xbc + (size_t)row_ * 768 + 512 + g_ * 64 + k16);             \
      const uint4* cp_ = (const uint4*)(xbc + (size_t)row_ * 768 + 640 + g_ * 64 + k16);             \
      const uint4* bp_ = (const uint4*)(xbc + (size_t)row_ * 768 + head * 64 + k16);                 \
      ra0 = ap_[0]; ra1 = ap_[1]; rc0 = cp_[0]; rc1 = cp_[1]; rb0 = bp_[0]; rb1 = bp_[1];            \
      rl.x = dtlr[(size_t)row_ * 48 + dir * 8 + head]; rl.y = 0.f; rl.z = 0.f; rl.w = 0.f;           \
    }                                                                                                \
  }
  CS_PREFETCH(0);
#pragma unroll 1
  for (int chunk = 0; chunk < KEYS / 64; ++chunk) {
    float dt = 0.f;
    if (GLA) {
      *(float4*)(lr_s + st * 16 + (tid & 3) * 4) = rl;
      __syncthreads();
      float Gl[16];
      float run = 0.f;
#pragma unroll
      for (int i = 0; i < 16; ++i) {
        const float* lrp = lr_s + (wave * 16 + i) * 16;
        const float4 l0 = *(const float4*)(lrp), l1 = *(const float4*)(lrp + 4), l2 = *(const float4*)(lrp + 8), l3 = *(const float4*)(lrp + 12);
        float z = bgk;
        z = fmaf(l0.x, wgk[0], z); z = fmaf(l0.y, wgk[1], z); z = fmaf(l0.z, wgk[2], z); z = fmaf(l0.w, wgk[3], z);
        z = fmaf(l1.x, wgk[4], z); z = fmaf(l1.y, wgk[5], z); z = fmaf(l1.z, wgk[6], z); z = fmaf(l1.w, wgk[7], z);
        z = fmaf(l2.x, wgk[8], z); z = fmaf(l2.y, wgk[9], z); z = fmaf(l2.z, wgk[10], z); z = fmaf(l2.w, wgk[11], z);
        z = fmaf(l3.x, wgk[12], z); z = fmaf(l3.y, wgk[13], z); z = fmaf(l3.z, wgk[14], z); z = fmaf(l3.w, wgk[15], z);
        run -= (fmaxf(-z, 0.f) + __logf(1.f + __expf(-fabsf(z)))) * (1.f / 16.f);
        Gl[i] = run;
      }
      tot[wave * 64 + lane] = run;
      __syncthreads();
      float off = 0.f;
      if (wave > 0) off += tot[lane];
      if (wave > 1) off += tot[64 + lane];
      if (wave > 2) off += tot[128 + lane];
#pragma unroll
      for (int i = 0; i < 16; ++i) Gf[(wave * 16 + i) * 64 + lane] = Gl[i] + off;
    } else {
      const float zz = rl.x + dtb;
      dt = zz > 20.f ? zz : log1pf(expf(zz));
      if ((tid & 3) == 0) lr_s[st] = dt;
      __syncthreads();
      if (wave == 0) {
        float g = lr_s[lane] * Aneg;
#pragma unroll
        for (int o = 1; o < 64; o <<= 1) {
          const float v = __shfl_up(g, o);
          if (lane >= o) g += v;
        }
        Gs[lane] = g;
      }
    }
#pragma unroll
    for (int i = 0; i < 16; ++i)
      ST[(32 * (wave >> 1) + (i & 3) + 8 * (i >> 2) + 4 * lh) * RS + 32 * (wave & 1) + l31] = f2b(Sacc[i]);
    __syncthreads();
    {
      const uint32_t au[8] = {ra0.x, ra0.y, ra0.z, ra0.w, ra1.x, ra1.y, ra1.z, ra1.w};
      const uint32_t cu[8] = {rc0.x, rc0.y, rc0.z, rc0.w, rc1.x, rc1.y, rc1.z, rc1.w};
      const uint32_t bu[8] = {rb0.x, rb0.y, rb0.z, rb0.w, rb1.x, rb1.y, rb1.z, rb1.w};
      uint32_t qo[8], ko[8];
      if (GLA) {
#pragma unroll
        for (int q = 0; q < 4; ++q) {
          const float4 G4 = *(const float4*)(Gf + st * 64 + k16 + 4 * q);
          const float4 L4 = *(const float4*)(Gf + 63 * 64 + k16 + 4 * q);
          const float gg[4] = {G4.x, G4.y, G4.z, G4.w}, ll[4] = {L4.x, L4.y, L4.z, L4.w};
#pragma unroll
          for (int h2 = 0; h2 < 2; ++h2) {
            const int w = 2 * q + h2;
            const float a0 = blo(au[w]), a1 = bhi(au[w]), c0 = blo(cu[w]), c1 = bhi(cu[w]);
            const float g0 = gg[2 * h2], g1 = gg[2 * h2 + 1];
            qo[w] = pack2(c0 * 0.125f * __expf(g0), c1 * 0.125f * __expf(g1));
            ko[w] = pack2(a0 * __expf(-g0), a1 * __expf(-g1));
            KeT[(k16 + 2 * w) * RS + st] = f2b(a0 * __expf(ll[2 * h2] - g0));
            KeT[(k16 + 2 * w + 1) * RS + st] = f2b(a1 * __expf(ll[2 * h2 + 1] - g1));
            bT[(k16 + 2 * w) * RS + st] = (bf16)(bu[w] & 0xffffu);
            bT[(k16 + 2 * w + 1) * RS + st] = (bf16)(bu[w] >> 16);
          }
        }
      } else {
        const float Gt = Gs[st], GL = Gs[63];
        const float e1 = __expf(Gt), e3 = __expf(GL - Gt);
#pragma unroll
        for (int w = 0; w < 8; ++w) {
          const float a0 = blo(au[w]), a1 = bhi(au[w]), c0 = blo(cu[w]), c1 = bhi(cu[w]);
          qo[w] = pack2(c0 * e1, c1 * e1);
          ko[w] = au[w];
          KeT[(k16 + 2 * w) * RS + st] = f2b(a0 * e3);
          KeT[(k16 + 2 * w + 1) * RS + st] = f2b(a1 * e3);
          bT[(k16 + 2 * w) * RS + st] = f2b(blo(bu[w]) * dt);
          bT[(k16 + 2 * w + 1) * RS + st] = f2b(bhi(bu[w]) * dt);
        }
        *(uint4*)(Cm + st * RS + k16) = rc0;
        *(uint4*)(Cm + st * RS + k16 + 8) = rc1;
      }
      *(uint4*)(Qm + st * RS + k16) = make_uint4(qo[0], qo[1], qo[2], qo[3]);
      *(uint4*)(Qm + st * RS + k16 + 8) = make_uint4(qo[4], qo[5], qo[6], qo[7]);
      *(uint4*)(Km + st * RS + k16) = make_uint4(ko[0], ko[1], ko[2], ko[3]);
      *(uint4*)(Km + st * RS + k16 + 8) = make_uint4(ko[4], ko[5], ko[6], ko[7]);
    }
    __syncthreads();
    if (chunk + 1 < KEYS / 64) CS_PREFETCH(chunk + 1);
    const int trow = scan_row(b, dir, chunk * 64 + 32 * nt + l31);
    uint2 xr0 = make_uint2(0, 0), xr1 = xr0, xr2 = xr0, xr3 = xr0;
    if (!GLA) {
      const bf16* xp = xbc + (size_t)trow * 768 + head * 64 + 32 * vh + 4 * lh;
      xr0 = *(const uint2*)(xp); xr1 = *(const uint2*)(xp + 8); xr2 = *(const uint2*)(xp + 16); xr3 = *(const uint2*)(xp + 24);
    }
    f32x16 outv;
#pragma unroll
    for (int i = 0; i < 16; ++i) outv[i] = 0.f;
    const bf16* Qp = GLA ? Qm : Cm;
#pragma unroll
    for (int ms = 0; ms < 2; ++ms) {
      if (ms <= nt) {
        f32x16 at;
#pragma unroll
        for (int i = 0; i < 16; ++i) at[i] = 0.f;
#pragma unroll
        for (int ks = 0; ks < 4; ++ks) {
          const bf16x8 kf = *(const bf16x8*)(Km + (32 * ms + l31) * RS + ks * 16 + lh * 8);
          const bf16x8 qf = *(const bf16x8*)(Qp + (32 * nt + l31) * RS + ks * 16 + lh * 8);
          at = MFMA32(kf, qf, at);
        }
        if (!GLA) {
          const float gt = Gs[32 * nt + l31];
#pragma unroll
          for (int g4 = 0; g4 < 4; ++g4) {
            const float4 gs4 = *(const float4*)(Gs + 32 * ms + 8 * g4 + 4 * lh);
            const float gsv[4] = {gs4.x, gs4.y, gs4.z, gs4.w};
#pragma unroll
            for (int j = 0; j < 4; ++j) {
              const int sl = 8 * g4 + 4 * lh + j;
              const bool keep = (ms < nt) || (sl <= l31);
              at[4 * g4 + j] = keep ? at[4 * g4 + j] * __expf(gt - gsv[j]) : 0.f;
            }
          }
        } else if (ms == nt) {
#pragma unroll
          for (int i = 0; i < 16; ++i) {
            const int sl = (i & 3) + 8 * (i >> 2) + 4 * lh;
            at[i] = (sl <= l31) ? at[i] : 0.f;
          }
        }
#pragma unroll
        for (int s2 = 0; s2 < 2; ++s2) {
          const bf16x8 pf = pack8(at, s2);
          const bf16* vp = bT + (32 * vh + l31) * RS + 32 * ms + 16 * s2 + 4 * lh;
          const uint2 lo = *(const uint2*)vp, hi = *(const uint2*)(vp + 8);
          const uint4 u = make_uint4(lo.x, lo.y, hi.x, hi.y);
          outv = MFMA32(__builtin_bit_cast(bf16x8, u), pf, outv);
        }
      }
    }
#pragma unroll
    for (int ks = 0; ks < 4; ++ks) {
      const bf16x8 sf = *(const bf16x8*)(ST + (32 * vh + l31) * RS + ks * 16 + lh * 8);
      const bf16x8 qf = *(const bf16x8*)(Qm + (32 * nt + l31) * RS + ks * 16 + lh * 8);
      outv = MFMA32(sf, qf, outv);
    }
    {
      const float dec = GLA ? __expf(Gf[63 * 64 + 32 * (wave & 1) + l31]) : __expf(Gs[63]);
#pragma unroll
      for (int i = 0; i < 16; ++i) Sacc[i] *= dec;
#pragma unroll
      for (int ks = 0; ks < 4; ++ks) {
        const bf16x8 bf_ = *(const bf16x8*)(bT + (32 * (wave >> 1) + l31) * RS + ks * 16 + lh * 8);
        const bf16x8 kf = *(const bf16x8*)(KeT + (32 * (wave & 1) + l31) * RS + ks * 16 + lh * 8);
        Sacc = MFMA32(bf_, kf, Sacc);
      }
    }
    {
      bf16* yp = yout + (size_t)trow * 512 + ocol + 32 * vh + 4 * lh;
      const uint2 xr[4] = {xr0, xr1, xr2, xr3};
#pragma unroll
      for (int g4 = 0; g4 < 4; ++g4) {
        float r0 = outv[4 * g4], r1 = outv[4 * g4 + 1], r2 = outv[4 * g4 + 2], r3 = outv[4 * g4 + 3];
        if (!GLA) {
          r0 = fmaf(Dsk, blo(xr[g4].x), r0); r1 = fmaf(Dsk, bhi(xr[g4].x), r1);
          r2 = fmaf(Dsk, blo(xr[g4].y), r2); r3 = fmaf(Dsk, bhi(xr[g4].y), r3);
        }
        uint2 pk; pk.x = pack2(r0, r1); pk.y = pack2(r2, r3);
        *(uint2*)(yp + 8 * g4) = pk;
      }
    }
    __syncthreads();
  }
#undef CS_PREFETCH
}


DI void attn_item(const Params& p, const int wid, int layer, int b, int head, int qrow0, int nkeys, char* lds) {
  bf16* Ks = (bf16*)lds;
  bf16* Vs = Ks + 64 * 136;
  bf16* Qa = (bf16*)(p.ws + OFF_QA);
  const bf16* Ka = (const bf16*)(p.ws + OFF_KA);
  const bf16* Vt = (const bf16*)(p.ws + OFF_VT) + (size_t)(b * 4 + head) * 128 * KEYS;
  const int tid = tid_fresh(p, wid), lane = tid & 63, wave = tid >> 6, l31 = lane & 31, lh = lane >> 5;

  bf16* Qs = Vs + 128 * 68;
#pragma unroll
  for (int i = 0; i < 8; ++i) {
    const int ch = tid + 256 * i;
    *(uint4*)(Qs + (ch >> 4) * 136 + (ch & 15) * 8) = *(const uint4*)(Qa + (size_t)(qrow0 + (ch >> 4)) * 512 + head * 128 + (ch & 15) * 8);
  }
  const bf16* qsw = Qs + (wave * 32 + l31) * 136 + lh * 8;
  f32x16 O[2][4];
#pragma unroll
  for (int c = 0; c < 2; ++c)
#pragma unroll
    for (int vt = 0; vt < 4; ++vt)
#pragma unroll
      for (int i = 0; i < 16; ++i) O[c][vt][i] = 0.f;
  float mrun[2] = {-1e30f, -1e30f}, lrun[2] = {0.f, 0.f};

  const int lkey = tid >> 2, lkq = (tid & 3) * 32, lvr = tid >> 1, lvh = (tid & 1) * 32;
#define KROW(key) ((key) < 256 ? NL + b * 256 + (key) : b * 8192 + (key) - 256)
#define KVLOAD(k0_)                                                                                  \
  {                                                                                                  \
    const uint4* kp_ = (const uint4*)(Ka + (size_t)KROW((k0_) + lkey) * 512 + head * 128 + lkq);      \
    rk0 = kp_[0]; rk1 = kp_[1]; rk2 = kp_[2]; rk3 = kp_[3];                                          \
    const uint4* vp_ = (const uint4*)(Vt + (size_t)lvr * KEYS + (k0_) + lvh);                        \
    rv0 = vp_[0]; rv1 = vp_[1]; rv2 = vp_[2]; rv3 = vp_[3];                                          \
  }
#define VST2(dst_, val) { (dst_)[0] = make_uint2((val).x, (val).y); (dst_)[1] = make_uint2((val).z, (val).w); }
  uint4 rk0, rk1, rk2, rk3, rv0, rv1, rv2, rv3;
  KVLOAD(0);
#pragma unroll 1
  for (int k0 = 0; k0 < nkeys; k0 += 64) {
    {
      uint4* kd = (uint4*)(Ks + lkey * 136 + lkq);
      kd[0] = rk0; kd[1] = rk1; kd[2] = rk2; kd[3] = rk3;
      uint2* vd = (uint2*)(Vs + lvr * 68 + lvh);
      VST2(vd, rv0); VST2(vd + 2, rv1); VST2(vd + 4, rv2); VST2(vd + 6, rv3);
    }
    __syncthreads();
    if (k0 + 64 < nkeys) KVLOAD(k0 + 64);
#pragma unroll
    for (int c = 0; c < 2; ++c) {
#pragma unroll
      for (int mt = 0; mt < 2; ++mt) {
        f32x16 sv;
#pragma unroll
        for (int i = 0; i < 16; ++i) sv[i] = 0.f;
#pragma unroll
        for (int ks = 0; ks < 4; ++ks) {
          const bf16x8 qf = *(const bf16x8*)(qsw + c * 64 + ks * 16);
          const bf16x8 kf = *(const bf16x8*)(Ks + (mt * 32 + l31) * 136 + c * 64 + ks * 16 + lh * 8);
          sv = MFMA32(kf, qf, sv);
        }
        __builtin_amdgcn_sched_barrier(0);
        const bf16* vpb = Vs + l31 * 68 + mt * 32 + 4 * lh;
#define VLD_(vt, st) ({ const bf16* vp_ = vpb + (vt) * 32 * 68 + 16 * (st); const uint2 lo_ = *(const uint2*)vp_, hi_ = *(const uint2*)(vp_ + 8); \
                        __builtin_bit_cast(bf16x8, make_uint4(lo_.x, lo_.y, hi_.x, hi_.y)); })
        bf16x8 v0, v1, v2, v3;
        float mx = fmaxf(sv[0], sv[1]);
#pragma unroll
        for (int i = 2; i < 16; i += 2) mx = max3f(mx, sv[i], sv[i + 1]);
        mx = xhalf_max(mx);
        if (__any(mx - mrun[c] > 8.0f)) {
          const float mnew = fmaxf(mrun[c], mx);
          const float alpha = __builtin_amdgcn_exp2f(mrun[c] - mnew);
          mrun[c] = mnew;
          lrun[c] *= alpha;
#pragma unroll
          for (int vt = 0; vt < 4; ++vt)
#pragma unroll
            for (int i = 0; i < 16; ++i) O[c][vt][i] *= alpha;
        }
        float psum = 0.f;
#pragma unroll
        for (int i = 0; i < 16; ++i) {
          float pv = __builtin_amdgcn_exp2f(sv[i] - mrun[c]);
          sv[i] = pv;
          psum += pv;
        }
        lrun[c] += psum;
        v0 = VLD_(0, 0); v1 = VLD_(1, 0); v2 = VLD_(2, 0); v3 = VLD_(3, 0);
        __builtin_amdgcn_sched_barrier(0);
        {
          const bf16x8 pf = pack8(sv, 0);
          O[c][0] = MFMA32(v0, pf, O[c][0]); O[c][1] = MFMA32(v1, pf, O[c][1]);
          O[c][2] = MFMA32(v2, pf, O[c][2]); O[c][3] = MFMA32(v3, pf, O[c][3]);
          v0 = VLD_(0, 1); v1 = VLD_(1, 1); v2 = VLD_(2, 1); v3 = VLD_(3, 1);
        }
        __builtin_amdgcn_sched_barrier(0);
        {
          const bf16x8 pf = pack8(sv, 1);
          O[c][0] = MFMA32(v0, pf, O[c][0]); O[c][1] = MFMA32(v1, pf, O[c][1]);
          O[c][2] = MFMA32(v2, pf, O[c][2]); O[c][3] = MFMA32(v3, pf, O[c][3]);
        }
        __builtin_amdgcn_sched_barrier(0);
#undef VLD_
      }
    }
    __syncthreads();
  }
  const float lam = ((const float*)(p.ws + OFF_MISC))[layer];
  const float lam_init = layer == 0 ? 0.2f : 0.8f - 0.6f * 0.7408182206817179f;
  const float l1 = lrun[0] + __shfl_xor(lrun[0], 32);
  const float l2 = lrun[1] + __shfl_xor(lrun[1], 32);
  const float i1 = 1.f / l1, i2 = lam / l2;
  float ss = 0.f;
#pragma unroll
  for (int vt = 0; vt < 4; ++vt)
#pragma unroll
    for (int i = 0; i < 16; ++i) {
      float o = O[0][vt][i] * i1 - O[1][vt][i] * i2;
      O[0][vt][i] = o;
      ss += o * o;
    }
  ss += __shfl_xor(ss, 32);
  const float rstd = rsqrtf(ss * (1.f / 128.f) + EPS) * (1.f - lam_init);
  const float* nw = p.da_norm_w + layer * 128;
  bf16* orow = Qa + (size_t)(qrow0 + wave * 32 + l31) * 512 + head * 128;
#pragma unroll
  for (int vt = 0; vt < 4; ++vt)
#pragma unroll
    for (int g = 0; g < 4; ++g) {
      const int v0 = vt * 32 + 8 * g + 4 * lh;
      float4 w4 = *(const float4*)(nw + v0);
      uint2 pk;
      pk.x = pack2(O[0][vt][4 * g] * rstd * w4.x, O[0][vt][4 * g + 1] * rstd * w4.y);
      pk.y = pack2(O[0][vt][4 * g + 2] * rstd * w4.z, O[0][vt][4 * g + 3] * rstd * w4.w);
      *(uint2*)(orow + v0) = pk;
    }
}

DI void phase_mixers(const Params& p, const int wid, int layer, char* lds) {
  __shared__ int s_item;
  const int x = blockIdx.x & 7;
  unsigned* counter = (unsigned*)(p.ws + OFF_MISC + 64) + layer * 8 + x;
  const int total = layer == 0 ? 32 + 256 + 8 : 32 + 256;
  for (;;) {
    if (tid_fresh(p, wid) == 0) s_item = (int)atomicAdd(counter, 1u);
    __syncthreads();
    const int li = s_item;
    __syncthreads();
    if (li >= total) break;
    if (li < 32) {
      const int sid = li * 8 + x;
      if (sid < 128) cscan_item<true>(p, wid, layer, sid, lds);
      else cscan_item<false>(p, wid, layer, sid - 128, lds);
    } else if (li < 288) {
      const int a = li - 32;
      const int bh = x + 8 * (a >> 6), qb = a & 63;
      attn_item(p, wid, layer, bh >> 2, bh & 3, (bh >> 2) * 8192 + qb * 128, KEYS, lds);
    } else {
      const int c = x * 8 + (li - 288);
      const int bh = c >> 1, qb = c & 1;
      attn_item(p, wid, layer, bh >> 2, bh & 3, NL + (bh >> 2) * 256 + qb * 128, 256, lds);
    }
  }
}

DI void phase_z(const Params& p, const int wid, int layer, int M, char* lds) {
  const bf16* h = (const bf16*)(p.ws + OFF_H);
  const bf16* W2 = (const bf16*)(p.ws + OFF_W + (size_t)layer * LW + SZ_W1);
  bf16* Z = (bf16*)(p.ws + OFF_Z);
  const int tidf = tid_fresh(p, wid); const int lane = tidf & 63, wave = tidf >> 6, wm = wave >> 1, wn = wave & 1, l31 = lane & 31, lh = lane >> 5;
  constexpr int NTN = N2 / 128;
  int mt_, nt_;
  for (int it = 0; xcd_tile(it, M / 256, NTN, 12, mt_, nt_); ++it) {
    const int m0 = mt_ * 256, n0 = nt_ * 128;
    f32x16 acc[4][2];
    zero_acc<4, 2>(acc);
    gemm_main256<true>(h + (size_t)m0 * 1024, 1024, W2 + (size_t)n0 * 1024, 1024, 1024, acc, lds, tidf);
#pragma unroll
    for (int tm = 0; tm < 4; ++tm)
#pragma unroll
      for (int tn = 0; tn < 2; ++tn)
        store_rows_bf16(Z + (size_t)(m0 + wm * 128 + tm * 32 + l31) * 1536 + n0 + wn * 64 + tn * 32, acc[tm][tn], lh);
  }
}

DI void phase_post(const Params& p, const int wid, int layer, int M) {
  const int tidf = tid_fresh(p, wid); const int lane = tidf & 63, wave = tidf >> 6;
  bf16* Z = (bf16*)(p.ws + OFF_Z);
  const bf16* oda = (const bf16*)(p.ws + OFF_QA);
  const bf16* ysf = (const bf16*)(p.ws + OFF_YSF);
  const bf16* ysb = (const bf16*)(p.ws + OFF_YSB);
  const bf16* ygf = (const bf16*)(p.ws + OFF_YGF);
  const bf16* ygb = (const bf16*)(p.ws + OFF_YGB);
  const float* snw = p.ssm_norm_w + layer * 512;
  const float* gnw = p.gla_norm_w + layer * 128;
  const int c0 = lane * 8;
  for (int row = blockIdx.x * 4 + wave; row < M; row += gridDim.x * 4) {
    bf16* zr = Z + (size_t)row * 1536;
    {
      uint4 o = *(const uint4*)(oda + (size_t)row * 512 + c0);
      uint4 z = *(const uint4*)(zr + c0);
      const uint32_t ou[4] = {o.x, o.y, o.z, o.w}, zu[4] = {z.x, z.y, z.z, z.w};
      uint32_t r[4];
#pragma unroll
      for (int q = 0; q < 4; ++q) r[q] = pack2(blo(ou[q]) * siluf(blo(zu[q])), bhi(ou[q]) * siluf(bhi(zu[q])));
      *(uint4*)(zr + c0) = make_uint4(r[0], r[1], r[2], r[3]);
    }
    {
      uint4 yf = *(const uint4*)(ysf + (size_t)row * 512 + c0), yb = *(const uint4*)(ysb + (size_t)row * 512 + c0);
      uint4 z = *(const uint4*)(zr + 512 + c0);
      const uint32_t fu[4] = {yf.x, yf.y, yf.z, yf.w}, bu[4] = {yb.x, yb.y, yb.z, yb.w}, zu[4] = {z.x, z.y, z.z, z.w};
      float y[8];
      float ss = 0.f;
#pragma unroll
      for (int q = 0; q < 4; ++q) {
        y[2 * q] = (blo(fu[q]) + blo(bu[q])) * siluf(blo(zu[q]));
        y[2 * q + 1] = (bhi(fu[q]) + bhi(bu[q])) * siluf(bhi(zu[q]));
        ss += y[2 * q] * y[2 * q] + y[2 * q + 1] * y[2 * q + 1];
      }
#pragma unroll
      for (int m = 16; m >= 1; m >>= 1) ss += __shfl_xor(ss, m);
      const float rstd = rsqrtf(ss * (1.f / 256.f) + EPS);
      float4 w0 = *(const float4*)(snw + c0), w1 = *(const float4*)(snw + c0 + 4);
      uint32_t r[4];
      r[0] = pack2(y[0] * rstd * w0.x, y[1] * rstd * w0.y); r[1] = pack2(y[2] * rstd * w0.z, y[3] * rstd * w0.w);
      r[2] = pack2(y[4] * rstd * w1.x, y[5] * rstd * w1.y); r[3] = pack2(y[6] * rstd * w1.z, y[7] * rstd * w1.w);
      *(uint4*)(zr + 512 + c0) = make_uint4(r[0], r[1], r[2], r[3]);
    }
    {
      uint4 yf = *(const uint4*)(ygf + (size_t)row * 512 + c0), yb = *(const uint4*)(ygb + (size_t)row * 512 + c0);
      uint4 z = *(const uint4*)(zr + 1024 + c0);
      const uint32_t fu[4] = {yf.x, yf.y, yf.z, yf.w}, bu[4] = {yb.x, yb.y, yb.z, yb.w}, zu[4] = {z.x, z.y, z.z, z.w};
      float y[8];
      float ss = 0.f;
#pragma unroll
      for (int q = 0; q < 4; ++q) {
        y[2 * q] = blo(fu[q]) + blo(bu[q]);
        y[2 * q + 1] = bhi(fu[q]) + bhi(bu[q]);
        ss += y[2 * q] * y[2 * q] + y[2 * q + 1] * y[2 * q + 1];
      }
#pragma unroll
      for (int m = 8; m >= 1; m >>= 1) ss += __shfl_xor(ss, m);
      const float rstd = rsqrtf(ss * (1.f / 128.f) + EPS);
      const int cw = c0 & 127;
      float4 w0 = *(const float4*)(gnw + cw), w1 = *(const float4*)(gnw + cw + 4);
      uint32_t r[4];
      r[0] = pack2(y[0] * rstd * w0.x * siluf(blo(zu[0])), y[1] * rstd * w0.y * siluf(bhi(zu[0])));
      r[1] = pack2(y[2] * rstd * w0.z * siluf(blo(zu[1])), y[3] * rstd * w0.w * siluf(bhi(zu[1])));
      r[2] = pack2(y[4] * rstd * w1.x * siluf(blo(zu[2])), y[5] * rstd * w1.y * siluf(bhi(zu[2])));
      r[3] = pack2(y[6] * rstd * w1.z * siluf(blo(zu[3])), y[7] * rstd * w1.w * siluf(bhi(zu[3])));
      *(uint4*)(zr + 1024 + c0) = make_uint4(r[0], r[1], r[2], r[3]);
    }
  }
}

DI void phase_merge(const Params& p, const int wid, int layer, int M, char* lds) {
  const bf16* h = (const bf16*)(p.ws + OFF_H);
  const bf16* osg = (const bf16*)(p.ws + OFF_Z);
  const char* wb = p.ws + OFF_W + (size_t)layer * LW;
  const bf16* W3 = (const bf16*)(wb + SZ_W1 + SZ_W2);
  const bf16* Wout = (const bf16*)(wb + SZ_W1 + SZ_W2 + SZ_W3);
  bf16* U = (bf16*)(p.ws + OFF_U);
  const int tidf = tid_fresh(p, wid); const int lane = tidf & 63, wave = tidf >> 6, wm = wave >> 1, wn = wave & 1, l31 = lane & 31, lh = lane >> 5;
  constexpr int NTN = 1024 / 128;
  int mt_, nt_;
  for (int it = 0; xcd_tile(it, M / 128, NTN, 8, mt_, nt_); ++it) {
    const int m0 = mt_ * 128, n0 = nt_ * 128;
    f32x16 u[2][2];
    zero_acc<2, 2>(u);
#pragma unroll 1
    for (int br = 0; br < 3; ++br) {
      uint32_t* sgl = (uint32_t*)(lds + 36864) + tidf;
      {
        f32x16 g[2][2];
        zero_acc<2, 2>(g);
        gemm_main128<true>(h + (size_t)m0 * 1024, 1024, W3 + (size_t)(br * 1024 + n0) * 1024, 1024, 1024, g, lds, tidf);
#pragma unroll
        for (int tm = 0; tm < 2; ++tm)
#pragma unroll
          for (int tn = 0; tn < 2; ++tn)
#pragma unroll
            for (int q = 0; q < 8; ++q) sgl[((tm * 2 + tn) * 8 + q) * 256] = pack2(sigmf(g[tm][tn][2 * q]), sigmf(g[tm][tn][2 * q + 1]));
      }
      f32x16 t[2][2];
      zero_acc<2, 2>(t);
      gemm_main128<true>(osg + (size_t)m0 * 1536 + br * 512, 1536, Wout + (size_t)br * 1024 * 512 + (size_t)n0 * 512, 512, 512, t, lds, tidf);
#pragma unroll
      for (int tm = 0; tm < 2; ++tm)
#pragma unroll
        for (int tn = 0; tn < 2; ++tn)
#pragma unroll
          for (int q = 0; q < 8; ++q) {
            const uint32_t sgv = sgl[((tm * 2 + tn) * 8 + q) * 256];
            u[tm][tn][2 * q] = fmaf(blo(sgv), t[tm][tn][2 * q], u[tm][tn][2 * q]);
            u[tm][tn][2 * q + 1] = fmaf(bhi(sgv), t[tm][tn][2 * q + 1], u[tm][tn][2 * q + 1]);
          }
    }
#pragma unroll
    for (int tm = 0; tm < 2; ++tm)
#pragma unroll
      for (int tn = 0; tn < 2; ++tn)
        store_rows_bf16(U + (size_t)(m0 + wm * 64 + tm * 32 + l31) * 1024 + n0 + wn * 64 + tn * 32, u[tm][tn], lh);
  }
}

DI void phase_out(const Params& p, const int wid, int layer, int M, const float* xl, const float* xc, float* ol, float* oc, char* lds) {
  const bf16* U = (const bf16*)(p.ws + OFF_U);
  const bf16* Wo = (const bf16*)(p.ws + OFF_W + (size_t)layer * LW + SZ_W1 + SZ_W2 + SZ_W3 + 3 * SZ_WOUT);
  const float* modv = (const float*)(p.ws + OFF_MOD) + (size_t)layer * 9 * 3072;
  const int tidf = tid_fresh(p, wid); const int lane = tidf & 63, wave = tidf >> 6, wm = wave >> 1, wn = wave & 1, l31 = lane & 31, lh = lane >> 5;
  constexpr int NTN = 1024 / 128;
  int mt_, nt_;
  for (int it = 0; xcd_tile(it, M / 256, NTN, 8, mt_, nt_); ++it) {
    const int m0 = mt_ * 256, n0 = nt_ * 128;
    f32x16 acc[4][2];
    zero_acc<4, 2>(acc);
    gemm_main256<true>(U + (size_t)m0 * 1024, 1024, Wo + (size_t)n0 * 1024, 1024, 1024, acc, lds, tidf);
    const bool lat = m0 < NL;
    const int j = lat ? (m0 >> 13) : 8;
    const float* gate = modv + j * 3072 + 2048;
    const float* src = lat ? xl + (size_t)m0 * 1024 : xc + (size_t)(m0 - NL) * 1024;
    float* dst = lat ? ol + (size_t)m0 * 1024 : oc + (size_t)(m0 - NL) * 1024;
    uint32_t eoff = (uint32_t)((wm * 128 + l31) * 1024 + n0 + wn * 64 + 4 * lh);
    asm volatile("" : "+v"(eoff));
    const float* sp = src + eoff;
    float* dp = dst + eoff;
    const float* gp = gate + n0 + wn * 64 + 4 * lh;
#pragma unroll
    for (int tm = 0; tm < 4; ++tm)
#pragma unroll
      for (int tn = 0; tn < 2; ++tn) {
#pragma unroll
        for (int g = 0; g < 4; ++g) {
          const int off = tm * 32 * 1024 + tn * 32 + 8 * g;
          const float4 gt = *(const float4*)(gp + tn * 32 + 8 * g);
          const float4 xo = *(const float4*)(sp + off);
          *(float4*)(dp + off) = make_float4(xo.x + gt.x * acc[tm][tn][4 * g], xo.y + gt.y * acc[tm][tn][4 * g + 1],
                                             xo.z + gt.z * acc[tm][tn][4 * g + 2], xo.w + gt.w * acc[tm][tn][4 * g + 3]);
        }
        __builtin_amdgcn_sched_barrier(0);
      }
  }
}

DI void phase_final(const Params& p, const int wid) {
  const int tidf = tid_fresh(p, wid); const int lane = tidf & 63, wave = tidf >> 6;
  const int stride = gridDim.x * 4;
  for (int row0 = blockIdx.x * 4 + wave; row0 < NL; row0 += 2 * stride) {
    float4 v[2][4];
    float ss[2] = {0.f, 0.f};
#pragma unroll
    for (int r = 0; r < 2; ++r) {
      int row = row0 + r * stride;
      if (row >= NL) row = row0;
      const float* src = p.out + (size_t)row * 1024;
#pragma unroll
      for (int i = 0; i < 4; ++i) v[r][i] = *(const float4*)(src + (i * 64 + lane) * 4);
    }
#pragma unroll
    for (int r = 0; r < 2; ++r) {
#pragma unroll
      for (int i = 0; i < 4; ++i) ss[r] += v[r][i].x * v[r][i].x + v[r][i].y * v[r][i].y + v[r][i].z * v[r][i].z + v[r][i].w * v[r][i].w;
      ss[r] = wave_sum(ss[r]);
    }
#pragma unroll
    for (int r = 0; r < 2; ++r) {
      const int row = row0 + r * stride;
      if (row < NL) {
        float* dst = p.out + (size_t)row * 1024;
        const float rstd = rsqrtf(ss[r] * (1.f / 1024.f) + EPS);
#pragma unroll
        for (int i = 0; i < 4; ++i) {
          const int c = (i * 64 + lane) * 4;
          float4 w4 = *(const float4*)(p.final_norm_w + c);
          *(float4*)(dst + c) = make_float4(v[r][i].x * rstd * w4.x, v[r][i].y * rstd * w4.y, v[r][i].z * rstd * w4.z, v[r][i].w * rstd * w4.w);
        }
      }
    }
  }
}

__global__ void __launch_bounds__(256, 2) hybrid_trunk_mega(Params p) {
  cg::grid_group grid = cg::this_grid();
  const int wid = __builtin_amdgcn_readfirstlane((int)(threadIdx.x >> 6));
  __shared__ __attribute__((aligned(16))) char lds[LDS_BYTES];
  __shared__ uint4 xb_words;
  if (tid_fresh(p, wid) == 0) xb_words = make_uint4(0u, 0u, 0u, 0u);
  phase0(p, wid, lds);
  grid.sync();
  if (tid_fresh(p, wid) == 0) (void)xb_add(&((unsigned*)(p.ws + OFF_BAR))[XB_XCNT(xb_xcc_id())], 1u);
  float* ctx1 = (float*)(p.ws + OFF_CTX1);
#pragma unroll 1
  for (int layer = 0; layer < 2; ++layer) {
    const float* xl = layer == 0 ? p.x : p.out;
    const float* xc = layer == 0 ? p.ctx : ctx1;
    const int M = layer == 0 ? NT : NL;
    phase_h(p, wid, layer, xl, xc, NT);
    xcd_barrier(p, wid, (volatile LAS unsigned*)&xb_words);
    phase_p1(p, wid, layer, NT, lds);
    xcd_barrier(p, wid, (volatile LAS unsigned*)&xb_words);
#ifdef DUP_GEMM
    phase_p1(p, wid, layer, NT, lds);
    xcd_barrier(p, wid, (volatile LAS unsigned*)&xb_words);
#endif
    phase_conv(p, wid, layer);
    xcd_barrier(p, wid, (volatile LAS unsigned*)&xb_words);
#ifdef PROBE_SCAN
    for (int it = blockIdx.x; it < 192; it += gridDim.x) { if (it < 64) scan_item<true>(p, wid, layer, it, lds); else scan_item<false>(p, wid, layer, it - 64, lds); }
    xcd_barrier(p, wid, (volatile LAS unsigned*)&xb_words);
#endif
    phase_mixers(p, wid, layer, lds);
    xcd_barrier(p, wid, (volatile LAS unsigned*)&xb_words);
    phase_z(p, wid, layer, M, lds);
    xcd_barrier(p, wid, (volatile LAS unsigned*)&xb_words);
#ifdef DUP_GEMM
    phase_z(p, wid, layer, M, lds);
    xcd_barrier(p, wid, (volatile LAS unsigned*)&xb_words);
#endif
    phase_post(p, wid, layer, M);
    xcd_barrier(p, wid, (volatile LAS unsigned*)&xb_words);
    phase_merge(p, wid, layer, M, lds);
    xcd_barrier(p, wid, (volatile LAS unsigned*)&xb_words);
#ifdef DUP_GEMM
    phase_merge(p, wid, layer, M, lds);
    xcd_barrier(p, wid, (volatile LAS unsigned*)&xb_words);
#endif
    phase_out(p, wid, layer, M, xl, xc, p.out, ctx1, lds);
    xcd_barrier(p, wid, (volatile LAS unsigned*)&xb_words);
  }
  phase_final(p, wid);
}

extern "C" void kernel_launch(void* const* d_in, const int* in_sizes, int n_in, void* d_out, int out_size, void* d_ws,
                              size_t ws_size, hipStream_t stream) {
  (void)in_sizes; (void)n_in; (void)out_size;
  static int grid_blocks = 0;
  if (!grid_blocks) {
    int dev = 0, cus = 0, per_cu = 0;
    hipGetDevice(&dev);
    hipDeviceGetAttribute(&cus, hipDeviceAttributeMultiprocessorCount, dev);
    hipOccupancyMaxActiveBlocksPerMultiprocessor(&per_cu, hybrid_trunk_mega, 256, 0);
    (void)per_cu;
    grid_blocks = cus * 2;
  }
  if (ws_size < WS_TOTAL) { fprintf(stderr, "workspace too small: %zu < %zu\n", ws_size, (size_t)WS_TOTAL); return; }
  Params p{};
  const float** f = (const float**)&p;
  for (int i = 0; i < 24; ++i) f[i] = (const float*)d_in[i];
  p.wid = 0; p.pad_ = 0;
  p.out = (float*)d_out;
  p.ws = (char*)d_ws;
  void* args[] = {&p};
  hipError_t e = hipLaunchCooperativeKernel((const void*)hybrid_trunk_mega, dim3(grid_blocks), dim3(256), args, 0, stream);
  if (e != hipSuccess && (grid_blocks & 15) == 0) {
    (void)hipGetLastError();
    grid_blocks >>= 1;
    e = hipLaunchCooperativeKernel((const void*)hybrid_trunk_mega, dim3(grid_blocks), dim3(256), args, 0, stream);
  }
  if (e != hipSuccess) fprintf(stderr, "cooperative launch failed: %s (grid %d)\n", hipGetErrorString(e), grid_blocks);
}
```

```cpp
#include <hip/hip_runtime.h>
#include <hip/hip_cooperative_groups.h>
#include <stdint.h>
#include <stdio.h>
namespace cg = cooperative_groups;

typedef unsigned short bf16;
using bf16x8 = __attribute__((ext_vector_type(8))) short;
using f32x16 = __attribute__((ext_vector_type(16))) float;
using u32x8 = __attribute__((ext_vector_type(8))) unsigned int;
#define DI __device__ __forceinline__
#define MFMA32(a, b, c) __builtin_amdgcn_mfma_f32_32x32x16_bf16((a), (b), (c), 0, 0, 0)
#define MM(a_, b_, c_) (SWAP ? MFMA32((b_), (a_), (c_)) : MFMA32((a_), (b_), (c_)))

typedef __bf16 hbf16x2 __attribute__((ext_vector_type(2)));
typedef float f32x2 __attribute__((ext_vector_type(2)));
DI uint32_t pack2(float a, float b) { f32x2 v = {a, b}; return __builtin_bit_cast(uint32_t, __builtin_convertvector(v, hbf16x2)); }
DI bf16 f2b(float x) { return (bf16)(pack2(x, x) & 0xffffu); }
DI float blo(uint32_t u) { return __uint_as_float(u << 16); }
DI float bhi(uint32_t u) { return __uint_as_float(u & 0xffff0000u); }
DI float max3f(float a, float b, float c) { float r; asm("v_max3_f32 %0, %1, %2, %3" : "=v"(r) : "v"(a), "v"(b), "v"(c)); return r; }
DI float xhalf_max(float x) {
  const unsigned u = __float_as_uint(x);
  const auto r = __builtin_amdgcn_permlane32_swap(u, u, false, false);
  float m; asm("v_max_f32 %0, %1, %2" : "=v"(m) : "v"(__uint_as_float(r[0])), "v"(__uint_as_float(r[1]))); return m;
}
DI float siluf(float x) { return x / (1.f + __expf(-x)); }
DI float sigmf(float x) { return 1.f / (1.f + __expf(-x)); }

constexpr int NB = 8, SEQ = 8192, CTX = 256, DM = 1024;
constexpr int NL = NB * SEQ;
constexpr int NC = NB * CTX;
constexpr int NT = NL + NC;
constexpr int KEYS = CTX + SEQ;
constexpr int INW = 7984;
constexpr int N1 = 3456, N2 = 1536, N3 = 3072;
constexpr float EPS = 1e-6f;
constexpr float QSCALE = 0.125f * 1.4426950408889634f;

constexpr size_t al256(size_t x) { return (x + 255) & ~(size_t)255; }
constexpr size_t SZ_W1 = (size_t)N1 * 1024 * 2, SZ_W2 = (size_t)N2 * 1024 * 2, SZ_W3 = (size_t)N3 * 1024 * 2;
constexpr size_t SZ_WOUT = (size_t)1024 * 512 * 2, SZ_WO = (size_t)1024 * 1024 * 2;
constexpr size_t LW = SZ_W1 + SZ_W2 + SZ_W3 + 3 * SZ_WOUT + SZ_WO;
constexpr size_t OFF_W = 0;
constexpr size_t OFF_MOD = OFF_W + 2 * LW;
constexpr size_t OFF_ROPE = OFF_MOD + al256((size_t)2 * 9 * 3072 * 4);
constexpr size_t OFF_MISC = OFF_ROPE + (size_t)128 * 16 * 2 * 4;
constexpr size_t OFF_H = OFF_MISC + 256;
constexpr size_t OFF_QA = OFF_H + (size_t)NT * 1024 * 2;
constexpr size_t OFF_KA = OFF_QA + (size_t)NT * 512 * 2;
constexpr size_t OFF_VT = OFF_KA + (size_t)NT * 512 * 2;
constexpr size_t OFF_XBC = OFF_VT + (size_t)NT * 512 * 2;
constexpr size_t OFF_XBC2 = OFF_XBC + (size_t)NT * 768 * 2;
constexpr size_t OFF_GQ = OFF_XBC2 + (size_t)NT * 768 * 2;
constexpr size_t OFF_GK = OFF_GQ + (size_t)NT * 256 * 2;
constexpr size_t OFF_GV = OFF_GK + (size_t)NT * 256 * 2;
constexpr size_t OFF_DTLR = OFF_GV + (size_t)NT * 512 * 2;
constexpr size_t OFF_YSF = OFF_DTLR + (size_t)NT * 48 * 4;
constexpr size_t OFF_YSB = OFF_YSF + (size_t)NT * 512 * 2;
constexpr size_t OFF_YGF = OFF_YSB + (size_t)NT * 512 * 2;
constexpr size_t OFF_YGB = OFF_YGF + (size_t)NT * 512 * 2;
constexpr size_t OFF_CTX1 = OFF_YGB + (size_t)NT * 512 * 2;
constexpr size_t OFF_BAR = OFF_CTX1 + (size_t)NC * 1024 * 4;
constexpr size_t WS_TOTAL = OFF_BAR + 16384;
constexpr size_t OFF_Z = OFF_KA;
constexpr size_t OFF_U = OFF_GQ;
static_assert(WS_TOTAL <= ((size_t)1 << 30), "workspace too large");
static_assert((size_t)NT * 1536 * 2 <= OFF_XBC2 - OFF_KA, "Z overlay");
static_assert((size_t)NT * 1024 * 2 <= OFF_DTLR - OFF_GQ, "U overlay");

struct Params {
  const float *x, *c, *ctx, *c_ctx, *w_mod, *b_mod, *norm_w, *w_in, *da_lambda, *da_norm_w, *w_out_da;
  const float *conv_w, *conv_b, *dt_bias, *a_log, *ssm_d, *ssm_norm_w, *w_out_ssm;
  const float *gla_w_gate, *gla_b_gate, *gla_norm_w, *w_out_gla, *w_o, *final_norm_w;
  float* out;
  char* ws;
  int wid, pad_;
};
DI int tid_fresh(const Params& p, const int wid) {
  int t = wid * 64 + (int)__builtin_amdgcn_mbcnt_hi(~0u, __builtin_amdgcn_mbcnt_lo(~0u, 0u));
  asm volatile("" : "+v"(t));
  return t;
}

constexpr int LDS_BYTES = 70 * 1024;

DI int map_w1(int n) {
  if (n < 1536) return n;
  if (n < 2048) return 2048 + (n - 1536);
  if (n < 2304) return 3072 + (n - 2048);
  if (n < 3328) return 3344 + (n - 2304);
  if (n < 3344) return 3328 + (n - 3328);
  if (n < 3376) return 4880 + (n - 3344);
  return -1;
}
DI int map_w2(int n) {
  if (n < 512) return 1536 + n;
  if (n < 1024) return 2560 + (n - 512);
  return 4368 + (n - 1024);
}

DI void tr_tile(const Params& p, const int wid, const float* __restrict__ src, int ldsrc, bf16* __restrict__ dst, int K, int n0, int k0, int mapk, float* tile) {
  const int tid = tid_fresh(p, wid), tx = tid & 63, ty = tid >> 6;
  const int n = n0 + tx;
  int col = n;
  if (mapk == 1) col = map_w1(n); else if (mapk == 2) col = map_w2(n); else if (mapk == 3) col = 4912 + n;
#pragma unroll
  for (int i = 0; i < 16; ++i) {
    int kk = ty + 4 * i;
    tile[kk * 65 + tx] = (col >= 0) ? src[(size_t)(k0 + kk) * ldsrc + col] : 0.f;
  }
  __syncthreads();
#pragma unroll
  for (int i = 0; i < 16; ++i) {
    int nn = ty + 4 * i;
    dst[(size_t)(n0 + nn) * K + k0 + tx] = f2b(tile[tx * 65 + nn]);
  }
  __syncthreads();
}

#define XB_TMO      128
#define XB_XCNT(j)  (256  + 64 * (j))
#define XB_XSUB(j)  (1280 + 64 * (j))
#define XB_XGEN(j)  (2304 + 64 * (j))
#define XB_TOP      3328
#define XB_TOPGEN   3392
#define XCD_BAR_WORDS 3456
#define XB_SPIN_CAP (1u << 18)
#define LAS __attribute__((address_space(3)))
DI unsigned xb_ld(unsigned* q) { return __hip_atomic_load(q, __ATOMIC_RELAXED, __HIP_MEMORY_SCOPE_AGENT); }
DI unsigned xb_add(unsigned* q, unsigned v) { return __hip_atomic_fetch_add(q, v, __ATOMIC_RELAXED, __HIP_MEMORY_SCOPE_AGENT); }
DI unsigned xb_xcc_id() { return (unsigned)__builtin_amdgcn_s_getreg((3 << 11) | 20) & 0xFu; }
#define XB_SPIN(cond, bar) do { unsigned _sp = 0; while (cond) { __builtin_amdgcn_s_sleep(1); \
    if ((++_sp & 255u) == 0u) { if (xb_ld(&(bar)[XB_TMO])) break; if (_sp > XB_SPIN_CAP) { atomicAdd(&(bar)[XB_TMO], 1u); break; } } } } while (0)
struct XcdBarrier { unsigned* bar; unsigned x; volatile LAS unsigned* st; };
DI XcdBarrier xcd_barrier_post(unsigned* bar, volatile LAS unsigned* st, bool t0) {
  XcdBarrier b; b.bar = bar; b.x = xb_xcc_id(); b.st = st;
  if (t0) (void)xb_add(&bar[XB_XCNT(b.x)], 1u);
  return b;
}
DI void xcd_barrier_complete(unsigned* bar, unsigned x, unsigned& nloc, unsigned& nx) {
  const unsigned G = gridDim.x * gridDim.y * gridDim.z;
  unsigned sum, cnt, mine, sp = 0u;
  for (;;) {
    sum = 0u; cnt = 0u; mine = 0u;
#pragma unroll
    for (unsigned j = 0; j < 16; ++j) { const unsigned c = xb_ld(&bar[XB_XCNT(j)]); sum += c; cnt += (c > 0u) ? 1u : 0u; mine = (j == x) ? c : mine; }
    if (sum == G) break;
    __builtin_amdgcn_s_sleep(1);
    if ((++sp & 255u) == 0u) { if (xb_ld(&bar[XB_TMO])) break; if (sp > XB_SPIN_CAP) { atomicAdd(&bar[XB_TMO], 1u); break; } }
  }
  nloc = mine > 0u ? mine : 1u; nx = cnt > 0u ? cnt : 1u;
}
DI void xcd_barrier(const Params& p, const int wid, volatile LAS unsigned* st) {
  asm volatile("s_waitcnt vmcnt(0)" ::: "memory");
  __syncthreads();
  if (tid_fresh(p, wid) == 0) {
    unsigned* bar = (unsigned*)(p.ws + OFF_BAR);
    const unsigned x = xb_xcc_id();
    __builtin_amdgcn_s_waitcnt(0);
    unsigned nloc = st[0], nx = st[1];
    if (nloc == 0u) { xcd_barrier_complete(bar, x, nloc, nx); st[0] = nloc; st[1] = nx; }
    const unsigned old = xb_add(&bar[XB_XSUB(x)], 1u);
    const unsigned gen = old / nloc;
    if (old + 1u == (gen + 1u) * nloc) {
      __builtin_amdgcn_fence(__ATOMIC_RELEASE, "agent");
      asm volatile("s_waitcnt vmcnt(0)" ::: "memory");
      const unsigned og = xb_add(&bar[XB_TOP], 1u);
      const unsigned tg = og / nx;
      if (og + 1u == (tg + 1u) * nx) xb_add(&bar[XB_TOPGEN], 1u);
      else XB_SPIN(xb_ld(&bar[XB_TOPGEN]) == tg, bar);
      __builtin_amdgcn_fence(__ATOMIC_ACQUIRE, "agent");
      xb_add(&bar[XB_XGEN(x)], 1u);
      asm volatile("s_waitcnt vmcnt(0)" ::: "memory");
    } else {
      XB_SPIN(xb_ld(&bar[XB_XGEN(x)]) == gen, bar);
      __builtin_amdgcn_fence(__ATOMIC_ACQUIRE, "agent");
      asm volatile("s_waitcnt vmcnt(0)" ::: "memory");
    }
  }
  __syncthreads();
}

constexpr int TR_PER_LAYER = 864 + 384 + 768 + 384 + 256;
constexpr int P0_ITEMS = 2 * TR_PER_LAYER + 96 + 1;

DI void phase0(const Params& p, const int wid, char* lds) {
  const int tid = tid_fresh(p, wid);
  float* fl = (float*)lds;
  if (blockIdx.x == 0) for (int i = tid; i < XCD_BAR_WORDS; i += 256) ((unsigned*)(p.ws + OFF_BAR))[i] = 0u;
  for (int item = blockIdx.x; item < P0_ITEMS; item += gridDim.x) {
    if (item < 2 * TR_PER_LAYER) {
      const int layer = item / TR_PER_LAYER;
      int j = item % TR_PER_LAYER;
      char* wb = p.ws + OFF_W + (size_t)layer * LW;
      const float* win = p.w_in + (size_t)layer * 1024 * INW;
      if (j < 864) {
        tr_tile(p, wid, win, INW, (bf16*)wb, 1024, (j >> 4) * 64, (j & 15) * 64, 1, fl);
      } else if (j < 1248) {
        j -= 864;
        tr_tile(p, wid, win, INW, (bf16*)(wb + SZ_W1), 1024, (j >> 4) * 64, (j & 15) * 64, 2, fl);
      } else if (j < 2016) {
        j -= 1248;
        tr_tile(p, wid, win, INW, (bf16*)(wb + SZ_W1 + SZ_W2), 1024, (j >> 4) * 64, (j & 15) * 64, 3, fl);
      } else if (j < 2400) {
        j -= 2016;
        const int br = j >> 7, r = j & 127;
        const float* src = (br == 0 ? p.w_out_da : br == 1 ? p.w_out_ssm : p.w_out_gla) + (size_t)layer * 512 * 1024;
        tr_tile(p, wid, src, 1024, (bf16*)(wb + SZ_W1 + SZ_W2 + SZ_W3 + (size_t)br * SZ_WOUT), 512, (r >> 3) * 64, (r & 7) * 64, 0, fl);
      } else {
        j -= 2400;
        tr_tile(p, wid, p.w_o + (size_t)layer * 1024 * 1024, 1024, (bf16*)(wb + SZ_W1 + SZ_W2 + SZ_W3 + 3 * SZ_WOUT), 1024,
                (j >> 4) * 64, (j & 15) * 64, 0, fl);
      }
    } else if (item < 2 * TR_PER_LAYER + 96) {
      const int m = item - 2 * TR_PER_LAYER;
      const int layer = m / 48, nc = (m % 48) * 64;
      float* sc = fl;
      float* red = fl + 9 * 1024;
      for (int idx = tid; idx < 9 * 1024; idx += 256) {
        int j = idx >> 10, k = idx & 1023;
        float v = j < 8 ? p.c[j * 1024 + k] : p.c_ctx[k];
        sc[idx] = v / (1.f + expf(-v));
      }
      __syncthreads();
      const int tx = tid & 63, q = tid >> 6;
      float acc[9];
#pragma unroll
      for (int j = 0; j < 9; ++j) acc[j] = 0.f;
      const float* wm = p.w_mod + (size_t)layer * 1024 * 3072 + nc + tx;
#pragma unroll 4
      for (int k = q * 256; k < q * 256 + 256; ++k) {
        float wv = wm[(size_t)k * 3072];
#pragma unroll
        for (int j = 0; j < 9; ++j) acc[j] = fmaf(sc[j * 1024 + k], wv, acc[j]);
      }
#pragma unroll
      for (int j = 0; j < 9; ++j) red[(q * 9 + j) * 64 + tx] = acc[j];
      __syncthreads();
      float* modv = (float*)(p.ws + OFF_MOD);
      for (int idx = tid; idx < 9 * 64; idx += 256) {
        int j = idx >> 6, t = idx & 63;
        float s = red[(0 * 9 + j) * 64 + t] + red[(1 * 9 + j) * 64 + t] + red[(2 * 9 + j) * 64 + t] + red[(3 * 9 + j) * 64 + t];
        modv[(size_t)(layer * 9 + j) * 3072 + nc + t] = s + p.b_mod[layer * 3072 + nc + t];
      }
      __syncthreads();
    } else {
      float* rope = (float*)(p.ws + OFF_ROPE);
      for (int idx = tid; idx < 2048; idx += 256) {
        int pos = idx >> 4, f = idx & 15;
        float inv = (float)exp(-(double)f / 16.0 * 9.210340371976184);
        float angf = (float)pos * inv;
        double a = (double)angf;
        double r = a - 6.283185307179586477 * rint(a * 0.15915494309189533577);
        double r2 = r * r;
        double ts = r, ss = r, tc = 1.0, cs = 1.0;
#pragma unroll 1
        for (int n = 1; n <= 12; ++n) {
          tc *= -r2 / (double)((2 * n - 1) * (2 * n));
          cs += tc;
          ts *= -r2 / (double)((2 * n) * (2 * n + 1));
          ss += ts;
        }
        rope[idx * 2] = (float)cs;
        rope[idx * 2 + 1] = (float)ss;
      }
      float* misc = (float*)(p.ws + OFF_MISC);
      if (tid < 2) {
        const float* lm = p.da_lambda + tid * 4 * 64;
        float s1 = 0.f, s2 = 0.f;
        for (int i = 0; i < 64; ++i) { s1 += lm[i] * lm[64 + i]; s2 += lm[128 + i] * lm[192 + i]; }
        float lam_init = 0.8f - 0.6f * expf(-0.3f * (float)tid);
        misc[tid] = expf(s1) - expf(s2) + lam_init;
      }
      if (tid < 16) ((unsigned*)(p.ws + OFF_MISC + 64))[tid] = 0u;
    }
  }
}

DI float wave_sum(float v) {
#pragma unroll
  for (int m = 32; m >= 1; m >>= 1) v += __shfl_xor(v, m);
  return v;
}

DI void phase_h(const Params& p, const int wid, int layer, const float* xl, const float* xc, int M) {
  const int tidf = tid_fresh(p, wid); const int lane = tidf & 63, wave = tidf >> 6;
  bf16* h = (bf16*)(p.ws + OFF_H);
  const float* modv = (const float*)(p.ws + OFF_MOD) + (size_t)layer * 9 * 3072;
  const float* nw = p.norm_w + layer * 1024;
  const int stride = gridDim.x * 4;
  for (int row0 = blockIdx.x * 4 + wave; row0 < M; row0 += 2 * stride) {
    float4 v[2][4];
    float ss[2] = {0.f, 0.f};
#pragma unroll
    for (int r = 0; r < 2; ++r) {
      int row = row0 + r * stride;
      if (row >= M) row = row0;
      const float* src = row < NL ? xl + (size_t)row * 1024 : xc + (size_t)(row - NL) * 1024;
#pragma unroll
      for (int i = 0; i < 4; ++i) v[r][i] = *(const float4*)(src + (i * 64 + lane) * 4);
    }
#pragma unroll
    for (int r = 0; r < 2; ++r) {
#pragma unroll
      for (int i = 0; i < 4; ++i) ss[r] += v[r][i].x * v[r][i].x + v[r][i].y * v[r][i].y + v[r][i].z * v[r][i].z + v[r][i].w * v[r][i].w;
      ss[r] = wave_sum(ss[r]);
    }
#pragma unroll
    for (int r = 0; r < 2; ++r) {
      const int row = row0 + r * stride;
      if (row < M) {
        const int j = row < NL ? (row >> 13) : 8;
        const float* shift = modv + j * 3072;
        const float* scale = shift + 1024;
        const float rstd = rsqrtf(ss[r] * (1.f / 1024.f) + EPS);
#pragma unroll
        for (int i = 0; i < 4; ++i) {
          const int c = (i * 64 + lane) * 4;
          float4 w4 = *(const float4*)(nw + c), sc4 = *(const float4*)(scale + c), sh4 = *(const float4*)(shift + c);
          float o0 = v[r][i].x * rstd * w4.x * (1.f + sc4.x) + sh4.x;
          float o1 = v[r][i].y * rstd * w4.y * (1.f + sc4.y) + sh4.y;
          float o2 = v[r][i].z * rstd * w4.z * (1.f + sc4.z) + sh4.z;
          float o3 = v[r][i].w * rstd * w4.w * (1.f + sc4.w) + sh4.w;
          uint2 pk; pk.x = pack2(o0, o1); pk.y = pack2(o2, o3);
          *(uint2*)(h + (size_t)row * 1024 + c) = pk;
        }
      }
    }
  }
}

template <bool SWAP>
DI void gemm_main128(const bf16* __restrict__ A, int lda, const bf16* __restrict__ Bt, int ldb, int K,
                     f32x16 (&acc)[2][2], char* lds, const int tid) {
  bf16* As = (bf16*)lds;
  bf16* Bs = As + 128 * 72;
  const int lane = tid & 63, wave = tid >> 6, wm = wave >> 1, wn = wave & 1;
  const int l31 = lane & 31, lh = lane >> 5;
  const uint32_t aoff = (uint32_t)(((tid >> 3) * lda + (tid & 7) * 8) * 2);
  const uint32_t boff = (uint32_t)(((tid >> 3) * ldb + (tid & 7) * 8) * 2);
  const uint32_t soff = (uint32_t)(((tid >> 3) * 72 + (tid & 7) * 8) * 2);
  const char* Ab = (const char*)A;
  const char* Bb = (const char*)Bt;
  char* Asb = (char*)As;
  char* Bsb = (char*)Bs;
  const size_t astep = (size_t)32 * lda * 2, bstep = (size_t)32 * ldb * 2;
  uint4 ra0, ra1, ra2, ra3, rb0, rb1, rb2, rb3;
#define ALD(i, kb) (*(const uint4*)(Ab + ((size_t)(i) * astep + (kb)) + aoff))
#define BLD(i, kb) (*(const uint4*)(Bb + ((size_t)(i) * bstep + (kb)) + boff))
#define LDALL(kb)                                                          \
  ra0 = ALD(0, kb); ra1 = ALD(1, kb); ra2 = ALD(2, kb); ra3 = ALD(3, kb);  \
  rb0 = BLD(0, kb); rb1 = BLD(1, kb); rb2 = BLD(2, kb); rb3 = BLD(3, kb);
#define SST(base, i, val) (*(uint4*)((base) + (i) * (32 * 72 * 2) + soff) = (val))
  LDALL((size_t)0)
#pragma unroll 1
  for (int k0 = 0; k0 < K; k0 += 64) {
    SST(Asb, 0, ra0); SST(Asb, 1, ra1); SST(Asb, 2, ra2); SST(Asb, 3, ra3);
    SST(Bsb, 0, rb0); SST(Bsb, 1, rb1); SST(Bsb, 2, rb2); SST(Bsb, 3, rb3);
    __syncthreads();
    if (k0 + 64 < K) {
      const size_t kb = (size_t)(k0 + 64) * 2;
      LDALL(kb)
    }
    {
      const bf16* ap = As + (wm * 64 + l31) * 72 + lh * 8;
      const bf16* bp = Bs + (wn * 64 + l31) * 72 + lh * 8;
#define LDA_(tm, ks) (*(const bf16x8*)(ap + (tm) * 32 * 72 + (ks) * 16))
#define LDB_(tn, ks) (*(const bf16x8*)(bp + (tn) * 32 * 72 + (ks) * 16))
#define STEP(B0_, B1_, N0_, N1_, ks, more)                                              \
  if (more) { N0_ = LDB_(0, (ks) + 1); N1_ = LDB_(1, (ks) + 1); }                       \
  acc[0][0] = MM(a0, B0_, acc[0][0]); acc[0][1] = MM(a0, B1_, acc[0][1]);       \
  if (more) a0 = LDA_(0, (ks) + 1);                                                     \
  acc[1][0] = MM(a1, B0_, acc[1][0]); acc[1][1] = MM(a1, B1_, acc[1][1]);       \
  if (more) a1 = LDA_(1, (ks) + 1);                                                     \
  __builtin_amdgcn_sched_barrier(0);
      bf16x8 a0 = LDA_(0, 0), a1 = LDA_(1, 0);
      bf16x8 p0 = LDB_(0, 0), p1 = LDB_(1, 0), q0, q1;
      __builtin_amdgcn_sched_barrier(0);
      STEP(p0, p1, q0, q1, 0, true)
      STEP(q0, q1, p0, p1, 1, true)
      STEP(p0, p1, q0, q1, 2, true)
      STEP(q0, q1, p0, p1, 3, false)
#undef LDA_
#undef LDB_
#undef STEP
    }
    __syncthreads();
  }
#undef LDALL
#undef ALD
#undef BLD
#undef SST
}

template <int TM, int WN>
DI void zero_acc(f32x16 (&acc)[TM][WN]) {
#pragma unroll
  for (int a = 0; a < TM; ++a)
#pragma unroll
    for (int b = 0; b < WN; ++b)
#pragma unroll
      for (int i = 0; i < 16; ++i) acc[a][b][i] = 0.f;
}

template <bool SWAP>
DI void gemm_main256(const bf16* __restrict__ A, int lda, const bf16* __restrict__ Bt, int ldb, int K,
                     f32x16 (&acc)[4][2], char* lds, const int tid) {
  bf16* As = (bf16*)lds;
  bf16* Bs = As + 256 * 72;
  const int lane = tid & 63, wave = tid >> 6, wm = wave >> 1, wn = wave & 1;
  const int l31 = lane & 31, lh = lane >> 5;
  const uint32_t aoff = (uint32_t)(((tid >> 3) * lda + (tid & 7) * 8) * 2);
  const uint32_t boff = (uint32_t)(((tid >> 3) * ldb + (tid & 7) * 8) * 2);
  const uint32_t soff = (uint32_t)(((tid >> 3) * 72 + (tid & 7) * 8) * 2);
  const char* Ab = (const char*)A;
  const char* Bb = (const char*)Bt;
  char* Asb = (char*)As;
  char* Bsb = (char*)Bs;
  const size_t astep = (size_t)32 * lda * 2, bstep = (size_t)32 * ldb * 2;
  uint4 ra0, ra1, ra2, ra3, ra4, ra5, ra6, ra7, rb0, rb1, rb2, rb3;
#define ALD(i, kb) (*(const uint4*)(Ab + ((size_t)(i) * astep + (kb)) + aoff))
#define BLD(i, kb) (*(const uint4*)(Bb + ((size_t)(i) * bstep + (kb)) + boff))
#define LDALL(kb)                                                                      \
  ra0 = ALD(0, kb); ra1 = ALD(1, kb); ra2 = ALD(2, kb); ra3 = ALD(3, kb);              \
  ra4 = ALD(4, kb); ra5 = ALD(5, kb); ra6 = ALD(6, kb); ra7 = ALD(7, kb);              \
  rb0 = BLD(0, kb); rb1 = BLD(1, kb); rb2 = BLD(2, kb); rb3 = BLD(3, kb);
#define SST(base, i, val) (*(uint4*)((base) + (i) * (32 * 72 * 2) + soff) = (val))
  LDALL((size_t)0)
#pragma unroll 1
  for (int k0 = 0; k0 < K; k0 += 64) {
    SST(Asb, 0, ra0); SST(Asb, 1, ra1); SST(Asb, 2, ra2); SST(Asb, 3, ra3);
    SST(Asb, 4, ra4); SST(Asb, 5, ra5); SST(Asb, 6, ra6); SST(Asb, 7, ra7);
    SST(Bsb, 0, rb0); SST(Bsb, 1, rb1); SST(Bsb, 2, rb2); SST(Bsb, 3, rb3);
    __syncthreads();
    if (k0 + 64 < K) {
      const size_t kb = (size_t)(k0 + 64) * 2;
      LDALL(kb)
    }
    {
      const bf16* ap = As + (wm * 128 + l31) * 72 + lh * 8;
      const bf16* bp = Bs + (wn * 64 + l31) * 72 + lh * 8;
#define LDA_(tm, ks) (*(const bf16x8*)(ap + (tm) * 32 * 72 + (ks) * 16))
#define LDB_(tn, ks) (*(const bf16x8*)(bp + (tn) * 32 * 72 + (ks) * 16))
#define STEP(B0_, B1_, N0_, N1_, ks, more)                                              \
  if (more) { N0_ = LDB_(0, (ks) + 1); N1_ = LDB_(1, (ks) + 1); }                       \
  acc[0][0] = MM(a0, B0_, acc[0][0]); acc[0][1] = MM(a0, B1_, acc[0][1]);       \
  if (more) a0 = LDA_(0, (ks) + 1);                                                     \
  acc[1][0] = MM(a1, B0_, acc[1][0]); acc[1][1] = MM(a1, B1_, acc[1][1]);       \
  if (more) a1 = LDA_(1, (ks) + 1);                                                     \
  acc[2][0] = MM(a2, B0_, acc[2][0]); acc[2][1] = MM(a2, B1_, acc[2][1]);       \
  if (more) a2 = LDA_(2, (ks) + 1);                                                     \
  acc[3][0] = MM(a3, B0_, acc[3][0]); acc[3][1] = MM(a3, B1_, acc[3][1]);       \
  if (more) a3 = LDA_(3, (ks) + 1);                                                     \
  __builtin_amdgcn_sched_barrier(0);
      bf16x8 a0 = LDA_(0, 0), a1 = LDA_(1, 0), a2 = LDA_(2, 0), a3 = LDA_(3, 0);
      bf16x8 p0 = LDB_(0, 0), p1 = LDB_(1, 0), q0, q1;
      __builtin_amdgcn_sched_barrier(0);
      STEP(p0, p1, q0, q1, 0, true)
      STEP(q0, q1, p0, p1, 1, true)
      STEP(p0, p1, q0, q1, 2, true)
      STEP(q0, q1, p0, p1, 3, false)
#undef LDA_
#undef LDB_
#undef STEP
    }
    __syncthreads();
  }
#undef LDALL
#undef ALD
#undef BLD
#undef SST
}

DI void store_rows_bf16(bf16* __restrict__ rowp, const f32x16& a, int lh) {
#pragma unroll
  for (int k = 0; k < 4; k += 2) {
    uint32_t ax = pack2(a[4 * k], a[4 * k + 1]), ay = pack2(a[4 * k + 2], a[4 * k + 3]);
    uint32_t bx = pack2(a[4 * k + 4], a[4 * k + 5]), by = pack2(a[4 * k + 6], a[4 * k + 7]);
    const auto rx = __builtin_amdgcn_permlane32_swap(ax, bx, false, false);
    const auto ry = __builtin_amdgcn_permlane32_swap(ay, by, false, false);
    *(uint4*)(rowp + 8 * k + (lh ? 8 : 0)) = make_uint4(rx[0], ry[0], rx[1], ry[1]);
  }
}

DI bool xcd_tile(int it, int MT, int NTN, int PN, int& mt, int& nt) {
  const int x = blockIdx.x & 7, slot = blockIdx.x >> 3, nslots = gridDim.x >> 3;
  const int MTx = MT >> 3;
  const int lt = slot + it * nslots;
  if (lt >= MTx * NTN) return false;
  const int per_panel = MTx * PN;
  const int pn = lt / per_panel, r = lt - pn * per_panel;
  mt = x * MTx + r / PN;
  nt = pn * PN + r % PN;
  return true;
}

DI void phase_p1(const Params& p, const int wid, int layer, int M, char* lds) {
  const bf16* h = (const bf16*)(p.ws + OFF_H);
  const bf16* W1 = (const bf16*)(p.ws + OFF_W + (size_t)layer * LW);
  constexpr int NTN = N1 / 128;
  int mt_, nt_;
  for (int it = 0; xcd_tile(it, M / 256, NTN, 9, mt_, nt_); ++it) {
    const int m0 = mt_ * 256, n0 = nt_ * 128;
    const int tidf = tid_fresh(p, wid); const int lane = tidf & 63, wave = tidf >> 6, wm = wave >> 1, wn = wave & 1, l31 = lane & 31, lh = lane >> 5;
    f32x16 acc[4][2];
    zero_acc<4, 2>(acc);
    const bool lat = m0 < NL;
    if (n0 >= 1024 && n0 < 1536) {
      gemm_main256<false>(h + (size_t)m0 * 1024, 1024, W1 + (size_t)n0 * 1024, 1024, 1024, acc, lds, tidf);
      bf16* Vt = (bf16*)(p.ws + OFF_VT);
#pragma unroll
      for (int tm = 0; tm < 4; ++tm)
#pragma unroll
        for (int tn = 0; tn < 2; ++tn) {
          const int col = n0 + wn * 64 + tn * 32 + l31;
          const int rowb = m0 + wm * 128 + tm * 32 + 4 * lh;
          const int hd = (col - 1024) >> 7, vv = (col - 1024) & 127;
#pragma unroll
          for (int g = 0; g < 4; ++g) {
            const int row0 = rowb + 8 * g;
            int b, key;
            if (lat) { b = row0 >> 13; key = 256 + (row0 & 8191); } else { b = (row0 - NL) >> 8; key = (row0 - NL) & 255; }
            uint2 pk;
            pk.x = pack2(acc[tm][tn][4 * g], acc[tm][tn][4 * g + 1]);
            pk.y = pack2(acc[tm][tn][4 * g + 2], acc[tm][tn][4 * g + 3]);
            *(uint2*)(Vt + ((size_t)((b * 4 + hd) * 128 + vv)) * KEYS + key) = pk;
          }
        }
    } else {
      gemm_main256<true>(h + (size_t)m0 * 1024, 1024, W1 + (size_t)n0 * 1024, 1024, 1024, acc, lds, tidf);
      int rbase = m0 + wm * 128 + l31, loff = wn * 64 + (lh ? 8 : 0);
      asm volatile("" : "+v"(rbase), "+v"(loff));
      if (n0 < 1024) {
        const float2* rope = (const float2*)(p.ws + OFF_ROPE);
        bf16* dst = (bf16*)(p.ws + (n0 < 512 ? OFF_QA : OFF_KA)) + (n0 & 511);
        const float qs = n0 < 512 ? QSCALE : 1.f;
#pragma unroll
        for (int tm = 0; tm < 4; ++tm)
#pragma unroll
          for (int tn = 0; tn < 2; ++tn) {
            const int row = rbase + tm * 32;
            f32x16& r = acc[tm][tn];
            if (lat) {
              const int t = row & 8191;
              const int pos = tn ? (t & 63) : (t >> 6);
              const float4* rp = (const float4*)(rope + pos * 16 + 4 * lh);
#pragma unroll
              for (int hb = 0; hb < 2; ++hb) {
                const float4 c01 = rp[4 * hb], c23 = rp[4 * hb + 1];
                const float cc[4] = {c01.x, c01.z, c23.x, c23.z}, sn[4] = {c01.y, c01.w, c23.y, c23.w};
#pragma unroll
                for (int j = 0; j < 4; ++j) {
                  const int i = 4 * hb + j;
                  const float x0 = r[i], x1 = r[i + 8];
                  r[i] = (x0 * cc[j] - x1 * sn[j]) * qs;
                  r[i + 8] = (x1 * cc[j] + x0 * sn[j]) * qs;
                }
                __builtin_amdgcn_sched_barrier(0);
              }
            } else {
#pragma unroll
              for (int i = 0; i < 16; ++i) r[i] *= qs;
            }
            store_rows_bf16(dst + (size_t)row * 512 + tn * 32 + loff, r, 0);
            __builtin_amdgcn_sched_barrier(0);
          }
      } else if (n0 < 3328) {
        bf16* dst; int ld;
        if (n0 < 2304) { dst = (bf16*)(p.ws + OFF_XBC) + (n0 - 1536); ld = 768; }
        else if (n0 < 2560) { dst = (bf16*)(p.ws + OFF_GQ) + (n0 - 2304); ld = 256; }
        else if (n0 < 2816) { dst = (bf16*)(p.ws + OFF_GK) + (n0 - 2560); ld = 256; }
        else { dst = (bf16*)(p.ws + OFF_GV) + (n0 - 2816); ld = 512; }
#pragma unroll
        for (int tm = 0; tm < 4; ++tm)
#pragma unroll
          for (int tn = 0; tn < 2; ++tn) {
            store_rows_bf16(dst + (size_t)(rbase + tm * 32) * ld + tn * 32 + loff, acc[tm][tn], 0);
            __builtin_amdgcn_sched_barrier(0);
          }
      } else if (wn == 0) {
        float* dtlr = (float*)(p.ws + OFF_DTLR);
#pragma unroll
        for (int tm = 0; tm < 4; ++tm)
#pragma unroll
          for (int tn = 0; tn < 2; ++tn)
#pragma unroll
            for (int g = 0; g < 4; ++g) {
              const int cc = tn * 32 + 8 * g + 4 * lh;
              if (cc < 48)
                *(float4*)(dtlr + (size_t)(rbase + tm * 32) * 48 + cc) =
                    make_float4(acc[tm][tn][4 * g], acc[tm][tn][4 * g + 1], acc[tm][tn][4 * g + 2], acc[tm][tn][4 * g + 3]);
            }
      }
    }
  }
}

DI void phase_conv(const Params& p, const int wid, int layer) {
  const bf16* xin = (const bf16*)(p.ws + OFF_XBC);
  bf16* xo = (bf16*)(p.ws + OFF_XBC2);
  const float* cw = p.conv_w + layer * 3 * 768;
  const float* cb = p.conv_b + layer * 768;
  const int total = NT * 96;
  for (int idx = blockIdx.x * 256 + tid_fresh(p, wid); idx < total; idx += gridDim.x * 256) {
    const int row = idx / 96, c0 = (idx % 96) * 8;
    int t, L;
    if (row < NL) { t = row & 8191; L = 8192; } else { t = (row - NL) & 255; L = 256; }
    uint4 cur = *(const uint4*)(xin + (size_t)row * 768 + c0);
    uint4 prv = make_uint4(0, 0, 0, 0), nxt = make_uint4(0, 0, 0, 0);
    if (t > 0) prv = *(const uint4*)(xin + (size_t)(row - 1) * 768 + c0);
    if (t < L - 1) nxt = *(const uint4*)(xin + (size_t)(row + 1) * 768 + c0);
    const uint32_t cu[4] = {cur.x, cur.y, cur.z, cur.w}, pu[4] = {prv.x, prv.y, prv.z, prv.w}, nu[4] = {nxt.x, nxt.y, nxt.z, nxt.w};
    uint32_t ou[4];
#pragma unroll
    for (int q = 0; q < 4; ++q) {
      const int c = c0 + 2 * q;
      float a0 = cw[c] * blo(pu[q]) + cw[768 + c] * blo(cu[q]) + cw[1536 + c] * blo(nu[q]) + cb[c];
      float a1 = cw[c + 1] * bhi(pu[q]) + cw[768 + c + 1] * bhi(cu[q]) + cw[1536 + c + 1] * bhi(nu[q]) + cb[c + 1];
      ou[q] = pack2(siluf(a0), siluf(a1));
    }
    *(uint4*)(xo + (size_t)row * 768 + c0) = make_uint4(ou[0], ou[1], ou[2], ou[3]);
  }
}

DI int scan_row(int b, int dir, int s) {
  if (s < 256) { int t = dir ? 255 - s : s; return NL + b * 256 + t; }
  int t = s - 256;
  if (dir) t = 8191 - t;
  return b * 8192 + t;
}

template <bool GLA>
DI void scan_item(const Params& p, const int wid, int layer, int item, char* lds) {
  constexpr int CT = 16;
  constexpr int V = GLA ? 128 : 64;
  constexpr int NJ = V / 32;
  constexpr int BV = V / 16;
  float* a_s = (float*)lds;
  float* c_s = a_s + CT * 64;
  float* w_s = c_s + CT * 64;
  float* b_s = w_s + CT * 64;
  float* x_s = b_s + CT * V;
  float* op = x_s + (GLA ? 0 : CT * V);
  float* wg_s = op + CT * 4 * V;
  const int tid = tid_fresh(p, wid), lane = tid & 63, wave = tid >> 6;
  int head, dir, b;
  if (GLA) { head = item & 3; dir = (item >> 2) & 1; b = item >> 3; } else { head = item & 7; dir = (item >> 3) & 1; b = item >> 4; }
  const bf16* xbc = (const bf16*)(p.ws + OFF_XBC2);
  const bf16* gq = (const bf16*)(p.ws + OFF_GQ);
  const bf16* gk = (const bf16*)(p.ws + OFF_GK);
  const bf16* gv = (const bf16*)(p.ws + OFF_GV);
  const float* dtlr = (const float*)(p.ws + OFF_DTLR);
  bf16* yout = (bf16*)(p.ws + (GLA ? (dir ? OFF_YGB : OFF_YGF) : (dir ? OFF_YSB : OFF_YSF)));
  const int ocol = head * V;
  float Aneg = 0.f, Dsk = 0.f, dtb = 0.f;
  if (!GLA) {
    Aneg = -expf(p.a_log[layer * 16 + dir * 8 + head]);
    Dsk = p.ssm_d[layer * 16 + dir * 8 + head];
    dtb = p.dt_bias[layer * 16 + dir * 8 + head];
  } else {
    const float* wg = p.gla_w_gate + ((size_t)(layer * 2 + dir) * 16) * 256 + head * 64;
    for (int idx = tid; idx < 16 * 64; idx += 256) wg_s[idx] = wg[(idx >> 6) * 256 + (idx & 63)];
    if (tid < 64) wg_s[1024 + tid] = p.gla_b_gate[(layer * 2 + dir) * 256 + head * 64 + tid];
  }
  const int st = tid >> 4, sk4 = (tid & 15) * 4, sv = (tid & 15) * BV;
  const int vq = lane & 31, kg = wave * 2 + (lane >> 5);
  float S[8][NJ];
#pragma unroll
  for (int i = 0; i < 8; ++i)
#pragma unroll
    for (int j = 0; j < NJ; ++j) S[i][j] = 0.f;

  uint2 ra, rc; uint4 rbv; float rdt = 0.f; float4 rlr0, rlr1, rlr2, rlr3;
  rlr0 = rlr1 = rlr2 = rlr3 = make_float4(0.f, 0.f, 0.f, 0.f);
  rbv = make_uint4(0, 0, 0, 0);
#define SCAN_PREFETCH(chunk_)                                                                   \
  {                                                                                             \
    const int row_ = scan_row(b, dir, (chunk_) * CT + st);                                      \
    if (GLA) {                                                                                  \
      ra = *(const uint2*)(gk + (size_t)row_ * 256 + head * 64 + sk4);                          \
      rc = *(const uint2*)(gq + (size_t)row_ * 256 + head * 64 + sk4);                          \
      rbv = *(const uint4*)(gv + (size_t)row_ * 512 + head * 128 + sv);                         \
      const float* lr_ = dtlr + (size_t)row_ * 48 + 16 + dir * 16;                              \
      rlr0 = *(const float4*)(lr_); rlr1 = *(const float4*)(lr_ + 4);                           \
      rlr2 = *(const float4*)(lr_ + 8); rlr3 = *(const float4*)(lr_ + 12);                      \
    } else {                                                                                    \
      const int g_ = head >> 2;                                                                 \
      ra = *(const uint2*)(xbc + (size_t)row_ * 768 + 512 + g_ * 64 + sk4);                     \
      rc = *(const uint2*)(xbc + (size_t)row_ * 768 + 640 + g_ * 64 + sk4);                     \
      const uint2 t_ = *(const uint2*)(xbc + (size_t)row_ * 768 + head * 64 + sv);              \
      rbv.x = t_.x; rbv.y = t_.y;                                                               \
      rdt = dtlr[(size_t)row_ * 48 + dir * 8 + head];                                           \
    }                                                                                           \
  }
  SCAN_PREFETCH(0);
  constexpr int NCH = KEYS / CT;
  for (int chunk = 0; chunk < NCH; ++chunk) {
    {
      const float cscale = GLA ? 0.125f : 1.f;
      *(float4*)(a_s + st * 64 + sk4) = make_float4(blo(ra.x), bhi(ra.x), blo(ra.y), bhi(ra.y));
      *(float4*)(c_s + st * 64 + sk4) = make_float4(blo(rc.x) * cscale, bhi(rc.x) * cscale, blo(rc.y) * cscale, bhi(rc.y) * cscale);
      if (GLA) {
        *(float4*)(b_s + st * V + sv) = make_float4(blo(rbv.x), bhi(rbv.x), blo(rbv.y), bhi(rbv.y));
        *(float4*)(b_s + st * V + sv + 4) = make_float4(blo(rbv.z), bhi(rbv.z), blo(rbv.w), bhi(rbv.w));
        float4 zb = *(const float4*)(wg_s + 1024 + sk4);
        float z0 = zb.x, z1 = zb.y, z2 = zb.z, z3 = zb.w;
#define GROW(r_, lv_)                                                  \
  {                                                                    \
    const float4 w0_ = *(const float4*)(wg_s + (r_) * 64 + sk4);       \
    z0 = fmaf((lv_), w0_.x, z0); z1 = fmaf((lv_), w0_.y, z1); z2 = fmaf((lv_), w0_.z, z2); z3 = fmaf((lv_), w0_.w, z3); \
  }
        GROW(0, rlr0.x) GROW(1, rlr0.y) GROW(2, rlr0.z) GROW(3, rlr0.w)
        GROW(4, rlr1.x) GROW(5, rlr1.y) GROW(6, rlr1.z) GROW(7, rlr1.w)
        GROW(8, rlr2.x) GROW(9, rlr2.y) GROW(10, rlr2.z) GROW(11, rlr2.w)
        GROW(12, rlr3.x) GROW(13, rlr3.y) GROW(14, rlr3.z) GROW(15, rlr3.w)
#define LSIG16(zz) expf(((zz) >= 0.f ? -log1pf(expf(-(zz))) : (zz) - log1pf(expf(zz))) * (1.f / 16.f))
        *(float4*)(w_s + st * 64 + sk4) = make_float4(LSIG16(z0), LSIG16(z1), LSIG16(z2), LSIG16(z3));
      } else {
        float zz = rdt + dtb;
        float dt = zz > 20.f ? zz : log1pf(expf(zz));
        float4 xv = make_float4(blo(rbv.x), bhi(rbv.x), blo(rbv.y), bhi(rbv.y));
        *(float4*)(b_s + st * V + sv) = make_float4(xv.x * dt, xv.y * dt, xv.z * dt, xv.w * dt);
        *(float4*)(x_s + st * V + sv) = xv;
        if ((tid & 15) == 0) w_s[st] = expf(dt * Aneg);
      }
    }
    __syncthreads();
    if (chunk + 1 < NCH) SCAN_PREFETCH(chunk + 1);
#pragma unroll 4
    for (int tt = 0; tt < CT; ++tt) {
      const float4 a0 = *(const float4*)(a_s + tt * 64 + kg * 8), a1 = *(const float4*)(a_s + tt * 64 + kg * 8 + 4);
      const float4 c0 = *(const float4*)(c_s + tt * 64 + kg * 8), c1 = *(const float4*)(c_s + tt * 64 + kg * 8 + 4);
      const float av[8] = {a0.x, a0.y, a0.z, a0.w, a1.x, a1.y, a1.z, a1.w};
      const float cv[8] = {c0.x, c0.y, c0.z, c0.w, c1.x, c1.y, c1.z, c1.w};
      float wv[8];
      if (GLA) {
        const float4 w0 = *(const float4*)(w_s + tt * 64 + kg * 8), w1 = *(const float4*)(w_s + tt * 64 + kg * 8 + 4);
        wv[0] = w0.x; wv[1] = w0.y; wv[2] = w0.z; wv[3] = w0.w; wv[4] = w1.x; wv[5] = w1.y; wv[6] = w1.z; wv[7] = w1.w;
      } else {
        const float w = w_s[tt];
#pragma unroll
        for (int i = 0; i < 8; ++i) wv[i] = w;
      }
      float bv[NJ], o[NJ];
#pragma unroll
      for (int j = 0; j < NJ; ++j) { bv[j] = b_s[tt * V + vq + 32 * j]; o[j] = 0.f; }
#pragma unroll
      for (int i = 0; i < 8; ++i)
#pragma unroll
        for (int j = 0; j < NJ; ++j) {
          S[i][j] = fmaf(wv[i], S[i][j], av[i] * bv[j]);
          o[j] = fmaf(cv[i], S[i][j], o[j]);
        }
#pragma unroll
      for (int j = 0; j < NJ; ++j) {
        o[j] += __shfl_xor(o[j], 32);
        if (lane < 32) op[(tt * 4 + wave) * V + vq + 32 * j] = o[j];
      }
    }
    __syncthreads();
    {
      const int row = scan_row(b, dir, chunk * CT + st);
#pragma unroll
      for (int q = 0; q < BV / 4; ++q) {
        const int vc = sv + 4 * q;
        float4 o0 = *(const float4*)(op + (st * 4 + 0) * V + vc), o1 = *(const float4*)(op + (st * 4 + 1) * V + vc);
        float4 o2 = *(const float4*)(op + (st * 4 + 2) * V + vc), o3 = *(const float4*)(op + (st * 4 + 3) * V + vc);
        float r0 = o0.x + o1.x + o2.x + o3.x, r1 = o0.y + o1.y + o2.y + o3.y, r2 = o0.z + o1.z + o2.z + o3.z, r3 = o0.w + o1.w + o2.w + o3.w;
        if (!GLA) {
          float4 xv = *(const float4*)(x_s + st * V + vc);
          r0 = fmaf(Dsk, xv.x, r0); r1 = fmaf(Dsk, xv.y, r1); r2 = fmaf(Dsk, xv.z, r2); r3 = fmaf(Dsk, xv.w, r3);
        }
        uint2 pk; pk.x = pack2(r0, r1); pk.y = pack2(r2, r3);
        *(uint2*)(yout + (size_t)row * 512 + ocol + vc) = pk;
      }
    }
  }
  __syncthreads();
#undef SCAN_PREFETCH
#undef GROW
#undef LSIG16
}

DI bf16x8 pack8(const f32x16& x, int s) {
  uint32_t p0 = pack2(x[8 * s], x[8 * s + 1]), p1 = pack2(x[8 * s + 2], x[8 * s + 3]);
  uint32_t p2 = pack2(x[8 * s + 4], x[8 * s + 5]), p3 = pack2(x[8 * s + 6], x[8 * s + 7]);
  uint4 u = make_uint4(p0, p1, p2, p3);
  return __builtin_bit_cast(bf16x8, u);
}

template <bool GLA>
DI void cscan_item(const Params& p, const int wid, int layer, int item, char* lds) {
  constexpr int RS = 72;
  bf16* Qm = (bf16*)lds;
  bf16* Km = Qm + 64 * RS;
  bf16* KeT = Km + 64 * RS;
  bf16* bT = KeT + 64 * RS;
  bf16* ST = bT + 64 * RS;
  char* R = (char*)(ST + 64 * RS);
  float* Gf = (float*)R;
  bf16* Cm = (bf16*)R;
  float* Gs = (float*)(R + 64 * RS * 2);
  float* tot = (float*)(R + 16384);
  float* lr_s = tot + 256;
  const int tid = tid_fresh(p, wid), lane = tid & 63, wave = tid >> 6, l31 = lane & 31, lh = lane >> 5;
  const int nt = wave & 1, vh = wave >> 1;
  int head, dir, b, vhalf = 0;
  if (GLA) { vhalf = item & 1; head = (item >> 1) & 3; } else { head = item & 7; }
  dir = (item >> 3) & 1; b = item >> 4;
  const bf16* xbc = (const bf16*)(p.ws + OFF_XBC2);
  const bf16* gq = (const bf16*)(p.ws + OFF_GQ);
  const bf16* gk = (const bf16*)(p.ws + OFF_GK);
  const bf16* gv = (const bf16*)(p.ws + OFF_GV);
  const float* dtlr = (const float*)(p.ws + OFF_DTLR);
  bf16* yout = (bf16*)(p.ws + (GLA ? (dir ? OFF_YGB : OFF_YGF) : (dir ? OFF_YSB : OFF_YSF)));
  const int ocol = GLA ? head * 128 + vhalf * 64 : head * 64;
  float Aneg = 0.f, Dsk = 0.f, dtb = 0.f, bgk = 0.f;
  float wgk[16];
#pragma unroll
  for (int r = 0; r < 16; ++r) wgk[r] = 0.f;
  if (!GLA) {
    Aneg = -expf(p.a_log[layer * 16 + dir * 8 + head]);
    Dsk = p.ssm_d[layer * 16 + dir * 8 + head];
    dtb = p.dt_bias[layer * 16 + dir * 8 + head];
  } else {
    const float* wg = p.gla_w_gate + ((size_t)(layer * 2 + dir) * 16) * 256 + head * 64 + (tid & 63);
#pragma unroll
    for (int r = 0; r < 16; ++r) wgk[r] = wg[r * 256];
    bgk = p.gla_b_gate[(layer * 2 + dir) * 256 + head * 64 + (tid & 63)];
  }
  const int st = tid >> 2, k16 = (tid & 3) * 16;
  f32x16 Sacc;
#pragma unroll
  for (int i = 0; i < 16; ++i) Sacc[i] = 0.f;

  uint4 ra0, ra1, rc0, rc1, rb0, rb1; float4 rl;
#define CS_PREFETCH(chunk_)                                                                          \
  {                                                                                                  \
    const int row_ = scan_row(b, dir, (chunk_) * 64 + st);                                           \
    if (GLA) {                                                                                       \
      const uint4* ap_ = (const uint4*)(gk + (size_t)row_ * 256 + head * 64 + k16);                  \
      const uint4* cp_ = (const uint4*)(gq + (size_t)row_ * 256 + head * 64 + k16);                  \
      const uint4* bp_ = (const uint4*)(gv + (size_t)row_ * 512 + head * 128 + vhalf * 64 + k16);    \
      ra0 = ap_[0]; ra1 = ap_[1]; rc0 = cp_[0]; rc1 = cp_[1]; rb0 = bp_[0]; rb1 = bp_[1];            \
      rl = *(const float4*)(dtlr + (size_t)row_ * 48 + 16 + dir * 16 + (tid & 3) * 4);               \
    } else {                                                                                         \
      const int g_ = head >> 2;                                                                      \
      const uint4* ap_ = (const uint4*)(xbc + (size_t)row_ * 768 + 512 + g_ * 64 + k16);             \
      const uint4* cp_ = (const uint4*)(xbc + (size_t)row_ * 768 + 640 + g_ * 64 + k16);             \
      const uint4* bp_ = (const uint4*)(xbc + (size_t)row_ * 768 + head * 64 + k16);                 \
      ra0 = ap_[0]; ra1 = ap_[1]; rc0 = cp_[0]; rc1 = cp_[1]; rb0 = bp_[0]; rb1 = bp_[1];            \
      rl.x = dtlr[(size_t)row_ * 48 + dir * 8 + head]; rl.y = 0.f; rl.z = 0.f; rl.w = 0.f;           \
    }                                                                                                \
  }
  CS_PREFETCH(0);
#pragma unroll 1
  for (int chunk = 0; chunk < KEYS / 64; ++chunk) {
    float dt = 0.f;
    if (GLA) {
      *(float4*)(lr_s + st * 16 + (tid & 3) * 4) = rl;
      __syncthreads();
      float Gl[16];
      float run = 0.f;
#pragma unroll
      for (int i = 0; i < 16; ++i) {
        const float* lrp = lr_s + (wave * 16 + i) * 16;
        const float4 l0 = *(const float4*)(lrp), l1 = *(const float4*)(lrp + 4), l2 = *(const float4*)(lrp + 8), l3 = *(const float4*)(lrp + 12);
        float z = bgk;
        z = fmaf(l0.x, wgk[0], z); z = fmaf(l0.y, wgk[1], z); z = fmaf(l0.z, wgk[2], z); z = fmaf(l0.w, wgk[3], z);
        z = fmaf(l1.x, wgk[4], z); z = fmaf(l1.y, wgk[5], z); z = fmaf(l1.z, wgk[6], z); z = fmaf(l1.w, wgk[7], z);
        z = fmaf(l2.x, wgk[8], z); z = fmaf(l2.y, wgk[9], z); z = fmaf(l2.z, wgk[10], z); z = fmaf(l2.w, wgk[11], z);
        z = fmaf(l3.x, wgk[12], z); z = fmaf(l3.y, wgk[13], z); z = fmaf(l3.z, wgk[14], z); z = fmaf(l3.w, wgk[15], z);
        run -= (fmaxf(-z, 0.f) + __logf(1.f + __expf(-fabsf(z)))) * (1.f / 16.f);
        Gl[i] = run;
      }
      tot[wave * 64 + lane] = run;
      __syncthreads();
      float off = 0.f;
      if (wave > 0) off += tot[lane];
      if (wave > 1) off += tot[64 + lane];
      if (wave > 2) off += tot[128 + lane];
#pragma unroll
      for (int i = 0; i < 16; ++i) Gf[(wave * 16 + i) * 64 + lane] = Gl[i] + off;
    } else {
      const float zz = rl.x + dtb;
      dt = zz > 20.f ? zz : log1pf(expf(zz));
      if ((tid & 3) == 0) lr_s[st] = dt;
      __syncthreads();
      if (wave == 0) {
        float g = lr_s[lane] * Aneg;
#pragma unroll
        for (int o = 1; o < 64; o <<= 1) {
          const float v = __shfl_up(g, o);
          if (lane >= o) g += v;
        }
        Gs[lane] = g;
      }
    }
#pragma unroll
    for (int i = 0; i < 16; ++i)
      ST[(32 * (wave >> 1) + (i & 3) + 8 * (i >> 2) + 4 * lh) * RS + 32 * (wave & 1) + l31] = f2b(Sacc[i]);
    __syncthreads();
    {
      const uint32_t au[8] = {ra0.x, ra0.y, ra0.z, ra0.w, ra1.x, ra1.y, ra1.z, ra1.w};
      const uint32_t cu[8] = {rc0.x, rc0.y, rc0.z, rc0.w, rc1.x, rc1.y, rc1.z, rc1.w};
      const uint32_t bu[8] = {rb0.x, rb0.y, rb0.z, rb0.w, rb1.x, rb1.y, rb1.z, rb1.w};
      uint32_t qo[8], ko[8];
      if (GLA) {
#pragma unroll
        for (int q = 0; q < 4; ++q) {
          const float4 G4 = *(const float4*)(Gf + st * 64 + k16 + 4 * q);
          const float4 L4 = *(const float4*)(Gf + 63 * 64 + k16 + 4 * q);
          const float gg[4] = {G4.x, G4.y, G4.z, G4.w}, ll[4] = {L4.x, L4.y, L4.z, L4.w};
#pragma unroll
          for (int h2 = 0; h2 < 2; ++h2) {
            const int w = 2 * q + h2;
            const float a0 = blo(au[w]), a1 = bhi(au[w]), c0 = blo(cu[w]), c1 = bhi(cu[w]);
            const float g0 = gg[2 * h2], g1 = gg[2 * h2 + 1];
            qo[w] = pack2(c0 * 0.125f * __expf(g0), c1 * 0.125f * __expf(g1));
            ko[w] = pack2(a0 * __expf(-g0), a1 * __expf(-g1));
            KeT[(k16 + 2 * w) * RS + st] = f2b(a0 * __expf(ll[2 * h2] - g0));
            KeT[(k16 + 2 * w + 1) * RS + st] = f2b(a1 * __expf(ll[2 * h2 + 1] - g1));
            bT[(k16 + 2 * w) * RS + st] = (bf16)(bu[w] & 0xffffu);
            bT[(k16 + 2 * w + 1) * RS + st] = (bf16)(bu[w] >> 16);
          }
        }
      } else {
        const float Gt = Gs[st], GL = Gs[63];
        const float e1 = __expf(Gt), e3 = __expf(GL - Gt);
#pragma unroll
        for (int w = 0; w < 8; ++w) {
          const float a0 = blo(au[w]), a1 = bhi(au[w]), c0 = blo(cu[w]), c1 = bhi(cu[w]);
          qo[w] = pack2(c0 * e1, c1 * e1);
          ko[w] = au[w];
          KeT[(k16 + 2 * w) * RS + st] = f2b(a0 * e3);
          KeT[(k16 + 2 * w + 1) * RS + st] = f2b(a1 * e3);
          bT[(k16 + 2 * w) * RS + st] = f2b(blo(bu[w]) * dt);
          bT[(k16 + 2 * w + 1) * RS + st] = f2b(bhi(bu[w]) * dt);
        }
        *(uint4*)(Cm + st * RS + k16) = rc0;
        *(uint4*)(Cm + st * RS + k16 + 8) = rc1;
      }
      *(uint4*)(Qm + st * RS + k16) = make_uint4(qo[0], qo[1], qo[2], qo[3]);
      *(uint4*)(Qm + st * RS + k16 + 8) = make_uint4(qo[4], qo[5], qo[6], qo[7]);
      *(uint4*)(Km + st * RS + k16) = make_uint4(ko[0], ko[1], ko[2], ko[3]);
      *(uint4*)(Km + st * RS + k16 + 8) = make_uint4(ko[4], ko[5], ko[6], ko[7]);
    }
    __syncthreads();
    if (chunk + 1 < KEYS / 64) CS_PREFETCH(chunk + 1);
    const int trow = scan_row(b, dir, chunk * 64 + 32 * nt + l31);
    uint2 xr0 = make_uint2(0, 0), xr1 = xr0, xr2 = xr0, xr3 = xr0;
    if (!GLA) {
      const bf16* xp = xbc + (size_t)trow * 768 + head * 64 + 32 * vh + 4 * lh;
      xr0 = *(const uint2*)(xp); xr1 = *(const uint2*)(xp + 8); xr2 = *(const uint2*)(xp + 16); xr3 = *(const uint2*)(xp + 24);
    }
    f32x16 outv;
#pragma unroll
    for (int i = 0; i < 16; ++i) outv[i] = 0.f;
    const bf16* Qp = GLA ? Qm : Cm;
#pragma unroll
    for (int ms = 0; ms < 2; ++ms) {
      if (ms <= nt) {
        f32x16 at;
#pragma unroll
        for (int i = 0; i < 16; ++i) at[i] = 0.f;
#pragma unroll
        for (int ks = 0; ks < 4; ++ks) {
          const bf16x8 kf = *(const bf16x8*)(Km + (32 * ms + l31) * RS + ks * 16 + lh * 8);
          const bf16x8 qf = *(const bf16x8*)(Qp + (32 * nt + l31) * RS + ks * 16 + lh * 8);
          at = MFMA32(kf, qf, at);
        }
        if (!GLA) {
          const float gt = Gs[32 * nt + l31];
#pragma unroll
          for (int g4 = 0; g4 < 4; ++g4) {
            const float4 gs4 = *(const float4*)(Gs + 32 * ms + 8 * g4 + 4 * lh);
            const float gsv[4] = {gs4.x, gs4.y, gs4.z, gs4.w};
#pragma unroll
            for (int j = 0; j < 4; ++j) {
              const int sl = 8 * g4 + 4 * lh + j;
              const bool keep = (ms < nt) || (sl <= l31);
              at[4 * g4 + j] = keep ? at[4 * g4 + j] * __expf(gt - gsv[j]) : 0.f;
            }
          }
        } else if (ms == nt) {
#pragma unroll
          for (int i = 0; i < 16; ++i) {
            const int sl = (i & 3) + 8 * (i >> 2) + 4 * lh;
            at[i] = (sl <= l31) ? at[i] : 0.f;
          }
        }
#pragma unroll
        for (int s2 = 0; s2 < 2; ++s2) {
          const bf16x8 pf = pack8(at, s2);
          const bf16* vp = bT + (32 * vh + l31) * RS + 32 * ms + 16 * s2 + 4 * lh;
          const uint2 lo = *(const uint2*)vp, hi = *(const uint2*)(vp + 8);
          const uint4 u = make_uint4(lo.x, lo.y, hi.x, hi.y);
          outv = MFMA32(__builtin_bit_cast(bf16x8, u), pf, outv);
        }
      }
    }
#pragma unroll
    for (int ks = 0; ks < 4; ++ks) {
      const bf16x8 sf = *(const bf16x8*)(ST + (32 * vh + l31) * RS + ks * 16 + lh * 8);
      const bf16x8 qf = *(const bf16x8*)(Qm + (32 * nt + l31) * RS + ks * 16 + lh * 8);
      outv = MFMA32(sf, qf, outv);
    }
    {
      const float dec = GLA ? __expf(Gf[63 * 64 + 32 * (wave & 1) + l31]) : __expf(Gs[63]);
#pragma unroll
      for (int i = 0; i < 16; ++i) Sacc[i] *= dec;
#pragma unroll
      for (int ks = 0; ks < 4; ++ks) {
        const bf16x8 bf_ = *(const bf16x8*)(bT + (32 * (wave >> 1) + l31) * RS + ks * 16 + lh * 8);
        const bf16x8 kf = *(const bf16x8*)(KeT + (32 * (wave & 1) + l31) * RS + ks * 16 + lh * 8);
        Sacc = MFMA32(bf_, kf, Sacc);
      }
    }
    {
      bf16* yp = yout + (size_t)trow * 512 + ocol + 32 * vh + 4 * lh;
      const uint2 xr[4] = {xr0, xr1, xr2, xr3};
#pragma unroll
      for (int g4 = 0; g4 < 4; ++g4) {
        float r0 = outv[4 * g4], r1 = outv[4 * g4 + 1], r2 = outv[4 * g4 + 2], r3 = outv[4 * g4 + 3];
        if (!GLA) {
          r0 = fmaf(Dsk, blo(xr[g4].x), r0); r1 = fmaf(Dsk, bhi(xr[g4].x), r1);
          r2 = fmaf(Dsk, blo(xr[g4].y), r2); r3 = fmaf(Dsk, bhi(xr[g4].y), r3);
        }
        uint2 pk; pk.x = pack2(r0, r1); pk.y = pack2(r2, r3);
        *(uint2*)(yp + 8 * g4) = pk;
      }
    }
    __syncthreads();
  }
#undef CS_PREFETCH
}


DI void attn_item(const Params& p, const int wid, int layer, int b, int head, int qrow0, int nkeys, char* lds) {
  bf16* Ks = (bf16*)lds;
  bf16* Vs = Ks + 64 * 136;
  bf16* Qa = (bf16*)(p.ws + OFF_QA);
  const bf16* Ka = (const bf16*)(p.ws + OFF_KA);
  const bf16* Vt = (const bf16*)(p.ws + OFF_VT) + (size_t)(b * 4 + head) * 128 * KEYS;
  const int tid = tid_fresh(p, wid), lane = tid & 63, wave = tid >> 6, l31 = lane & 31, lh = lane >> 5;

  bf16* Qs = Vs + 128 * 68;
#pragma unroll
  for (int i = 0; i < 8; ++i) {
    const int ch = tid + 256 * i;
    *(uint4*)(Qs + (ch >> 4) * 136 + (ch & 15) * 8) = *(const uint4*)(Qa + (size_t)(qrow0 + (ch >> 4)) * 512 + head * 128 + (ch & 15) * 8);
  }
  const bf16* qsw = Qs + (wave * 32 + l31) * 136 + lh * 8;
  f32x16 O[2][4];
#pragma unroll
  for (int c = 0; c < 2; ++c)
#pragma unroll
    for (int vt = 0; vt < 4; ++vt)
#pragma unroll
      for (int i = 0; i < 16; ++i) O[c][vt][i] = 0.f;
  float mrun[2] = {-1e30f, -1e30f}, lrun[2] = {0.f, 0.f};

  const int lkey = tid >> 2, lkq = (tid & 3) * 32, lvr = tid >> 1, lvh = (tid & 1) * 32;
#define KROW(key) ((key) < 256 ? NL + b * 256 + (key) : b * 8192 + (key) - 256)
#define KVLOAD(k0_)                                                                                  \
  {                                                                                                  \
    const uint4* kp_ = (const uint4*)(Ka + (size_t)KROW((k0_) + lkey) * 512 + head * 128 + lkq);      \
    rk0 = kp_[0]; rk1 = kp_[1]; rk2 = kp_[2]; rk3 = kp_[3];                                          \
    const uint4* vp_ = (const uint4*)(Vt + (size_t)lvr * KEYS + (k0_) + lvh);                        \
    rv0 = vp_[0]; rv1 = vp_[1]; rv2 = vp_[2]; rv3 = vp_[3];                                          \
  }
#define VST2(dst_, val) { (dst_)[0] = make_uint2((val).x, (val).y); (dst_)[1] = make_uint2((val).z, (val).w); }
  uint4 rk0, rk1, rk2, rk3, rv0, rv1, rv2, rv3;
  KVLOAD(0);
#pragma unroll 1
  for (int k0 = 0; k0 < nkeys; k0 += 64) {
    {
      uint4* kd = (uint4*)(Ks + lkey * 136 + lkq);
      kd[0] = rk0; kd[1] = rk1; kd[2] = rk2; kd[3] = rk3;
      uint2* vd = (uint2*)(Vs + lvr * 68 + lvh);
      VST2(vd, rv0); VST2(vd + 2, rv1); VST2(vd + 4, rv2); VST2(vd + 6, rv3);
    }
    __syncthreads();
    if (k0 + 64 < nkeys) KVLOAD(k0 + 64);
#pragma unroll
    for (int c = 0; c < 2; ++c) {
#pragma unroll
      for (int mt = 0; mt < 2; ++mt) {
        f32x16 sv;
#pragma unroll
        for (int i = 0; i < 16; ++i) sv[i] = 0.f;
#pragma unroll
        for (int ks = 0; ks < 4; ++ks) {
          const bf16x8 qf = *(const bf16x8*)(qsw + c * 64 + ks * 16);
          const bf16x8 kf = *(const bf16x8*)(Ks + (mt * 32 + l31) * 136 + c * 64 + ks * 16 + lh * 8);
          sv = MFMA32(kf, qf, sv);
        }
        __builtin_amdgcn_sched_barrier(0);
        const bf16* vpb = Vs + l31 * 68 + mt * 32 + 4 * lh;
#define VLD_(vt, st) ({ const bf16* vp_ = vpb + (vt) * 32 * 68 + 16 * (st); const uint2 lo_ = *(const uint2*)vp_, hi_ = *(const uint2*)(vp_ + 8); \
                        __builtin_bit_cast(bf16x8, make_uint4(lo_.x, lo_.y, hi_.x, hi_.y)); })
        bf16x8 v0, v1, v2, v3;
        float mx = fmaxf(sv[0], sv[1]);
#pragma unroll
        for (int i = 2; i < 16; i += 2) mx = max3f(mx, sv[i], sv[i + 1]);
        mx = xhalf_max(mx);
        if (__any(mx - mrun[c] > 8.0f)) {
          const float mnew = fmaxf(mrun[c], mx);
          const float alpha = __builtin_amdgcn_exp2f(mrun[c] - mnew);
          mrun[c] = mnew;
          lrun[c] *= alpha;
#pragma unroll
          for (int vt = 0; vt < 4; ++vt)
#pragma unroll
            for (int i = 0; i < 16; ++i) O[c][vt][i] *= alpha;
        }
        float psum = 0.f;
#pragma unroll
        for (int i = 0; i < 16; ++i) {
          float pv = __builtin_amdgcn_exp2f(sv[i] - mrun[c]);
          sv[i] = pv;
          psum += pv;
        }
        lrun[c] += psum;
        v0 = VLD_(0, 0); v1 = VLD_(1, 0); v2 = VLD_(2, 0); v3 = VLD_(3, 0);
        __builtin_amdgcn_sched_barrier(0);
        {
          const bf16x8 pf = pack8(sv, 0);
          O[c][0] = MFMA32(v0, pf, O[c][0]); O[c][1] = MFMA32(v1, pf, O[c][1]);
          O[c][2] = MFMA32(v2, pf, O[c][2]); O[c][3] = MFMA32(v3, pf, O[c][3]);
          v0 = VLD_(0, 1); v1 = VLD_(1, 1); v2 = VLD_(2, 1); v3 = VLD_(3, 1);
        }
        __builtin_amdgcn_sched_barrier(0);
        {
          const bf16x8 pf = pack8(sv, 1);
          O[c][0] = MFMA32(v0, pf, O[c][0]); O[c][1] = MFMA32(v1, pf, O[c][1]);
          O[c][2] = MFMA32(v2, pf, O[c][2]); O[c][3] = MFMA32(v3, pf, O[c][3]);
        }
        __builtin_amdgcn_sched_barrier(0);
#undef VLD_
      }
    }
    __syncthreads();
  }
  const float lam = ((const float*)(p.ws + OFF_MISC))[layer];
  const float lam_init = layer == 0 ? 0.2f : 0.8f - 0.6f * 0.7408182206817179f;
  const float l1 = lrun[0] + __shfl_xor(lrun[0], 32);
  const float l2 = lrun[1] + __shfl_xor(lrun[1], 32);
  const float i1 = 1.f / l1, i2 = lam / l2;
  float ss = 0.f;
#pragma unroll
  for (int vt = 0; vt < 4; ++vt)
#pragma unroll
    for (int i = 0; i < 16; ++i) {
      float o = O[0][vt][i] * i1 - O[1][vt][i] * i2;
      O[0][vt][i] = o;
      ss += o * o;
    }
  ss += __shfl_xor(ss, 32);
  const float rstd = rsqrtf(ss * (1.f / 128.f) + EPS) * (1.f - lam_init);
  const float* nw = p.da_norm_w + layer * 128;
  bf16* orow = Qa + (size_t)(qrow0 + wave * 32 + l31) * 512 + head * 128;
#pragma unroll
  for (int vt = 0; vt < 4; ++vt)
#pragma unroll
    for (int g = 0; g < 4; ++g) {
      const int v0 = vt * 32 + 8 * g + 4 * lh;
      float4 w4 = *(const float4*)(nw + v0);
      uint2 pk;
      pk.x = pack2(O[0][vt][4 * g] * rstd * w4.x, O[0][vt][4 * g + 1] * rstd * w4.y);
      pk.y = pack2(O[0][vt][4 * g + 2] * rstd * w4.z, O[0][vt][4 * g + 3] * rstd * w4.w);
      *(uint2*)(orow + v0) = pk;
    }
}

DI void phase_mixers(const Params& p, const int wid, int layer, char* lds) {
  __shared__ int s_item;
  const int x = blockIdx.x & 7;
  unsigned* counter = (unsigned*)(p.ws + OFF_MISC + 64) + layer * 8 + x;
  const int total = layer == 0 ? 32 + 256 + 8 : 32 + 256;
  for (;;) {
    if (tid_fresh(p, wid) == 0) s_item = (int)atomicAdd(counter, 1u);
    __syncthreads();
    const int li = s_item;
    __syncthreads();
    if (li >= total) break;
    if (li < 32) {
      const int sid = li * 8 + x;
      if (sid < 128) cscan_item<true>(p, wid, layer, sid, lds);
      else cscan_item<false>(p, wid, layer, sid - 128, lds);
    } else if (li < 288) {
      const int a = li - 32;
      const int bh = x + 8 * (a >> 6), qb = a & 63;
      attn_item(p, wid, layer, bh >> 2, bh & 3, (bh >> 2) * 8192 + qb * 128, KEYS, lds);
    } else {
      const int c = x * 8 + (li - 288);
      const int bh = c >> 1, qb = c & 1;
      attn_item(p, wid, layer, bh >> 2, bh & 3, NL + (bh >> 2) * 256 + qb * 128, 256, lds);
    }
  }
}

DI void phase_z(const Params& p, const int wid, int layer, int M, char* lds) {
  const bf16* h = (const bf16*)(p.ws + OFF_H);
  const bf16* W2 = (const bf16*)(p.ws + OFF_W + (size_t)layer * LW + SZ_W1);
  bf16* Z = (bf16*)(p.ws + OFF_Z);
  const int tidf = tid_fresh(p, wid); const int lane = tidf & 63, wave = tidf >> 6, wm = wave >> 1, wn = wave & 1, l31 = lane & 31, lh = lane >> 5;
  constexpr int NTN = N2 / 128;
  int mt_, nt_;
  for (int it = 0; xcd_tile(it, M / 256, NTN, 12, mt_, nt_); ++it) {
    const int m0 = mt_ * 256, n0 = nt_ * 128;
    f32x16 acc[4][2];
    zero_acc<4, 2>(acc);
    gemm_main256<true>(h + (size_t)m0 * 1024, 1024, W2 + (size_t)n0 * 1024, 1024, 1024, acc, lds, tidf);
#pragma unroll
    for (int tm = 0; tm < 4; ++tm)
#pragma unroll
      for (int tn = 0; tn < 2; ++tn)
        store_rows_bf16(Z + (size_t)(m0 + wm * 128 + tm * 32 + l31) * 1536 + n0 + wn * 64 + tn * 32, acc[tm][tn], lh);
  }
}

DI void phase_post(const Params& p, const int wid, int layer, int M) {
  const int tidf = tid_fresh(p, wid); const int lane = tidf & 63, wave = tidf >> 6;
  bf16* Z = (bf16*)(p.ws + OFF_Z);
  const bf16* oda = (const bf16*)(p.ws + OFF_QA);
  const bf16* ysf = (const bf16*)(p.ws + OFF_YSF);
  const bf16* ysb = (const bf16*)(p.ws + OFF_YSB);
  const bf16* ygf = (const bf16*)(p.ws + OFF_YGF);
  const bf16* ygb = (const bf16*)(p.ws + OFF_YGB);
  const float* snw = p.ssm_norm_w + layer * 512;
  const float* gnw = p.gla_norm_w + layer * 128;
  const int c0 = lane * 8;
  for (int row = blockIdx.x * 4 + wave; row < M; row += gridDim.x * 4) {
    bf16* zr = Z + (size_t)row * 1536;
    {
      uint4 o = *(const uint4*)(oda + (size_t)row * 512 + c0);
      uint4 z = *(const uint4*)(zr + c0);
      const uint32_t ou[4] = {o.x, o.y, o.z, o.w}, zu[4] = {z.x, z.y, z.z, z.w};
      uint32_t r[4];
#pragma unroll
      for (int q = 0; q < 4; ++q) r[q] = pack2(blo(ou[q]) * siluf(blo(zu[q])), bhi(ou[q]) * siluf(bhi(zu[q])));
      *(uint4*)(zr + c0) = make_uint4(r[0], r[1], r[2], r[3]);
    }
    {
      uint4 yf = *(const uint4*)(ysf + (size_t)row * 512 + c0), yb = *(const uint4*)(ysb + (size_t)row * 512 + c0);
      uint4 z = *(const uint4*)(zr + 512 + c0);
      const uint32_t fu[4] = {yf.x, yf.y, yf.z, yf.w}, bu[4] = {yb.x, yb.y, yb.z, yb.w}, zu[4] = {z.x, z.y, z.z, z.w};
      float y[8];
      float ss = 0.f;
#pragma unroll
      for (int q = 0; q < 4; ++q) {
        y[2 * q] = (blo(fu[q]) + blo(bu[q])) * siluf(blo(zu[q]));
        y[2 * q + 1] = (bhi(fu[q]) + bhi(bu[q])) * siluf(bhi(zu[q]));
        ss += y[2 * q] * y[2 * q] + y[2 * q + 1] * y[2 * q + 1];
      }
#pragma unroll
      for (int m = 16; m >= 1; m >>= 1) ss += __shfl_xor(ss, m);
      const float rstd = rsqrtf(ss * (1.f / 256.f) + EPS);
      float4 w0 = *(const float4*)(snw + c0), w1 = *(const float4*)(snw + c0 + 4);
      uint32_t r[4];
      r[0] = pack2(y[0] * rstd * w0.x, y[1] * rstd * w0.y); r[1] = pack2(y[2] * rstd * w0.z, y[3] * rstd * w0.w);
      r[2] = pack2(y[4] * rstd * w1.x, y[5] * rstd * w1.y); r[3] = pack2(y[6] * rstd * w1.z, y[7] * rstd * w1.w);
      *(uint4*)(zr + 512 + c0) = make_uint4(r[0], r[1], r[2], r[3]);
    }
    {
      uint4 yf = *(const uint4*)(ygf + (size_t)row * 512 + c0), yb = *(const uint4*)(ygb + (size_t)row * 512 + c0);
      uint4 z = *(const uint4*)(zr + 1024 + c0);
      const uint32_t fu[4] = {yf.x, yf.y, yf.z, yf.w}, bu[4] = {yb.x, yb.y, yb.z, yb.w}, zu[4] = {z.x, z.y, z.z, z.w};
      float y[8];
      float ss = 0.f;
#pragma unroll
      for (int q = 0; q < 4; ++q) {
        y[2 * q] = blo(fu[q]) + blo(bu[q]);
        y[2 * q + 1] = bhi(fu[q]) + bhi(bu[q]);
        ss += y[2 * q] * y[2 * q] + y[2 * q + 1] * y[2 * q + 1];
      }
#pragma unroll
      for (int m = 8; m >= 1; m >>= 1) ss += __shfl_xor(ss, m);
      const float rstd = rsqrtf(ss * (1.f / 128.f) + EPS);
      const int cw = c0 & 127;
      float4 w0 = *(const float4*)(gnw + cw), w1 = *(const float4*)(gnw + cw + 4);
      uint32_t r[4];
      r[0] = pack2(y[0] * rstd * w0.x * siluf(blo(zu[0])), y[1] * rstd * w0.y * siluf(bhi(zu[0])));
      r[1] = pack2(y[2] * rstd * w0.z * siluf(blo(zu[1])), y[3] * rstd * w0.w * siluf(bhi(zu[1])));
      r[2] = pack2(y[4] * rstd * w1.x * siluf(blo(zu[2])), y[5] * rstd * w1.y * siluf(bhi(zu[2])));
      r[3] = pack2(y[6] * rstd * w1.z * siluf(blo(zu[3])), y[7] * rstd * w1.w * siluf(bhi(zu[3])));
      *(uint4*)(zr + 1024 + c0) = make_uint4(r[0], r[1], r[2], r[3]);
    }
  }
}

DI void phase_merge(const Params& p, const int wid, int layer, int M, char* lds) {
  const bf16* h = (const bf16*)(p.ws + OFF_H);
  const bf16* osg = (const bf16*)(p.ws + OFF_Z);
  const char* wb = p.ws + OFF_W + (size_t)layer * LW;
  const bf16* W3 = (const bf16*)(wb + SZ_W1 + SZ_W2);
  const bf16* Wout = (const bf16*)(wb + SZ_W1 + SZ_W2 + SZ_W3);
  bf16* U = (bf16*)(p.ws + OFF_U);
  const int tidf = tid_fresh(p, wid); const int lane = tidf & 63, wave = tidf >> 6, wm = wave >> 1, wn = wave & 1, l31 = lane & 31, lh = lane >> 5;
  constexpr int NTN = 1024 / 128;
  int mt_, nt_;
  for (int it = 0; xcd_tile(it, M / 128, NTN, 8, mt_, nt_); ++it) {
    const int m0 = mt_ * 128, n0 = nt_ * 128;
    f32x16 u[2][2];
    zero_acc<2, 2>(u);
#pragma unroll 1
    for (int br = 0; br < 3; ++br) {
      uint32_t* sgl = (uint32_t*)(lds + 36864) + tidf;
      {
        f32x16 g[2][2];
        zero_acc<2, 2>(g);
        gemm_main128<true>(h + (size_t)m0 * 1024, 1024, W3 + (size_t)(br * 1024 + n0) * 1024, 1024, 1024, g, lds, tidf);
#pragma unroll
        for (int tm = 0; tm < 2; ++tm)
#pragma unroll
          for (int tn = 0; tn < 2; ++tn)
#pragma unroll
            for (int q = 0; q < 8; ++q) sgl[((tm * 2 + tn) * 8 + q) * 256] = pack2(sigmf(g[tm][tn][2 * q]), sigmf(g[tm][tn][2 * q + 1]));
      }
      f32x16 t[2][2];
      zero_acc<2, 2>(t);
      gemm_main128<true>(osg + (size_t)m0 * 1536 + br * 512, 1536, Wout + (size_t)br * 1024 * 512 + (size_t)n0 * 512, 512, 512, t, lds, tidf);
#pragma unroll
      for (int tm = 0; tm < 2; ++tm)
#pragma unroll
        for (int tn = 0; tn < 2; ++tn)
#pragma unroll
          for (int q = 0; q < 8; ++q) {
            const uint32_t sgv = sgl[((tm * 2 + tn) * 8 + q) * 256];
            u[tm][tn][2 * q] = fmaf(blo(sgv), t[tm][tn][2 * q], u[tm][tn][2 * q]);
            u[tm][tn][2 * q + 1] = fmaf(bhi(sgv), t[tm][tn][2 * q + 1], u[tm][tn][2 * q + 1]);
          }
    }
#pragma unroll
    for (int tm = 0; tm < 2; ++tm)
#pragma unroll
      for (int tn = 0; tn < 2; ++tn)
        store_rows_bf16(U + (size_t)(m0 + wm * 64 + tm * 32 + l31) * 1024 + n0 + wn * 64 + tn * 32, u[tm][tn], lh);
  }
}

DI void phase_out(const Params& p, const int wid, int layer, int M, const float* xl, const float* xc, float* ol, float* oc, char* lds) {
  const bf16* U = (const bf16*)(p.ws + OFF_U);
  const bf16* Wo = (const bf16*)(p.ws + OFF_W + (size_t)layer * LW + SZ_W1 + SZ_W2 + SZ_W3 + 3 * SZ_WOUT);
  const float* modv = (const float*)(p.ws + OFF_MOD) + (size_t)layer * 9 * 3072;
  const int tidf = tid_fresh(p, wid); const int lane = tidf & 63, wave = tidf >> 6, wm = wave >> 1, wn = wave & 1, l31 = lane & 31, lh = lane >> 5;
  constexpr int NTN = 1024 / 128;
  int mt_, nt_;
  for (int it = 0; xcd_tile(it, M / 256, NTN, 8, mt_, nt_); ++it) {
    const int m0 = mt_ * 256, n0 = nt_ * 128;
    f32x16 acc[4][2];
    zero_acc<4, 2>(acc);
    gemm_main256<true>(U + (size_t)m0 * 1024, 1024, Wo + (size_t)n0 * 1024, 1024, 1024, acc, lds, tidf);
    const bool lat = m0 < NL;
    const int j = lat ? (m0 >> 13) : 8;
    const float* gate = modv + j * 3072 + 2048;
    const float* src = lat ? xl + (size_t)m0 * 1024 : xc + (size_t)(m0 - NL) * 1024;
    float* dst = lat ? ol + (size_t)m0 * 1024 : oc + (size_t)(m0 - NL) * 1024;
    uint32_t eoff = (uint32_t)((wm * 128 + l31) * 1024 + n0 + wn * 64 + 4 * lh);
    asm volatile("" : "+v"(eoff));
    const float* sp = src + eoff;
    float* dp = dst + eoff;
    const float* gp = gate + n0 + wn * 64 + 4 * lh;
#pragma unroll
    for (int tm = 0; tm < 4; ++tm)
#pragma unroll
      for (int tn = 0; tn < 2; ++tn) {
#pragma unroll
        for (int g = 0; g < 4; ++g) {
          const int off = tm * 32 * 1024 + tn * 32 + 8 * g;
          const float4 gt = *(const float4*)(gp + tn * 32 + 8 * g);
          const float4 xo = *(const float4*)(sp + off);
          *(float4*)(dp + off) = make_float4(xo.x + gt.x * acc[tm][tn][4 * g], xo.y + gt.y * acc[tm][tn][4 * g + 1],
                                             xo.z + gt.z * acc[tm][tn][4 * g + 2], xo.w + gt.w * acc[tm][tn][4 * g + 3]);
        }
        __builtin_amdgcn_sched_barrier(0);
      }
  }
}

DI void phase_final(const Params& p, const int wid) {
  const int tidf = tid_fresh(p, wid); const int lane = tidf & 63, wave = tidf >> 6;
  const int stride = gridDim.x * 4;
  for (int row0 = blockIdx.x * 4 + wave; row0 < NL; row0 += 2 * stride) {
    float4 v[2][4];
    float ss[2] = {0.f, 0.f};
#pragma unroll
    for (int r = 0; r < 2; ++r) {
      int row = row0 + r * stride;
      if (row >= NL) row = row0;
      const float* src = p.out + (size_t)row * 1024;
#pragma unroll
      for (int i = 0; i < 4; ++i) v[r][i] = *(const float4*)(src + (i * 64 + lane) * 4);
    }
#pragma unroll
    for (int r = 0; r < 2; ++r) {
#pragma unroll
      for (int i = 0; i < 4; ++i) ss[r] += v[r][i].x * v[r][i].x + v[r][i].y * v[r][i].y + v[r][i].z * v[r][i].z + v[r][i].w * v[r][i].w;
      ss[r] = wave_sum(ss[r]);
    }
#pragma unroll
    for (int r = 0; r < 2; ++r) {
      const int row = row0 + r * stride;
      if (row < NL) {
        float* dst = p.out + (size_t)row * 1024;
        const float rstd = rsqrtf(ss[r] * (1.f / 1024.f) + EPS);
#pragma unroll
        for (int i = 0; i < 4; ++i) {
          const int c = (i * 64 + lane) * 4;
          float4 w4 = *(const float4*)(p.final_norm_w + c);
          *(float4*)(dst + c) = make_float4(v[r][i].x * rstd * w4.x, v[r][i].y * rstd * w4.y, v[r][i].z * rstd * w4.z, v[r][i].w * rstd * w4.w);
        }
      }
    }
  }
}

__global__ void __launch_bounds__(256, 2) hybrid_trunk_mega(Params p) {
  cg::grid_group grid = cg::this_grid();
  const int wid = __builtin_amdgcn_readfirstlane((int)(threadIdx.x >> 6));
  __shared__ __attribute__((aligned(16))) char lds[LDS_BYTES];
  __shared__ uint4 xb_words;
  if (tid_fresh(p, wid) == 0) xb_words = make_uint4(0u, 0u, 0u, 0u);
  phase0(p, wid, lds);
  grid.sync();
  if (tid_fresh(p, wid) == 0) (void)xb_add(&((unsigned*)(p.ws + OFF_BAR))[XB_XCNT(xb_xcc_id())], 1u);
  float* ctx1 = (float*)(p.ws + OFF_CTX1);
#pragma unroll 1
  for (int layer = 0; layer < 2; ++layer) {
    const float* xl = layer == 0 ? p.x : p.out;
    const float* xc = layer == 0 ? p.ctx : ctx1;
    const int M = layer == 0 ? NT : NL;
    phase_h(p, wid, layer, xl, xc, NT);
    xcd_barrier(p, wid, (volatile LAS unsigned*)&xb_words);
    phase_p1(p, wid, layer, NT, lds);
    xcd_barrier(p, wid, (volatile LAS unsigned*)&xb_words);
#ifdef DUP_GEMM
    phase_p1(p, wid, layer, NT, lds);
    xcd_barrier(p, wid, (volatile LAS unsigned*)&xb_words);
#endif
    phase_conv(p, wid, layer);
    xcd_barrier(p, wid, (volatile LAS unsigned*)&xb_words);
#ifdef PROBE_SCAN
    for (int it = blockIdx.x; it < 192; it += gridDim.x) { if (it < 64) scan_item<true>(p, wid, layer, it, lds); else scan_item<false>(p, wid, layer, it - 64, lds); }
    xcd_barrier(p, wid, (volatile LAS unsigned*)&xb_words);
#endif
    phase_mixers(p, wid, layer, lds);
    xcd_barrier(p, wid, (volatile LAS unsigned*)&xb_words);
    phase_z(p, wid, layer, M, lds);
    xcd_barrier(p, wid, (volatile LAS unsigned*)&xb_words);
#ifdef DUP_GEMM
    phase_z(p, wid, layer, M, lds);
    xcd_barrier(p, wid, (volatile LAS unsigned*)&xb_words);
#endif
    phase_post(p, wid, layer, M);
    xcd_barrier(p, wid, (volatile LAS unsigned*)&xb_words);
    phase_merge(p, wid, layer, M, lds);
    xcd_barrier(p, wid, (volatile LAS unsigned*)&xb_words);
#ifdef DUP_GEMM
    phase_merge(p, wid, layer, M, lds);
    xcd_barrier(p, wid, (volatile LAS unsigned*)&xb_words);
#endif
    phase_out(p, wid, layer, M, xl, xc, p.out, ctx1, lds);
    xcd_barrier(p, wid, (volatile LAS unsigned*)&xb_words);
  }
  phase_final(p, wid);
}

extern "C" void kernel_launch(void* const* d_in, const int* in_sizes, int n_in, void* d_out, int out_size, void* d_ws,
                              size_t ws_size, hipStream_t stream) {
  (void)in_sizes; (void)n_in; (void)out_size;
  static int grid_blocks = 0;
  if (!grid_blocks) {
    int dev = 0, cus = 0, per_cu = 0;
    hipGetDevice(&dev);
    hipDeviceGetAttribute(&cus, hipDeviceAttributeMultiprocessorCount, dev);
    hipOccupancyMaxActiveBlocksPerMultiprocessor(&per_cu, hybrid_trunk_mega, 256, 0);
    (void)per_cu;
    grid_blocks = cus * 2;
  }
  if (ws_size < WS_TOTAL) { fprintf(stderr, "workspace too small: %zu < %zu\n", ws_size, (size_t)WS_TOTAL); return; }
  Params p{};
  const float** f = (const float**)&p;
  for (int i = 0; i < 24; ++i) f[i] = (const float*)d_in[i];
  p.wid = 0; p.pad_ = 0;
  p.out = (float*)d_out;
  p.ws = (char*)d_ws;
  void* args[] = {&p};
  hipError_t e = hipLaunchCooperativeKernel((const void*)hybrid_trunk_mega, dim3(grid_blocks), dim3(256), args, 0, stream);
  if (e != hipSuccess && (grid_blocks & 15) == 0) {
    (void)hipGetLastError();
    grid_blocks >>= 1;
    e = hipLaunchCooperativeKernel((const void*)hybrid_trunk_mega, dim3(grid_blocks), dim3(256), args, 0, stream);
  }
  if (e != hipSuccess) fprintf(stderr, "cooperative launch failed: %s (grid %d)\n", hipGetErrorString(e), grid_blocks);
}
```

```cpp
#include <hip/hip_runtime.h>
#include <hip/hip_cooperative_groups.h>
#include <stdint.h>
#include <stdio.h>
namespace cg = cooperative_groups;

typedef unsigned short bf16;
using bf16x8 = __attribute__((ext_vector_type(8))) short;
using f32x16 = __attribute__((ext_vector_type(16))) float;
using u32x8 = __attribute__((ext_vector_type(8))) unsigned int;
#define DI __device__ __forceinline__
#define MFMA32(a, b, c) __builtin_amdgcn_mfma_f32_32x32x16_bf16((a), (b), (c), 0, 0, 0)
#define MM(a_, b_, c_) (SWAP ? MFMA32((b_), (a_), (c_)) : MFMA32((a_), (b_), (c_)))

typedef __bf16 hbf16x2 __attribute__((ext_vector_type(2)));
typedef float f32x2 __attribute__((ext_vector_type(2)));
DI uint32_t pack2(float a, float b) { f32x2 v = {a, b}; return __builtin_bit_cast(uint32_t, __builtin_convertvector(v, hbf16x2)); }
DI bf16 f2b(float x) { return (bf16)(pack2(x, x) & 0xffffu); }
DI float blo(uint32_t u) { return __uint_as_float(u << 16); }
DI float bhi(uint32_t u) { return __uint_as_float(u & 0xffff0000u); }
DI float max3f(float a, float b, float c) { float r; asm("v_max3_f32 %0, %1, %2, %3" : "=v"(r) : "v"(a), "v"(b), "v"(c)); return r; }
DI float xhalf_max(float x) {
  const unsigned u = __float_as_uint(x);
  const auto r = __builtin_amdgcn_permlane32_swap(u, u, false, false);
  float m; asm("v_max_f32 %0, %1, %2" : "=v"(m) : "v"(__uint_as_float(r[0])), "v"(__uint_as_float(r[1]))); return m;
}
DI float siluf(float x) { return x / (1.f + __expf(-x)); }
DI float sigmf(float x) { return 1.f / (1.f + __expf(-x)); }

constexpr int NB = 8, SEQ = 8192, CTX = 256, DM = 1024;
constexpr int NL = NB * SEQ;
constexpr int NC = NB * CTX;
constexpr int NT = NL + NC;
constexpr int KEYS = CTX + SEQ;
constexpr int INW = 7984;
constexpr int N1 = 3456, N2 = 1536, N3 = 3072;
constexpr float EPS = 1e-6f;
constexpr float QSCALE = 0.125f * 1.4426950408889634f;

constexpr size_t al256(size_t x) { return (x + 255) & ~(size_t)255; }
constexpr size_t SZ_W1 = (size_t)N1 * 1024 * 2, SZ_W2 = (size_t)N2 * 1024 * 2, SZ_W3 = (size_t)N3 * 1024 * 2;
constexpr size_t SZ_WOUT = (size_t)1024 * 512 * 2, SZ_WO = (size_t)1024 * 1024 * 2;
constexpr size_t LW = SZ_W1 + SZ_W2 + SZ_W3 + 3 * SZ_WOUT + SZ_WO;
constexpr size_t OFF_W = 0;
constexpr size_t OFF_MOD = OFF_W + 2 * LW;
constexpr size_t OFF_ROPE = OFF_MOD + al256((size_t)2 * 9 * 3072 * 4);
constexpr size_t OFF_MISC = OFF_ROPE + (size_t)128 * 16 * 2 * 4;
constexpr size_t OFF_H = OFF_MISC + 256;
constexpr size_t OFF_QA = OFF_H + (size_t)NT * 1024 * 2;
constexpr size_t OFF_KA = OFF_QA + (size_t)NT * 512 * 2;
constexpr size_t OFF_VT = OFF_KA + (size_t)NT * 512 * 2;
constexpr size_t OFF_XBC = OFF_VT + (size_t)NT * 512 * 2;
constexpr size_t OFF_XBC2 = OFF_XBC + (size_t)NT * 768 * 2;
constexpr size_t OFF_GQ = OFF_XBC2 + (size_t)NT * 768 * 2;
constexpr size_t OFF_GK = OFF_GQ + (size_t)NT * 256 * 2;
constexpr size_t OFF_GV = OFF_GK + (size_t)NT * 256 * 2;
constexpr size_t OFF_DTLR = OFF_GV + (size_t)NT * 512 * 2;
constexpr size_t OFF_YSF = OFF_DTLR + (size_t)NT * 48 * 4;
constexpr size_t OFF_YSB = OFF_YSF + (size_t)NT * 512 * 2;
constexpr size_t OFF_YGF = OFF_YSB + (size_t)NT * 512 * 2;
constexpr size_t OFF_YGB = OFF_YGF + (size_t)NT * 512 * 2;
constexpr size_t OFF_CTX1 = OFF_YGB + (size_t)NT * 512 * 2;
constexpr size_t OFF_BAR = OFF_CTX1 + (size_t)NC * 1024 * 4;
constexpr size_t WS_TOTAL = OFF_BAR + 16384;
constexpr size_t OFF_Z = OFF_KA;
constexpr size_t OFF_U = OFF_GQ;
static_assert(WS_TOTAL <= ((size_t)1 << 30), "workspace too large");
static_assert((size_t)NT * 1536 * 2 <= OFF_XBC2 - OFF_KA, "Z overlay");
static_assert((size_t)NT * 1024 * 2 <= OFF_DTLR - OFF_GQ, "U overlay");

struct Params {
  const float *x, *c, *ctx, *c_ctx, *w_mod, *b_mod, *norm_w, *w_in, *da_lambda, *da_norm_w, *w_out_da;
  const float *conv_w, *conv_b, *dt_bias, *a_log, *ssm_d, *ssm_norm_w, *w_out_ssm;
  const float *gla_w_gate, *gla_b_gate, *gla_norm_w, *w_out_gla, *w_o, *final_norm_w;
  float* out;
  char* ws;
  int wid, pad_;
};
DI int tid_fresh(const Params& p, const int wid) {
  int t = wid * 64 + (int)__builtin_amdgcn_mbcnt_hi(~0u, __builtin_amdgcn_mbcnt_lo(~0u, 0u));
  asm volatile("" : "+v"(t));
  return t;
}

constexpr int LDS_BYTES = 70 * 1024;

DI int map_w1(int n) {
  if (n < 1536) return n;
  if (n < 2048) return 2048 + (n - 1536);
  if (n < 2304) return 3072 + (n - 2048);
  if (n < 3328) return 3344 + (n - 2304);
  if (n < 3344) return 3328 + (n - 3328);
  if (n < 3376) return 4880 + (n - 3344);
  return -1;
}
DI int map_w2(int n) {
  if (n < 512) return 1536 + n;
  if (n < 1024) return 2560 + (n - 512);
  return 4368 + (n - 1024);
}

DI void tr_tile(const Params& p, const int wid, const float* __restrict__ src, int ldsrc, bf16* __restrict__ dst, int K, int n0, int k0, int mapk, float* tile) {
  const int tid = tid_fresh(p, wid), tx = tid & 63, ty = tid >> 6;
  const int n = n0 + tx;
  int col = n;
  if (mapk == 1) col = map_w1(n); else if (mapk == 2) col = map_w2(n); else if (mapk == 3) col = 4912 + n;
#pragma unroll
  for (int i = 0; i < 16; ++i) {
    int kk = ty + 4 * i;
    tile[kk * 65 + tx] = (col >= 0) ? src[(size_t)(k0 + kk) * ldsrc + col] : 0.f;
  }
  __syncthreads();
#pragma unroll
  for (int i = 0; i < 16; ++i) {
    int nn = ty + 4 * i;
    dst[(size_t)(n0 + nn) * K + k0 + tx] = f2b(tile[tx * 65 + nn]);
  }
  __syncthreads();
}

#define XB_TMO      128
#define XB_XCNT(j)  (256  + 64 * (j))
#define XB_XSUB(j)  (1280 + 64 * (j))
#define XB_XGEN(j)  (2304 + 64 * (j))
#define XB_TOP      3328
#define XB_TOPGEN   3392
#define XCD_BAR_WORDS 3456
#define XB_SPIN_CAP (1u << 18)
#define LAS __attribute__((address_space(3)))
DI unsigned xb_ld(unsigned* q) { return __hip_atomic_load(q, __ATOMIC_RELAXED, __HIP_MEMORY_SCOPE_AGENT); }
DI unsigned xb_add(unsigned* q, unsigned v) { return __hip_atomic_fetch_add(q, v, __ATOMIC_RELAXED, __HIP_MEMORY_SCOPE_AGENT); }
DI unsigned xb_xcc_id() { return (unsigned)__builtin_amdgcn_s_getreg((3 << 11) | 20) & 0xFu; }
#define XB_SPIN(cond, bar) do { unsigned _sp = 0; while (cond) { __builtin_amdgcn_s_sleep(1); \
    if ((++_sp & 255u) == 0u) { if (xb_ld(&(bar)[XB_TMO])) break; if (_sp > XB_SPIN_CAP) { atomicAdd(&(bar)[XB_TMO], 1u); break; } } } } while (0)
struct XcdBarrier { unsigned* bar; unsigned x; volatile LAS unsigned* st; };
DI XcdBarrier xcd_barrier_post(unsigned* bar, volatile LAS unsigned* st, bool t0) {
  XcdBarrier b; b.bar = bar; b.x = xb_xcc_id(); b.st = st;
  if (t0) (void)xb_add(&bar[XB_XCNT(b.x)], 1u);
  return b;
}
DI void xcd_barrier_complete(unsigned* bar, unsigned x, unsigned& nloc, unsigned& nx) {
  const unsigned G = gridDim.x * gridDim.y * gridDim.z;
  unsigned sum, cnt, mine, sp = 0u;
  for (;;) {
    sum = 0u; cnt = 0u; mine = 0u;
#pragma unroll
    for (unsigned j = 0; j < 16; ++j) { const unsigned c = xb_ld(&bar[XB_XCNT(j)]); sum += c; cnt += (c > 0u) ? 1u : 0u; mine = (j == x) ? c : mine; }
    if (sum == G) break;
    __builtin_amdgcn_s_sleep(1);
    if ((++sp & 255u) == 0u) { if (xb_ld(&bar[XB_TMO])) break; if (sp > XB_SPIN_CAP) { atomicAdd(&bar[XB_TMO], 1u); break; } }
  }
  nloc = mine > 0u ? mine : 1u; nx = cnt > 0u ? cnt : 1u;
}
DI void xcd_barrier(const Params& p, const int wid, volatile LAS unsigned* st) {
  asm volatile("s_waitcnt vmcnt(0)" ::: "memory");
  __syncthreads();
  if (tid_fresh(p, wid) == 0) {
    unsigned* bar = (unsigned*)(p.ws + OFF_BAR);
    const unsigned x = xb_xcc_id();
    __builtin_amdgcn_s_waitcnt(0);
    unsigned nloc = st[0], nx = st[1];
    if (nloc == 0u) { xcd_barrier_complete(bar, x, nloc, nx); st[0] = nloc; st[1] = nx; }
    const unsigned old = xb_add(&bar[XB_XSUB(x)], 1u);
    const unsigned gen = old / nloc;
    if (old + 1u == (gen + 1u) * nloc) {
      __builtin_amdgcn_fence(__ATOMIC_RELEASE, "agent");
      asm volatile("s_waitcnt vmcnt(0)" ::: "memory");
      const unsigned og = xb_add(&bar[XB_TOP], 1u);
      const unsigned tg = og / nx;
      if (og + 1u == (tg + 1u) * nx) xb_add(&bar[XB_TOPGEN], 1u);
      else XB_SPIN(xb_ld(&bar[XB_TOPGEN]) == tg, bar);
      __builtin_amdgcn_fence(__ATOMIC_ACQUIRE, "agent");
      xb_add(&bar[XB_XGEN(x)], 1u);
      asm volatile("s_waitcnt vmcnt(0)" ::: "memory");
    } else {
      XB_SPIN(xb_ld(&bar[XB_XGEN(x)]) == gen, bar);
      __builtin_amdgcn_fence(__ATOMIC_ACQUIRE, "agent");
      asm volatile("s_waitcnt vmcnt(0)" ::: "memory");
    }
  }
  __syncthreads();
}

constexpr int TR_PER_LAYER = 864 + 384 + 768 + 384 + 256;
constexpr int P0_ITEMS = 2 * TR_PER_LAYER + 96 + 1;

DI void phase0(const Params& p, const int wid, char* lds) {
  const int tid = tid_fresh(p, wid);
  float* fl = (float*)lds;
  if (blockIdx.x == 0) for (int i = tid; i < XCD_BAR_WORDS; i += 256) ((unsigned*)(p.ws + OFF_BAR))[i] = 0u;
  for (int item = blockIdx.x; item < P0_ITEMS; item += gridDim.x) {
    if (item < 2 * TR_PER_LAYER) {
      const int layer = item / TR_PER_LAYER;
      int j = item % TR_PER_LAYER;
      char* wb = p.ws + OFF_W + (size_t)layer * LW;
      const float* win = p.w_in + (size_t)layer * 1024 * INW;
      if (j < 864) {
        tr_tile(p, wid, win, INW, (bf16*)wb, 1024, (j >> 4) * 64, (j & 15) * 64, 1, fl);
      } else if (j < 1248) {
        j -= 864;
        tr_tile(p, wid, win, INW, (bf16*)(wb + SZ_W1), 1024, (j >> 4) * 64, (j & 15) * 64, 2, fl);
      } else if (j < 2016) {
        j -= 1248;
        tr_tile(p, wid, win, INW, (bf16*)(wb + SZ_W1 + SZ_W2), 1024, (j >> 4) * 64, (j & 15) * 64, 3, fl);
      } else if (j < 2400) {
        j -= 2016;
        const int br = j >> 7, r = j & 127;
        const float* src = (br == 0 ? p.w_out_da : br == 1 ? p.w_out_ssm : p.w_out_gla) + (size_t)layer * 512 * 1024;
        tr_tile(p, wid, src, 1024, (bf16*)(wb + SZ_W1 + SZ_W2 + SZ_W3 + (size_t)br * SZ_WOUT), 512, (r >> 3) * 64, (r & 7) * 64, 0, fl);
      } else {
        j -= 2400;
        tr_tile(p, wid, p.w_o + (size_t)layer * 1024 * 1024, 1024, (bf16*)(wb + SZ_W1 + SZ_W2 + SZ_W3 + 3 * SZ_WOUT), 1024,
                (j >> 4) * 64, (j & 15) * 64, 0, fl);
      }
    } else if (item < 2 * TR_PER_LAYER + 96) {
      const int m = item - 2 * TR_PER_LAYER;
      const int layer = m / 48, nc = (m % 48) * 64;
      float* sc = fl;
      float* red = fl + 9 * 1024;
      for (int idx = tid; idx < 9 * 1024; idx += 256) {
        int j = idx >> 10, k = idx & 1023;
        float v = j < 8 ? p.c[j * 1024 + k] : p.c_ctx[k];
        sc[idx] = v / (1.f + expf(-v));
      }
      __syncthreads();
      const int tx = tid & 63, q = tid >> 6;
      float acc[9];
#pragma unroll
      for (int j = 0; j < 9; ++j) acc[j] = 0.f;
      const float* wm = p.w_mod + (size_t)layer * 1024 * 3072 + nc + tx;
#pragma unroll 4
      for (int k = q * 256; k < q * 256 + 256; ++k) {
        float wv = wm[(size_t)k * 3072];
#pragma unroll
        for (int j = 0; j < 9; ++j) acc[j] = fmaf(sc[j * 1024 + k], wv, acc[j]);
      }
#pragma unroll
      for (int j = 0; j < 9; ++j) red[(q * 9 + j) * 64 + tx] = acc[j];
      __syncthreads();
      float* modv = (float*)(p.ws + OFF_MOD);
      for (int idx = tid; idx < 9 * 64; idx += 256) {
        int j = idx >> 6, t = idx & 63;
        float s = red[(0 * 9 + j) * 64 + t] + red[(1 * 9 + j) * 64 + t] + red[(2 * 9 + j) * 64 + t] + red[(3 * 9 + j) * 64 + t];
        modv[(size_t)(layer * 9 + j) * 3072 + nc + t] = s + p.b_mod[layer * 3072 + nc + t];
      }
      __syncthreads();
    } else {
      float* rope = (float*)(p.ws + OFF_ROPE);
      for (int idx = tid; idx < 2048; idx += 256) {
        int pos = idx >> 4, f = idx & 15;
        float inv = (float)exp(-(double)f / 16.0 * 9.210340371976184);
        float angf = (float)pos * inv;
        double a = (double)angf;
        double r = a - 6.283185307179586477 * rint(a * 0.15915494309189533577);
        double r2 = r * r;
        double ts = r, ss = r, tc = 1.0, cs = 1.0;
#pragma unroll 1
        for (int n = 1; n <= 12; ++n) {
          tc *= -r2 / (double)((2 * n - 1) * (2 * n));
          cs += tc;
          ts *= -r2 / (double)((2 * n) * (2 * n + 1));
          ss += ts;
        }
        rope[idx * 2] = (float)cs;
        rope[idx * 2 + 1] = (float)ss;
      }
      float* misc = (float*)(p.ws + OFF_MISC);
      if (tid < 2) {
        const float* lm = p.da_lambda + tid * 4 * 64;
        float s1 = 0.f, s2 = 0.f;
        for (int i = 0; i < 64; ++i) { s1 += lm[i] * lm[64 + i]; s2 += lm[128 + i] * lm[192 + i]; }
        float lam_init = 0.8f - 0.6f * expf(-0.3f * (float)tid);
        misc[tid] = expf(s1) - expf(s2) + lam_init;
      }
      if (tid < 16) ((unsigned*)(p.ws + OFF_MISC + 64))[tid] = 0u;
    }
  }
}

DI float wave_sum(float v) {
#pragma unroll
  for (int m = 32; m >= 1; m >>= 1) v += __shfl_xor(v, m);
  return v;
}

DI void phase_h(const Params& p, const int wid, int layer, const float* xl, const float* xc, int M) {
  const int tidf = tid_fresh(p, wid); const int lane = tidf & 63, wave = tidf >> 6;
  bf16* h = (bf16*)(p.ws + OFF_H);
  const float* modv = (const float*)(p.ws + OFF_MOD) + (size_t)layer * 9 * 3072;
  const float* nw = p.norm_w + layer * 1024;
  const int stride = gridDim.x * 4;
  for (int row0 = blockIdx.x * 4 + wave; row0 < M; row0 += 2 * stride) {
    float4 v[2][4];
    float ss[2] = {0.f, 0.f};
#pragma unroll
    for (int r = 0; r < 2; ++r) {
      int row = row0 + r * stride;
      if (row >= M) row = row0;
      const float* src = row < NL ? xl + (size_t)row * 1024 : xc + (size_t)(row - NL) * 1024;
#pragma unroll
      for (int i = 0; i < 4; ++i) v[r][i] = *(const float4*)(src + (i * 64 + lane) * 4);
    }
#pragma unroll
    for (int r = 0; r < 2; ++r) {
#pragma unroll
      for (int i = 0; i < 4; ++i) ss[r] += v[r][i].x * v[r][i].x + v[r][i].y * v[r][i].y + v[r][i].z * v[r][i].z + v[r][i].w * v[r][i].w;
      ss[r] = wave_sum(ss[r]);
    }
#pragma unroll
    for (int r = 0; r < 2; ++r) {
      const int row = row0 + r * stride;
      if (row < M) {
        const int j = row < NL ? (row >> 13) : 8;
        const float* shift = modv + j * 3072;
        const float* scale = shift + 1024;
        const float rstd = rsqrtf(ss[r] * (1.f / 1024.f) + EPS);
#pragma unroll
        for (int i = 0; i < 4; ++i) {
          const int c = (i * 64 + lane) * 4;
          float4 w4 = *(const float4*)(nw + c), sc4 = *(const float4*)(scale + c), sh4 = *(const float4*)(shift + c);
          float o0 = v[r][i].x * rstd * w4.x * (1.f + sc4.x) + sh4.x;
          float o1 = v[r][i].y * rstd * w4.y * (1.f + sc4.y) + sh4.y;
          float o2 = v[r][i].z * rstd * w4.z * (1.f + sc4.z) + sh4.z;
          float o3 = v[r][i].w * rstd * w4.w * (1.f + sc4.w) + sh4.w;
          uint2 pk; pk.x = pack2(o0, o1); pk.y = pack2(o2, o3);
          *(uint2*)(h + (size_t)row * 1024 + c) = pk;
        }
      }
    }
  }
}

template <bool SWAP>
DI void gemm_main128(const bf16* __restrict__ A, int lda, const bf16* __restrict__ Bt, int ldb, int K,
                     f32x16 (&acc)[2][2], char* lds, const int tid) {
  bf16* As = (bf16*)lds;
  bf16* Bs = As + 128 * 72;
  const int lane = tid & 63, wave = tid >> 6, wm = wave >> 1, wn = wave & 1;
  const int l31 = lane & 31, lh = lane >> 5;
  const uint32_t aoff = (uint32_t)(((tid >> 3) * lda + (tid & 7) * 8) * 2);
  const uint32_t boff = (uint32_t)(((tid >> 3) * ldb + (tid & 7) * 8) * 2);
  const uint32_t soff = (uint32_t)(((tid >> 3) * 72 + (tid & 7) * 8) * 2);
  const char* Ab = (const char*)A;
  const char* Bb = (const char*)Bt;
  char* Asb = (char*)As;
  char* Bsb = (char*)Bs;
  const size_t astep = (size_t)32 * lda * 2, bstep = (size_t)32 * ldb * 2;
  uint4 ra0, ra1, ra2, ra3, rb0, rb1, rb2, rb3;
#define ALD(i, kb) (*(const uint4*)(Ab + ((size_t)(i) * astep + (kb)) + aoff))
#define BLD(i, kb) (*(const uint4*)(Bb + ((size_t)(i) * bstep + (kb)) + boff))
#define LDALL(kb)                                                          \
  ra0 = ALD(0, kb); ra1 = ALD(1, kb); ra2 = ALD(2, kb); ra3 = ALD(3, kb);  \
  rb0 = BLD(0, kb); rb1 = BLD(1, kb); rb2 = BLD(2, kb); rb3 = BLD(3, kb);
#define SST(base, i, val) (*(uint4*)((base) + (i) * (32 * 72 * 2) + soff) = (val))
  LDALL((size_t)0)
#pragma unroll 1
  for (int k0 = 0; k0 < K; k0 += 64) {
    SST(Asb, 0, ra0); SST(Asb, 1, ra1); SST(Asb, 2, ra2); SST(Asb, 3, ra3);
    SST(Bsb, 0, rb0); SST(Bsb, 1, rb1); SST(Bsb, 2, rb2); SST(Bsb, 3, rb3);
    __syncthreads();
    if (k0 + 64 < K) {
      const size_t kb = (size_t)(k0 + 64) * 2;
      LDALL(kb)
    }
    {
      const bf16* ap = As + (wm * 64 + l31) * 72 + lh * 8;
      const bf16* bp = Bs + (wn * 64 + l31) * 72 + lh * 8;
#define LDA_(tm, ks) (*(const bf16x8*)(ap + (tm) * 32 * 72 + (ks) * 16))
#define LDB_(tn, ks) (*(const bf16x8*)(bp + (tn) * 32 * 72 + (ks) * 16))
#define STEP(B0_, B1_, N0_, N1_, ks, more)                                              \
  if (more) { N0_ = LDB_(0, (ks) + 1); N1_ = LDB_(1, (ks) + 1); }                       \
  acc[0][0] = MM(a0, B0_, acc[0][0]); acc[0][1] = MM(a0, B1_, acc[0][1]);       \
  if (more) a0 = LDA_(0, (ks) + 1);                                                     \
  acc[1][0] = MM(a1, B0_, acc[1][0]); acc[1][1] = MM(a1, B1_, acc[1][1]);       \
  if (more) a1 = LDA_(1, (ks) + 1);                                                     \
  __builtin_amdgcn_sched_barrier(0);
      bf16x8 a0 = LDA_(0, 0), a1 = LDA_(1, 0);
      bf16x8 p0 = LDB_(0, 0), p1 = LDB_(1, 0), q0, q1;
      __builtin_amdgcn_sched_barrier(0);
      STEP(p0, p1, q0, q1, 0, true)
      STEP(q0, q1, p0, p1, 1, true)
      STEP(p0, p1, q0, q1, 2, true)
      STEP(q0, q1, p0, p1, 3, false)
#undef LDA_
#undef LDB_
#undef STEP
    }
    __syncthreads();
  }
#undef LDALL
#undef ALD
#undef BLD
#undef SST
}

template <int TM, int WN>
DI void zero_acc(f32x16 (&acc)[TM][WN]) {
#pragma unroll
  for (int a = 0; a < TM; ++a)
#pragma unroll
    for (int b = 0; b < WN; ++b)
#pragma unroll
      for (int i = 0; i < 16; ++i) acc[a][b][i] = 0.f;
}

template <bool SWAP>
DI void gemm_main256(const bf16* __restrict__ A, int lda, const bf16* __restrict__ Bt, int ldb, int K,
                     f32x16 (&acc)[4][2], char* lds, const int tid) {
  bf16* As = (bf16*)lds;
  bf16* Bs = As + 256 * 72;
  const int lane = tid & 63, wave = tid >> 6, wm = wave >> 1, wn = wave & 1;
  const int l31 = lane & 31, lh = lane >> 5;
  const uint32_t aoff = (uint32_t)(((tid >> 3) * lda + (tid & 7) * 8) * 2);
  const uint32_t boff = (uint32_t)(((tid >> 3) * ldb + (tid & 7) * 8) * 2);
  const uint32_t soff = (uint32_t)(((tid >> 3) * 72 + (tid & 7) * 8) * 2);
  const char* Ab = (const char*)A;
  const char* Bb = (const char*)Bt;
  char* Asb = (char*)As;
  char* Bsb = (char*)Bs;
  const size_t astep = (size_t)32 * lda * 2, bstep = (size_t)32 * ldb * 2;
  uint4 ra0, ra1, ra2, ra3, ra4, ra5, ra6, ra7, rb0, rb1, rb2, rb3;
#define ALD(i, kb) (*(const uint4*)(Ab + ((size_t)(i) * astep + (kb)) + aoff))
#define BLD(i, kb) (*(const uint4*)(Bb + ((size_t)(i) * bstep + (kb)) + boff))
#define LDALL(kb)                                                                      \
  ra0 = ALD(0, kb); ra1 = ALD(1, kb); ra2 = ALD(2, kb); ra3 = ALD(3, kb);              \
  ra4 = ALD(4, kb); ra5 = ALD(5, kb); ra6 = ALD(6, kb); ra7 = ALD(7, kb);              \
  rb0 = BLD(0, kb); rb1 = BLD(1, kb); rb2 = BLD(2, kb); rb3 = BLD(3, kb);
#define SST(base, i, val) (*(uint4*)((base) + (i) * (32 * 72 * 2) + soff) = (val))
  LDALL((size_t)0)
#pragma unroll 1
  for (int k0 = 0; k0 < K; k0 += 64) {
    SST(Asb, 0, ra0); SST(Asb, 1, ra1); SST(Asb, 2, ra2); SST(Asb, 3, ra3);
    SST(Asb, 4, ra4); SST(Asb, 5, ra5); SST(Asb, 6, ra6); SST(Asb, 7, ra7);
    SST(Bsb, 0, rb0); SST(Bsb, 1, rb1); SST(Bsb, 2, rb2); SST(Bsb, 3, rb3);
    __syncthreads();
    if (k0 + 64 < K) {
      const size_t kb = (size_t)(k0 + 64) * 2;
      LDALL(kb)
    }
    {
      const bf16* ap = As + (wm * 128 + l31) * 72 + lh * 8;
      const bf16* bp = Bs + (wn * 64 + l31) * 72 + lh * 8;
#define LDA_(tm, ks) (*(const bf16x8*)(ap + (tm) * 32 * 72 + (ks) * 16))
#define LDB_(tn, ks) (*(const bf16x8*)(bp + (tn) * 32 * 72 + (ks) * 16))
#define STEP(B0_, B1_, N0_, N1_, ks, more)                                              \
  if (more) { N0_ = LDB_(0, (ks) + 1); N1_ = LDB_(1, (ks) + 1); }                       \
  acc[0][0] = MM(a0, B0_, acc[0][0]); acc[0][1] = MM(a0, B1_, acc[0][1]);       \
  if (more) a0 = LDA_(0, (ks) + 1);                                                     \
  acc[1][0] = MM(a1, B0_, acc[1][0]); acc[1][1] = MM(a1, B1_, acc[1][1]);       \
  if (more) a1 = LDA_(1, (ks) + 1);                                                     \
  acc[2][0] = MM(a2, B0_, acc[2][0]); acc[2][1] = MM(a2, B1_, acc[2][1]);       \
  if (more) a2 = LDA_(2, (ks) + 1);                                                     \
  acc[3][0] = MM(a3, B0_, acc[3][0]); acc[3][1] = MM(a3, B1_, acc[3][1]);       \
  if (more) a3 = LDA_(3, (ks) + 1);                                                     \
  __builtin_amdgcn_sched_barrier(0);
      bf16x8 a0 = LDA_(0, 0), a1 = LDA_(1, 0), a2 = LDA_(2, 0), a3 = LDA_(3, 0);
      bf16x8 p0 = LDB_(0, 0), p1 = LDB_(1, 0), q0, q1;
      __builtin_amdgcn_sched_barrier(0);
      STEP(p0, p1, q0, q1, 0, true)
      STEP(q0, q1, p0, p1, 1, true)
      STEP(p0, p1, q0, q1, 2, true)
      STEP(q0, q1, p0, p1, 3, false)
#undef LDA_
#undef LDB_
#undef STEP
    }
    __syncthreads();
  }
#undef LDALL
#undef ALD
#undef BLD
#undef SST
}

DI void store_rows_bf16(bf16* __restrict__ rowp, const f32x16& a, int lh) {
#pragma unroll
  for (int k = 0; k < 4; k += 2) {
    uint32_t ax = pack2(a[4 * k], a[4 * k + 1]), ay = pack2(a[4 * k + 2], a[4 * k + 3]);
    uint32_t bx = pack2(a[4 * k + 4], a[4 * k + 5]), by = pack2(a[4 * k + 6], a[4 * k + 7]);
    const auto rx = __builtin_amdgcn_permlane32_swap(ax, bx, false, false);
    const auto ry = __builtin_amdgcn_permlane32_swap(ay, by, false, false);
    *(uint4*)(rowp + 8 * k + (lh ? 8 : 0)) = make_uint4(rx[0], ry[0], rx[1], ry[1]);
  }
}

DI bool xcd_tile(int it, int MT, int NTN, int PN, int& mt, int& nt) {
  const int x = blockIdx.x & 7, slot = blockIdx.x >> 3, nslots = gridDim.x >> 3;
  const int MTx = MT >> 3;
  const int lt = slot + it * nslots;
  if (lt >= MTx * NTN) return false;
  const int per_panel = MTx * PN;
  const int pn = lt / per_panel, r = lt - pn * per_panel;
  mt = x * MTx + r / PN;
  nt = pn * PN + r % PN;
  return true;
}

DI void phase_p1(const Params& p, const int wid, int layer, int M, char* lds) {
  const bf16* h = (const bf16*)(p.ws + OFF_H);
  const bf16* W1 = (const bf16*)(p.ws + OFF_W + (size_t)layer * LW);
  constexpr int NTN = N1 / 128;
  int mt_, nt_;
  for (int it = 0; xcd_tile(it, M / 256, NTN, 9, mt_, nt_); ++it) {
    const int m0 = mt_ * 256, n0 = nt_ * 128;
    const int tidf = tid_fresh(p, wid); const int lane = tidf & 63, wave = tidf >> 6, wm = wave >> 1, wn = wave & 1, l31 = lane & 31, lh = lane >> 5;
    f32x16 acc[4][2];
    zero_acc<4, 2>(acc);
    const bool lat = m0 < NL;
    if (n0 >= 1024 && n0 < 1536) {
      gemm_main256<false>(h + (size_t)m0 * 1024, 1024, W1 + (size_t)n0 * 1024, 1024, 1024, acc, lds, tidf);
      bf16* Vt = (bf16*)(p.ws + OFF_VT);
#pragma unroll
      for (int tm = 0; tm < 4; ++tm)
#pragma unroll
        for (int tn = 0; tn < 2; ++tn) {
          const int col = n0 + wn * 64 + tn * 32 + l31;
          const int rowb = m0 + wm * 128 + tm * 32 + 4 * lh;
          const int hd = (col - 1024) >> 7, vv = (col - 1024) & 127;
#pragma unroll
          for (int g = 0; g < 4; ++g) {
            const int row0 = rowb + 8 * g;
            int b, key;
            if (lat) { b = row0 >> 13; key = 256 + (row0 & 8191); } else { b = (row0 - NL) >> 8; key = (row0 - NL) & 255; }
            uint2 pk;
            pk.x = pack2(acc[tm][tn][4 * g], acc[tm][tn][4 * g + 1]);
            pk.y = pack2(acc[tm][tn][4 * g + 2], acc[tm][tn][4 * g + 3]);
            *(uint2*)(Vt + ((size_t)((b * 4 + hd) * 128 + vv)) * KEYS + key) = pk;
          }
        }
    } else {
      gemm_main256<true>(h + (size_t)m0 * 1024, 1024, W1 + (size_t)n0 * 1024, 1024, 1024, acc, lds, tidf);
      int rbase = m0 + wm * 128 + l31, loff = wn * 64 + (lh ? 8 : 0);
      asm volatile("" : "+v"(rbase), "+v"(loff));
      if (n0 < 1024) {
        const float2* rope = (const float2*)(p.ws + OFF_ROPE);
        bf16* dst = (bf16*)(p.ws + (n0 < 512 ? OFF_QA : OFF_KA)) + (n0 & 511);
        const float qs = n0 < 512 ? QSCALE : 1.f;
#pragma unroll
        for (int tm = 0; tm < 4; ++tm)
#pragma unroll
          for (int tn = 0; tn < 2; ++tn) {
            const int row = rbase + tm * 32;
            f32x16& r = acc[tm][tn];
            if (lat) {
              const int t = row & 8191;
              const int pos = tn ? (t & 63) : (t >> 6);
              const float4* rp = (const float4*)(rope + pos * 16 + 4 * lh);
#pragma unroll
              for (int hb = 0; hb < 2; ++hb) {
                const float4 c01 = rp[4 * hb], c23 = rp[4 * hb + 1];
                const float cc[4] = {c01.x, c01.z, c23.x, c23.z}, sn[4] = {c01.y, c01.w, c23.y, c23.w};
#pragma unroll
                for (int j = 0; j < 4; ++j) {
                  const int i = 4 * hb + j;
                  const float x0 = r[i], x1 = r[i + 8];
                  r[i] = (x0 * cc[j] - x1 * sn[j]) * qs;
                  r[i + 8] = (x1 * cc[j] + x0 * sn[j]) * qs;
                }
                __builtin_amdgcn_sched_barrier(0);
              }
            } else {
#pragma unroll
              for (int i = 0; i < 16; ++i) r[i] *= qs;
            }
            store_rows_bf16(dst + (size_t)row * 512 + tn * 32 + loff, r, 0);
            __builtin_amdgcn_sched_barrier(0);
          }
      } else if (n0 < 3328) {
        bf16* dst; int ld;
        if (n0 < 2304) { dst = (bf16*)(p.ws + OFF_XBC) + (n0 - 1536); ld = 768; }
        else if (n0 < 2560) { dst = (bf16*)(p.ws + OFF_GQ) + (n0 - 2304); ld = 256; }
        else if (n0 < 2816) { dst = (bf16*)(p.ws + OFF_GK) + (n0 - 2560); ld = 256; }
        else { dst = (bf16*)(p.ws + OFF_GV) + (n0 - 2816); ld = 512; }
#pragma unroll
        for (int tm = 0; tm < 4; ++tm)
#pragma unroll
          for (int tn = 0; tn < 2; ++tn) {
            store_rows_bf16(dst + (size_t)(rbase + tm * 32) * ld + tn * 32 + loff, acc[tm][tn], 0);
            __builtin_amdgcn_sched_barrier(0);
          }
      } else if (wn == 0) {
        float* dtlr = (float*)(p.ws + OFF_DTLR);
#pragma unroll
        for (int tm = 0; tm < 4; ++tm)
#pragma unroll
          for (int tn = 0; tn < 2; ++tn)
#pragma unroll
            for (int g = 0; g < 4; ++g) {
              const int cc = tn * 32 + 8 * g + 4 * lh;
              if (cc < 48)
                *(float4*)(dtlr + (size_t)(rbase + tm * 32) * 48 + cc) =
                    make_float4(acc[tm][tn][4 * g], acc[tm][tn][4 * g + 1], acc[tm][tn][4 * g + 2], acc[tm][tn][4 * g + 3]);
            }
      }
    }
  }
}

DI void phase_conv(const Params& p, const int wid, int layer) {
  const bf16* xin = (const bf16*)(p.ws + OFF_XBC);
  bf16* xo = (bf16*)(p.ws + OFF_XBC2);
  const float* cw = p.conv_w + layer * 3 * 768;
  const float* cb = p.conv_b + layer * 768;
  const int total = NT * 96;
  for (int idx = blockIdx.x * 256 + tid_fresh(p, wid); idx < total; idx += gridDim.x * 256) {
    const int row = idx / 96, c0 = (idx % 96) * 8;
    int t, L;
    if (row < NL) { t = row & 8191; L = 8192; } else { t = (row - NL) & 255; L = 256; }
    uint4 cur = *(const uint4*)(xin + (size_t)row * 768 + c0);
    uint4 prv = make_uint4(0, 0, 0, 0), nxt = make_uint4(0, 0, 0, 0);
    if (t > 0) prv = *(const uint4*)(xin + (size_t)(row - 1) * 768 + c0);
    if (t < L - 1) nxt = *(const uint4*)(xin + (size_t)(row + 1) * 768 + c0);
    const uint32_t cu[4] = {cur.x, cur.y, cur.z, cur.w}, pu[4] = {prv.x, prv.y, prv.z, prv.w}, nu[4] = {nxt.x, nxt.y, nxt.z, nxt.w};
    uint32_t ou[4];
#pragma unroll
    for (int q = 0; q < 4; ++q) {
      const int c = c0 + 2 * q;
      float a0 = cw[c] * blo(pu[q]) + cw[768 + c] * blo(cu[q]) + cw[1536 + c] * blo(nu[q]) + cb[c];
      float a1 = cw[c + 1] * bhi(pu[q]) + cw[768 + c + 1] * bhi(cu[q]) + cw[1536 + c + 1] * bhi(nu[q]) + cb[c + 1];
      ou[q] = pack2(siluf(a0), siluf(a1));
    }
    *(uint4*)(xo + (size_t)row * 768 + c0) = make_uint4(ou[0], ou[1], ou[2], ou[3]);
  }
}

DI int scan_row(int b, int dir, int s) {
  if (s < 256) { int t = dir ? 255 - s : s; return NL + b * 256 + t; }
  int t = s - 256;
  if (dir) t = 8191 - t;
  return b * 8192 + t;
}

template <bool GLA>
DI void scan_item(const Params& p, const int wid, int layer, int item, char* lds) {
  constexpr int CT = 16;
  constexpr int V = GLA ? 128 : 64;
  constexpr int NJ = V / 32;
  constexpr int BV = V / 16;
  float* a_s = (float*)lds;
  float* c_s = a_s + CT * 64;
  float* w_s = c_s + CT * 64;
  float* b_s = w_s + CT * 64;
  float* x_s = b_s + CT * V;
  float* op = x_s + (GLA ? 0 : CT * V);
  float* wg_s = op + CT * 4 * V;
  const int tid = tid_fresh(p, wid), lane = tid & 63, wave = tid >> 6;
  int head, dir, b;
  if (GLA) { head = item & 3; dir = (item >> 2) & 1; b = item >> 3; } else { head = item & 7; dir = (item >> 3) & 1; b = item >> 4; }
  const bf16* xbc = (const bf16*)(p.ws + OFF_XBC2);
  const bf16* gq = (const bf16*)(p.ws + OFF_GQ);
  const bf16* gk = (const bf16*)(p.ws + OFF_GK);
  const bf16* gv = (const bf16*)(p.ws + OFF_GV);
  const float* dtlr = (const float*)(p.ws + OFF_DTLR);
  bf16* yout = (bf16*)(p.ws + (GLA ? (dir ? OFF_YGB : OFF_YGF) : (dir ? OFF_YSB : OFF_YSF)));
  const int ocol = head * V;
  float Aneg = 0.f, Dsk = 0.f, dtb = 0.f;
  if (!GLA) {
    Aneg = -expf(p.a_log[layer * 16 + dir * 8 + head]);
    Dsk = p.ssm_d[layer * 16 + dir * 8 + head];
    dtb = p.dt_bias[layer * 16 + dir * 8 + head];
  } else {
    const float* wg = p.gla_w_gate + ((size_t)(layer * 2 + dir) * 16) * 256 + head * 64;
    for (int idx = tid; idx < 16 * 64; idx += 256) wg_s[idx] = wg[(idx >> 6) * 256 + (idx & 63)];
    if (tid < 64) wg_s[1024 + tid] = p.gla_b_gate[(layer * 2 + dir) * 256 + head * 64 + tid];
  }
  const int st = tid >> 4, sk4 = (tid & 15) * 4, sv = (tid & 15) * BV;
  const int vq = lane & 31, kg = wave * 2 + (lane >> 5);
  float S[8][NJ];
#pragma unroll
  for (int i = 0; i < 8; ++i)
#pragma unroll
    for (int j = 0; j < NJ; ++j) S[i][j] = 0.f;

  uint2 ra, rc; uint4 rbv; float rdt = 0.f; float4 rlr0, rlr1, rlr2, rlr3;
  rlr0 = rlr1 = rlr2 = rlr3 = make_float4(0.f, 0.f, 0.f, 0.f);
  rbv = make_uint4(0, 0, 0, 0);
#define SCAN_PREFETCH(chunk_)                                                                   \
  {                                                                                             \
    const int row_ = scan_row(b, dir, (chunk_) * CT + st);                                      \
    if (GLA) {                                                                                  \
      ra = *(const uint2*)(gk + (size_t)row_ * 256 + head * 64 + sk4);                          \
      rc = *(const uint2*)(gq + (size_t)row_ * 256 + head * 64 + sk4);                          \
      rbv = *(const uint4*)(gv + (size_t)row_ * 512 + head * 128 + sv);                         \
      const float* lr_ = dtlr + (size_t)row_ * 48 + 16 + dir * 16;                              \
      rlr0 = *(const float4*)(lr_); rlr1 = *(const float4*)(lr_ + 4);                           \
      rlr2 = *(const float4*)(lr_ + 8); rlr3 = *(const float4*)(lr_ + 12);                      \
    } else {                                                                                    \
      const int g_ = head >> 2;                                                                 \
      ra = *(const uint2*)(xbc + (size_t)row_ * 768 + 512 + g_ * 64 + sk4);                     \
      rc = *(const uint2*)(xbc + (size_t)row_ * 768 + 640 + g_ * 64 + sk4);                     \
      const uint2 t_ = *(const uint2*)(xbc + (size_t)row_ * 768 + head * 64 + sv);              \
      rbv.x = t_.x; rbv.y = t_.y;                                                               \
      rdt = dtlr[(size_t)row_ * 48 + dir * 8 + head];                                           \
    }                                                                                           \
  }
  SCAN_PREFETCH(0);
  constexpr int NCH = KEYS / CT;
  for (int chunk = 0; chunk < NCH; ++chunk) {
    {
      const float cscale = GLA ? 0.125f : 1.f;
      *(float4*)(a_s + st * 64 + sk4) = make_float4(blo(ra.x), bhi(ra.x), blo(ra.y), bhi(ra.y));
      *(float4*)(c_s + st * 64 + sk4) = make_float4(blo(rc.x) * cscale, bhi(rc.x) * cscale, blo(rc.y) * cscale, bhi(rc.y) * cscale);
      if (GLA) {
        *(float4*)(b_s + st * V + sv) = make_float4(blo(rbv.x), bhi(rbv.x), blo(rbv.y), bhi(rbv.y));
        *(float4*)(b_s + st * V + sv + 4) = make_float4(blo(rbv.z), bhi(rbv.z), blo(rbv.w), bhi(rbv.w));
        float4 zb = *(const float4*)(wg_s + 1024 + sk4);
        float z0 = zb.x, z1 = zb.y, z2 = zb.z, z3 = zb.w;
#define GROW(r_, lv_)                                                  \
  {                                                                    \
    const float4 w0_ = *(const float4*)(wg_s + (r_) * 64 + sk4);       \
    z0 = fmaf((lv_), w0_.x, z0); z1 = fmaf((lv_), w0_.y, z1); z2 = fmaf((lv_), w0_.z, z2); z3 = fmaf((lv_), w0_.w, z3); \
  }
        GROW(0, rlr0.x) GROW(1, rlr0.y) GROW(2, rlr0.z) GROW(3, rlr0.w)
        GROW(4, rlr1.x) GROW(5, rlr1.y) GROW(6, rlr1.z) GROW(7, rlr1.w)
        GROW(8, rlr2.x) GROW(9, rlr2.y) GROW(10, rlr2.z) GROW(11, rlr2.w)
        GROW(12, rlr3.x) GROW(13, rlr3.y) GROW(14, rlr3.z) GROW(15, rlr3.w)
#define LSIG16(zz) expf(((zz) >= 0.f ? -log1pf(expf(-(zz))) : (zz) - log1pf(expf(zz))) * (1.f / 16.f))
        *(float4*)(w_s + st * 64 + sk4) = make_float4(LSIG16(z0), LSIG16(z1), LSIG16(z2), LSIG16(z3));
      } else {
        float zz = rdt + dtb;
        float dt = zz > 20.f ? zz : log1pf(expf(zz));
        float4 xv = make_float4(blo(rbv.x), bhi(rbv.x), blo(rbv.y), bhi(rbv.y));
        *(float4*)(b_s + st * V + sv) = make_float4(xv.x * dt, xv.y * dt, xv.z * dt, xv.w * dt);
        *(float4*)(x_s + st * V + sv) = xv;
        if ((tid & 15) == 0) w_s[st] = expf(dt * Aneg);
      }
    }
    __syncthreads();
    if (chunk + 1 < NCH) SCAN_PREFETCH(chunk + 1);
#pragma unroll 4
    for (int tt = 0; tt < CT; ++tt) {
      const float4 a0 = *(const float4*)(a_s + tt * 64 + kg * 8), a1 = *(const float4*)(a_s + tt * 64 + kg * 8 + 4);
      const float4 c0 = *(const float4*)(c_s + tt * 64 + kg * 8), c1 = *(const float4*)(c_s + tt * 64 + kg * 8 + 4);
      const float av[8] = {a0.x, a0.y, a0.z, a0.w, a1.x, a1.y, a1.z, a1.w};
      const float cv[8] = {c0.x, c0.y, c0.z, c0.w, c1.x, c1.y, c1.z, c1.w};
      float wv[8];
      if (GLA) {
        const float4 w0 = *(const float4*)(w_s + tt * 64 + kg * 8), w1 = *(const float4*)(w_s + tt * 64 + kg * 8 + 4);
        wv[0] = w0.x; wv[1] = w0.y; wv[2] = w0.z; wv[3] = w0.w; wv[4] = w1.x; wv[5] = w1.y; wv[6] = w1.z; wv[7] = w1.w;
      } else {
        const float w = w_s[tt];
#pragma unroll
        for (int i = 0; i < 8; ++i) wv[i] = w;
      }
      float bv[NJ], o[NJ];
#pragma unroll
      for (int j = 0; j < NJ; ++j) { bv[j] = b_s[tt * V + vq + 32 * j]; o[j] = 0.f; }
#pragma unroll
      for (int i = 0; i < 8; ++i)
#pragma unroll
        for (int j = 0; j < NJ; ++j) {
          S[i][j] = fmaf(wv[i], S[i][j], av[i] * bv[j]);
          o[j] = fmaf(cv[i], S[i][j], o[j]);
        }
#pragma unroll
      for (int j = 0; j < NJ; ++j) {
        o[j] += __shfl_xor(o[j], 32);
        if (lane < 32) op[(tt * 4 + wave) * V + vq + 32 * j] = o[j];
      }
    }
    __syncthreads();
    {
      const int row = scan_row(b, dir, chunk * CT + st);
#pragma unroll
      for (int q = 0; q < BV / 4; ++q) {
        const int vc = sv + 4 * q;
        float4 o0 = *(const float4*)(op + (st * 4 + 0) * V + vc), o1 = *(const float4*)(op + (st * 4 + 1) * V + vc);
        float4 o2 = *(const float4*)(op + (st * 4 + 2) * V + vc), o3 = *(const float4*)(op + (st * 4 + 3) * V + vc);
        float r0 = o0.x + o1.x + o2.x + o3.x, r1 = o0.y + o1.y + o2.y + o3.y, r2 = o0.z + o1.z + o2.z + o3.z, r3 = o0.w + o1.w + o2.w + o3.w;
        if (!GLA) {
          float4 xv = *(const float4*)(x_s + st * V + vc);
          r0 = fmaf(Dsk, xv.x, r0); r1 = fmaf(Dsk, xv.y, r1); r2 = fmaf(Dsk, xv.z, r2); r3 = fmaf(Dsk, xv.w, r3);
        }
        uint2 pk; pk.x = pack2(r0, r1); pk.y = pack2(r2, r3);
        *(uint2*)(yout + (size_t)row * 512 + ocol + vc) = pk;
      }
    }
  }
  __syncthreads();
#undef SCAN_PREFETCH
#undef GROW
#undef LSIG16
}

DI bf16x8 pack8(const f32x16& x, int s) {
  uint32_t p0 = pack2(x[8 * s], x[8 * s + 1]), p1 = pack2(x[8 * s + 2], x[8 * s + 3]);
  uint32_t p2 = pack2(x[8 * s + 4], x[8 * s + 5]), p3 = pack2(x[8 * s + 6], x[8 * s + 7]);
  uint4 u = make_uint4(p0, p1, p2, p3);
  return __builtin_bit_cast(bf16x8, u);
}

template <bool GLA>
DI void cscan_item(const Params& p, const int wid, int layer, int item, char* lds) {
  constexpr int RS = 72;
  bf16* Qm = (bf16*)lds;
  bf16* Km = Qm + 64 * RS;
  bf16* KeT = Km + 64 * RS;
  bf16* bT = KeT + 64 * RS;
  bf16* ST = bT + 64 * RS;
  char* R = (char*)(ST + 64 * RS);
  float* Gf = (float*)R;
  bf16* Cm = (bf16*)R;
  float* Gs = (float*)(R + 64 * RS * 2);
  float* tot = (float*)(R + 16384);
  float* lr_s = tot + 256;
  const int tid = tid_fresh(p, wid), lane = tid & 63, wave = tid >> 6, l31 = lane & 31, lh = lane >> 5;
  const int nt = wave & 1, vh = wave >> 1;
  int head, dir, b, vhalf = 0;
  if (GLA) { vhalf = item & 1; head = (item >> 1) & 3; } else { head = item & 7; }
  dir = (item >> 3) & 1; b = item >> 4;
  const bf16* xbc = (const bf16*)(p.ws + OFF_XBC2);
  const bf16* gq = (const bf16*)(p.ws + OFF_GQ);
  const bf16* gk = (const bf16*)(p.ws + OFF_GK);
  const bf16* gv = (const bf16*)(p.ws + OFF_GV);
  const float* dtlr = (const float*)(p.ws + OFF_DTLR);
  bf16* yout = (bf16*)(p.ws + (GLA ? (dir ? OFF_YGB : OFF_YGF) : (dir ? OFF_YSB : OFF_YSF)));
  const int ocol = GLA ? head * 128 + vhalf * 64 : head * 64;
  float Aneg = 0.f, Dsk = 0.f, dtb = 0.f, bgk = 0.f;
  float wgk[16];
#pragma unroll
  for (int r = 0; r < 16; ++r) wgk[r] = 0.f;
  if (!GLA) {
    Aneg = -expf(p.a_log[layer * 16 + dir * 8 + head]);
    Dsk = p.ssm_d[layer * 16 + dir * 8 + head];
    dtb = p.dt_bias[layer * 16 + dir * 8 + head];
  } else {
    const float* wg = p.gla_w_gate + ((size_t)(layer * 2 + dir) * 16) * 256 + head * 64 + (tid & 63);
#pragma unroll
    for (int r = 0; r < 16; ++r) wgk[r] = wg[r * 256];
    bgk = p.gla_b_gate[(layer * 2 + dir) * 256 + head * 64 + (tid & 63)];
  }
  const int st = tid >> 2, k16 = (tid & 3) * 16;
  f32x16 Sacc;
#pragma unroll
  for (int i = 0; i < 16; ++i) Sacc[i] = 0.f;

  uint4 ra0, ra1, rc0, rc1, rb0, rb1; float4 rl;
#define CS_PREFETCH(chunk_)                                                                          \
  {                                                                                                  \
    const int row_ = scan_row(b, dir, (chunk_) * 64 + st);                                           \
    if (GLA) {                                                                                       \
      const uint4* ap_ = (const uint4*)(gk + (size_t)row_ * 256 + head * 64 + k16);                  \
      const uint4* cp_ = (const uint4*)(gq + (size_t)row_ * 256 + head * 64 + k16);                  \
      const uint4* bp_ = (const uint4*)(gv + (size_t)row_ * 512 + head * 128 + vhalf * 64 + k16);    \
      ra0 = ap_[0]; ra1 = ap_[1]; rc0 = cp_[0]; rc1 = cp_[1]; rb0 = bp_[0]; rb1 = bp_[1];            \
      rl = *(const float4*)(dtlr + (size_t)row_ * 48 + 16 + dir * 16 + (tid & 3) * 4);               \
    } else {                                                                                         \
      const int g_ = head >> 2;                                                                      \
      const uint4* ap_ = (const uint4*)(xbc + (size_t)row_ * 768 + 512 + g_ * 64 + k16);             \
      const uint4* cp_ = (const uint4*)(xbc + (size_t)row_ * 768 + 640 + g_ * 64 + k16);             \
      const uint4* bp_ = (const uint4*)(xbc + (size_t)row_ * 768 + head * 64 + k16);                 \
      ra0 = ap_[0]; ra1 = ap_[1]; rc0 = cp_[0]; rc1 = cp_[1]; rb0 = bp_[0]; rb1 = bp_[1];            \
      rl.x = dtlr[(size_t)row_ * 48 + dir * 8 + head]; rl.y = 0.f; rl.z = 0.f; rl.w = 0.f;           \
    }                                                                                                \
  }
  CS_PREFETCH(0);
#pragma unroll 1
  for (int chunk = 0; chunk < KEYS / 64; ++chunk) {
    float dt = 0.f;
    if (GLA) {
      *(float4*)(lr_s + st * 16 + (tid & 3) * 4) = rl;
      __syncthreads();
      float Gl[16];
      float run = 0.f;
#pragma unroll
      for (int i = 0; i < 16; ++i) {
        const float* lrp = lr_s + (wave * 16 + i) * 16;
        const float4 l0 = *(const float4*)(lrp), l1 = *(const float4*)(lrp + 4), l2 = *(const float4*)(lrp + 8), l3 = *(const float4*)(lrp + 12);
        float z = bgk;
        z = fmaf(l0.x, wgk[0], z); z = fmaf(l0.y, wgk[1], z); z = fmaf(l0.z, wgk[2], z); z = fmaf(l0.w, wgk[3], z);
        z = fmaf(l1.x, wgk[4], z); z = fmaf(l1.y, wgk[5], z); z = fmaf(l1.z, wgk[6], z); z = fmaf(l1.w, wgk[7], z);
        z = fmaf(l2.x, wgk[8], z); z = fmaf(l2.y, wgk[9], z); z = fmaf(l2.z, wgk[10], z); z = fmaf(l2.w, wgk[11], z);
        z = fmaf(l3.x, wgk[12], z); z = fmaf(l3.y, wgk[13], z); z = fmaf(l3.z, wgk[14], z); z = fmaf(l3.w, wgk[15], z);
        run -= (fmaxf(-z, 0.f) + __logf(1.f + __expf(-fabsf(z)))) * (1.f / 16.f);
        Gl[i] = run;
      }
      tot[wave * 64 + lane] = run;
      __syncthreads();
      float off = 0.f;
      if (wave > 0) off += tot[lane];
      if (wave > 1) off += tot[64 + lane];
      if (wave > 2) off += tot[128 + lane];
#pragma unroll
      for (int i = 0; i < 16; ++i) Gf[(wave * 16 + i) * 64 + lane] = Gl[i] + off;
    } else {
      const float zz = rl.x + dtb;
      dt = zz > 20.f ? zz : log1pf(expf(zz));
      if ((tid & 3) == 0) lr_s[st] = dt;
      __syncthreads();
      if (wave == 0) {
        float g = lr_s[lane] * Aneg;
#pragma unroll
        for (int o = 1; o < 64; o <<= 1) {
          const float v = __shfl_up(g, o);
          if (lane >= o) g += v;
        }
        Gs[lane] = g;
      }
    }
#pragma unroll
    for (int i = 0; i < 16; ++i)
      ST[(32 * (wave >> 1) + (i & 3) + 8 * (i >> 2) + 4 * lh) * RS + 32 * (wave & 1) + l31] = f2b(Sacc[i]);
    __syncthreads();
    {
      const uint32_t au[8] = {ra0.x, ra0.y, ra0.z, ra0.w, ra1.x, ra1.y, ra1.z, ra1.w};
      const uint32_t cu[8] = {rc0.x, rc0.y, rc0.z, rc0.w, rc1.x, rc1.y, rc1.z, rc1.w};
      const uint32_t bu[8] = {rb0.x, rb0.y, rb0.z, rb0.w, rb1.x, rb1.y, rb1.z, rb1.w};
      uint32_t qo[8], ko[8];
      if (GLA) {
#pragma unroll
        for (int q = 0; q < 4; ++q) {
          const float4 G4 = *(const float4*)(Gf + st * 64 + k16 + 4 * q);
          const float4 L4 = *(const float4*)(Gf + 63 * 64 + k16 + 4 * q);
          const float gg[4] = {G4.x, G4.y, G4.z, G4.w}, ll[4] = {L4.x, L4.y, L4.z, L4.w};
#pragma unroll
          for (int h2 = 0; h2 < 2; ++h2) {
            const int w = 2 * q + h2;
            const float a0 = blo(au[w]), a1 = bhi(au[w]), c0 = blo(cu[w]), c1 = bhi(cu[w]);
            const float g0 = gg[2 * h2], g1 = gg[2 * h2 + 1];
            qo[w] = pack2(c0 * 0.125f * __expf(g0), c1 * 0.125f * __expf(g1));
            ko[w] = pack2(a0 * __expf(-g0), a1 * __expf(-g1));
            KeT[(k16 + 2 * w) * RS + st] = f2b(a0 * __expf(ll[2 * h2] - g0));
            KeT[(k16 + 2 * w + 1) * RS + st] = f2b(a1 * __expf(ll[2 * h2 + 1] - g1));
            bT[(k16 + 2 * w) * RS + st] = (bf16)(bu[w] & 0xffffu);
            bT[(k16 + 2 * w + 1) * RS + st] = (bf16)(bu[w] >> 16);
          }
        }
      } else {
        const float Gt = Gs[st], GL = Gs[63];
        const float e1 = __expf(Gt), e3 = __expf(GL - Gt);
#pragma unroll
        for (int w = 0; w < 8; ++w) {
          const float a0 = blo(au[w]), a1 = bhi(au[w]), c0 = blo(cu[w]), c1 = bhi(cu[w]);
          qo[w] = pack2(c0 * e1, c1 * e1);
          ko[w] = au[w];
          KeT[(k16 + 2 * w) * RS + st] = f2b(a0 * e3);
          KeT[(k16 + 2 * w + 1) * RS + st] = f2b(a1 * e3);
          bT[(k16 + 2 * w) * RS + st] = f2b(blo(bu[w]) * dt);
          bT[(k16 + 2 * w + 1) * RS + st] = f2b(bhi(bu[w]) * dt);
        }
        *(uint4*)(Cm + st * RS + k16) = rc0;
        *(uint4*)(Cm + st * RS + k16 + 8) = rc1;
      }
      *(uint4*)(Qm + st * RS + k16) = make_uint4(qo[0], qo[1], qo[2], qo[3]);
      *(uint4*)(Qm + st * RS + k16 + 8) = make_uint4(qo[4], qo[5], qo[6], qo[7]);
      *(uint4*)(Km + st * RS + k16) = make_uint4(ko[0], ko[1], ko[2], ko[3]);
      *(uint4*)(Km + st * RS + k16 + 8) = make_uint4(ko[4], ko[5], ko[6], ko[7]);
    }
    __syncthreads();
    if (chunk + 1 < KEYS / 64) CS_PREFETCH(chunk + 1);
    const int trow = scan_row(b, dir, chunk * 64 + 32 * nt + l31);
    uint2 xr0 = make_uint2(0, 0), xr1 = xr0, xr2 = xr0, xr3 = xr0;
    if (!GLA) {
      const bf16* xp = xbc + (size_t)trow * 768 + head * 64 + 32 * vh + 4 * lh;
      xr0 = *(const uint2*)(xp); xr1 = *(const uint2*)(xp + 8); xr2 = *(const uint2*)(xp + 16); xr3 = *(const uint2*)(xp + 24);
    }
    f32x16 outv;
#pragma unroll
    for (int i = 0; i < 16; ++i) outv[i] = 0.f;
    const bf16* Qp = GLA ? Qm : Cm;
#pragma unroll
    for (int ms = 0; ms < 2; ++ms) {
      if (ms <= nt) {
        f32x16 at;
#pragma unroll
        for (int i = 0; i < 16; ++i) at[i] = 0.f;
#pragma unroll
        for (int ks = 0; ks < 4; ++ks) {
          const bf16x8 kf = *(const bf16x8*)(Km + (32 * ms + l31) * RS + ks * 16 + lh * 8);
          const bf16x8 qf = *(const bf16x8*)(Qp + (32 * nt + l31) * RS + ks * 16 + lh * 8);
          at = MFMA32(kf, qf, at);
        }
        if (!GLA) {
          const float gt = Gs[32 * nt + l31];
#pragma unroll
          for (int g4 = 0; g4 < 4; ++g4) {
            const float4 gs4 = *(const float4*)(Gs + 32 * ms + 8 * g4 + 4 * lh);
            const float gsv[4] = {gs4.x, gs4.y, gs4.z, gs4.w};
#pragma unroll
            for (int j = 0; j < 4; ++j) {
              const int sl = 8 * g4 + 4 * lh + j;
              const bool keep = (ms < nt) || (sl <= l31);
              at[4 * g4 + j] = keep ? at[4 * g4 + j] * __expf(gt - gsv[j]) : 0.f;
            }
          }
        } else if (ms == nt) {
#pragma unroll
          for (int i = 0; i < 16; ++i) {
            const int sl = (i & 3) + 8 * (i >> 2) + 4 * lh;
            at[i] = (sl <= l31) ? at[i] : 0.f;
          }
        }
#pragma unroll
        for (int s2 = 0; s2 < 2; ++s2) {
          const bf16x8 pf = pack8(at, s2);
          const bf16* vp = bT + (32 * vh + l31) * RS + 32 * ms + 16 * s2 + 4 * lh;
          const uint2 lo = *(const uint2*)vp, hi = *(const uint2*)(vp + 8);
          const uint4 u = make_uint4(lo.x, lo.y, hi.x, hi.y);
          outv = MFMA32(__builtin_bit_cast(bf16x8, u), pf, outv);
        }
      }
    }
#pragma unroll
    for (int ks = 0; ks < 4; ++ks) {
      const bf16x8 sf = *(const bf16x8*)(ST + (32 * vh + l31) * RS + ks * 16 + lh * 8);
      const bf16x8 qf = *(const bf16x8*)(Qm + (32 * nt + l31) * RS + ks * 16 + lh * 8);
      outv = MFMA32(sf, qf, outv);
    }
    {
      const float dec = GLA ? __expf(Gf[63 * 64 + 32 * (wave & 1) + l31]) : __expf(Gs[63]);
#pragma unroll
      for (int i = 0; i < 16; ++i) Sacc[i] *= dec;
#pragma unroll
      for (int ks = 0; ks < 4; ++ks) {
        const bf16x8 bf_ = *(const bf16x8*)(bT + (32 * (wave >> 1) + l31) * RS + ks * 16 + lh * 8);
        const bf16x8 kf = *(const bf16x8*)(KeT + (32 * (wave & 1) + l31) * RS + ks * 16 + lh * 8);
        Sacc = MFMA32(bf_, kf, Sacc);
      }
    }
    {
      bf16* yp = yout + (size_t)trow * 512 + ocol + 32 * vh + 4 * lh;
      const uint2 xr[4] = {xr0, xr1, xr2, xr3};
#pragma unroll
      for (int g4 = 0; g4 < 4; ++g4) {
        float r0 = outv[4 * g4], r1 = outv[4 * g4 + 1], r2 = outv[4 * g4 + 2], r3 = outv[4 * g4 + 3];
        if (!GLA) {
          r0 = fmaf(Dsk, blo(xr[g4].x), r0); r1 = fmaf(Dsk, bhi(xr[g4].x), r1);
          r2 = fmaf(Dsk, blo(xr[g4].y), r2); r3 = fmaf(Dsk, bhi(xr[g4].y), r3);
        }
        uint2 pk; pk.x = pack2(r0, r1); pk.y = pack2(r2, r3);
        *(uint2*)(yp + 8 * g4) = pk;
      }
    }
    __syncthreads();
  }
#undef CS_PREFETCH
}


DI void attn_item(const Params& p, const int wid, int layer, int b, int head, int qrow0, int nkeys, char* lds) {
  bf16* Ks = (bf16*)lds;
  bf16* Vs = Ks + 64 * 136;
  bf16* Qa = (bf16*)(p.ws + OFF_QA);
  const bf16* Ka = (const bf16*)(p.ws + OFF_KA);
  const bf16* Vt = (const bf16*)(p.ws + OFF_VT) + (size_t)(b * 4 + head) * 128 * KEYS;
  const int tid = tid_fresh(p, wid), lane = tid & 63, wave = tid >> 6, l31 = lane & 31, lh = lane >> 5;

  bf16* Qs = Vs + 128 * 68;
#pragma unroll
  for (int i = 0; i < 8; ++i) {
    const int ch = tid + 256 * i;
    *(uint4*)(Qs + (ch >> 4) * 136 + (ch & 15) * 8) = *(const uint4*)(Qa + (size_t)(qrow0 + (ch >> 4)) * 512 + head * 128 + (ch & 15) * 8);
  }
  const bf16* qsw = Qs + (wave * 32 + l31) * 136 + lh * 8;
  f32x16 O[2][4];
#pragma unroll
  for (int c = 0; c < 2; ++c)
#pragma unroll
    for (int vt = 0; vt < 4; ++vt)
#pragma unroll
      for (int i = 0; i < 16; ++i) O[c][vt][i] = 0.f;
  float mrun[2] = {-1e30f, -1e30f}, lrun[2] = {0.f, 0.f};

  const int lkey = tid >> 2, lkq = (tid & 3) * 32, lvr = tid >> 1, lvh = (tid & 1) * 32;
#define KROW(key) ((key) < 256 ? NL + b * 256 + (key) : b * 8192 + (key) - 256)
#define KVLOAD(k0_)                                                                                  \
  {                                                                                                  \
    const uint4* kp_ = (const uint4*)(Ka + (size_t)KROW((k0_) + lkey) * 512 + head * 128 + lkq);      \
    rk0 = kp_[0]; rk1 = kp_[1]; rk2 = kp_[2]; rk3 = kp_[3];                                          \
    const uint4* vp_ = (const uint4*)(Vt + (size_t)lvr * KEYS + (k0_) + lvh);                        \
    rv0 = vp_[0]; rv1 = vp_[1]; rv2 = vp_[2]; rv3 = vp_[3];                                          \
  }
#define VST2(dst_, val) { (dst_)[0] = make_uint2((val).x, (val).y); (dst_)[1] = make_uint2((val).z, (val).w); }
  uint4 rk0, rk1, rk2, rk3, rv0, rv1, rv2, rv3;
  KVLOAD(0);
#pragma unroll 1
  for (int k0 = 0; k0 < nkeys; k0 += 64) {
    {
      uint4* kd = (uint4*)(Ks + lkey * 136 + lkq);
      kd[0] = rk0; kd[1] = rk1; kd[2] = rk2; kd[3] = rk3;
      uint2* vd = (uint2*)(Vs + lvr * 68 + lvh);
      VST2(vd, rv0); VST2(vd + 2, rv1); VST2(vd + 4, rv2); VST2(vd + 6, rv3);
    }
    __syncthreads();
    if (k0 + 64 < nkeys) KVLOAD(k0 + 64);
#pragma unroll
    for (int c = 0; c < 2; ++c) {
#pragma unroll
      for (int mt = 0; mt < 2; ++mt) {
        f32x16 sv;
#pragma unroll
        for (int i = 0; i < 16; ++i) sv[i] = 0.f;
#pragma unroll
        for (int ks = 0; ks < 4; ++ks) {
          const bf16x8 qf = *(const bf16x8*)(qsw + c * 64 + ks * 16);
          const bf16x8 kf = *(const bf16x8*)(Ks + (mt * 32 + l31) * 136 + c * 64 + ks * 16 + lh * 8);
          sv = MFMA32(kf, qf, sv);
        }
        __builtin_amdgcn_sched_barrier(0);
        const bf16* vpb = Vs + l31 * 68 + mt * 32 + 4 * lh;
#define VLD_(vt, st) ({ const bf16* vp_ = vpb + (vt) * 32 * 68 + 16 * (st); const uint2 lo_ = *(const uint2*)vp_, hi_ = *(const uint2*)(vp_ + 8); \
                        __builtin_bit_cast(bf16x8, make_uint4(lo_.x, lo_.y, hi_.x, hi_.y)); })
        bf16x8 v0, v1, v2, v3;
        float mx = fmaxf(sv[0], sv[1]);
#pragma unroll
        for (int i = 2; i < 16; i += 2) mx = max3f(mx, sv[i], sv[i + 1]);
        mx = xhalf_max(mx);
        if (__any(mx - mrun[c] > 8.0f)) {
          const float mnew = fmaxf(mrun[c], mx);
          const float alpha = __builtin_amdgcn_exp2f(mrun[c] - mnew);
          mrun[c] = mnew;
          lrun[c] *= alpha;
#pragma unroll
          for (int vt = 0; vt < 4; ++vt)
#pragma unroll
            for (int i = 0; i < 16; ++i) O[c][vt][i] *= alpha;
        }
        float psum = 0.f;
#pragma unroll
        for (int i = 0; i < 16; ++i) {
          float pv = __builtin_amdgcn_exp2f(sv[i] - mrun[c]);
          sv[i] = pv;
          psum += pv;
        }
        lrun[c] += psum;
        v0 = VLD_(0, 0); v1 = VLD_(1, 0); v2 = VLD_(2, 0); v3 = VLD_(3, 0);
        __builtin_amdgcn_sched_barrier(0);
        {
          const bf16x8 pf = pack8(sv, 0);
          O[c][0] = MFMA32(v0, pf, O[c][0]); O[c][1] = MFMA32(v1, pf, O[c][1]);
          O[c][2] = MFMA32(v2, pf, O[c][2]); O[c][3] = MFMA32(v3, pf, O[c][3]);
          v0 = VLD_(0, 1); v1 = VLD_(1, 1); v2 = VLD_(2, 1); v3 = VLD_(3, 1);
        }
        __builtin_amdgcn_sched_barrier(0);
        {
          const bf16x8 pf = pack8(sv, 1);
          O[c][0] = MFMA32(v0, pf, O[c][0]); O[c][1] = MFMA32(v1, pf, O[c][1]);
          O[c][2] = MFMA32(v2, pf, O[c][2]); O[c][3] = MFMA32(v3, pf, O[c][3]);
        }
        __builtin_amdgcn_sched_barrier(0);
#undef VLD_
      }
    }
    __syncthreads();
  }
  const float lam = ((const float*)(p.ws + OFF_MISC))[layer];
  const float lam_init = layer == 0 ? 0.2f : 0.8f - 0.6f * 0.7408182206817179f;
  const float l1 = lrun[0] + __shfl_xor(lrun[0], 32);
  const float l2 = lrun[1] + __shfl_xor(lrun[1], 32);
  const float i1 = 1.f / l1, i2 = lam / l2;
  float ss = 0.f;
#pragma unroll
  for (int vt = 0; vt < 4; ++vt)
#pragma unroll
    for (int i = 0; i < 16; ++i) {
      float o = O[0][vt][i] * i1 - O[1][vt][i] * i2;
      O[0][vt][i] = o;
      ss += o * o;
    }
  ss += __shfl_xor(ss, 32);
  const float rstd = rsqrtf(ss * (1.f / 128.f) + EPS) * (1.f - lam_init);
  const float* nw = p.da_norm_w + layer * 128;
  bf16* orow = Qa + (size_t)(qrow0 + wave * 32 + l31) * 512 + head * 128;
#pragma unroll
  for (int vt = 0; vt < 4; ++vt)
#pragma unroll
    for (int g = 0; g < 4; ++g) {
      const int v0 = vt * 32 + 8 * g + 4 * lh;
      float4 w4 = *(const float4*)(nw + v0);
      uint2 pk;
      pk.x = pack2(O[0][vt][4 * g] * rstd * w4.x, O[0][vt][4 * g + 1] * rstd * w4.y);
      pk.y = pack2(O[0][vt][4 * g + 2] * rstd * w4.z, O[0][vt][4 * g + 3] * rstd * w4.w);
      *(uint2*)(orow + v0) = pk;
    }
}

DI void phase_mixers(const Params& p, const int wid, int layer, char* lds) {
  __shared__ int s_item;
  const int x = blockIdx.x & 7;
  unsigned* counter = (unsigned*)(p.ws + OFF_MISC + 64) + layer * 8 + x;
  const int total = layer == 0 ? 32 + 256 + 8 : 32 + 256;
  bool first = blockIdx.x < 256;
  for (;;) {
    if (tid_fresh(p, wid) == 0) s_item = first ? (int)(blockIdx.x >> 3) : 32 + (int)atomicAdd(counter, 1u);
    first = false;
    __syncthreads();
    const int li = s_item;
    __syncthreads();
    if (li >= total) break;
    if (li < 32) {
      const int sid = li * 8 + x;
      if (sid < 128) cscan_item<true>(p, wid, layer, sid, lds);
      else cscan_item<false>(p, wid, layer, sid - 128, lds);
    } else if (li < 288) {
      const int a = li - 32;
      const int bh = x + 8 * (a >> 6), qb = a & 63;
      attn_item(p, wid, layer, bh >> 2, bh & 3, (bh >> 2) * 8192 + qb * 128, KEYS, lds);
    } else {
      const int c = x * 8 + (li - 288);
      const int bh = c >> 1, qb = c & 1;
      attn_item(p, wid, layer, bh >> 2, bh & 3, NL + (bh >> 2) * 256 + qb * 128, 256, lds);
    }
  }
}

DI void phase_z(const Params& p, const int wid, int layer, int M, char* lds) {
  const bf16* h = (const bf16*)(p.ws + OFF_H);
  const bf16* W2 = (const bf16*)(p.ws + OFF_W + (size_t)layer * LW + SZ_W1);
  bf16* Z = (bf16*)(p.ws + OFF_Z);
  const int tidf = tid_fresh(p, wid); const int lane = tidf & 63, wave = tidf >> 6, wm = wave >> 1, wn = wave & 1, l31 = lane & 31, lh = lane >> 5;
  constexpr int NTN = N2 / 128;
  int mt_, nt_;
  for (int it = 0; xcd_tile(it, M / 256, NTN, 12, mt_, nt_); ++it) {
    const int m0 = mt_ * 256, n0 = nt_ * 128;
    f32x16 acc[4][2];
    zero_acc<4, 2>(acc);
    gemm_main256<true>(h + (size_t)m0 * 1024, 1024, W2 + (size_t)n0 * 1024, 1024, 1024, acc, lds, tidf);
#pragma unroll
    for (int tm = 0; tm < 4; ++tm)
#pragma unroll
      for (int tn = 0; tn < 2; ++tn)
        store_rows_bf16(Z + (size_t)(m0 + wm * 128 + tm * 32 + l31) * 1536 + n0 + wn * 64 + tn * 32, acc[tm][tn], lh);
  }
}

DI void phase_post(const Params& p, const int wid, int layer, int M) {
  const int tidf = tid_fresh(p, wid); const int lane = tidf & 63, wave = tidf >> 6;
  bf16* Z = (bf16*)(p.ws + OFF_Z);
  const bf16* oda = (const bf16*)(p.ws + OFF_QA);
  const bf16* ysf = (const bf16*)(p.ws + OFF_YSF);
  const bf16* ysb = (const bf16*)(p.ws + OFF_YSB);
  const bf16* ygf = (const bf16*)(p.ws + OFF_YGF);
  const bf16* ygb = (const bf16*)(p.ws + OFF_YGB);
  const float* snw = p.ssm_norm_w + layer * 512;
  const float* gnw = p.gla_norm_w + layer * 128;
  const int c0 = lane * 8;
  for (int row = blockIdx.x * 4 + wave; row < M; row += gridDim.x * 4) {
    bf16* zr = Z + (size_t)row * 1536;
    {
      uint4 o = *(const uint4*)(oda + (size_t)row * 512 + c0);
      uint4 z = *(const uint4*)(zr + c0);
      const uint32_t ou[4] = {o.x, o.y, o.z, o.w}, zu[4] = {z.x, z.y, z.z, z.w};
      uint32_t r[4];
#pragma unroll
      for (int q = 0; q < 4; ++q) r[q] = pack2(blo(ou[q]) * siluf(blo(zu[q])), bhi(ou[q]) * siluf(bhi(zu[q])));
      *(uint4*)(zr + c0) = make_uint4(r[0], r[1], r[2], r[3]);
    }
    {
      uint4 yf = *(const uint4*)(ysf + (size_t)row * 512 + c0), yb = *(const uint4*)(ysb + (size_t)row * 512 + c0);
      uint4 z = *(const uint4*)(zr + 512 + c0);
      const uint32_t fu[4] = {yf.x, yf.y, yf.z, yf.w}, bu[4] = {yb.x, yb.y, yb.z, yb.w}, zu[4] = {z.x, z.y, z.z, z.w};
      float y[8];
      float ss = 0.f;
#pragma unroll
      for (int q = 0; q < 4; ++q) {
        y[2 * q] = (blo(fu[q]) + blo(bu[q])) * siluf(blo(zu[q]));
        y[2 * q + 1] = (bhi(fu[q]) + bhi(bu[q])) * siluf(bhi(zu[q]));
        ss += y[2 * q] * y[2 * q] + y[2 * q + 1] * y[2 * q + 1];
      }
#pragma unroll
      for (int m = 16; m >= 1; m >>= 1) ss += __shfl_xor(ss, m);
      const float rstd = rsqrtf(ss * (1.f / 256.f) + EPS);
      float4 w0 = *(const float4*)(snw + c0), w1 = *(const float4*)(snw + c0 + 4);
      uint32_t r[4];
      r[0] = pack2(y[0] * rstd * w0.x, y[1] * rstd * w0.y); r[1] = pack2(y[2] * rstd * w0.z, y[3] * rstd * w0.w);
      r[2] = pack2(y[4] * rstd * w1.x, y[5] * rstd * w1.y); r[3] = pack2(y[6] * rstd * w1.z, y[7] * rstd * w1.w);
      *(uint4*)(zr + 512 + c0) = make_uint4(r[0], r[1], r[2], r[3]);
    }
    {
      uint4 yf = *(const uint4*)(ygf + (size_t)row * 512 + c0), yb = *(const uint4*)(ygb + (size_t)row * 512 + c0);
      uint4 z = *(const uint4*)(zr + 1024 + c0);
      const uint32_t fu[4] = {yf.x, yf.y, yf.z, yf.w}, bu[4] = {yb.x, yb.y, yb.z, yb.w}, zu[4] = {z.x, z.y, z.z, z.w};
      float y[8];
      float ss = 0.f;
#pragma unroll
      for (int q = 0; q < 4; ++q) {
        y[2 * q] = blo(fu[q]) + blo(bu[q]);
        y[2 * q + 1] = bhi(fu[q]) + bhi(bu[q]);
        ss += y[2 * q] * y[2 * q] + y[2 * q + 1] * y[2 * q + 1];
      }
#pragma unroll
      for (int m = 8; m >= 1; m >>= 1) ss += __shfl_xor(ss, m);
      const float rstd = rsqrtf(ss * (1.f / 128.f) + EPS);
      const int cw = c0 & 127;
      float4 w0 = *(const float4*)(gnw + cw), w1 = *(const float4*)(gnw + cw + 4);
      uint32_t r[4];
      r[0] = pack2(y[0] * rstd * w0.x * siluf(blo(zu[0])), y[1] * rstd * w0.y * siluf(bhi(zu[0])));
      r[1] = pack2(y[2] * rstd * w0.z * siluf(blo(zu[1])), y[3] * rstd * w0.w * siluf(bhi(zu[1])));
      r[2] = pack2(y[4] * rstd * w1.x * siluf(blo(zu[2])), y[5] * rstd * w1.y * siluf(bhi(zu[2])));
      r[3] = pack2(y[6] * rstd * w1.z * siluf(blo(zu[3])), y[7] * rstd * w1.w * siluf(bhi(zu[3])));
      *(uint4*)(zr + 1024 + c0) = make_uint4(r[0], r[1], r[2], r[3]);
    }
  }
}

DI void phase_merge(const Params& p, const int wid, int layer, int M, char* lds) {
  const bf16* h = (const bf16*)(p.ws + OFF_H);
  const bf16* osg = (const bf16*)(p.ws + OFF_Z);
  const char* wb = p.ws + OFF_W + (size_t)layer * LW;
  const bf16* W3 = (const bf16*)(wb + SZ_W1 + SZ_W2);
  const bf16* Wout = (const bf16*)(wb + SZ_W1 + SZ_W2 + SZ_W3);
  bf16* U = (bf16*)(p.ws + OFF_U);
  const int tidf = tid_fresh(p, wid); const int lane = tidf & 63, wave = tidf >> 6, wm = wave >> 1, wn = wave & 1, l31 = lane & 31, lh = lane >> 5;
  constexpr int NTN = 1024 / 128;
  int mt_, nt_;
  for (int it = 0; xcd_tile(it, M / 128, NTN, 8, mt_, nt_); ++it) {
    const int m0 = mt_ * 128, n0 = nt_ * 128;
    f32x16 u[2][2];
    zero_acc<2, 2>(u);
#pragma unroll 1
    for (int br = 0; br < 3; ++br) {
      uint32_t* sgl = (uint32_t*)(lds + 36864) + tidf;
      {
        f32x16 g[2][2];
        zero_acc<2, 2>(g);
        gemm_main128<true>(h + (size_t)m0 * 1024, 1024, W3 + (size_t)(br * 1024 + n0) * 1024, 1024, 1024, g, lds, tidf);
#pragma unroll
        for (int tm = 0; tm < 2; ++tm)
#pragma unroll
          for (int tn = 0; tn < 2; ++tn)
#pragma unroll
            for (int q = 0; q < 8; ++q) sgl[((tm * 2 + tn) * 8 + q) * 256] = pack2(sigmf(g[tm][tn][2 * q]), sigmf(g[tm][tn][2 * q + 1]));
      }
      f32x16 t[2][2];
      zero_acc<2, 2>(t);
      gemm_main128<true>(osg + (size_t)m0 * 1536 + br * 512, 1536, Wout + (size_t)br * 1024 * 512 + (size_t)n0 * 512, 512, 512, t, lds, tidf);
#pragma unroll
      for (int tm = 0; tm < 2; ++tm)
#pragma unroll
        for (int tn = 0; tn < 2; ++tn)
#pragma unroll
          for (int q = 0; q < 8; ++q) {
            const uint32_t sgv = sgl[((tm * 2 + tn) * 8 + q) * 256];
            u[tm][tn][2 * q] = fmaf(blo(sgv), t[tm][tn][2 * q], u[tm][tn][2 * q]);
            u[tm][tn][2 * q + 1] = fmaf(bhi(sgv), t[tm][tn][2 * q + 1], u[tm][tn][2 * q + 1]);
          }
    }
#pragma unroll
    for (int tm = 0; tm < 2; ++tm)
#pragma unroll
      for (int tn = 0; tn < 2; ++tn)
        store_rows_bf16(U + (size_t)(m0 + wm * 64 + tm * 32 + l31) * 1024 + n0 + wn * 64 + tn * 32, u[tm][tn], lh);
  }
}

DI void phase_out(const Params& p, const int wid, int layer, int M, const float* xl, const float* xc, float* ol, float* oc, char* lds) {
  const bf16* U = (const bf16*)(p.ws + OFF_U);
  const bf16* Wo = (const bf16*)(p.ws + OFF_W + (size_t)layer * LW + SZ_W1 + SZ_W2 + SZ_W3 + 3 * SZ_WOUT);
  const float* modv = (const float*)(p.ws + OFF_MOD) + (size_t)layer * 9 * 3072;
  const int tidf = tid_fresh(p, wid); const int lane = tidf & 63, wave = tidf >> 6, wm = wave >> 1, wn = wave & 1, l31 = lane & 31, lh = lane >> 5;
  constexpr int NTN = 1024 / 128;
  int mt_, nt_;
  for (int it = 0; xcd_tile(it, M / 256, NTN, 8, mt_, nt_); ++it) {
    const int m0 = mt_ * 256, n0 = nt_ * 128;
    f32x16 acc[4][2];
    zero_acc<4, 2>(acc);
    gemm_main256<true>(U + (size_t)m0 * 1024, 1024, Wo + (size_t)n0 * 1024, 1024, 1024, acc, lds, tidf);
    const bool lat = m0 < NL;
    const int j = lat ? (m0 >> 13) : 8;
    const float* gate = modv + j * 3072 + 2048;
    const float* src = lat ? xl + (size_t)m0 * 1024 : xc + (size_t)(m0 - NL) * 1024;
    float* dst = lat ? ol + (size_t)m0 * 1024 : oc + (size_t)(m0 - NL) * 1024;
    uint32_t eoff = (uint32_t)((wm * 128 + l31) * 1024 + n0 + wn * 64 + 4 * lh);
    asm volatile("" : "+v"(eoff));
    const float* sp = src + eoff;
    float* dp = dst + eoff;
    const float* gp = gate + n0 + wn * 64 + 4 * lh;
#pragma unroll
    for (int tm = 0; tm < 4; ++tm)
#pragma unroll
      for (int tn = 0; tn < 2; ++tn) {
#pragma unroll
        for (int g = 0; g < 4; ++g) {
          const int off = tm * 32 * 1024 + tn * 32 + 8 * g;
          const float4 gt = *(const float4*)(gp + tn * 32 + 8 * g);
          const float4 xo = *(const float4*)(sp + off);
          *(float4*)(dp + off) = make_float4(xo.x + gt.x * acc[tm][tn][4 * g], xo.y + gt.y * acc[tm][tn][4 * g + 1],
                                             xo.z + gt.z * acc[tm][tn][4 * g + 2], xo.w + gt.w * acc[tm][tn][4 * g + 3]);
        }
        __builtin_amdgcn_sched_barrier(0);
      }
  }
}

DI void phase_final(const Params& p, const int wid) {
  const int tidf = tid_fresh(p, wid); const int lane = tidf & 63, wave = tidf >> 6;
  const int stride = gridDim.x * 4;
  for (int row0 = blockIdx.x * 4 + wave; row0 < NL; row0 += 2 * stride) {
    float4 v[2][4];
    float ss[2] = {0.f, 0.f};
#pragma unroll
    for (int r = 0; r < 2; ++r) {
      int row = row0 + r * stride;
      if (row >= NL) row = row0;
      const float* src = p.out + (size_t)row * 1024;
#pragma unroll
      for (int i = 0; i < 4; ++i) v[r][i] = *(const float4*)(src + (i * 64 + lane) * 4);
    }
#pragma unroll
    for (int r = 0; r < 2; ++r) {
#pragma unroll
      for (int i = 0; i < 4; ++i) ss[r] += v[r][i].x * v[r][i].x + v[r][i].y * v[r][i].y + v[r][i].z * v[r][i].z + v[r][i].w * v[r][i].w;
      ss[r] = wave_sum(ss[r]);
    }
#pragma unroll
    for (int r = 0; r < 2; ++r) {
      const int row = row0 + r * stride;
      if (row < NL) {
        float* dst = p.out + (size_t)row * 1024;
        const float rstd = rsqrtf(ss[r] * (1.f / 1024.f) + EPS);
#pragma unroll
        for (int i = 0; i < 4; ++i) {
          const int c = (i * 64 + lane) * 4;
          float4 w4 = *(const float4*)(p.final_norm_w + c);
          *(float4*)(dst + c) = make_float4(v[r][i].x * rstd * w4.x, v[r][i].y * rstd * w4.y, v[r][i].z * rstd * w4.z, v[r][i].w * rstd * w4.w);
        }
      }
    }
  }
}

__global__ void __launch_bounds__(256, 2) hybrid_trunk_mega(Params p) {
  cg::grid_group grid = cg::this_grid();
  const int wid = __builtin_amdgcn_readfirstlane((int)(threadIdx.x >> 6));
  __shared__ __attribute__((aligned(16))) char lds[LDS_BYTES];
  __shared__ uint4 xb_words;
  if (tid_fresh(p, wid) == 0) xb_words = make_uint4(0u, 0u, 0u, 0u);
  phase0(p, wid, lds);
  grid.sync();
  if (tid_fresh(p, wid) == 0) (void)xb_add(&((unsigned*)(p.ws + OFF_BAR))[XB_XCNT(xb_xcc_id())], 1u);
  float* ctx1 = (float*)(p.ws + OFF_CTX1);
#pragma unroll 1
  for (int layer = 0; layer < 2; ++layer) {
    const float* xl = layer == 0 ? p.x : p.out;
    const float* xc = layer == 0 ? p.ctx : ctx1;
    const int M = layer == 0 ? NT : NL;
    phase_h(p, wid, layer, xl, xc, NT);
    xcd_barrier(p, wid, (volatile LAS unsigned*)&xb_words);
    phase_p1(p, wid, layer, NT, lds);
    xcd_barrier(p, wid, (volatile LAS unsigned*)&xb_words);
#ifdef DUP_GEMM
    phase_p1(p, wid, layer, NT, lds);
    xcd_barrier(p, wid, (volatile LAS unsigned*)&xb_words);
#endif
    phase_conv(p, wid, layer);
    xcd_barrier(p, wid, (volatile LAS unsigned*)&xb_words);
#ifdef PROBE_SCAN
    for (int it = blockIdx.x; it < 192; it += gridDim.x) { if (it < 64) scan_item<true>(p, wid, layer, it, lds); else scan_item<false>(p, wid, layer, it - 64, lds); }
    xcd_barrier(p, wid, (volatile LAS unsigned*)&xb_words);
#endif
    phase_mixers(p, wid, layer, lds);
    xcd_barrier(p, wid, (volatile LAS unsigned*)&xb_words);
    phase_z(p, wid, layer, M, lds);
    xcd_barrier(p, wid, (volatile LAS unsigned*)&xb_words);
#ifdef DUP_GEMM
    phase_z(p, wid, layer, M, lds);
    xcd_barrier(p, wid, (volatile LAS unsigned*)&xb_words);
#endif
    phase_post(p, wid, layer, M);
    xcd_barrier(p, wid, (volatile LAS unsigned*)&xb_words);
    phase_merge(p, wid, layer, M, lds);
    xcd_barrier(p, wid, (volatile LAS unsigned*)&xb_words);
#ifdef DUP_GEMM
    phase_merge(p, wid, layer, M, lds);
    xcd_barrier(p, wid, (volatile LAS unsigned*)&xb_words);
#endif
    phase_out(p, wid, layer, M, xl, xc, p.out, ctx1, lds);
    xcd_barrier(p, wid, (volatile LAS unsigned*)&xb_words);
  }
  phase_final(p, wid);
}

extern "C" void kernel_launch(void* const* d_in, const int* in_sizes, int n_in, void* d_out, int out_size, void* d_ws,
                              size_t ws_size, hipStream_t stream) {
  (void)in_sizes; (void)n_in; (void)out_size;
  static int grid_blocks = 0;
  if (!grid_blocks) {
    int dev = 0, cus = 0, per_cu = 0;
    hipGetDevice(&dev);
    hipDeviceGetAttribute(&cus, hipDeviceAttributeMultiprocessorCount, dev);
    hipOccupancyMaxActiveBlocksPerMultiprocessor(&per_cu, hybrid_trunk_mega, 256, 0);
    (void)per_cu;
    grid_blocks = cus * 2;
  }
  if (ws_size < WS_TOTAL) { fprintf(stderr, "workspace too small: %zu < %zu\n", ws_size, (size_t)WS_TOTAL); return; }
  Params p{};
  const float** f = (const float**)&p;
  for (int i = 0; i < 24; ++i) f[i] = (const float*)d_in[i];
  p.wid = 0; p.pad_ = 0;
  p.out = (float*)d_out;
  p.ws = (char*)d_ws;
  void* args[] = {&p};
  hipError_t e = hipLaunchCooperativeKernel((const void*)hybrid_trunk_mega, dim3(grid_blocks), dim3(256), args, 0, stream);
  if (e != hipSuccess && (grid_blocks & 15) == 0) {
    (void)hipGetLastError();
    grid_blocks >>= 1;
    e = hipLaunchCooperativeKernel((const void*)hybrid_trunk_mega, dim3(grid_blocks), dim3(256), args, 0, stream);
  }
  if (e != hipSuccess) fprintf(stderr, "cooperative launch failed: %s (grid %d)\n", hipGetErrorString(e), grid_blocks);
}
```

```cpp
#include <hip/hip_runtime.h>
#include <hip/hip_cooperative_groups.h>
#include <stdint.h>
#include <stdio.h>
namespace cg = cooperative_groups;

typedef unsigned short bf16;
using bf16x8 = __attribute__((ext_vector_type(8))) short;
using f32x16 = __attribute__((ext_vector_type(16))) float;
using u32x8 = __attribute__((ext_vector_type(8))) unsigned int;
#define DI __device__ __forceinline__
#define MFMA32(a, b, c) __builtin_amdgcn_mfma_f32_32x32x16_bf16((a), (b), (c), 0, 0, 0)
#define MM(a_, b_, c_) (SWAP ? MFMA32((b_), (a_), (c_)) : MFMA32((a_), (b_), (c_)))

typedef __bf16 hbf16x2 __attribute__((ext_vector_type(2)));
typedef float f32x2 __attribute__((ext_vector_type(2)));
DI uint32_t pack2(float a, float b) { f32x2 v = {a, b}; return __builtin_bit_cast(uint32_t, __builtin_convertvector(v, hbf16x2)); }
DI bf16 f2b(float x) { return (bf16)(pack2(x, x) & 0xffffu); }
DI float blo(uint32_t u) { return __uint_as_float(u << 16); }
DI float bhi(uint32_t u) { return __uint_as_float(u & 0xffff0000u); }
DI float max3f(float a, float b, float c) { float r; asm("v_max3_f32 %0, %1, %2, %3" : "=v"(r) : "v"(a), "v"(b), "v"(c)); return r; }
DI float xhalf_max(float x) {
  const unsigned u = __float_as_uint(x);
  const auto r = __builtin_amdgcn_permlane32_swap(u, u, false, false);
  float m; asm("v_max_f32 %0, %1, %2" : "=v"(m) : "v"(__uint_as_float(r[0])), "v"(__uint_as_float(r[1]))); return m;
}
DI float siluf(float x) { return x / (1.f + __expf(-x)); }
DI float sigmf(float x) { return 1.f / (1.f + __expf(-x)); }

constexpr int NB = 8, SEQ = 8192, CTX = 256, DM = 1024;
constexpr int NL = NB * SEQ;
constexpr int NC = NB * CTX;
constexpr int NT = NL + NC;
constexpr int KEYS = CTX + SEQ;
constexpr int INW = 7984;
constexpr int N1 = 3456, N2 = 1536, N3 = 3072;
constexpr float EPS = 1e-6f;
constexpr float QSCALE = 0.125f * 1.4426950408889634f;

constexpr size_t al256(size_t x) { return (x + 255) & ~(size_t)255; }
constexpr size_t SZ_W1 = (size_t)N1 * 1024 * 2, SZ_W2 = (size_t)N2 * 1024 * 2, SZ_W3 = (size_t)N3 * 1024 * 2;
constexpr size_t SZ_WOUT = (size_t)1024 * 512 * 2, SZ_WO = (size_t)1024 * 1024 * 2;
constexpr size_t LW = SZ_W1 + SZ_W2 + SZ_W3 + 3 * SZ_WOUT + SZ_WO;
constexpr size_t OFF_W = 0;
constexpr size_t OFF_MOD = OFF_W + 2 * LW;
constexpr size_t OFF_ROPE = OFF_MOD + al256((size_t)2 * 9 * 3072 * 4);
constexpr size_t OFF_MISC = OFF_ROPE + (size_t)128 * 16 * 2 * 4;
constexpr size_t OFF_H = OFF_MISC + 256;
constexpr size_t OFF_QA = OFF_H + (size_t)NT * 1024 * 2;
constexpr size_t OFF_KA = OFF_QA + (size_t)NT * 512 * 2;
constexpr size_t OFF_VT = OFF_KA + (size_t)NT * 512 * 2;
constexpr size_t OFF_XBC = OFF_VT + (size_t)NT * 512 * 2;
constexpr size_t OFF_XBC2 = OFF_XBC + (size_t)NT * 768 * 2;
constexpr size_t OFF_GQ = OFF_XBC2 + (size_t)NT * 768 * 2;
constexpr size_t OFF_GK = OFF_GQ + (size_t)NT * 256 * 2;
constexpr size_t OFF_GV = OFF_GK + (size_t)NT * 256 * 2;
constexpr size_t OFF_DTLR = OFF_GV + (size_t)NT * 512 * 2;
constexpr size_t OFF_YSF = OFF_DTLR + (size_t)NT * 48 * 4;
constexpr size_t OFF_YSB = OFF_YSF + (size_t)NT * 512 * 2;
constexpr size_t OFF_YGF = OFF_YSB + (size_t)NT * 512 * 2;
constexpr size_t OFF_YGB = OFF_YGF + (size_t)NT * 512 * 2;
constexpr size_t OFF_CTX1 = OFF_YGB + (size_t)NT * 512 * 2;
constexpr size_t OFF_BAR = OFF_CTX1 + (size_t)NC * 1024 * 4;
constexpr size_t WS_TOTAL = OFF_BAR + 16384;
constexpr size_t OFF_Z = OFF_KA;
constexpr size_t OFF_U = OFF_GQ;
static_assert(WS_TOTAL <= ((size_t)1 << 30), "workspace too large");
static_assert((size_t)NT * 1536 * 2 <= OFF_XBC2 - OFF_KA, "Z overlay");
static_assert((size_t)NT * 1024 * 2 <= OFF_DTLR - OFF_GQ, "U overlay");

struct Params {
  const float *x, *c, *ctx, *c_ctx, *w_mod, *b_mod, *norm_w, *w_in, *da_lambda, *da_norm_w, *w_out_da;
  const float *conv_w, *conv_b, *dt_bias, *a_log, *ssm_d, *ssm_norm_w, *w_out_ssm;
  const float *gla_w_gate, *gla_b_gate, *gla_norm_w, *w_out_gla, *w_o, *final_norm_w;
  float* out;
  char* ws;
  int wid, pad_;
};
DI int tid_fresh(const Params& p, const int wid) {
  int t = wid * 64 + (int)__builtin_amdgcn_mbcnt_hi(~0u, __builtin_amdgcn_mbcnt_lo(~0u, 0u));
  asm volatile("" : "+v"(t));
  return t;
}

constexpr int LDS_BYTES = 70 * 1024;

DI int map_w1(int n) {
  if (n < 1536) return n;
  if (n < 2048) return 2048 + (n - 1536);
  if (n < 2304) return 3072 + (n - 2048);
  if (n < 3328) return 3344 + (n - 2304);
  if (n < 3344) return 3328 + (n - 3328);
  if (n < 3376) return 4880 + (n - 3344);
  return -1;
}
DI int map_w2(int n) {
  if (n < 512) return 1536 + n;
  if (n < 1024) return 2560 + (n - 512);
  return 4368 + (n - 1024);
}

DI void tr_tile(const Params& p, const int wid, const float* __restrict__ src, int ldsrc, bf16* __restrict__ dst, int K, int n0, int k0, int mapk, float* tile) {
  const int tid = tid_fresh(p, wid), tx = tid & 63, ty = tid >> 6;
  const int n = n0 + tx;
  int col = n;
  if (mapk == 1) col = map_w1(n); else if (mapk == 2) col = map_w2(n); else if (mapk == 3) col = 4912 + n;
#pragma unroll
  for (int i = 0; i < 16; ++i) {
    int kk = ty + 4 * i;
    tile[kk * 65 + tx] = (col >= 0) ? src[(size_t)(k0 + kk) * ldsrc + col] : 0.f;
  }
  __syncthreads();
#pragma unroll
  for (int i = 0; i < 16; ++i) {
    int nn = ty + 4 * i;
    dst[(size_t)(n0 + nn) * K + k0 + tx] = f2b(tile[tx * 65 + nn]);
  }
  __syncthreads();
}

#define XB_TMO      128
#define XB_XCNT(j)  (256  + 64 * (j))
#define XB_XSUB(j)  (1280 + 64 * (j))
#define XB_XGEN(j)  (2304 + 64 * (j))
#define XB_TOP      3328
#define XB_TOPGEN   3392
#define XCD_BAR_WORDS 3456
#define XB_SPIN_CAP (1u << 18)
#define LAS __attribute__((address_space(3)))
DI unsigned xb_ld(unsigned* q) { return __hip_atomic_load(q, __ATOMIC_RELAXED, __HIP_MEMORY_SCOPE_AGENT); }
DI unsigned xb_add(unsigned* q, unsigned v) { return __hip_atomic_fetch_add(q, v, __ATOMIC_RELAXED, __HIP_MEMORY_SCOPE_AGENT); }
DI unsigned xb_xcc_id() { return (unsigned)__builtin_amdgcn_s_getreg((3 << 11) | 20) & 0xFu; }
#define XB_SPIN(cond, bar) do { unsigned _sp = 0; while (cond) { __builtin_amdgcn_s_sleep(1); \
    if ((++_sp & 255u) == 0u) { if (xb_ld(&(bar)[XB_TMO])) break; if (_sp > XB_SPIN_CAP) { atomicAdd(&(bar)[XB_TMO], 1u); break; } } } } while (0)
struct XcdBarrier { unsigned* bar; unsigned x; volatile LAS unsigned* st; };
DI XcdBarrier xcd_barrier_post(unsigned* bar, volatile LAS unsigned* st, bool t0) {
  XcdBarrier b; b.bar = bar; b.x = xb_xcc_id(); b.st = st;
  if (t0) (void)xb_add(&bar[XB_XCNT(b.x)], 1u);
  return b;
}
DI void xcd_barrier_complete(unsigned* bar, unsigned x, unsigned& nloc, unsigned& nx) {
  const unsigned G = gridDim.x * gridDim.y * gridDim.z;
  unsigned sum, cnt, mine, sp = 0u;
  for (;;) {
    sum = 0u; cnt = 0u; mine = 0u;
#pragma unroll
    for (unsigned j = 0; j < 16; ++j) { const unsigned c = xb_ld(&bar[XB_XCNT(j)]); sum += c; cnt += (c > 0u) ? 1u : 0u; mine = (j == x) ? c : mine; }
    if (sum == G) break;
    __builtin_amdgcn_s_sleep(1);
    if ((++sp & 255u) == 0u) { if (xb_ld(&bar[XB_TMO])) break; if (sp > XB_SPIN_CAP) { atomicAdd(&bar[XB_TMO], 1u); break; } }
  }
  nloc = mine > 0u ? mine : 1u; nx = cnt > 0u ? cnt : 1u;
}
DI void xcd_barrier(const Params& p, const int wid, volatile LAS unsigned* st) {
  asm volatile("s_waitcnt vmcnt(0)" ::: "memory");
  __syncthreads();
  if (tid_fresh(p, wid) == 0) {
    unsigned* bar = (unsigned*)(p.ws + OFF_BAR);
    const unsigned x = xb_xcc_id();
    __builtin_amdgcn_s_waitcnt(0);
    unsigned nloc = st[0], nx = st[1];
    if (nloc == 0u) { xcd_barrier_complete(bar, x, nloc, nx); st[0] = nloc; st[1] = nx; }
    const unsigned old = xb_add(&bar[XB_XSUB(x)], 1u);
    const unsigned gen = old / nloc;
    if (old + 1u == (gen + 1u) * nloc) {
      __builtin_amdgcn_fence(__ATOMIC_RELEASE, "agent");
      asm volatile("s_waitcnt vmcnt(0)" ::: "memory");
      const unsigned og = xb_add(&bar[XB_TOP], 1u);
      const unsigned tg = og / nx;
      if (og + 1u == (tg + 1u) * nx) xb_add(&bar[XB_TOPGEN], 1u);
      else XB_SPIN(xb_ld(&bar[XB_TOPGEN]) == tg, bar);
      __builtin_amdgcn_fence(__ATOMIC_ACQUIRE, "agent");
      xb_add(&bar[XB_XGEN(x)], 1u);
      asm volatile("s_waitcnt vmcnt(0)" ::: "memory");
    } else {
      XB_SPIN(xb_ld(&bar[XB_XGEN(x)]) == gen, bar);
      __builtin_amdgcn_fence(__ATOMIC_ACQUIRE, "agent");
      asm volatile("s_waitcnt vmcnt(0)" ::: "memory");
    }
  }
  __syncthreads();
}

constexpr int TR_PER_LAYER = 864 + 384 + 768 + 384 + 256;
constexpr int P0_ITEMS = 2 * TR_PER_LAYER + 96 + 1;

DI void phase0(const Params& p, const int wid, char* lds) {
  const int tid = tid_fresh(p, wid);
  float* fl = (float*)lds;
  if (blockIdx.x == 0) for (int i = tid; i < XCD_BAR_WORDS; i += 256) ((unsigned*)(p.ws + OFF_BAR))[i] = 0u;
  for (int item = blockIdx.x; item < P0_ITEMS; item += gridDim.x) {
    if (item < 2 * TR_PER_LAYER) {
      const int layer = item / TR_PER_LAYER;
      int j = item % TR_PER_LAYER;
      char* wb = p.ws + OFF_W + (size_t)layer * LW;
      const float* win = p.w_in + (size_t)layer * 1024 * INW;
      if (j < 864) {
        tr_tile(p, wid, win, INW, (bf16*)wb, 1024, (j >> 4) * 64, (j & 15) * 64, 1, fl);
      } else if (j < 1248) {
        j -= 864;
        tr_tile(p, wid, win, INW, (bf16*)(wb + SZ_W1), 1024, (j >> 4) * 64, (j & 15) * 64, 2, fl);
      } else if (j < 2016) {
        j -= 1248;
        tr_tile(p, wid, win, INW, (bf16*)(wb + SZ_W1 + SZ_W2), 1024, (j >> 4) * 64, (j & 15) * 64, 3, fl);
      } else if (j < 2400) {
        j -= 2016;
        const int br = j >> 7, r = j & 127;
        const float* src = (br == 0 ? p.w_out_da : br == 1 ? p.w_out_ssm : p.w_out_gla) + (size_t)layer * 512 * 1024;
        tr_tile(p, wid, src, 1024, (bf16*)(wb + SZ_W1 + SZ_W2 + SZ_W3 + (size_t)br * SZ_WOUT), 512, (r >> 3) * 64, (r & 7) * 64, 0, fl);
      } else {
        j -= 2400;
        tr_tile(p, wid, p.w_o + (size_t)layer * 1024 * 1024, 1024, (bf16*)(wb + SZ_W1 + SZ_W2 + SZ_W3 + 3 * SZ_WOUT), 1024,
                (j >> 4) * 64, (j & 15) * 64, 0, fl);
      }
    } else if (item < 2 * TR_PER_LAYER + 96) {
      const int m = item - 2 * TR_PER_LAYER;
      const int layer = m / 48, nc = (m % 48) * 64;
      float* sc = fl;
      float* red = fl + 9 * 1024;
      for (int idx = tid; idx < 9 * 1024; idx += 256) {
        int j = idx >> 10, k = idx & 1023;
        float v = j < 8 ? p.c[j * 1024 + k] : p.c_ctx[k];
        sc[idx] = v / (1.f + expf(-v));
      }
      __syncthreads();
      const int tx = tid & 63, q = tid >> 6;
      float acc[9];
#pragma unroll
      for (int j = 0; j < 9; ++j) acc[j] = 0.f;
      const float* wm = p.w_mod + (size_t)layer * 1024 * 3072 + nc + tx;
#pragma unroll 4
      for (int k = q * 256; k < q * 256 + 256; ++k) {
        float wv = wm[(size_t)k * 3072];
#pragma unroll
        for (int j = 0; j < 9; ++j) acc[j] = fmaf(sc[j * 1024 + k], wv, acc[j]);
      }
#pragma unroll
      for (int j = 0; j < 9; ++j) red[(q * 9 + j) * 64 + tx] = acc[j];
      __syncthreads();
      float* modv = (float*)(p.ws + OFF_MOD);
      for (int idx = tid; idx < 9 * 64; idx += 256) {
        int j = idx >> 6, t = idx & 63;
        float s = red[(0 * 9 + j) * 64 + t] + red[(1 * 9 + j) * 64 + t] + red[(2 * 9 + j) * 64 + t] + red[(3 * 9 + j) * 64 + t];
        modv[(size_t)(layer * 9 + j) * 3072 + nc + t] = s + p.b_mod[layer * 3072 + nc + t];
      }
      __syncthreads();
    } else {
      float* rope = (float*)(p.ws + OFF_ROPE);
      for (int idx = tid; idx < 2048; idx += 256) {
        int pos = idx >> 4, f = idx & 15;
        float inv = (float)exp(-(double)f / 16.0 * 9.210340371976184);
        float angf = (float)pos * inv;
        double a = (double)angf;
        double r = a - 6.283185307179586477 * rint(a * 0.15915494309189533577);
        double r2 = r * r;
        double ts = r, ss = r, tc = 1.0, cs = 1.0;
#pragma unroll 1
        for (int n = 1; n <= 12; ++n) {
          tc *= -r2 / (double)((2 * n - 1) * (2 * n));
          cs += tc;
          ts *= -r2 / (double)((2 * n) * (2 * n + 1));
          ss += ts;
        }
        rope[idx * 2] = (float)cs;
        rope[idx * 2 + 1] = (float)ss;
      }
      float* misc = (float*)(p.ws + OFF_MISC);
      if (tid < 2) {
        const float* lm = p.da_lambda + tid * 4 * 64;
        float s1 = 0.f, s2 = 0.f;
        for (int i = 0; i < 64; ++i) { s1 += lm[i] * lm[64 + i]; s2 += lm[128 + i] * lm[192 + i]; }
        float lam_init = 0.8f - 0.6f * expf(-0.3f * (float)tid);
        misc[tid] = expf(s1) - expf(s2) + lam_init;
      }
      if (tid < 32) ((unsigned*)(p.ws + OFF_MISC + 64))[tid] = 0u;
    }
  }
}

DI float wave_sum(float v) {
#pragma unroll
  for (int m = 32; m >= 1; m >>= 1) v += __shfl_xor(v, m);
  return v;
}

DI void phase_h(const Params& p, const int wid, int layer, const float* xl, const float* xc, int M) {
  const int tidf = tid_fresh(p, wid); const int lane = tidf & 63, wave = tidf >> 6;
  bf16* h = (bf16*)(p.ws + OFF_H);
  const float* modv = (const float*)(p.ws + OFF_MOD) + (size_t)layer * 9 * 3072;
  const float* nw = p.norm_w + layer * 1024;
  const int stride = gridDim.x * 4;
  for (int row0 = blockIdx.x * 4 + wave; row0 < M; row0 += 2 * stride) {
    float4 v[2][4];
    float ss[2] = {0.f, 0.f};
#pragma unroll
    for (int r = 0; r < 2; ++r) {
      int row = row0 + r * stride;
      if (row >= M) row = row0;
      const float* src = row < NL ? xl + (size_t)row * 1024 : xc + (size_t)(row - NL) * 1024;
#pragma unroll
      for (int i = 0; i < 4; ++i) v[r][i] = *(const float4*)(src + (i * 64 + lane) * 4);
    }
#pragma unroll
    for (int r = 0; r < 2; ++r) {
#pragma unroll
      for (int i = 0; i < 4; ++i) ss[r] += v[r][i].x * v[r][i].x + v[r][i].y * v[r][i].y + v[r][i].z * v[r][i].z + v[r][i].w * v[r][i].w;
      ss[r] = wave_sum(ss[r]);
    }
#pragma unroll
    for (int r = 0; r < 2; ++r) {
      const int row = row0 + r * stride;
      if (row < M) {
        const int j = row < NL ? (row >> 13) : 8;
        const float* shift = modv + j * 3072;
        const float* scale = shift + 1024;
        const float rstd = rsqrtf(ss[r] * (1.f / 1024.f) + EPS);
#pragma unroll
        for (int i = 0; i < 4; ++i) {
          const int c = (i * 64 + lane) * 4;
          float4 w4 = *(const float4*)(nw + c), sc4 = *(const float4*)(scale + c), sh4 = *(const float4*)(shift + c);
          float o0 = v[r][i].x * rstd * w4.x * (1.f + sc4.x) + sh4.x;
          float o1 = v[r][i].y * rstd * w4.y * (1.f + sc4.y) + sh4.y;
          float o2 = v[r][i].z * rstd * w4.z * (1.f + sc4.z) + sh4.z;
          float o3 = v[r][i].w * rstd * w4.w * (1.f + sc4.w) + sh4.w;
          uint2 pk; pk.x = pack2(o0, o1); pk.y = pack2(o2, o3);
          *(uint2*)(h + (size_t)row * 1024 + c) = pk;
        }
      }
    }
  }
}

template <bool SWAP>
DI void gemm_main128(const bf16* __restrict__ A, int lda, const bf16* __restrict__ Bt, int ldb, int K,
                     f32x16 (&acc)[2][2], char* lds, const int tid) {
  bf16* As = (bf16*)lds;
  bf16* Bs = As + 128 * 72;
  const int lane = tid & 63, wave = tid >> 6, wm = wave >> 1, wn = wave & 1;
  const int l31 = lane & 31, lh = lane >> 5;
  const uint32_t aoff = (uint32_t)(((tid >> 3) * lda + (tid & 7) * 8) * 2);
  const uint32_t boff = (uint32_t)(((tid >> 3) * ldb + (tid & 7) * 8) * 2);
  const uint32_t soff = (uint32_t)(((tid >> 3) * 72 + (tid & 7) * 8) * 2);
  const char* Ab = (const char*)A;
  const char* Bb = (const char*)Bt;
  char* Asb = (char*)As;
  char* Bsb = (char*)Bs;
  const size_t astep = (size_t)32 * lda * 2, bstep = (size_t)32 * ldb * 2;
  uint4 ra0, ra1, ra2, ra3, rb0, rb1, rb2, rb3;
#define ALD(i, kb) (*(const uint4*)(Ab + ((size_t)(i) * astep + (kb)) + aoff))
#define BLD(i, kb) (*(const uint4*)(Bb + ((size_t)(i) * bstep + (kb)) + boff))
#define LDALL(kb)                                                          \
  ra0 = ALD(0, kb); ra1 = ALD(1, kb); ra2 = ALD(2, kb); ra3 = ALD(3, kb);  \
  rb0 = BLD(0, kb); rb1 = BLD(1, kb); rb2 = BLD(2, kb); rb3 = BLD(3, kb);
#define SST(base, i, val) (*(uint4*)((base) + (i) * (32 * 72 * 2) + soff) = (val))
  LDALL((size_t)0)
#pragma unroll 1
  for (int k0 = 0; k0 < K; k0 += 64) {
    SST(Asb, 0, ra0); SST(Asb, 1, ra1); SST(Asb, 2, ra2); SST(Asb, 3, ra3);
    SST(Bsb, 0, rb0); SST(Bsb, 1, rb1); SST(Bsb, 2, rb2); SST(Bsb, 3, rb3);
    __syncthreads();
    if (k0 + 64 < K) {
      const size_t kb = (size_t)(k0 + 64) * 2;
      LDALL(kb)
    }
    {
      const bf16* ap = As + (wm * 64 + l31) * 72 + lh * 8;
      const bf16* bp = Bs + (wn * 64 + l31) * 72 + lh * 8;
#define LDA_(tm, ks) (*(const bf16x8*)(ap + (tm) * 32 * 72 + (ks) * 16))
#define LDB_(tn, ks) (*(const bf16x8*)(bp + (tn) * 32 * 72 + (ks) * 16))
#define STEP(B0_, B1_, N0_, N1_, ks, more)                                              \
  if (more) { N0_ = LDB_(0, (ks) + 1); N1_ = LDB_(1, (ks) + 1); }                       \
  acc[0][0] = MM(a0, B0_, acc[0][0]); acc[0][1] = MM(a0, B1_, acc[0][1]);       \
  if (more) a0 = LDA_(0, (ks) + 1);                                                     \
  acc[1][0] = MM(a1, B0_, acc[1][0]); acc[1][1] = MM(a1, B1_, acc[1][1]);       \
  if (more) a1 = LDA_(1, (ks) + 1);                                                     \
  __builtin_amdgcn_sched_barrier(0);
      bf16x8 a0 = LDA_(0, 0), a1 = LDA_(1, 0);
      bf16x8 p0 = LDB_(0, 0), p1 = LDB_(1, 0), q0, q1;
      __builtin_amdgcn_sched_barrier(0);
      STEP(p0, p1, q0, q1, 0, true)
      STEP(q0, q1, p0, p1, 1, true)
      STEP(p0, p1, q0, q1, 2, true)
      STEP(q0, q1, p0, p1, 3, false)
#undef LDA_
#undef LDB_
#undef STEP
    }
    __syncthreads();
  }
#undef LDALL
#undef ALD
#undef BLD
#undef SST
}

template <int TM, int WN>
DI void zero_acc(f32x16 (&acc)[TM][WN]) {
#pragma unroll
  for (int a = 0; a < TM; ++a)
#pragma unroll
    for (int b = 0; b < WN; ++b)
#pragma unroll
      for (int i = 0; i < 16; ++i) acc[a][b][i] = 0.f;
}

template <bool SWAP>
DI void gemm_main256(const bf16* __restrict__ A, int lda, const bf16* __restrict__ Bt, int ldb, int K,
                     f32x16 (&acc)[4][2], char* lds, const int tid) {
  bf16* As = (bf16*)lds;
  bf16* Bs = As + 256 * 72;
  const int lane = tid & 63, wave = tid >> 6, wm = wave >> 1, wn = wave & 1;
  const int l31 = lane & 31, lh = lane >> 5;
  const uint32_t aoff = (uint32_t)(((tid >> 3) * lda + (tid & 7) * 8) * 2);
  const uint32_t boff = (uint32_t)(((tid >> 3) * ldb + (tid & 7) * 8) * 2);
  const uint32_t soff = (uint32_t)(((tid >> 3) * 72 + (tid & 7) * 8) * 2);
  const char* Ab = (const char*)A;
  const char* Bb = (const char*)Bt;
  char* Asb = (char*)As;
  char* Bsb = (char*)Bs;
  const size_t astep = (size_t)32 * lda * 2, bstep = (size_t)32 * ldb * 2;
  uint4 ra0, ra1, ra2, ra3, ra4, ra5, ra6, ra7, rb0, rb1, rb2, rb3;
#define ALD(i, kb) (*(const uint4*)(Ab + ((size_t)(i) * astep + (kb)) + aoff))
#define BLD(i, kb) (*(const uint4*)(Bb + ((size_t)(i) * bstep + (kb)) + boff))
#define LDALL(kb)                                                                      \
  ra0 = ALD(0, kb); ra1 = ALD(1, kb); ra2 = ALD(2, kb); ra3 = ALD(3, kb);              \
  ra4 = ALD(4, kb); ra5 = ALD(5, kb); ra6 = ALD(6, kb); ra7 = ALD(7, kb);              \
  rb0 = BLD(0, kb); rb1 = BLD(1, kb); rb2 = BLD(2, kb); rb3 = BLD(3, kb);
#define SST(base, i, val) (*(uint4*)((base) + (i) * (32 * 72 * 2) + soff) = (val))
  LDALL((size_t)0)
#pragma unroll 1
  for (int k0 = 0; k0 < K; k0 += 64) {
    SST(Asb, 0, ra0); SST(Asb, 1, ra1); SST(Asb, 2, ra2); SST(Asb, 3, ra3);
    SST(Asb, 4, ra4); SST(Asb, 5, ra5); SST(Asb, 6, ra6); SST(Asb, 7, ra7);
    SST(Bsb, 0, rb0); SST(Bsb, 1, rb1); SST(Bsb, 2, rb2); SST(Bsb, 3, rb3);
    __syncthreads();
    if (k0 + 64 < K) {
      const size_t kb = (size_t)(k0 + 64) * 2;
      LDALL(kb)
    }
    {
      const bf16* ap = As + (wm * 128 + l31) * 72 + lh * 8;
      const bf16* bp = Bs + (wn * 64 + l31) * 72 + lh * 8;
#define LDA_(tm, ks) (*(const bf16x8*)(ap + (tm) * 32 * 72 + (ks) * 16))
#define LDB_(tn, ks) (*(const bf16x8*)(bp + (tn) * 32 * 72 + (ks) * 16))
#define STEP(B0_, B1_, N0_, N1_, ks, more)                                              \
  if (more) { N0_ = LDB_(0, (ks) + 1); N1_ = LDB_(1, (ks) + 1); }                       \
  acc[0][0] = MM(a0, B0_, acc[0][0]); acc[0][1] = MM(a0, B1_, acc[0][1]);       \
  if (more) a0 = LDA_(0, (ks) + 1);                                                     \
  acc[1][0] = MM(a1, B0_, acc[1][0]); acc[1][1] = MM(a1, B1_, acc[1][1]);       \
  if (more) a1 = LDA_(1, (ks) + 1);                                                     \
  acc[2][0] = MM(a2, B0_, acc[2][0]); acc[2][1] = MM(a2, B1_, acc[2][1]);       \
  if (more) a2 = LDA_(2, (ks) + 1);                                                     \
  acc[3][0] = MM(a3, B0_, acc[3][0]); acc[3][1] = MM(a3, B1_, acc[3][1]);       \
  if (more) a3 = LDA_(3, (ks) + 1);                                                     \
  __builtin_amdgcn_sched_barrier(0);
      bf16x8 a0 = LDA_(0, 0), a1 = LDA_(1, 0), a2 = LDA_(2, 0), a3 = LDA_(3, 0);
      bf16x8 p0 = LDB_(0, 0), p1 = LDB_(1, 0), q0, q1;
      __builtin_amdgcn_sched_barrier(0);
      STEP(p0, p1, q0, q1, 0, true)
      STEP(q0, q1, p0, p1, 1, true)
      STEP(p0, p1, q0, q1, 2, true)
      STEP(q0, q1, p0, p1, 3, false)
#undef LDA_
#undef LDB_
#undef STEP
    }
    __syncthreads();
  }
#undef LDALL
#undef ALD
#undef BLD
#undef SST
}

DI void store_rows_bf16(bf16* __restrict__ rowp, const f32x16& a, int lh) {
#pragma unroll
  for (int k = 0; k < 4; k += 2) {
    uint32_t ax = pack2(a[4 * k], a[4 * k + 1]), ay = pack2(a[4 * k + 2], a[4 * k + 3]);
    uint32_t bx = pack2(a[4 * k + 4], a[4 * k + 5]), by = pack2(a[4 * k + 6], a[4 * k + 7]);
    const auto rx = __builtin_amdgcn_permlane32_swap(ax, bx, false, false);
    const auto ry = __builtin_amdgcn_permlane32_swap(ay, by, false, false);
    *(uint4*)(rowp + 8 * k + (lh ? 8 : 0)) = make_uint4(rx[0], ry[0], rx[1], ry[1]);
  }
}

DI bool xcd_tile(int it, int MT, int NTN, int PN, int& mt, int& nt) {
  const int x = blockIdx.x & 7, slot = blockIdx.x >> 3, nslots = gridDim.x >> 3;
  const int MTx = MT >> 3;
  const int lt = slot + it * nslots;
  if (lt >= MTx * NTN) return false;
  const int per_panel = MTx * PN;
  const int pn = lt / per_panel, r = lt - pn * per_panel;
  mt = x * MTx + r / PN;
  nt = pn * PN + r % PN;
  return true;
}

DI void phase_p1(const Params& p, const int wid, int layer, int M, char* lds) {
  const bf16* h = (const bf16*)(p.ws + OFF_H);
  const bf16* W1 = (const bf16*)(p.ws + OFF_W + (size_t)layer * LW);
  constexpr int NTN = N1 / 128;
  int mt_, nt_;
  for (int it = 0; xcd_tile(it, M / 256, NTN, 9, mt_, nt_); ++it) {
    const int m0 = mt_ * 256, n0 = nt_ * 128;
    const int tidf = tid_fresh(p, wid); const int lane = tidf & 63, wave = tidf >> 6, wm = wave >> 1, wn = wave & 1, l31 = lane & 31, lh = lane >> 5;
    f32x16 acc[4][2];
    zero_acc<4, 2>(acc);
    const bool lat = m0 < NL;
    if (n0 >= 1024 && n0 < 1536) {
      gemm_main256<false>(h + (size_t)m0 * 1024, 1024, W1 + (size_t)n0 * 1024, 1024, 1024, acc, lds, tidf);
      bf16* Vt = (bf16*)(p.ws + OFF_VT);
#pragma unroll
      for (int tm = 0; tm < 4; ++tm)
#pragma unroll
        for (int tn = 0; tn < 2; ++tn) {
          const int col = n0 + wn * 64 + tn * 32 + l31;
          const int rowb = m0 + wm * 128 + tm * 32 + 4 * lh;
          const int hd = (col - 1024) >> 7, vv = (col - 1024) & 127;
#pragma unroll
          for (int g = 0; g < 4; ++g) {
            const int row0 = rowb + 8 * g;
            int b, key;
            if (lat) { b = row0 >> 13; key = 256 + (row0 & 8191); } else { b = (row0 - NL) >> 8; key = (row0 - NL) & 255; }
            uint2 pk;
            pk.x = pack2(acc[tm][tn][4 * g], acc[tm][tn][4 * g + 1]);
            pk.y = pack2(acc[tm][tn][4 * g + 2], acc[tm][tn][4 * g + 3]);
            *(uint2*)(Vt + ((size_t)((b * 4 + hd) * 128 + vv)) * KEYS + key) = pk;
          }
        }
    } else {
      gemm_main256<true>(h + (size_t)m0 * 1024, 1024, W1 + (size_t)n0 * 1024, 1024, 1024, acc, lds, tidf);
      int rbase = m0 + wm * 128 + l31, loff = wn * 64 + (lh ? 8 : 0);
      asm volatile("" : "+v"(rbase), "+v"(loff));
      if (n0 < 1024) {
        const float2* rope = (const float2*)(p.ws + OFF_ROPE);
        bf16* dst = (bf16*)(p.ws + (n0 < 512 ? OFF_QA : OFF_KA)) + (n0 & 511);
        const float qs = n0 < 512 ? QSCALE : 1.f;
#pragma unroll
        for (int tm = 0; tm < 4; ++tm)
#pragma unroll
          for (int tn = 0; tn < 2; ++tn) {
            const int row = rbase + tm * 32;
            f32x16& r = acc[tm][tn];
            if (lat) {
              const int t = row & 8191;
              const int pos = tn ? (t & 63) : (t >> 6);
              const float4* rp = (const float4*)(rope + pos * 16 + 4 * lh);
#pragma unroll
              for (int hb = 0; hb < 2; ++hb) {
                const float4 c01 = rp[4 * hb], c23 = rp[4 * hb + 1];
                const float cc[4] = {c01.x, c01.z, c23.x, c23.z}, sn[4] = {c01.y, c01.w, c23.y, c23.w};
#pragma unroll
                for (int j = 0; j < 4; ++j) {
                  const int i = 4 * hb + j;
                  const float x0 = r[i], x1 = r[i + 8];
                  r[i] = (x0 * cc[j] - x1 * sn[j]) * qs;
                  r[i + 8] = (x1 * cc[j] + x0 * sn[j]) * qs;
                }
                __builtin_amdgcn_sched_barrier(0);
              }
            } else {
#pragma unroll
              for (int i = 0; i < 16; ++i) r[i] *= qs;
            }
            store_rows_bf16(dst + (size_t)row * 512 + tn * 32 + loff, r, 0);
            __builtin_amdgcn_sched_barrier(0);
          }
      } else if (n0 < 3328) {
        bf16* dst; int ld;
        if (n0 < 2304) { dst = (bf16*)(p.ws + OFF_XBC) + (n0 - 1536); ld = 768; }
        else if (n0 < 2560) { dst = (bf16*)(p.ws + OFF_GQ) + (n0 - 2304); ld = 256; }
        else if (n0 < 2816) { dst = (bf16*)(p.ws + OFF_GK) + (n0 - 2560); ld = 256; }
        else { dst = (bf16*)(p.ws + OFF_GV) + (n0 - 2816); ld = 512; }
#pragma unroll
        for (int tm = 0; tm < 4; ++tm)
#pragma unroll
          for (int tn = 0; tn < 2; ++tn) {
            store_rows_bf16(dst + (size_t)(rbase + tm * 32) * ld + tn * 32 + loff, acc[tm][tn], 0);
            __builtin_amdgcn_sched_barrier(0);
          }
      } else if (wn == 0) {
        float* dtlr = (float*)(p.ws + OFF_DTLR);
#pragma unroll
        for (int tm = 0; tm < 4; ++tm)
#pragma unroll
          for (int tn = 0; tn < 2; ++tn)
#pragma unroll
            for (int g = 0; g < 4; ++g) {
              const int cc = tn * 32 + 8 * g + 4 * lh;
              if (cc < 48)
                *(float4*)(dtlr + (size_t)(rbase + tm * 32) * 48 + cc) =
                    make_float4(acc[tm][tn][4 * g], acc[tm][tn][4 * g + 1], acc[tm][tn][4 * g + 2], acc[tm][tn][4 * g + 3]);
            }
      }
    }
  }
}

DI void phase_conv(const Params& p, const int wid, int layer, int worker, int nworkers) {
  const bf16* xin = (const bf16*)(p.ws + OFF_XBC);
  bf16* xo = (bf16*)(p.ws + OFF_XBC2);
  const float* cw = p.conv_w + layer * 3 * 768;
  const float* cb = p.conv_b + layer * 768;
  const int total = NT * 96;
  for (int idx = worker * 256 + tid_fresh(p, wid); idx < total; idx += nworkers * 256) {
    const int row = idx / 96, c0 = (idx % 96) * 8;
    int t, L;
    if (row < NL) { t = row & 8191; L = 8192; } else { t = (row - NL) & 255; L = 256; }
    uint4 cur = *(const uint4*)(xin + (size_t)row * 768 + c0);
    uint4 prv = make_uint4(0, 0, 0, 0), nxt = make_uint4(0, 0, 0, 0);
    if (t > 0) prv = *(const uint4*)(xin + (size_t)(row - 1) * 768 + c0);
    if (t < L - 1) nxt = *(const uint4*)(xin + (size_t)(row + 1) * 768 + c0);
    const uint32_t cu[4] = {cur.x, cur.y, cur.z, cur.w}, pu[4] = {prv.x, prv.y, prv.z, prv.w}, nu[4] = {nxt.x, nxt.y, nxt.z, nxt.w};
    uint32_t ou[4];
#pragma unroll
    for (int q = 0; q < 4; ++q) {
      const int c = c0 + 2 * q;
      float a0 = cw[c] * blo(pu[q]) + cw[768 + c] * blo(cu[q]) + cw[1536 + c] * blo(nu[q]) + cb[c];
      float a1 = cw[c + 1] * bhi(pu[q]) + cw[768 + c + 1] * bhi(cu[q]) + cw[1536 + c + 1] * bhi(nu[q]) + cb[c + 1];
      ou[q] = pack2(siluf(a0), siluf(a1));
    }
    *(uint4*)(xo + (size_t)row * 768 + c0) = make_uint4(ou[0], ou[1], ou[2], ou[3]);
  }
}

DI int scan_row(int b, int dir, int s) {
  if (s < 256) { int t = dir ? 255 - s : s; return NL + b * 256 + t; }
  int t = s - 256;
  if (dir) t = 8191 - t;
  return b * 8192 + t;
}

template <bool GLA>
DI void scan_item(const Params& p, const int wid, int layer, int item, char* lds) {
  constexpr int CT = 16;
  constexpr int V = GLA ? 128 : 64;
  constexpr int NJ = V / 32;
  constexpr int BV = V / 16;
  float* a_s = (float*)lds;
  float* c_s = a_s + CT * 64;
  float* w_s = c_s + CT * 64;
  float* b_s = w_s + CT * 64;
  float* x_s = b_s + CT * V;
  float* op = x_s + (GLA ? 0 : CT * V);
  float* wg_s = op + CT * 4 * V;
  const int tid = tid_fresh(p, wid), lane = tid & 63, wave = tid >> 6;
  int head, dir, b;
  if (GLA) { head = item & 3; dir = (item >> 2) & 1; b = item >> 3; } else { head = item & 7; dir = (item >> 3) & 1; b = item >> 4; }
  const bf16* xbc = (const bf16*)(p.ws + OFF_XBC2);
  const bf16* gq = (const bf16*)(p.ws + OFF_GQ);
  const bf16* gk = (const bf16*)(p.ws + OFF_GK);
  const bf16* gv = (const bf16*)(p.ws + OFF_GV);
  const float* dtlr = (const float*)(p.ws + OFF_DTLR);
  bf16* yout = (bf16*)(p.ws + (GLA ? (dir ? OFF_YGB : OFF_YGF) : (dir ? OFF_YSB : OFF_YSF)));
  const int ocol = head * V;
  float Aneg = 0.f, Dsk = 0.f, dtb = 0.f;
  if (!GLA) {
    Aneg = -expf(p.a_log[layer * 16 + dir * 8 + head]);
    Dsk = p.ssm_d[layer * 16 + dir * 8 + head];
    dtb = p.dt_bias[layer * 16 + dir * 8 + head];
  } else {
    const float* wg = p.gla_w_gate + ((size_t)(layer * 2 + dir) * 16) * 256 + head * 64;
    for (int idx = tid; idx < 16 * 64; idx += 256) wg_s[idx] = wg[(idx >> 6) * 256 + (idx & 63)];
    if (tid < 64) wg_s[1024 + tid] = p.gla_b_gate[(layer * 2 + dir) * 256 + head * 64 + tid];
  }
  const int st = tid >> 4, sk4 = (tid & 15) * 4, sv = (tid & 15) * BV;
  const int vq = lane & 31, kg = wave * 2 + (lane >> 5);
  float S[8][NJ];
#pragma unroll
  for (int i = 0; i < 8; ++i)
#pragma unroll
    for (int j = 0; j < NJ; ++j) S[i][j] = 0.f;

  uint2 ra, rc; uint4 rbv; float rdt = 0.f; float4 rlr0, rlr1, rlr2, rlr3;
  rlr0 = rlr1 = rlr2 = rlr3 = make_float4(0.f, 0.f, 0.f, 0.f);
  rbv = make_uint4(0, 0, 0, 0);
#define SCAN_PREFETCH(chunk_)                                                                   \
  {                                                                                             \
    const int row_ = scan_row(b, dir, (chunk_) * CT + st);                                      \
    if (GLA) {                                                                                  \
      ra = *(const uint2*)(gk + (size_t)row_ * 256 + head * 64 + sk4);                          \
      rc = *(const uint2*)(gq + (size_t)row_ * 256 + head * 64 + sk4);                          \
      rbv = *(const uint4*)(gv + (size_t)row_ * 512 + head * 128 + sv);                         \
      const float* lr_ = dtlr + (size_t)row_ * 48 + 16 + dir * 16;                              \
      rlr0 = *(const float4*)(lr_); rlr1 = *(const float4*)(lr_ + 4);                           \
      rlr2 = *(const float4*)(lr_ + 8); rlr3 = *(const float4*)(lr_ + 12);                      \
    } else {                                                                                    \
      const int g_ = head >> 2;                                                                 \
      ra = *(const uint2*)(xbc + (size_t)row_ * 768 + 512 + g_ * 64 + sk4);                     \
      rc = *(const uint2*)(xbc + (size_t)row_ * 768 + 640 + g_ * 64 + sk4);                     \
      const uint2 t_ = *(const uint2*)(xbc + (size_t)row_ * 768 + head * 64 + sv);              \
      rbv.x = t_.x; rbv.y = t_.y;                                                               \
      rdt = dtlr[(size_t)row_ * 48 + dir * 8 + head];                                           \
    }                                                                                           \
  }
  SCAN_PREFETCH(0);
  constexpr int NCH = KEYS / CT;
  for (int chunk = 0; chunk < NCH; ++chunk) {
    {
      const float cscale = GLA ? 0.125f : 1.f;
      *(float4*)(a_s + st * 64 + sk4) = make_float4(blo(ra.x), bhi(ra.x), blo(ra.y), bhi(ra.y));
      *(float4*)(c_s + st * 64 + sk4) = make_float4(blo(rc.x) * cscale, bhi(rc.x) * cscale, blo(rc.y) * cscale, bhi(rc.y) * cscale);
      if (GLA) {
        *(float4*)(b_s + st * V + sv) = make_float4(blo(rbv.x), bhi(rbv.x), blo(rbv.y), bhi(rbv.y));
        *(float4*)(b_s + st * V + sv + 4) = make_float4(blo(rbv.z), bhi(rbv.z), blo(rbv.w), bhi(rbv.w));
        float4 zb = *(const float4*)(wg_s + 1024 + sk4);
        float z0 = zb.x, z1 = zb.y, z2 = zb.z, z3 = zb.w;
#define GROW(r_, lv_)                                                  \
  {                                                                    \
    const float4 w0_ = *(const float4*)(wg_s + (r_) * 64 + sk4);       \
    z0 = fmaf((lv_), w0_.x, z0); z1 = fmaf((lv_), w0_.y, z1); z2 = fmaf((lv_), w0_.z, z2); z3 = fmaf((lv_), w0_.w, z3); \
  }
        GROW(0, rlr0.x) GROW(1, rlr0.y) GROW(2, rlr0.z) GROW(3, rlr0.w)
        GROW(4, rlr1.x) GROW(5, rlr1.y) GROW(6, rlr1.z) GROW(7, rlr1.w)
        GROW(8, rlr2.x) GROW(9, rlr2.y) GROW(10, rlr2.z) GROW(11, rlr2.w)
        GROW(12, rlr3.x) GROW(13, rlr3.y) GROW(14, rlr3.z) GROW(15, rlr3.w)
#define LSIG16(zz) expf(((zz) >= 0.f ? -log1pf(expf(-(zz))) : (zz) - log1pf(expf(zz))) * (1.f / 16.f))
        *(float4*)(w_s + st * 64 + sk4) = make_float4(LSIG16(z0), LSIG16(z1), LSIG16(z2), LSIG16(z3));
      } else {
        float zz = rdt + dtb;
        float dt = zz > 20.f ? zz : log1pf(expf(zz));
        float4 xv = make_float4(blo(rbv.x), bhi(rbv.x), blo(rbv.y), bhi(rbv.y));
        *(float4*)(b_s + st * V + sv) = make_float4(xv.x * dt, xv.y * dt, xv.z * dt, xv.w * dt);
        *(float4*)(x_s + st * V + sv) = xv;
        if ((tid & 15) == 0) w_s[st] = expf(dt * Aneg);
      }
    }
    __syncthreads();
    if (chunk + 1 < NCH) SCAN_PREFETCH(chunk + 1);
#pragma unroll 4
    for (int tt = 0; tt < CT; ++tt) {
      const float4 a0 = *(const float4*)(a_s + tt * 64 + kg * 8), a1 = *(const float4*)(a_s + tt * 64 + kg * 8 + 4);
      const float4 c0 = *(const float4*)(c_s + tt * 64 + kg * 8), c1 = *(const float4*)(c_s + tt * 64 + kg * 8 + 4);
      const float av[8] = {a0.x, a0.y, a0.z, a0.w, a1.x, a1.y, a1.z, a1.w};
      const float cv[8] = {c0.x, c0.y, c0.z, c0.w, c1.x, c1.y, c1.z, c1.w};
      float wv[8];
      if (GLA) {
        const float4 w0 = *(const float4*)(w_s + tt * 64 + kg * 8), w1 = *(const float4*)(w_s + tt * 64 + kg * 8 + 4);
        wv[0] = w0.x; wv[1] = w0.y; wv[2] = w0.z; wv[3] = w0.w; wv[4] = w1.x; wv[5] = w1.y; wv[6] = w1.z; wv[7] = w1.w;
      } else {
        const float w = w_s[tt];
#pragma unroll
        for (int i = 0; i < 8; ++i) wv[i] = w;
      }
      float bv[NJ], o[NJ];
#pragma unroll
      for (int j = 0; j < NJ; ++j) { bv[j] = b_s[tt * V + vq + 32 * j]; o[j] = 0.f; }
#pragma unroll
      for (int i = 0; i < 8; ++i)
#pragma unroll
        for (int j = 0; j < NJ; ++j) {
          S[i][j] = fmaf(wv[i], S[i][j], av[i] * bv[j]);
          o[j] = fmaf(cv[i], S[i][j], o[j]);
        }
#pragma unroll
      for (int j = 0; j < NJ; ++j) {
        o[j] += __shfl_xor(o[j], 32);
        if (lane < 32) op[(tt * 4 + wave) * V + vq + 32 * j] = o[j];
      }
    }
    __syncthreads();
    {
      const int row = scan_row(b, dir, chunk * CT + st);
#pragma unroll
      for (int q = 0; q < BV / 4; ++q) {
        const int vc = sv + 4 * q;
        float4 o0 = *(const float4*)(op + (st * 4 + 0) * V + vc), o1 = *(const float4*)(op + (st * 4 + 1) * V + vc);
        float4 o2 = *(const float4*)(op + (st * 4 + 2) * V + vc), o3 = *(const float4*)(op + (st * 4 + 3) * V + vc);
        float r0 = o0.x + o1.x + o2.x + o3.x, r1 = o0.y + o1.y + o2.y + o3.y, r2 = o0.z + o1.z + o2.z + o3.z, r3 = o0.w + o1.w + o2.w + o3.w;
        if (!GLA) {
          float4 xv = *(const float4*)(x_s + st * V + vc);
          r0 = fmaf(Dsk, xv.x, r0); r1 = fmaf(Dsk, xv.y, r1); r2 = fmaf(Dsk, xv.z, r2); r3 = fmaf(Dsk, xv.w, r3);
        }
        uint2 pk; pk.x = pack2(r0, r1); pk.y = pack2(r2, r3);
        *(uint2*)(yout + (size_t)row * 512 + ocol + vc) = pk;
      }
    }
  }
  __syncthreads();
#undef SCAN_PREFETCH
#undef GROW
#undef LSIG16
}

DI bf16x8 pack8(const f32x16& x, int s) {
  uint32_t p0 = pack2(x[8 * s], x[8 * s + 1]), p1 = pack2(x[8 * s + 2], x[8 * s + 3]);
  uint32_t p2 = pack2(x[8 * s + 4], x[8 * s + 5]), p3 = pack2(x[8 * s + 6], x[8 * s + 7]);
  uint4 u = make_uint4(p0, p1, p2, p3);
  return __builtin_bit_cast(bf16x8, u);
}

template <bool GLA>
DI void cscan_item(const Params& p, const int wid, int layer, int item, char* lds) {
  constexpr int RS = 72;
  bf16* Qm = (bf16*)lds;
  bf16* Km = Qm + 64 * RS;
  bf16* KeT = Km + 64 * RS;
  bf16* bT = KeT + 64 * RS;
  bf16* ST = bT + 64 * RS;
  char* R = (char*)(ST + 64 * RS);
  float* Gf = (float*)R;
  bf16* Cm = (bf16*)R;
  float* Gs = (float*)(R + 64 * RS * 2);
  float* tot = (float*)(R + 16384);
  float* lr_s = tot + 256;
  const int tid = tid_fresh(p, wid), lane = tid & 63, wave = tid >> 6, l31 = lane & 31, lh = lane >> 5;
  const int nt = wave & 1, vh = wave >> 1;
  int head, dir, b, vhalf = 0;
  if (GLA) { vhalf = item & 1; head = (item >> 1) & 3; } else { head = item & 7; }
  dir = (item >> 3) & 1; b = item >> 4;
  const bf16* xbc = (const bf16*)(p.ws + OFF_XBC2);
  const bf16* gq = (const bf16*)(p.ws + OFF_GQ);
  const bf16* gk = (const bf16*)(p.ws + OFF_GK);
  const bf16* gv = (const bf16*)(p.ws + OFF_GV);
  const float* dtlr = (const float*)(p.ws + OFF_DTLR);
  bf16* yout = (bf16*)(p.ws + (GLA ? (dir ? OFF_YGB : OFF_YGF) : (dir ? OFF_YSB : OFF_YSF)));
  const int ocol = GLA ? head * 128 + vhalf * 64 : head * 64;
  float Aneg = 0.f, Dsk = 0.f, dtb = 0.f, bgk = 0.f;
  float wgk[16];
#pragma unroll
  for (int r = 0; r < 16; ++r) wgk[r] = 0.f;
  if (!GLA) {
    Aneg = -expf(p.a_log[layer * 16 + dir * 8 + head]);
    Dsk = p.ssm_d[layer * 16 + dir * 8 + head];
    dtb = p.dt_bias[layer * 16 + dir * 8 + head];
  } else {
    const float* wg = p.gla_w_gate + ((size_t)(layer * 2 + dir) * 16) * 256 + head * 64 + (tid & 63);
#pragma unroll
    for (int r = 0; r < 16; ++r) wgk[r] = wg[r * 256];
    bgk = p.gla_b_gate[(layer * 2 + dir) * 256 + head * 64 + (tid & 63)];
  }
  const int st = tid >> 2, k16 = (tid & 3) * 16;
  f32x16 Sacc;
#pragma unroll
  for (int i = 0; i < 16; ++i) Sacc[i] = 0.f;

  uint4 ra0, ra1, rc0, rc1, rb0, rb1; float4 rl;
#define CS_PREFETCH(chunk_)                                                                          \
  {                                                                                                  \
    const int row_ = scan_row(b, dir, (chunk_) * 64 + st);                                           \
    if (GLA) {                                                                                       \
      const uint4* ap_ = (const uint4*)(gk + (size_t)row_ * 256 + head * 64 + k16);                  \
      const uint4* cp_ = (const uint4*)(gq + (size_t)row_ * 256 + head * 64 + k16);                  \
      const uint4* bp_ = (const uint4*)(gv + (size_t)row_ * 512 + head * 128 + vhalf * 64 + k16);    \
      ra0 = ap_[0]; ra1 = ap_[1]; rc0 = cp_[0]; rc1 = cp_[1]; rb0 = bp_[0]; rb1 = bp_[1];            \
      rl = *(const float4*)(dtlr + (size_t)row_ * 48 + 16 + dir * 16 + (tid & 3) * 4);               \
    } else {                                                                                         \
      const int g_ = head >> 2;                                                                      \
      const uint4* ap_ = (const uint4*)(xbc + (size_t)row_ * 768 + 512 + g_ * 64 + k16);             \
      const uint4* cp_ = (const uint4*)(xbc + (size_t)row_ * 768 + 640 + g_ * 64 + k16);             \
      const uint4* bp_ = (const uint4*)(xbc + (size_t)row_ * 768 + head * 64 + k16);                 \
      ra0 = ap_[0]; ra1 = ap_[1]; rc0 = cp_[0]; rc1 = cp_[1]; rb0 = bp_[0]; rb1 = bp_[1];            \
      rl.x = dtlr[(size_t)row_ * 48 + dir * 8 + head]; rl.y = 0.f; rl.z = 0.f; rl.w = 0.f;           \
    }                                                                                                \
  }
  CS_PREFETCH(0);
#pragma unroll 1
  for (int chunk = 0; chunk < KEYS / 64; ++chunk) {
    float dt = 0.f;
    if (GLA) {
      *(float4*)(lr_s + st * 16 + (tid & 3) * 4) = rl;
      __syncthreads();
      float Gl[16];
      float run = 0.f;
#pragma unroll
      for (int i = 0; i < 16; ++i) {
        const float* lrp = lr_s + (wave * 16 + i) * 16;
        const float4 l0 = *(const float4*)(lrp), l1 = *(const float4*)(lrp + 4), l2 = *(const float4*)(lrp + 8), l3 = *(const float4*)(lrp + 12);
        float z = bgk;
        z = fmaf(l0.x, wgk[0], z); z = fmaf(l0.y, wgk[1], z); z = fmaf(l0.z, wgk[2], z); z = fmaf(l0.w, wgk[3], z);
        z = fmaf(l1.x, wgk[4], z); z = fmaf(l1.y, wgk[5], z); z = fmaf(l1.z, wgk[6], z); z = fmaf(l1.w, wgk[7], z);
        z = fmaf(l2.x, wgk[8], z); z = fmaf(l2.y, wgk[9], z); z = fmaf(l2.z, wgk[10], z); z = fmaf(l2.w, wgk[11], z);
        z = fmaf(l3.x, wgk[12], z); z = fmaf(l3.y, wgk[13], z); z = fmaf(l3.z, wgk[14], z); z = fmaf(l3.w, wgk[15], z);
        run -= (fmaxf(-z, 0.f) + __logf(1.f + __expf(-fabsf(z)))) * (1.f / 16.f);
        Gl[i] = run;
      }
      tot[wave * 64 + lane] = run;
      __syncthreads();
      float off = 0.f;
      if (wave > 0) off += tot[lane];
      if (wave > 1) off += tot[64 + lane];
      if (wave > 2) off += tot[128 + lane];
#pragma unroll
      for (int i = 0; i < 16; ++i) Gf[(wave * 16 + i) * 64 + lane] = Gl[i] + off;
    } else {
      const float zz = rl.x + dtb;
      dt = zz > 20.f ? zz : log1pf(expf(zz));
      if ((tid & 3) == 0) lr_s[st] = dt;
      __syncthreads();
      if (wave == 0) {
        float g = lr_s[lane] * Aneg;
#pragma unroll
        for (int o = 1; o < 64; o <<= 1) {
          const float v = __shfl_up(g, o);
          if (lane >= o) g += v;
        }
        Gs[lane] = g;
      }
    }
#pragma unroll
    for (int i = 0; i < 16; ++i)
      ST[(32 * (wave >> 1) + (i & 3) + 8 * (i >> 2) + 4 * lh) * RS + 32 * (wave & 1) + l31] = f2b(Sacc[i]);
    __syncthreads();
    {
      const uint32_t au[8] = {ra0.x, ra0.y, ra0.z, ra0.w, ra1.x, ra1.y, ra1.z, ra1.w};
      const uint32_t cu[8] = {rc0.x, rc0.y, rc0.z, rc0.w, rc1.x, rc1.y, rc1.z, rc1.w};
      const uint32_t bu[8] = {rb0.x, rb0.y, rb0.z, rb0.w, rb1.x, rb1.y, rb1.z, rb1.w};
      uint32_t qo[8], ko[8];
      if (GLA) {
#pragma unroll
        for (int q = 0; q < 4; ++q) {
          const float4 G4 = *(const float4*)(Gf + st * 64 + k16 + 4 * q);
          const float4 L4 = *(const float4*)(Gf + 63 * 64 + k16 + 4 * q);
          const float gg[4] = {G4.x, G4.y, G4.z, G4.w}, ll[4] = {L4.x, L4.y, L4.z, L4.w};
#pragma unroll
          for (int h2 = 0; h2 < 2; ++h2) {
            const int w = 2 * q + h2;
            const float a0 = blo(au[w]), a1 = bhi(au[w]), c0 = blo(cu[w]), c1 = bhi(cu[w]);
            const float g0 = gg[2 * h2], g1 = gg[2 * h2 + 1];
            qo[w] = pack2(c0 * 0.125f * __expf(g0), c1 * 0.125f * __expf(g1));
            ko[w] = pack2(a0 * __expf(-g0), a1 * __expf(-g1));
            KeT[(k16 + 2 * w) * RS + st] = f2b(a0 * __expf(ll[2 * h2] - g0));
            KeT[(k16 + 2 * w + 1) * RS + st] = f2b(a1 * __expf(ll[2 * h2 + 1] - g1));
            bT[(k16 + 2 * w) * RS + st] = (bf16)(bu[w] & 0xffffu);
            bT[(k16 + 2 * w + 1) * RS + st] = (bf16)(bu[w] >> 16);
          }
        }
      } else {
        const float Gt = Gs[st], GL = Gs[63];
        const float e1 = __expf(Gt), e3 = __expf(GL - Gt);
#pragma unroll
        for (int w = 0; w < 8; ++w) {
          const float a0 = blo(au[w]), a1 = bhi(au[w]), c0 = blo(cu[w]), c1 = bhi(cu[w]);
          qo[w] = pack2(c0 * e1, c1 * e1);
          ko[w] = au[w];
          KeT[(k16 + 2 * w) * RS + st] = f2b(a0 * e3);
          KeT[(k16 + 2 * w + 1) * RS + st] = f2b(a1 * e3);
          bT[(k16 + 2 * w) * RS + st] = f2b(blo(bu[w]) * dt);
          bT[(k16 + 2 * w + 1) * RS + st] = f2b(bhi(bu[w]) * dt);
        }
        *(uint4*)(Cm + st * RS + k16) = rc0;
        *(uint4*)(Cm + st * RS + k16 + 8) = rc1;
      }
      *(uint4*)(Qm + st * RS + k16) = make_uint4(qo[0], qo[1], qo[2], qo[3]);
      *(uint4*)(Qm + st * RS + k16 + 8) = make_uint4(qo[4], qo[5], qo[6], qo[7]);
      *(uint4*)(Km + st * RS + k16) = make_uint4(ko[0], ko[1], ko[2], ko[3]);
      *(uint4*)(Km + st * RS + k16 + 8) = make_uint4(ko[4], ko[5], ko[6], ko[7]);
    }
    __syncthreads();
    if (chunk + 1 < KEYS / 64) CS_PREFETCH(chunk + 1);
    const int trow = scan_row(b, dir, chunk * 64 + 32 * nt + l31);
    uint2 xr0 = make_uint2(0, 0), xr1 = xr0, xr2 = xr0, xr3 = xr0;
    if (!GLA) {
      const bf16* xp = xbc + (size_t)trow * 768 + head * 64 + 32 * vh + 4 * lh;
      xr0 = *(const uint2*)(xp); xr1 = *(const uint2*)(xp + 8); xr2 = *(const uint2*)(xp + 16); xr3 = *(const uint2*)(xp + 24);
    }
    f32x16 outv;
#pragma unroll
    for (int i = 0; i < 16; ++i) outv[i] = 0.f;
    const bf16* Qp = GLA ? Qm : Cm;
#pragma unroll
    for (int ms = 0; ms < 2; ++ms) {
      if (ms <= nt) {
        f32x16 at;
#pragma unroll
        for (int i = 0; i < 16; ++i) at[i] = 0.f;
#pragma unroll
        for (int ks = 0; ks < 4; ++ks) {
          const bf16x8 kf = *(const bf16x8*)(Km + (32 * ms + l31) * RS + ks * 16 + lh * 8);
          const bf16x8 qf = *(const bf16x8*)(Qp + (32 * nt + l31) * RS + ks * 16 + lh * 8);
          at = MFMA32(kf, qf, at);
        }
        if (!GLA) {
          const float gt = Gs[32 * nt + l31];
#pragma unroll
          for (int g4 = 0; g4 < 4; ++g4) {
            const float4 gs4 = *(const float4*)(Gs + 32 * ms + 8 * g4 + 4 * lh);
            const float gsv[4] = {gs4.x, gs4.y, gs4.z, gs4.w};
#pragma unroll
            for (int j = 0; j < 4; ++j) {
              const int sl = 8 * g4 + 4 * lh + j;
              const bool keep = (ms < nt) || (sl <= l31);
              at[4 * g4 + j] = keep ? at[4 * g4 + j] * __expf(gt - gsv[j]) : 0.f;
            }
          }
        } else if (ms == nt) {
#pragma unroll
          for (int i = 0; i < 16; ++i) {
            const int sl = (i & 3) + 8 * (i >> 2) + 4 * lh;
            at[i] = (sl <= l31) ? at[i] : 0.f;
          }
        }
#pragma unroll
        for (int s2 = 0; s2 < 2; ++s2) {
          const bf16x8 pf = pack8(at, s2);
          const bf16* vp = bT + (32 * vh + l31) * RS + 32 * ms + 16 * s2 + 4 * lh;
          const uint2 lo = *(const uint2*)vp, hi = *(const uint2*)(vp + 8);
          const uint4 u = make_uint4(lo.x, lo.y, hi.x, hi.y);
          outv = MFMA32(__builtin_bit_cast(bf16x8, u), pf, outv);
        }
      }
    }
#pragma unroll
    for (int ks = 0; ks < 4; ++ks) {
      const bf16x8 sf = *(const bf16x8*)(ST + (32 * vh + l31) * RS + ks * 16 + lh * 8);
      const bf16x8 qf = *(const bf16x8*)(Qm + (32 * nt + l31) * RS + ks * 16 + lh * 8);
      outv = MFMA32(sf, qf, outv);
    }
    {
      const float dec = GLA ? __expf(Gf[63 * 64 + 32 * (wave & 1) + l31]) : __expf(Gs[63]);
#pragma unroll
      for (int i = 0; i < 16; ++i) Sacc[i] *= dec;
#pragma unroll
      for (int ks = 0; ks < 4; ++ks) {
        const bf16x8 bf_ = *(const bf16x8*)(bT + (32 * (wave >> 1) + l31) * RS + ks * 16 + lh * 8);
        const bf16x8 kf = *(const bf16x8*)(KeT + (32 * (wave & 1) + l31) * RS + ks * 16 + lh * 8);
        Sacc = MFMA32(bf_, kf, Sacc);
      }
    }
    {
      bf16* yp = yout + (size_t)trow * 512 + ocol + 32 * vh + 4 * lh;
      const uint2 xr[4] = {xr0, xr1, xr2, xr3};
#pragma unroll
      for (int g4 = 0; g4 < 4; ++g4) {
        float r0 = outv[4 * g4], r1 = outv[4 * g4 + 1], r2 = outv[4 * g4 + 2], r3 = outv[4 * g4 + 3];
        if (!GLA) {
          r0 = fmaf(Dsk, blo(xr[g4].x), r0); r1 = fmaf(Dsk, bhi(xr[g4].x), r1);
          r2 = fmaf(Dsk, blo(xr[g4].y), r2); r3 = fmaf(Dsk, bhi(xr[g4].y), r3);
        }
        uint2 pk; pk.x = pack2(r0, r1); pk.y = pack2(r2, r3);
        *(uint2*)(yp + 8 * g4) = pk;
      }
    }
    __syncthreads();
  }
#undef CS_PREFETCH
}


DI void attn_item(const Params& p, const int wid, int layer, int b, int head, int qrow0, int nkeys, char* lds) {
  bf16* Ks = (bf16*)lds;
  bf16* Vs = Ks + 64 * 136;
  bf16* Qa = (bf16*)(p.ws + OFF_QA);
  const bf16* Ka = (const bf16*)(p.ws + OFF_KA);
  const bf16* Vt = (const bf16*)(p.ws + OFF_VT) + (size_t)(b * 4 + head) * 128 * KEYS;
  const int tid = tid_fresh(p, wid), lane = tid & 63, wave = tid >> 6, l31 = lane & 31, lh = lane >> 5;

  bf16* Qs = Vs + 128 * 68;
#pragma unroll
  for (int i = 0; i < 8; ++i) {
    const int ch = tid + 256 * i;
    *(uint4*)(Qs + (ch >> 4) * 136 + (ch & 15) * 8) = *(const uint4*)(Qa + (size_t)(qrow0 + (ch >> 4)) * 512 + head * 128 + (ch & 15) * 8);
  }
  const bf16* qsw = Qs + (wave * 32 + l31) * 136 + lh * 8;
  f32x16 O[2][4];
#pragma unroll
  for (int c = 0; c < 2; ++c)
#pragma unroll
    for (int vt = 0; vt < 4; ++vt)
#pragma unroll
      for (int i = 0; i < 16; ++i) O[c][vt][i] = 0.f;
  float mrun[2] = {-1e30f, -1e30f}, lrun[2] = {0.f, 0.f};

  const int lkey = tid >> 2, lkq = (tid & 3) * 32, lvr = tid >> 1, lvh = (tid & 1) * 32;
#define KROW(key) ((key) < 256 ? NL + b * 256 + (key) : b * 8192 + (key) - 256)
#define KVLOAD(k0_)                                                                                  \
  {                                                                                                  \
    const uint4* kp_ = (const uint4*)(Ka + (size_t)KROW((k0_) + lkey) * 512 + head * 128 + lkq);      \
    rk0 = kp_[0]; rk1 = kp_[1]; rk2 = kp_[2]; rk3 = kp_[3];                                          \
    const uint4* vp_ = (const uint4*)(Vt + (size_t)lvr * KEYS + (k0_) + lvh);                        \
    rv0 = vp_[0]; rv1 = vp_[1]; rv2 = vp_[2]; rv3 = vp_[3];                                          \
  }
#define VST2(dst_, val) { (dst_)[0] = make_uint2((val).x, (val).y); (dst_)[1] = make_uint2((val).z, (val).w); }
  uint4 rk0, rk1, rk2, rk3, rv0, rv1, rv2, rv3;
  KVLOAD(0);
#pragma unroll 1
  for (int k0 = 0; k0 < nkeys; k0 += 64) {
    {
      uint4* kd = (uint4*)(Ks + lkey * 136 + lkq);
      kd[0] = rk0; kd[1] = rk1; kd[2] = rk2; kd[3] = rk3;
      uint2* vd = (uint2*)(Vs + lvr * 68 + lvh);
      VST2(vd, rv0); VST2(vd + 2, rv1); VST2(vd + 4, rv2); VST2(vd + 6, rv3);
    }
    __syncthreads();
    if (k0 + 64 < nkeys) KVLOAD(k0 + 64);
#pragma unroll
    for (int c = 0; c < 2; ++c) {
#pragma unroll
      for (int mt = 0; mt < 2; ++mt) {
        f32x16 sv;
#pragma unroll
        for (int i = 0; i < 16; ++i) sv[i] = 0.f;
#pragma unroll
        for (int ks = 0; ks < 4; ++ks) {
          const bf16x8 qf = *(const bf16x8*)(qsw + c * 64 + ks * 16);
          const bf16x8 kf = *(const bf16x8*)(Ks + (mt * 32 + l31) * 136 + c * 64 + ks * 16 + lh * 8);
          sv = MFMA32(kf, qf, sv);
        }
        __builtin_amdgcn_sched_barrier(0);
        const bf16* vpb = Vs + l31 * 68 + mt * 32 + 4 * lh;
#define VLD_(vt, st) ({ const bf16* vp_ = vpb + (vt) * 32 * 68 + 16 * (st); const uint2 lo_ = *(const uint2*)vp_, hi_ = *(const uint2*)(vp_ + 8); \
                        __builtin_bit_cast(bf16x8, make_uint4(lo_.x, lo_.y, hi_.x, hi_.y)); })
        bf16x8 v0, v1, v2, v3;
        float mx = fmaxf(sv[0], sv[1]);
#pragma unroll
        for (int i = 2; i < 16; i += 2) mx = max3f(mx, sv[i], sv[i + 1]);
        mx = xhalf_max(mx);
        if (__any(mx - mrun[c] > 8.0f)) {
          const float mnew = fmaxf(mrun[c], mx);
          const float alpha = __builtin_amdgcn_exp2f(mrun[c] - mnew);
          mrun[c] = mnew;
          lrun[c] *= alpha;
#pragma unroll
          for (int vt = 0; vt < 4; ++vt)
#pragma unroll
            for (int i = 0; i < 16; ++i) O[c][vt][i] *= alpha;
        }
        float psum = 0.f;
#pragma unroll
        for (int i = 0; i < 16; ++i) {
          float pv = __builtin_amdgcn_exp2f(sv[i] - mrun[c]);
          sv[i] = pv;
          psum += pv;
        }
        lrun[c] += psum;
        v0 = VLD_(0, 0); v1 = VLD_(1, 0); v2 = VLD_(2, 0); v3 = VLD_(3, 0);
        __builtin_amdgcn_sched_barrier(0);
        {
          const bf16x8 pf = pack8(sv, 0);
          O[c][0] = MFMA32(v0, pf, O[c][0]); O[c][1] = MFMA32(v1, pf, O[c][1]);
          O[c][2] = MFMA32(v2, pf, O[c][2]); O[c][3] = MFMA32(v3, pf, O[c][3]);
          v0 = VLD_(0, 1); v1 = VLD_(1, 1); v2 = VLD_(2, 1); v3 = VLD_(3, 1);
        }
        __builtin_amdgcn_sched_barrier(0);
        {
          const bf16x8 pf = pack8(sv, 1);
          O[c][0] = MFMA32(v0, pf, O[c][0]); O[c][1] = MFMA32(v1, pf, O[c][1]);
          O[c][2] = MFMA32(v2, pf, O[c][2]); O[c][3] = MFMA32(v3, pf, O[c][3]);
        }
        __builtin_amdgcn_sched_barrier(0);
#undef VLD_
      }
    }
    __syncthreads();
  }
  const float lam = ((const float*)(p.ws + OFF_MISC))[layer];
  const float lam_init = layer == 0 ? 0.2f : 0.8f - 0.6f * 0.7408182206817179f;
  const float l1 = lrun[0] + __shfl_xor(lrun[0], 32);
  const float l2 = lrun[1] + __shfl_xor(lrun[1], 32);
  const float i1 = 1.f / l1, i2 = lam / l2;
  float ss = 0.f;
#pragma unroll
  for (int vt = 0; vt < 4; ++vt)
#pragma unroll
    for (int i = 0; i < 16; ++i) {
      float o = O[0][vt][i] * i1 - O[1][vt][i] * i2;
      O[0][vt][i] = o;
      ss += o * o;
    }
  ss += __shfl_xor(ss, 32);
  const float rstd = rsqrtf(ss * (1.f / 128.f) + EPS) * (1.f - lam_init);
  const float* nw = p.da_norm_w + layer * 128;
  bf16* orow = Qa + (size_t)(qrow0 + wave * 32 + l31) * 512 + head * 128;
#pragma unroll
  for (int vt = 0; vt < 4; ++vt)
#pragma unroll
    for (int g = 0; g < 4; ++g) {
      const int v0 = vt * 32 + 8 * g + 4 * lh;
      float4 w4 = *(const float4*)(nw + v0);
      uint2 pk;
      pk.x = pack2(O[0][vt][4 * g] * rstd * w4.x, O[0][vt][4 * g + 1] * rstd * w4.y);
      pk.y = pack2(O[0][vt][4 * g + 2] * rstd * w4.z, O[0][vt][4 * g + 3] * rstd * w4.w);
      *(uint2*)(orow + v0) = pk;
    }
}

DI void phase_mixers(const Params& p, const int wid, int layer, char* lds) {
  __shared__ int s_item;
  const int x = blockIdx.x & 7;
  unsigned* counter = (unsigned*)(p.ws + OFF_MISC + 64) + layer * 8 + x;
  const int total = layer == 0 ? 32 + 256 + 8 : 32 + 256;
  bool first = blockIdx.x < 256;
  if (first) {
    phase_conv(p, wid, layer, (int)blockIdx.x, 256);
    asm volatile("s_waitcnt vmcnt(0)" ::: "memory");
    __syncthreads();
    if (tid_fresh(p, wid) == 0) {
      unsigned* cd = (unsigned*)(p.ws + OFF_MISC + 64) + 16 + layer;
      __builtin_amdgcn_fence(__ATOMIC_RELEASE, "agent");
      asm volatile("s_waitcnt vmcnt(0)" ::: "memory");
      (void)xb_add(cd, 1u);
      unsigned sp = 0u;
      while (xb_ld(cd) < 256u) { __builtin_amdgcn_s_sleep(2); if (++sp > (1u << 22)) break; }
      __builtin_amdgcn_fence(__ATOMIC_ACQUIRE, "agent");
      asm volatile("s_waitcnt vmcnt(0)" ::: "memory");
    }
    __syncthreads();
  }
  for (;;) {
    if (tid_fresh(p, wid) == 0) s_item = first ? (int)(blockIdx.x >> 3) : 32 + (int)atomicAdd(counter, 1u);
    first = false;
    __syncthreads();
    const int li = s_item;
    __syncthreads();
    if (li >= total) break;
    if (li < 32) {
      const int sid = li * 8 + x;
      if (sid < 128) cscan_item<true>(p, wid, layer, sid, lds);
      else cscan_item<false>(p, wid, layer, sid - 128, lds);
    } else if (li < 288) {
      const int a = li - 32;
      const int bh = x + 8 * (a >> 6), qb = a & 63;
      attn_item(p, wid, layer, bh >> 2, bh & 3, (bh >> 2) * 8192 + qb * 128, KEYS, lds);
    } else {
      const int c = x * 8 + (li - 288);
      const int bh = c >> 1, qb = c & 1;
      attn_item(p, wid, layer, bh >> 2, bh & 3, NL + (bh >> 2) * 256 + qb * 128, 256, lds);
    }
  }
}

DI void phase_z(const Params& p, const int wid, int layer, int M, char* lds) {
  const bf16* h = (const bf16*)(p.ws + OFF_H);
  const bf16* W2 = (const bf16*)(p.ws + OFF_W + (size_t)layer * LW + SZ_W1);
  bf16* Z = (bf16*)(p.ws + OFF_Z);
  const int tidf = tid_fresh(p, wid); const int lane = tidf & 63, wave = tidf >> 6, wm = wave >> 1, wn = wave & 1, l31 = lane & 31, lh = lane >> 5;
  constexpr int NTN = N2 / 128;
  int mt_, nt_;
  for (int it = 0; xcd_tile(it, M / 256, NTN, 12, mt_, nt_); ++it) {
    const int m0 = mt_ * 256, n0 = nt_ * 128;
    f32x16 acc[4][2];
    zero_acc<4, 2>(acc);
    gemm_main256<true>(h + (size_t)m0 * 1024, 1024, W2 + (size_t)n0 * 1024, 1024, 1024, acc, lds, tidf);
#pragma unroll
    for (int tm = 0; tm < 4; ++tm)
#pragma unroll
      for (int tn = 0; tn < 2; ++tn)
        store_rows_bf16(Z + (size_t)(m0 + wm * 128 + tm * 32 + l31) * 1536 + n0 + wn * 64 + tn * 32, acc[tm][tn], lh);
  }
}

DI void phase_post(const Params& p, const int wid, int layer, int M) {
  const int tidf = tid_fresh(p, wid); const int lane = tidf & 63, wave = tidf >> 6;
  bf16* Z = (bf16*)(p.ws + OFF_Z);
  const bf16* oda = (const bf16*)(p.ws + OFF_QA);
  const bf16* ysf = (const bf16*)(p.ws + OFF_YSF);
  const bf16* ysb = (const bf16*)(p.ws + OFF_YSB);
  const bf16* ygf = (const bf16*)(p.ws + OFF_YGF);
  const bf16* ygb = (const bf16*)(p.ws + OFF_YGB);
  const float* snw = p.ssm_norm_w + layer * 512;
  const float* gnw = p.gla_norm_w + layer * 128;
  const int c0 = lane * 8;
  for (int row = blockIdx.x * 4 + wave; row < M; row += gridDim.x * 4) {
    bf16* zr = Z + (size_t)row * 1536;
    {
      uint4 o = *(const uint4*)(oda + (size_t)row * 512 + c0);
      uint4 z = *(const uint4*)(zr + c0);
      const uint32_t ou[4] = {o.x, o.y, o.z, o.w}, zu[4] = {z.x, z.y, z.z, z.w};
      uint32_t r[4];
#pragma unroll
      for (int q = 0; q < 4; ++q) r[q] = pack2(blo(ou[q]) * siluf(blo(zu[q])), bhi(ou[q]) * siluf(bhi(zu[q])));
      *(uint4*)(zr + c0) = make_uint4(r[0], r[1], r[2], r[3]);
    }
    {
      uint4 yf = *(const uint4*)(ysf + (size_t)row * 512 + c0), yb = *(const uint4*)(ysb + (size_t)row * 512 + c0);
      uint4 z = *(const uint4*)(zr + 512 + c0);
      const uint32_t fu[4] = {yf.x, yf.y, yf.z, yf.w}, bu[4] = {yb.x, yb.y, yb.z, yb.w}, zu[4] = {z.x, z.y, z.z, z.w};
      float y[8];
      float ss = 0.f;
#pragma unroll
      for (int q = 0; q < 4; ++q) {
        y[2 * q] = (blo(fu[q]) + blo(bu[q])) * siluf(blo(zu[q]));
        y[2 * q + 1] = (bhi(fu[q]) + bhi(bu[q])) * siluf(bhi(zu[q]));
        ss += y[2 * q] * y[2 * q] + y[2 * q + 1] * y[2 * q + 1];
      }
#pragma unroll
      for (int m = 16; m >= 1; m >>= 1) ss += __shfl_xor(ss, m);
      const float rstd = rsqrtf(ss * (1.f / 256.f) + EPS);
      float4 w0 = *(const float4*)(snw + c0), w1 = *(const float4*)(snw + c0 + 4);
      uint32_t r[4];
      r[0] = pack2(y[0] * rstd * w0.x, y[1] * rstd * w0.y); r[1] = pack2(y[2] * rstd * w0.z, y[3] * rstd * w0.w);
      r[2] = pack2(y[4] * rstd * w1.x, y[5] * rstd * w1.y); r[3] = pack2(y[6] * rstd * w1.z, y[7] * rstd * w1.w);
      *(uint4*)(zr + 512 + c0) = make_uint4(r[0], r[1], r[2], r[3]);
    }
    {
      uint4 yf = *(const uint4*)(ygf + (size_t)row * 512 + c0), yb = *(const uint4*)(ygb + (size_t)row * 512 + c0);
      uint4 z = *(const uint4*)(zr + 1024 + c0);
      const uint32_t fu[4] = {yf.x, yf.y, yf.z, yf.w}, bu[4] = {yb.x, yb.y, yb.z, yb.w}, zu[4] = {z.x, z.y, z.z, z.w};
      float y[8];
      float ss = 0.f;
#pragma unroll
      for (int q = 0; q < 4; ++q) {
        y[2 * q] = blo(fu[q]) + blo(bu[q]);
        y[2 * q + 1] = bhi(fu[q]) + bhi(bu[q]);
        ss += y[2 * q] * y[2 * q] + y[2 * q + 1] * y[2 * q + 1];
      }
#pragma unroll
      for (int m = 8; m >= 1; m >>= 1) ss += __shfl_xor(ss, m);
      const float rstd = rsqrtf(ss * (1.f / 128.f) + EPS);
      const int cw = c0 & 127;
      float4 w0 = *(const float4*)(gnw + cw), w1 = *(const float4*)(gnw + cw + 4);
      uint32_t r[4];
      r[0] = pack2(y[0] * rstd * w0.x * siluf(blo(zu[0])), y[1] * rstd * w0.y * siluf(bhi(zu[0])));
      r[1] = pack2(y[2] * rstd * w0.z * siluf(blo(zu[1])), y[3] * rstd * w0.w * siluf(bhi(zu[1])));
      r[2] = pack2(y[4] * rstd * w1.x * siluf(blo(zu[2])), y[5] * rstd * w1.y * siluf(bhi(zu[2])));
      r[3] = pack2(y[6] * rstd * w1.z * siluf(blo(zu[3])), y[7] * rstd * w1.w * siluf(bhi(zu[3])));
      *(uint4*)(zr + 1024 + c0) = make_uint4(r[0], r[1], r[2], r[3]);
    }
  }
}

DI void phase_merge(const Params& p, const int wid, int layer, int M, char* lds) {
  const bf16* h = (const bf16*)(p.ws + OFF_H);
  const bf16* osg = (const bf16*)(p.ws + OFF_Z);
  const char* wb = p.ws + OFF_W + (size_t)layer * LW;
  const bf16* W3 = (const bf16*)(wb + SZ_W1 + SZ_W2);
  const bf16* Wout = (const bf16*)(wb + SZ_W1 + SZ_W2 + SZ_W3);
  bf16* U = (bf16*)(p.ws + OFF_U);
  const int tidf = tid_fresh(p, wid); const int lane = tidf & 63, wave = tidf >> 6, wm = wave >> 1, wn = wave & 1, l31 = lane & 31, lh = lane >> 5;
  constexpr int NTN = 1024 / 128;
  int mt_, nt_;
  for (int it = 0; xcd_tile(it, M / 128, NTN, 8, mt_, nt_); ++it) {
    const int m0 = mt_ * 128, n0 = nt_ * 128;
    f32x16 u[2][2];
    zero_acc<2, 2>(u);
#pragma unroll 1
    for (int br = 0; br < 3; ++br) {
      uint32_t* sgl = (uint32_t*)(lds + 36864) + tidf;
      {
        f32x16 g[2][2];
        zero_acc<2, 2>(g);
        gemm_main128<true>(h + (size_t)m0 * 1024, 1024, W3 + (size_t)(br * 1024 + n0) * 1024, 1024, 1024, g, lds, tidf);
#pragma unroll
        for (int tm = 0; tm < 2; ++tm)
#pragma unroll
          for (int tn = 0; tn < 2; ++tn)
#pragma unroll
            for (int q = 0; q < 8; ++q) sgl[((tm * 2 + tn) * 8 + q) * 256] = pack2(sigmf(g[tm][tn][2 * q]), sigmf(g[tm][tn][2 * q + 1]));
      }
      f32x16 t[2][2];
      zero_acc<2, 2>(t);
      gemm_main128<true>(osg + (size_t)m0 * 1536 + br * 512, 1536, Wout + (size_t)br * 1024 * 512 + (size_t)n0 * 512, 512, 512, t, lds, tidf);
#pragma unroll
      for (int tm = 0; tm < 2; ++tm)
#pragma unroll
        for (int tn = 0; tn < 2; ++tn)
#pragma unroll
          for (int q = 0; q < 8; ++q) {
            const uint32_t sgv = sgl[((tm * 2 + tn) * 8 + q) * 256];
            u[tm][tn][2 * q] = fmaf(blo(sgv), t[tm][tn][2 * q], u[tm][tn][2 * q]);
            u[tm][tn][2 * q + 1] = fmaf(bhi(sgv), t[tm][tn][2 * q + 1], u[tm][tn][2 * q + 1]);
          }
    }
#pragma unroll
    for (int tm = 0; tm < 2; ++tm)
#pragma unroll
      for (int tn = 0; tn < 2; ++tn)
        store_rows_bf16(U + (size_t)(m0 + wm * 64 + tm * 32 + l31) * 1024 + n0 + wn * 64 + tn * 32, u[tm][tn], lh);
  }
}

DI void phase_out(const Params& p, const int wid, int layer, int M, const float* xl, const float* xc, float* ol, float* oc, char* lds) {
  const bf16* U = (const bf16*)(p.ws + OFF_U);
  const bf16* Wo = (const bf16*)(p.ws + OFF_W + (size_t)layer * LW + SZ_W1 + SZ_W2 + SZ_W3 + 3 * SZ_WOUT);
  const float* modv = (const float*)(p.ws + OFF_MOD) + (size_t)layer * 9 * 3072;
  const int tidf = tid_fresh(p, wid); const int lane = tidf & 63, wave = tidf >> 6, wm = wave >> 1, wn = wave & 1, l31 = lane & 31, lh = lane >> 5;
  constexpr int NTN = 1024 / 128;
  int mt_, nt_;
  for (int it = 0; xcd_tile(it, M / 256, NTN, 8, mt_, nt_); ++it) {
    const int m0 = mt_ * 256, n0 = nt_ * 128;
    f32x16 acc[4][2];
    zero_acc<4, 2>(acc);
    gemm_main256<true>(U + (size_t)m0 * 1024, 1024, Wo + (size_t)n0 * 1024, 1024, 1024, acc, lds, tidf);
    const bool lat = m0 < NL;
    const int j = lat ? (m0 >> 13) : 8;
    const float* gate = modv + j * 3072 + 2048;
    const float* src = lat ? xl + (size_t)m0 * 1024 : xc + (size_t)(m0 - NL) * 1024;
    float* dst = lat ? ol + (size_t)m0 * 1024 : oc + (size_t)(m0 - NL) * 1024;
    uint32_t eoff = (uint32_t)((wm * 128 + l31) * 1024 + n0 + wn * 64 + 4 * lh);
    asm volatile("" : "+v"(eoff));
    const float* sp = src + eoff;
    float* dp = dst + eoff;
    const float* gp = gate + n0 + wn * 64 + 4 * lh;
#pragma unroll
    for (int tm = 0; tm < 4; ++tm)
#pragma unroll
      for (int tn = 0; tn < 2; ++tn) {
#pragma unroll
        for (int g = 0; g < 4; ++g) {
          const int off = tm * 32 * 1024 + tn * 32 + 8 * g;
          const float4 gt = *(const float4*)(gp + tn * 32 + 8 * g);
          const float4 xo = *(const float4*)(sp + off);
          *(float4*)(dp + off) = make_float4(xo.x + gt.x * acc[tm][tn][4 * g], xo.y + gt.y * acc[tm][tn][4 * g + 1],
                                             xo.z + gt.z * acc[tm][tn][4 * g + 2], xo.w + gt.w * acc[tm][tn][4 * g + 3]);
        }
        __builtin_amdgcn_sched_barrier(0);
      }
  }
}

DI void phase_final(const Params& p, const int wid) {
  const int tidf = tid_fresh(p, wid); const int lane = tidf & 63, wave = tidf >> 6;
  const int stride = gridDim.x * 4;
  for (int row0 = blockIdx.x * 4 + wave; row0 < NL; row0 += 2 * stride) {
    float4 v[2][4];
    float ss[2] = {0.f, 0.f};
#pragma unroll
    for (int r = 0; r < 2; ++r) {
      int row = row0 + r * stride;
      if (row >= NL) row = row0;
      const float* src = p.out + (size_t)row * 1024;
#pragma unroll
      for (int i = 0; i < 4; ++i) v[r][i] = *(const float4*)(src + (i * 64 + lane) * 4);
    }
#pragma unroll
    for (int r = 0; r < 2; ++r) {
#pragma unroll
      for (int i = 0; i < 4; ++i) ss[r] += v[r][i].x * v[r][i].x + v[r][i].y * v[r][i].y + v[r][i].z * v[r][i].z + v[r][i].w * v[r][i].w;
      ss[r] = wave_sum(ss[r]);
    }
#pragma unroll
    for (int r = 0; r < 2; ++r) {
      const int row = row0 + r * stride;
      if (row < NL) {
        float* dst = p.out + (size_t)row * 1024;
        const float rstd = rsqrtf(ss[r] * (1.f / 1024.f) + EPS);
#pragma unroll
        for (int i = 0; i < 4; ++i) {
          const int c = (i * 64 + lane) * 4;
          float4 w4 = *(const float4*)(p.final_norm_w + c);
          *(float4*)(dst + c) = make_float4(v[r][i].x * rstd * w4.x, v[r][i].y * rstd * w4.y, v[r][i].z * rstd * w4.z, v[r][i].w * rstd * w4.w);
        }
      }
    }
  }
}

__global__ void __launch_bounds__(256, 2) hybrid_trunk_mega(Params p) {
  cg::grid_group grid = cg::this_grid();
  const int wid = __builtin_amdgcn_readfirstlane((int)(threadIdx.x >> 6));
  __shared__ __attribute__((aligned(16))) char lds[LDS_BYTES];
  __shared__ uint4 xb_words;
  if (tid_fresh(p, wid) == 0) xb_words = make_uint4(0u, 0u, 0u, 0u);
  phase0(p, wid, lds);
  grid.sync();
  if (tid_fresh(p, wid) == 0) (void)xb_add(&((unsigned*)(p.ws + OFF_BAR))[XB_XCNT(xb_xcc_id())], 1u);
  float* ctx1 = (float*)(p.ws + OFF_CTX1);
#pragma unroll 1
  for (int layer = 0; layer < 2; ++layer) {
    const float* xl = layer == 0 ? p.x : p.out;
    const float* xc = layer == 0 ? p.ctx : ctx1;
    const int M = layer == 0 ? NT : NL;
    phase_h(p, wid, layer, xl, xc, NT);
    xcd_barrier(p, wid, (volatile LAS unsigned*)&xb_words);
    phase_p1(p, wid, layer, NT, lds);
    xcd_barrier(p, wid, (volatile LAS unsigned*)&xb_words);
#ifdef DUP_GEMM
    phase_p1(p, wid, layer, NT, lds);
    xcd_barrier(p, wid, (volatile LAS unsigned*)&xb_words);
#endif
#ifdef PROBE_SCAN
    for (int it = blockIdx.x; it < 192; it += gridDim.x) { if (it < 64) scan_item<true>(p, wid, layer, it, lds); else scan_item<false>(p, wid, layer, it - 64, lds); }
    xcd_barrier(p, wid, (volatile LAS unsigned*)&xb_words);
#endif
    phase_mixers(p, wid, layer, lds);
    xcd_barrier(p, wid, (volatile LAS unsigned*)&xb_words);
    phase_z(p, wid, layer, M, lds);
    xcd_barrier(p, wid, (volatile LAS unsigned*)&xb_words);
#ifdef DUP_GEMM
    phase_z(p, wid, layer, M, lds);
    xcd_barrier(p, wid, (volatile LAS unsigned*)&xb_words);
#endif
    phase_post(p, wid, layer, M);
    xcd_barrier(p, wid, (volatile LAS unsigned*)&xb_words);
    phase_merge(p, wid, layer, M, lds);
    xcd_barrier(p, wid, (volatile LAS unsigned*)&xb_words);
#ifdef DUP_GEMM
    phase_merge(p, wid, layer, M, lds);
    xcd_barrier(p, wid, (volatile LAS unsigned*)&xb_words);
#endif
    phase_out(p, wid, layer, M, xl, xc, p.out, ctx1, lds);
    xcd_barrier(p, wid, (volatile LAS unsigned*)&xb_words);
  }
  phase_final(p, wid);
}

extern "C" void kernel_launch(void* const* d_in, const int* in_sizes, int n_in, void* d_out, int out_size, void* d_ws,
                              size_t ws_size, hipStream_t stream) {
  (void)in_sizes; (void)n_in; (void)out_size;
  static int grid_blocks = 0;
  if (!grid_blocks) {
    int dev = 0, cus = 0, per_cu = 0;
    hipGetDevice(&dev);
    hipDeviceGetAttribute(&cus, hipDeviceAttributeMultiprocessorCount, dev);
    hipOccupancyMaxActiveBlocksPerMultiprocessor(&per_cu, hybrid_trunk_mega, 256, 0);
    (void)per_cu;
    grid_blocks = cus * 2;
  }
  if (ws_size < WS_TOTAL) { fprintf(stderr, "workspace too small: %zu < %zu\n", ws_size, (size_t)WS_TOTAL); return; }
  Params p{};
  const float** f = (const float**)&p;
  for (int i = 0; i < 24; ++i) f[i] = (const float*)d_in[i];
  p.wid = 0; p.pad_ = 0;
  p.out = (float*)d_out;
  p.ws = (char*)d_ws;
  void* args[] = {&p};
  hipError_t e = hipLaunchCooperativeKernel((const void*)hybrid_trunk_mega, dim3(grid_blocks), dim3(256), args, 0, stream);
  if (e != hipSuccess && (grid_blocks & 15) == 0) {
    (void)hipGetLastError();
    grid_blocks >>= 1;
    e = hipLaunchCooperativeKernel((const void*)hybrid_trunk_mega, dim3(grid_blocks), dim3(256), args, 0, stream);
  }
  if (e != hipSuccess) fprintf(stderr, "cooperative launch failed: %s (grid %d)\n", hipGetErrorString(e), grid_blocks);
}
```

```cpp
#include <hip/hip_runtime.h>
#include <hip/hip_cooperative_groups.h>
#include <stdint.h>
#include <stdio.h>
namespace cg = cooperative_groups;

typedef unsigned short bf16;
using bf16x8 = __attribute__((ext_vector_type(8))) short;
using f32x16 = __attribute__((ext_vector_type(16))) float;
using u32x8 = __attribute__((ext_vector_type(8))) unsigned int;
#define DI __device__ __forceinline__
#define MFMA32(a, b, c) __builtin_amdgcn_mfma_f32_32x32x16_bf16((a), (b), (c), 0, 0, 0)
#define MM(a_, b_, c_) (SWAP ? MFMA32((b_), (a_), (c_)) : MFMA32((a_), (b_), (c_)))

typedef __bf16 hbf16x2 __attribute__((ext_vector_type(2)));
typedef float f32x2 __attribute__((ext_vector_type(2)));
DI uint32_t pack2(float a, float b) { f32x2 v = {a, b}; return __builtin_bit_cast(uint32_t, __builtin_convertvector(v, hbf16x2)); }
DI bf16 f2b(float x) { return (bf16)(pack2(x, x) & 0xffffu); }
DI float blo(uint32_t u) { return __uint_as_float(u << 16); }
DI float bhi(uint32_t u) { return __uint_as_float(u & 0xffff0000u); }
DI float max3f(float a, float b, float c) { float r; asm("v_max3_f32 %0, %1, %2, %3" : "=v"(r) : "v"(a), "v"(b), "v"(c)); return r; }
DI float xhalf_max(float x) {
  const unsigned u = __float_as_uint(x);
  const auto r = __builtin_amdgcn_permlane32_swap(u, u, false, false);
  float m; asm("v_max_f32 %0, %1, %2" : "=v"(m) : "v"(__uint_as_float(r[0])), "v"(__uint_as_float(r[1]))); return m;
}
DI float siluf(float x) { return x / (1.f + __expf(-x)); }
DI float sigmf(float x) { return 1.f / (1.f + __expf(-x)); }

constexpr int NB = 8, SEQ = 8192, CTX = 256, DM = 1024;
constexpr int NL = NB * SEQ;
constexpr int NC = NB * CTX;
constexpr int NT = NL + NC;
constexpr int KEYS = CTX + SEQ;
constexpr int INW = 7984;
constexpr int N1 = 3456, N2 = 1536, N3 = 3072;
constexpr float EPS = 1e-6f;
constexpr float QSCALE = 0.125f * 1.4426950408889634f;

constexpr size_t al256(size_t x) { return (x + 255) & ~(size_t)255; }
constexpr size_t SZ_W1 = (size_t)N1 * 1024 * 2, SZ_W2 = (size_t)N2 * 1024 * 2, SZ_W3 = (size_t)N3 * 1024 * 2;
constexpr size_t SZ_WOUT = (size_t)1024 * 512 * 2, SZ_WO = (size_t)1024 * 1024 * 2;
constexpr size_t LW = SZ_W1 + SZ_W2 + SZ_W3 + 3 * SZ_WOUT + SZ_WO;
constexpr size_t OFF_W = 0;
constexpr size_t OFF_MOD = OFF_W + 2 * LW;
constexpr size_t OFF_ROPE = OFF_MOD + al256((size_t)2 * 9 * 3072 * 4);
constexpr size_t OFF_MISC = OFF_ROPE + (size_t)128 * 16 * 2 * 4;
constexpr size_t OFF_H = OFF_MISC + 256;
constexpr size_t OFF_QA = OFF_H + (size_t)NT * 1024 * 2;
constexpr size_t OFF_KA = OFF_QA + (size_t)NT * 512 * 2;
constexpr size_t OFF_VT = OFF_KA + (size_t)NT * 512 * 2;
constexpr size_t OFF_XBC = OFF_VT + (size_t)NT * 512 * 2;
constexpr size_t OFF_XBC2 = OFF_XBC + (size_t)NT * 768 * 2;
constexpr size_t OFF_GQ = OFF_XBC2 + (size_t)NT * 768 * 2;
constexpr size_t OFF_GK = OFF_GQ + (size_t)NT * 256 * 2;
constexpr size_t OFF_GV = OFF_GK + (size_t)NT * 256 * 2;
constexpr size_t OFF_DTLR = OFF_GV + (size_t)NT * 512 * 2;
constexpr size_t OFF_YSF = OFF_DTLR + (size_t)NT * 48 * 4;
constexpr size_t OFF_YSB = OFF_YSF + (size_t)NT * 512 * 2;
constexpr size_t OFF_YGF = OFF_YSB + (size_t)NT * 512 * 2;
constexpr size_t OFF_YGB = OFF_YGF + (size_t)NT * 512 * 2;
constexpr size_t OFF_CTX1 = OFF_YGB + (size_t)NT * 512 * 2;
constexpr size_t OFF_BAR = OFF_CTX1 + (size_t)NC * 1024 * 4;
constexpr size_t WS_TOTAL = OFF_BAR + 16384;
constexpr size_t OFF_Z = OFF_KA;
constexpr size_t OFF_U = OFF_GQ;
static_assert(WS_TOTAL <= ((size_t)1 << 30), "workspace too large");
static_assert((size_t)NT * 1536 * 2 <= OFF_XBC2 - OFF_KA, "Z overlay");
static_assert((size_t)NT * 1024 * 2 <= OFF_DTLR - OFF_GQ, "U overlay");

struct Params {
  const float *x, *c, *ctx, *c_ctx, *w_mod, *b_mod, *norm_w, *w_in, *da_lambda, *da_norm_w, *w_out_da;
  const float *conv_w, *conv_b, *dt_bias, *a_log, *ssm_d, *ssm_norm_w, *w_out_ssm;
  const float *gla_w_gate, *gla_b_gate, *gla_norm_w, *w_out_gla, *w_o, *final_norm_w;
  float* out;
  char* ws;
  int wid, pad_;
};
DI int tid_fresh(const Params& p, const int wid) {
  int t = wid * 64 + (int)__builtin_amdgcn_mbcnt_hi(~0u, __builtin_amdgcn_mbcnt_lo(~0u, 0u));
  asm volatile("" : "+v"(t));
  return t;
}

constexpr int LDS_BYTES = 70 * 1024;

DI int map_w1(int n) {
  if (n < 1536) return n;
  if (n < 2048) return 2048 + (n - 1536);
  if (n < 2304) return 3072 + (n - 2048);
  if (n < 3328) return 3344 + (n - 2304);
  if (n < 3344) return 3328 + (n - 3328);
  if (n < 3376) return 4880 + (n - 3344);
  return -1;
}
DI int map_w2(int n) {
  if (n < 512) return 1536 + n;
  if (n < 1024) return 2560 + (n - 512);
  return 4368 + (n - 1024);
}

DI void tr_tile(const Params& p, const int wid, const float* __restrict__ src, int ldsrc, bf16* __restrict__ dst, int K, int n0, int k0, int mapk, float* tile) {
  const int tid = tid_fresh(p, wid), tx = tid & 63, ty = tid >> 6;
  const int n = n0 + tx;
  int col = n;
  if (mapk == 1) col = map_w1(n); else if (mapk == 2) col = map_w2(n); else if (mapk == 3) col = 4912 + n;
#pragma unroll
  for (int i = 0; i < 16; ++i) {
    int kk = ty + 4 * i;
    tile[kk * 65 + tx] = (col >= 0) ? src[(size_t)(k0 + kk) * ldsrc + col] : 0.f;
  }
  __syncthreads();
#pragma unroll
  for (int i = 0; i < 16; ++i) {
    int nn = ty + 4 * i;
    dst[(size_t)(n0 + nn) * K + k0 + tx] = f2b(tile[tx * 65 + nn]);
  }
  __syncthreads();
}

#define XB_TMO      128
#define XB_XCNT(j)  (256  + 64 * (j))
#define XB_XSUB(j)  (1280 + 64 * (j))
#define XB_XGEN(j)  (2304 + 64 * (j))
#define XB_TOP      3328
#define XB_TOPGEN   3392
#define XCD_BAR_WORDS 3456
#define XB_SPIN_CAP (1u << 18)
#define LAS __attribute__((address_space(3)))
DI unsigned xb_ld(unsigned* q) { return __hip_atomic_load(q, __ATOMIC_RELAXED, __HIP_MEMORY_SCOPE_AGENT); }
DI unsigned xb_add(unsigned* q, unsigned v) { return __hip_atomic_fetch_add(q, v, __ATOMIC_RELAXED, __HIP_MEMORY_SCOPE_AGENT); }
DI unsigned xb_xcc_id() { return (unsigned)__builtin_amdgcn_s_getreg((3 << 11) | 20) & 0xFu; }
#define XB_SPIN(cond, bar) do { unsigned _sp = 0; while (cond) { __builtin_amdgcn_s_sleep(1); \
    if ((++_sp & 255u) == 0u) { if (xb_ld(&(bar)[XB_TMO])) break; if (_sp > XB_SPIN_CAP) { atomicAdd(&(bar)[XB_TMO], 1u); break; } } } } while (0)
struct XcdBarrier { unsigned* bar; unsigned x; volatile LAS unsigned* st; };
DI XcdBarrier xcd_barrier_post(unsigned* bar, volatile LAS unsigned* st, bool t0) {
  XcdBarrier b; b.bar = bar; b.x = xb_xcc_id(); b.st = st;
  if (t0) (void)xb_add(&bar[XB_XCNT(b.x)], 1u);
  return b;
}
DI void xcd_barrier_complete(unsigned* bar, unsigned x, unsigned& nloc, unsigned& nx) {
  const unsigned G = gridDim.x * gridDim.y * gridDim.z;
  unsigned sum, cnt, mine, sp = 0u;
  for (;;) {
    sum = 0u; cnt = 0u; mine = 0u;
#pragma unroll
    for (unsigned j = 0; j < 16; ++j) { const unsigned c = xb_ld(&bar[XB_XCNT(j)]); sum += c; cnt += (c > 0u) ? 1u : 0u; mine = (j == x) ? c : mine; }
    if (sum == G) break;
    __builtin_amdgcn_s_sleep(1);
    if ((++sp & 255u) == 0u) { if (xb_ld(&bar[XB_TMO])) break; if (sp > XB_SPIN_CAP) { atomicAdd(&bar[XB_TMO], 1u); break; } }
  }
  nloc = mine > 0u ? mine : 1u; nx = cnt > 0u ? cnt : 1u;
}
DI void xcd_barrier(const Params& p, const int wid, volatile LAS unsigned* st) {
  asm volatile("s_waitcnt vmcnt(0)" ::: "memory");
  __syncthreads();
  if (tid_fresh(p, wid) == 0) {
    unsigned* bar = (unsigned*)(p.ws + OFF_BAR);
    const unsigned x = xb_xcc_id();
    __builtin_amdgcn_s_waitcnt(0);
    unsigned nloc = st[0], nx = st[1];
    if (nloc == 0u) { xcd_barrier_complete(bar, x, nloc, nx); st[0] = nloc; st[1] = nx; }
    const unsigned old = xb_add(&bar[XB_XSUB(x)], 1u);
    const unsigned gen = old / nloc;
    if (old + 1u == (gen + 1u) * nloc) {
      __builtin_amdgcn_fence(__ATOMIC_RELEASE, "agent");
      asm volatile("s_waitcnt vmcnt(0)" ::: "memory");
      const unsigned og = xb_add(&bar[XB_TOP], 1u);
      const unsigned tg = og / nx;
      if (og + 1u == (tg + 1u) * nx) xb_add(&bar[XB_TOPGEN], 1u);
      else XB_SPIN(xb_ld(&bar[XB_TOPGEN]) == tg, bar);
      __builtin_amdgcn_fence(__ATOMIC_ACQUIRE, "agent");
      xb_add(&bar[XB_XGEN(x)], 1u);
      asm volatile("s_waitcnt vmcnt(0)" ::: "memory");
    } else {
      XB_SPIN(xb_ld(&bar[XB_XGEN(x)]) == gen, bar);
      __builtin_amdgcn_fence(__ATOMIC_ACQUIRE, "agent");
      asm volatile("s_waitcnt vmcnt(0)" ::: "memory");
    }
  }
  __syncthreads();
}

constexpr int TR_PER_LAYER = 864 + 384 + 768 + 384 + 256;
constexpr int P0_ITEMS = 2 * TR_PER_LAYER + 96 + 1;

DI void tr_job(const Params& p, const int wid, int layer, int j, float* fl) {
      char* wb = p.ws + OFF_W + (size_t)layer * LW;
      const float* win = p.w_in + (size_t)layer * 1024 * INW;
      if (j < 864) {
        tr_tile(p, wid, win, INW, (bf16*)wb, 1024, (j >> 4) * 64, (j & 15) * 64, 1, fl);
      } else if (j < 1248) {
        j -= 864;
        tr_tile(p, wid, win, INW, (bf16*)(wb + SZ_W1), 1024, (j >> 4) * 64, (j & 15) * 64, 2, fl);
      } else if (j < 2016) {
        j -= 1248;
        tr_tile(p, wid, win, INW, (bf16*)(wb + SZ_W1 + SZ_W2), 1024, (j >> 4) * 64, (j & 15) * 64, 3, fl);
      } else if (j < 2400) {
        j -= 2016;
        const int br = j >> 7, r = j & 127;
        const float* src = (br == 0 ? p.w_out_da : br == 1 ? p.w_out_ssm : p.w_out_gla) + (size_t)layer * 512 * 1024;
        tr_tile(p, wid, src, 1024, (bf16*)(wb + SZ_W1 + SZ_W2 + SZ_W3 + (size_t)br * SZ_WOUT), 512, (r >> 3) * 64, (r & 7) * 64, 0, fl);
      } else {
        j -= 2400;
        tr_tile(p, wid, p.w_o + (size_t)layer * 1024 * 1024, 1024, (bf16*)(wb + SZ_W1 + SZ_W2 + SZ_W3 + 3 * SZ_WOUT), 1024,
                (j >> 4) * 64, (j & 15) * 64, 0, fl);
      }
}

DI void phase0(const Params& p, const int wid, char* lds) {
  const int tid = tid_fresh(p, wid);
  float* fl = (float*)lds;
  if (blockIdx.x == 0) for (int i = tid; i < XCD_BAR_WORDS; i += 256) ((unsigned*)(p.ws + OFF_BAR))[i] = 0u;
  for (int item = blockIdx.x; item < P0_ITEMS; item += gridDim.x) {
    if (item < 2 * TR_PER_LAYER) {
      if (item < TR_PER_LAYER) tr_job(p, wid, 0, item, fl);
    } else if (item < 2 * TR_PER_LAYER + 96) {
      const int m = item - 2 * TR_PER_LAYER;
      const int layer = m / 48, nc = (m % 48) * 64;
      float* sc = fl;
      float* red = fl + 9 * 1024;
      for (int idx = tid; idx < 9 * 1024; idx += 256) {
        int j = idx >> 10, k = idx & 1023;
        float v = j < 8 ? p.c[j * 1024 + k] : p.c_ctx[k];
        sc[idx] = v / (1.f + expf(-v));
      }
      __syncthreads();
      const int tx = tid & 63, q = tid >> 6;
      float acc[9];
#pragma unroll
      for (int j = 0; j < 9; ++j) acc[j] = 0.f;
      const float* wm = p.w_mod + (size_t)layer * 1024 * 3072 + nc + tx;
#pragma unroll 4
      for (int k = q * 256; k < q * 256 + 256; ++k) {
        float wv = wm[(size_t)k * 3072];
#pragma unroll
        for (int j = 0; j < 9; ++j) acc[j] = fmaf(sc[j * 1024 + k], wv, acc[j]);
      }
#pragma unroll
      for (int j = 0; j < 9; ++j) red[(q * 9 + j) * 64 + tx] = acc[j];
      __syncthreads();
      float* modv = (float*)(p.ws + OFF_MOD);
      for (int idx = tid; idx < 9 * 64; idx += 256) {
        int j = idx >> 6, t = idx & 63;
        float s = red[(0 * 9 + j) * 64 + t] + red[(1 * 9 + j) * 64 + t] + red[(2 * 9 + j) * 64 + t] + red[(3 * 9 + j) * 64 + t];
        modv[(size_t)(layer * 9 + j) * 3072 + nc + t] = s + p.b_mod[layer * 3072 + nc + t];
      }
      __syncthreads();
    } else {
      float* rope = (float*)(p.ws + OFF_ROPE);
      for (int idx = tid; idx < 2048; idx += 256) {
        int pos = idx >> 4, f = idx & 15;
        float inv = (float)exp(-(double)f / 16.0 * 9.210340371976184);
        float angf = (float)pos * inv;
        double a = (double)angf;
        double r = a - 6.283185307179586477 * rint(a * 0.15915494309189533577);
        double r2 = r * r;
        double ts = r, ss = r, tc = 1.0, cs = 1.0;
#pragma unroll 1
        for (int n = 1; n <= 12; ++n) {
          tc *= -r2 / (double)((2 * n - 1) * (2 * n));
          cs += tc;
          ts *= -r2 / (double)((2 * n) * (2 * n + 1));
          ss += ts;
        }
        rope[idx * 2] = (float)cs;
        rope[idx * 2 + 1] = (float)ss;
      }
      float* misc = (float*)(p.ws + OFF_MISC);
      if (tid < 2) {
        const float* lm = p.da_lambda + tid * 4 * 64;
        float s1 = 0.f, s2 = 0.f;
        for (int i = 0; i < 64; ++i) { s1 += lm[i] * lm[64 + i]; s2 += lm[128 + i] * lm[192 + i]; }
        float lam_init = 0.8f - 0.6f * expf(-0.3f * (float)tid);
        misc[tid] = expf(s1) - expf(s2) + lam_init;
      }
      if (tid < 32) ((unsigned*)(p.ws + OFF_MISC + 64))[tid] = 0u;
    }
  }
}

DI float wave_sum(float v) {
#pragma unroll
  for (int m = 32; m >= 1; m >>= 1) v += __shfl_xor(v, m);
  return v;
}

DI void phase_h(const Params& p, const int wid, int layer, const float* xl, const float* xc, int M) {
  const int tidf = tid_fresh(p, wid); const int lane = tidf & 63, wave = tidf >> 6;
  bf16* h = (bf16*)(p.ws + OFF_H);
  const float* modv = (const float*)(p.ws + OFF_MOD) + (size_t)layer * 9 * 3072;
  const float* nw = p.norm_w + layer * 1024;
  const int stride = gridDim.x * 4;
  for (int row0 = blockIdx.x * 4 + wave; row0 < M; row0 += 2 * stride) {
    float4 v[2][4];
    float ss[2] = {0.f, 0.f};
#pragma unroll
    for (int r = 0; r < 2; ++r) {
      int row = row0 + r * stride;
      if (row >= M) row = row0;
      const float* src = row < NL ? xl + (size_t)row * 1024 : xc + (size_t)(row - NL) * 1024;
#pragma unroll
      for (int i = 0; i < 4; ++i) v[r][i] = *(const float4*)(src + (i * 64 + lane) * 4);
    }
#pragma unroll
    for (int r = 0; r < 2; ++r) {
#pragma unroll
      for (int i = 0; i < 4; ++i) ss[r] += v[r][i].x * v[r][i].x + v[r][i].y * v[r][i].y + v[r][i].z * v[r][i].z + v[r][i].w * v[r][i].w;
      ss[r] = wave_sum(ss[r]);
    }
#pragma unroll
    for (int r = 0; r < 2; ++r) {
      const int row = row0 + r * stride;
      if (row < M) {
        const int j = row < NL ? (row >> 13) : 8;
        const float* shift = modv + j * 3072;
        const float* scale = shift + 1024;
        const float rstd = rsqrtf(ss[r] * (1.f / 1024.f) + EPS);
#pragma unroll
        for (int i = 0; i < 4; ++i) {
          const int c = (i * 64 + lane) * 4;
          float4 w4 = *(const float4*)(nw + c), sc4 = *(const float4*)(scale + c), sh4 = *(const float4*)(shift + c);
          float o0 = v[r][i].x * rstd * w4.x * (1.f + sc4.x) + sh4.x;
          float o1 = v[r][i].y * rstd * w4.y * (1.f + sc4.y) + sh4.y;
          float o2 = v[r][i].z * rstd * w4.z * (1.f + sc4.z) + sh4.z;
          float o3 = v[r][i].w * rstd * w4.w * (1.f + sc4.w) + sh4.w;
          uint2 pk; pk.x = pack2(o0, o1); pk.y = pack2(o2, o3);
          *(uint2*)(h + (size_t)row * 1024 + c) = pk;
        }
      }
    }
  }
}

template <bool SWAP>
DI void gemm_main128(const bf16* __restrict__ A, int lda, const bf16* __restrict__ Bt, int ldb, int K,
                     f32x16 (&acc)[2][2], char* lds, const int tid) {
  bf16* As = (bf16*)lds;
  bf16* Bs = As + 128 * 72;
  const int lane = tid & 63, wave = tid >> 6, wm = wave >> 1, wn = wave & 1;
  const int l31 = lane & 31, lh = lane >> 5;
  const uint32_t aoff = (uint32_t)(((tid >> 3) * lda + (tid & 7) * 8) * 2);
  const uint32_t boff = (uint32_t)(((tid >> 3) * ldb + (tid & 7) * 8) * 2);
  const uint32_t soff = (uint32_t)(((tid >> 3) * 72 + (tid & 7) * 8) * 2);
  const char* Ab = (const char*)A;
  const char* Bb = (const char*)Bt;
  char* Asb = (char*)As;
  char* Bsb = (char*)Bs;
  const size_t astep = (size_t)32 * lda * 2, bstep = (size_t)32 * ldb * 2;
  uint4 ra0, ra1, ra2, ra3, rb0, rb1, rb2, rb3;
#define ALD(i, kb) (*(const uint4*)(Ab + ((size_t)(i) * astep + (kb)) + aoff))
#define BLD(i, kb) (*(const uint4*)(Bb + ((size_t)(i) * bstep + (kb)) + boff))
#define LDALL(kb)                                                          \
  ra0 = ALD(0, kb); ra1 = ALD(1, kb); ra2 = ALD(2, kb); ra3 = ALD(3, kb);  \
  rb0 = BLD(0, kb); rb1 = BLD(1, kb); rb2 = BLD(2, kb); rb3 = BLD(3, kb);
#define SST(base, i, val) (*(uint4*)((base) + (i) * (32 * 72 * 2) + soff) = (val))
  LDALL((size_t)0)
#pragma unroll 1
  for (int k0 = 0; k0 < K; k0 += 64) {
    SST(Asb, 0, ra0); SST(Asb, 1, ra1); SST(Asb, 2, ra2); SST(Asb, 3, ra3);
    SST(Bsb, 0, rb0); SST(Bsb, 1, rb1); SST(Bsb, 2, rb2); SST(Bsb, 3, rb3);
    __syncthreads();
    if (k0 + 64 < K) {
      const size_t kb = (size_t)(k0 + 64) * 2;
      LDALL(kb)
    }
    {
      const bf16* ap = As + (wm * 64 + l31) * 72 + lh * 8;
      const bf16* bp = Bs + (wn * 64 + l31) * 72 + lh * 8;
#define LDA_(tm, ks) (*(const bf16x8*)(ap + (tm) * 32 * 72 + (ks) * 16))
#define LDB_(tn, ks) (*(const bf16x8*)(bp + (tn) * 32 * 72 + (ks) * 16))
#define STEP(B0_, B1_, N0_, N1_, ks, more)                                              \
  if (more) { N0_ = LDB_(0, (ks) + 1); N1_ = LDB_(1, (ks) + 1); }                       \
  acc[0][0] = MM(a0, B0_, acc[0][0]); acc[0][1] = MM(a0, B1_, acc[0][1]);       \
  if (more) a0 = LDA_(0, (ks) + 1);                                                     \
  acc[1][0] = MM(a1, B0_, acc[1][0]); acc[1][1] = MM(a1, B1_, acc[1][1]);       \
  if (more) a1 = LDA_(1, (ks) + 1);                                                     \
  __builtin_amdgcn_sched_barrier(0);
      bf16x8 a0 = LDA_(0, 0), a1 = LDA_(1, 0);
      bf16x8 p0 = LDB_(0, 0), p1 = LDB_(1, 0), q0, q1;
      __builtin_amdgcn_sched_barrier(0);
      STEP(p0, p1, q0, q1, 0, true)
      STEP(q0, q1, p0, p1, 1, true)
      STEP(p0, p1, q0, q1, 2, true)
      STEP(q0, q1, p0, p1, 3, false)
#undef LDA_
#undef LDB_
#undef STEP
    }
    __syncthreads();
  }
#undef LDALL
#undef ALD
#undef BLD
#undef SST
}

template <int TM, int WN>
DI void zero_acc(f32x16 (&acc)[TM][WN]) {
#pragma unroll
  for (int a = 0; a < TM; ++a)
#pragma unroll
    for (int b = 0; b < WN; ++b)
#pragma unroll
      for (int i = 0; i < 16; ++i) acc[a][b][i] = 0.f;
}

template <bool SWAP>
DI void gemm_main256(const bf16* __restrict__ A, int lda, const bf16* __restrict__ Bt, int ldb, int K,
                     f32x16 (&acc)[4][2], char* lds, const int tid) {
  bf16* As = (bf16*)lds;
  bf16* Bs = As + 256 * 72;
  const int lane = tid & 63, wave = tid >> 6, wm = wave >> 1, wn = wave & 1;
  const int l31 = lane & 31, lh = lane >> 5;
  const uint32_t aoff = (uint32_t)(((tid >> 3) * lda + (tid & 7) * 8) * 2);
  const uint32_t boff = (uint32_t)(((tid >> 3) * ldb + (tid & 7) * 8) * 2);
  const uint32_t soff = (uint32_t)(((tid >> 3) * 72 + (tid & 7) * 8) * 2);
  const char* Ab = (const char*)A;
  const char* Bb = (const char*)Bt;
  char* Asb = (char*)As;
  char* Bsb = (char*)Bs;
  const size_t astep = (size_t)32 * lda * 2, bstep = (size_t)32 * ldb * 2;
  uint4 ra0, ra1, ra2, ra3, ra4, ra5, ra6, ra7, rb0, rb1, rb2, rb3;
#define ALD(i, kb) (*(const uint4*)(Ab + ((size_t)(i) * astep + (kb)) + aoff))
#define BLD(i, kb) (*(const uint4*)(Bb + ((size_t)(i) * bstep + (kb)) + boff))
#define LDALL(kb)                                                                      \
  ra0 = ALD(0, kb); ra1 = ALD(1, kb); ra2 = ALD(2, kb); ra3 = ALD(3, kb);              \
  ra4 = ALD(4, kb); ra5 = ALD(5, kb); ra6 = ALD(6, kb); ra7 = ALD(7, kb);              \
  rb0 = BLD(0, kb); rb1 = BLD(1, kb); rb2 = BLD(2, kb); rb3 = BLD(3, kb);
#define SST(base, i, val) (*(uint4*)((base) + (i) * (32 * 72 * 2) + soff) = (val))
  LDALL((size_t)0)
#pragma unroll 1
  for (int k0 = 0; k0 < K; k0 += 64) {
    SST(Asb, 0, ra0); SST(Asb, 1, ra1); SST(Asb, 2, ra2); SST(Asb, 3, ra3);
    SST(Asb, 4, ra4); SST(Asb, 5, ra5); SST(Asb, 6, ra6); SST(Asb, 7, ra7);
    SST(Bsb, 0, rb0); SST(Bsb, 1, rb1); SST(Bsb, 2, rb2); SST(Bsb, 3, rb3);
    __syncthreads();
    if (k0 + 64 < K) {
      const size_t kb = (size_t)(k0 + 64) * 2;
      LDALL(kb)
    }
    {
      const bf16* ap = As + (wm * 128 + l31) * 72 + lh * 8;
      const bf16* bp = Bs + (wn * 64 + l31) * 72 + lh * 8;
#define LDA_(tm, ks) (*(const bf16x8*)(ap + (tm) * 32 * 72 + (ks) * 16))
#define LDB_(tn, ks) (*(const bf16x8*)(bp + (tn) * 32 * 72 + (ks) * 16))
#define STEP(B0_, B1_, N0_, N1_, ks, more)                                              \
  if (more) { N0_ = LDB_(0, (ks) + 1); N1_ = LDB_(1, (ks) + 1); }                       \
  acc[0][0] = MM(a0, B0_, acc[0][0]); acc[0][1] = MM(a0, B1_, acc[0][1]);       \
  if (more) a0 = LDA_(0, (ks) + 1);                                                     \
  acc[1][0] = MM(a1, B0_, acc[1][0]); acc[1][1] = MM(a1, B1_, acc[1][1]);       \
  if (more) a1 = LDA_(1, (ks) + 1);                                                     \
  acc[2][0] = MM(a2, B0_, acc[2][0]); acc[2][1] = MM(a2, B1_, acc[2][1]);       \
  if (more) a2 = LDA_(2, (ks) + 1);                                                     \
  acc[3][0] = MM(a3, B0_, acc[3][0]); acc[3][1] = MM(a3, B1_, acc[3][1]);       \
  if (more) a3 = LDA_(3, (ks) + 1);                                                     \
  __builtin_amdgcn_sched_barrier(0);
      bf16x8 a0 = LDA_(0, 0), a1 = LDA_(1, 0), a2 = LDA_(2, 0), a3 = LDA_(3, 0);
      bf16x8 p0 = LDB_(0, 0), p1 = LDB_(1, 0), q0, q1;
      __builtin_amdgcn_sched_barrier(0);
      STEP(p0, p1, q0, q1, 0, true)
      STEP(q0, q1, p0, p1, 1, true)
      STEP(p0, p1, q0, q1, 2, true)
      STEP(q0, q1, p0, p1, 3, false)
#undef LDA_
#undef LDB_
#undef STEP
    }
    __syncthreads();
  }
#undef LDALL
#undef ALD
#undef BLD
#undef SST
}

DI void store_rows_bf16(bf16* __restrict__ rowp, const f32x16& a, int lh) {
#pragma unroll
  for (int k = 0; k < 4; k += 2) {
    uint32_t ax = pack2(a[4 * k], a[4 * k + 1]), ay = pack2(a[4 * k + 2], a[4 * k + 3]);
    uint32_t bx = pack2(a[4 * k + 4], a[4 * k + 5]), by = pack2(a[4 * k + 6], a[4 * k + 7]);
    const auto rx = __builtin_amdgcn_permlane32_swap(ax, bx, false, false);
    const auto ry = __builtin_amdgcn_permlane32_swap(ay, by, false, false);
    *(uint4*)(rowp + 8 * k + (lh ? 8 : 0)) = make_uint4(rx[0], ry[0], rx[1], ry[1]);
  }
}

DI bool xcd_tile(int it, int MT, int NTN, int PN, int& mt, int& nt) {
  const int x = blockIdx.x & 7, slot = blockIdx.x >> 3, nslots = gridDim.x >> 3;
  const int MTx = MT >> 3;
  const int lt = slot + it * nslots;
  if (lt >= MTx * NTN) return false;
  const int per_panel = MTx * PN;
  const int pn = lt / per_panel, r = lt - pn * per_panel;
  mt = x * MTx + r / PN;
  nt = pn * PN + r % PN;
  return true;
}

DI void phase_p1(const Params& p, const int wid, int layer, int M, char* lds) {
  const bf16* h = (const bf16*)(p.ws + OFF_H);
  const bf16* W1 = (const bf16*)(p.ws + OFF_W + (size_t)layer * LW);
  constexpr int NTN = N1 / 128;
  int mt_, nt_;
  for (int it = 0; xcd_tile(it, M / 256, NTN, 9, mt_, nt_); ++it) {
    const int m0 = mt_ * 256, n0 = nt_ * 128;
    const int tidf = tid_fresh(p, wid); const int lane = tidf & 63, wave = tidf >> 6, wm = wave >> 1, wn = wave & 1, l31 = lane & 31, lh = lane >> 5;
    f32x16 acc[4][2];
    zero_acc<4, 2>(acc);
    const bool lat = m0 < NL;
    if (n0 >= 1024 && n0 < 1536) {
      gemm_main256<false>(h + (size_t)m0 * 1024, 1024, W1 + (size_t)n0 * 1024, 1024, 1024, acc, lds, tidf);
      bf16* Vt = (bf16*)(p.ws + OFF_VT);
#pragma unroll
      for (int tm = 0; tm < 4; ++tm)
#pragma unroll
        for (int tn = 0; tn < 2; ++tn) {
          const int col = n0 + wn * 64 + tn * 32 + l31;
          const int rowb = m0 + wm * 128 + tm * 32 + 4 * lh;
          const int hd = (col - 1024) >> 7, vv = (col - 1024) & 127;
#pragma unroll
          for (int g = 0; g < 4; ++g) {
            const int row0 = rowb + 8 * g;
            int b, key;
            if (lat) { b = row0 >> 13; key = 256 + (row0 & 8191); } else { b = (row0 - NL) >> 8; key = (row0 - NL) & 255; }
            uint2 pk;
            pk.x = pack2(acc[tm][tn][4 * g], acc[tm][tn][4 * g + 1]);
            pk.y = pack2(acc[tm][tn][4 * g + 2], acc[tm][tn][4 * g + 3]);
            *(uint2*)(Vt + ((size_t)((b * 4 + hd) * 128 + vv)) * KEYS + key) = pk;
          }
        }
    } else {
      gemm_main256<true>(h + (size_t)m0 * 1024, 1024, W1 + (size_t)n0 * 1024, 1024, 1024, acc, lds, tidf);
      int rbase = m0 + wm * 128 + l31, loff = wn * 64 + (lh ? 8 : 0);
      asm volatile("" : "+v"(rbase), "+v"(loff));
      if (n0 < 1024) {
        const float2* rope = (const float2*)(p.ws + OFF_ROPE);
        bf16* dst = (bf16*)(p.ws + (n0 < 512 ? OFF_QA : OFF_KA)) + (n0 & 511);
        const float qs = n0 < 512 ? QSCALE : 1.f;
#pragma unroll
        for (int tm = 0; tm < 4; ++tm)
#pragma unroll
          for (int tn = 0; tn < 2; ++tn) {
            const int row = rbase + tm * 32;
            f32x16& r = acc[tm][tn];
            if (lat) {
              const int t = row & 8191;
              const int pos = tn ? (t & 63) : (t >> 6);
              const float4* rp = (const float4*)(rope + pos * 16 + 4 * lh);
#pragma unroll
              for (int hb = 0; hb < 2; ++hb) {
                const float4 c01 = rp[4 * hb], c23 = rp[4 * hb + 1];
                const float cc[4] = {c01.x, c01.z, c23.x, c23.z}, sn[4] = {c01.y, c01.w, c23.y, c23.w};
#pragma unroll
                for (int j = 0; j < 4; ++j) {
                  const int i = 4 * hb + j;
                  const float x0 = r[i], x1 = r[i + 8];
                  r[i] = (x0 * cc[j] - x1 * sn[j]) * qs;
                  r[i + 8] = (x1 * cc[j] + x0 * sn[j]) * qs;
                }
                __builtin_amdgcn_sched_barrier(0);
              }
            } else {
#pragma unroll
              for (int i = 0; i < 16; ++i) r[i] *= qs;
            }
            store_rows_bf16(dst + (size_t)row * 512 + tn * 32 + loff, r, 0);
            __builtin_amdgcn_sched_barrier(0);
          }
      } else if (n0 < 3328) {
        bf16* dst; int ld;
        if (n0 < 2304) { dst = (bf16*)(p.ws + OFF_XBC) + (n0 - 1536); ld = 768; }
        else if (n0 < 2560) { dst = (bf16*)(p.ws + OFF_GQ) + (n0 - 2304); ld = 256; }
        else if (n0 < 2816) { dst = (bf16*)(p.ws + OFF_GK) + (n0 - 2560); ld = 256; }
        else { dst = (bf16*)(p.ws + OFF_GV) + (n0 - 2816); ld = 512; }
#pragma unroll
        for (int tm = 0; tm < 4; ++tm)
#pragma unroll
          for (int tn = 0; tn < 2; ++tn) {
            store_rows_bf16(dst + (size_t)(rbase + tm * 32) * ld + tn * 32 + loff, acc[tm][tn], 0);
            __builtin_amdgcn_sched_barrier(0);
          }
      } else if (wn == 0) {
        float* dtlr = (float*)(p.ws + OFF_DTLR);
#pragma unroll
        for (int tm = 0; tm < 4; ++tm)
#pragma unroll
          for (int tn = 0; tn < 2; ++tn)
#pragma unroll
            for (int g = 0; g < 4; ++g) {
              const int cc = tn * 32 + 8 * g + 4 * lh;
              if (cc < 48)
                *(float4*)(dtlr + (size_t)(rbase + tm * 32) * 48 + cc) =
                    make_float4(acc[tm][tn][4 * g], acc[tm][tn][4 * g + 1], acc[tm][tn][4 * g + 2], acc[tm][tn][4 * g + 3]);
            }
      }
    }
  }
}

DI void phase_conv(const Params& p, const int wid, int layer, int worker, int nworkers) {
  const bf16* xin = (const bf16*)(p.ws + OFF_XBC);
  bf16* xo = (bf16*)(p.ws + OFF_XBC2);
  const float* cw = p.conv_w + layer * 3 * 768;
  const float* cb = p.conv_b + layer * 768;
  const int total = NT * 96;
  for (int idx = worker * 256 + tid_fresh(p, wid); idx < total; idx += nworkers * 256) {
    const int row = idx / 96, c0 = (idx % 96) * 8;
    int t, L;
    if (row < NL) { t = row & 8191; L = 8192; } else { t = (row - NL) & 255; L = 256; }
    uint4 cur = *(const uint4*)(xin + (size_t)row * 768 + c0);
    uint4 prv = make_uint4(0, 0, 0, 0), nxt = make_uint4(0, 0, 0, 0);
    if (t > 0) prv = *(const uint4*)(xin + (size_t)(row - 1) * 768 + c0);
    if (t < L - 1) nxt = *(const uint4*)(xin + (size_t)(row + 1) * 768 + c0);
    const uint32_t cu[4] = {cur.x, cur.y, cur.z, cur.w}, pu[4] = {prv.x, prv.y, prv.z, prv.w}, nu[4] = {nxt.x, nxt.y, nxt.z, nxt.w};
    uint32_t ou[4];
#pragma unroll
    for (int q = 0; q < 4; ++q) {
      const int c = c0 + 2 * q;
      float a0 = cw[c] * blo(pu[q]) + cw[768 + c] * blo(cu[q]) + cw[1536 + c] * blo(nu[q]) + cb[c];
      float a1 = cw[c + 1] * bhi(pu[q]) + cw[768 + c + 1] * bhi(cu[q]) + cw[1536 + c + 1] * bhi(nu[q]) + cb[c + 1];
      ou[q] = pack2(siluf(a0), siluf(a1));
    }
    *(uint4*)(xo + (size_t)row * 768 + c0) = make_uint4(ou[0], ou[1], ou[2], ou[3]);
  }
}

DI int scan_row(int b, int dir, int s) {
  if (s < 256) { int t = dir ? 255 - s : s; return NL + b * 256 + t; }
  int t = s - 256;
  if (dir) t = 8191 - t;
  return b * 8192 + t;
}

template <bool GLA>
DI void scan_item(const Params& p, const int wid, int layer, int item, char* lds) {
  constexpr int CT = 16;
  constexpr int V = GLA ? 128 : 64;
  constexpr int NJ = V / 32;
  constexpr int BV = V / 16;
  float* a_s = (float*)lds;
  float* c_s = a_s + CT * 64;
  float* w_s = c_s + CT * 64;
  float* b_s = w_s + CT * 64;
  float* x_s = b_s + CT * V;
  float* op = x_s + (GLA ? 0 : CT * V);
  float* wg_s = op + CT * 4 * V;
  const int tid = tid_fresh(p, wid), lane = tid & 63, wave = tid >> 6;
  int head, dir, b;
  if (GLA) { head = item & 3; dir = (item >> 2) & 1; b = item >> 3; } else { head = item & 7; dir = (item >> 3) & 1; b = item >> 4; }
  const bf16* xbc = (const bf16*)(p.ws + OFF_XBC2);
  const bf16* gq = (const bf16*)(p.ws + OFF_GQ);
  const bf16* gk = (const bf16*)(p.ws + OFF_GK);
  const bf16* gv = (const bf16*)(p.ws + OFF_GV);
  const float* dtlr = (const float*)(p.ws + OFF_DTLR);
  bf16* yout = (bf16*)(p.ws + (GLA ? (dir ? OFF_YGB : OFF_YGF) : (dir ? OFF_YSB : OFF_YSF)));
  const int ocol = head * V;
  float Aneg = 0.f, Dsk = 0.f, dtb = 0.f;
  if (!GLA) {
    Aneg = -expf(p.a_log[layer * 16 + dir * 8 + head]);
    Dsk = p.ssm_d[layer * 16 + dir * 8 + head];
    dtb = p.dt_bias[layer * 16 + dir * 8 + head];
  } else {
    const float* wg = p.gla_w_gate + ((size_t)(layer * 2 + dir) * 16) * 256 + head * 64;
    for (int idx = tid; idx < 16 * 64; idx += 256) wg_s[idx] = wg[(idx >> 6) * 256 + (idx & 63)];
    if (tid < 64) wg_s[1024 + tid] = p.gla_b_gate[(layer * 2 + dir) * 256 + head * 64 + tid];
  }
  const int st = tid >> 4, sk4 = (tid & 15) * 4, sv = (tid & 15) * BV;
  const int vq = lane & 31, kg = wave * 2 + (lane >> 5);
  float S[8][NJ];
#pragma unroll
  for (int i = 0; i < 8; ++i)
#pragma unroll
    for (int j = 0; j < NJ; ++j) S[i][j] = 0.f;

  uint2 ra, rc; uint4 rbv; float rdt = 0.f; float4 rlr0, rlr1, rlr2, rlr3;
  rlr0 = rlr1 = rlr2 = rlr3 = make_float4(0.f, 0.f, 0.f, 0.f);
  rbv = make_uint4(0, 0, 0, 0);
#define SCAN_PREFETCH(chunk_)                                                                   \
  {                                                                                             \
    const int row_ = scan_row(b, dir, (chunk_) * CT + st);                                      \
    if (GLA) {                                                                                  \
      ra = *(const uint2*)(gk + (size_t)row_ * 256 + head * 64 + sk4);                          \
      rc = *(const uint2*)(gq + (size_t)row_ * 256 + head * 64 + sk4);                          \
      rbv = *(const uint4*)(gv + (size_t)row_ * 512 + head * 128 + sv);                         \
      const float* lr_ = dtlr + (size_t)row_ * 48 + 16 + dir * 16;                              \
      rlr0 = *(const float4*)(lr_); rlr1 = *(const float4*)(lr_ + 4);                           \
      rlr2 = *(const float4*)(lr_ + 8); rlr3 = *(const float4*)(lr_ + 12);                      \
    } else {                                                                                    \
      const int g_ = head >> 2;                                                                 \
      ra = *(const uint2*)(xbc + (size_t)row_ * 768 + 512 + g_ * 64 + sk4);                     \
      rc = *(const uint2*)(xbc + (size_t)row_ * 768 + 640 + g_ * 64 + sk4);                     \
      const uint2 t_ = *(const uint2*)(xbc + (size_t)row_ * 768 + head * 64 + sv);              \
      rbv.x = t_.x; rbv.y = t_.y;                                                               \
      rdt = dtlr[(size_t)row_ * 48 + dir * 8 + head];                                           \
    }                                                                                           \
  }
  SCAN_PREFETCH(0);
  constexpr int NCH = KEYS / CT;
  for (int chunk = 0; chunk < NCH; ++chunk) {
    {
      const float cscale = GLA ? 0.125f : 1.f;
      *(float4*)(a_s + st * 64 + sk4) = make_float4(blo(ra.x), bhi(ra.x), blo(ra.y), bhi(ra.y));
      *(float4*)(c_s + st * 64 + sk4) = make_float4(blo(rc.x) * cscale, bhi(rc.x) * cscale, blo(rc.y) * cscale, bhi(rc.y) * cscale);
      if (GLA) {
        *(float4*)(b_s + st * V + sv) = make_float4(blo(rbv.x), bhi(rbv.x), blo(rbv.y), bhi(rbv.y));
        *(float4*)(b_s + st * V + sv + 4) = make_float4(blo(rbv.z), bhi(rbv.z), blo(rbv.w), bhi(rbv.w));
        float4 zb = *(const float4*)(wg_s + 1024 + sk4);
        float z0 = zb.x, z1 = zb.y, z2 = zb.z, z3 = zb.w;
#define GROW(r_, lv_)                                                  \
  {                                                                    \
    const float4 w0_ = *(const float4*)(wg_s + (r_) * 64 + sk4);       \
    z0 = fmaf((lv_), w0_.x, z0); z1 = fmaf((lv_), w0_.y, z1); z2 = fmaf((lv_), w0_.z, z2); z3 = fmaf((lv_), w0_.w, z3); \
  }
        GROW(0, rlr0.x) GROW(1, rlr0.y) GROW(2, rlr0.z) GROW(3, rlr0.w)
        GROW(4, rlr1.x) GROW(5, rlr1.y) GROW(6, rlr1.z) GROW(7, rlr1.w)
        GROW(8, rlr2.x) GROW(9, rlr2.y) GROW(10, rlr2.z) GROW(11, rlr2.w)
        GROW(12, rlr3.x) GROW(13, rlr3.y) GROW(14, rlr3.z) GROW(15, rlr3.w)
#define LSIG16(zz) expf(((zz) >= 0.f ? -log1pf(expf(-(zz))) : (zz) - log1pf(expf(zz))) * (1.f / 16.f))
        *(float4*)(w_s + st * 64 + sk4) = make_float4(LSIG16(z0), LSIG16(z1), LSIG16(z2), LSIG16(z3));
      } else {
        float zz = rdt + dtb;
        float dt = zz > 20.f ? zz : log1pf(expf(zz));
        float4 xv = make_float4(blo(rbv.x), bhi(rbv.x), blo(rbv.y), bhi(rbv.y));
        *(float4*)(b_s + st * V + sv) = make_float4(xv.x * dt, xv.y * dt, xv.z * dt, xv.w * dt);
        *(float4*)(x_s + st * V + sv) = xv;
        if ((tid & 15) == 0) w_s[st] = expf(dt * Aneg);
      }
    }
    __syncthreads();
    if (chunk + 1 < NCH) SCAN_PREFETCH(chunk + 1);
#pragma unroll 4
    for (int tt = 0; tt < CT; ++tt) {
      const float4 a0 = *(const float4*)(a_s + tt * 64 + kg * 8), a1 = *(const float4*)(a_s + tt * 64 + kg * 8 + 4);
      const float4 c0 = *(const float4*)(c_s + tt * 64 + kg * 8), c1 = *(const float4*)(c_s + tt * 64 + kg * 8 + 4);
      const float av[8] = {a0.x, a0.y, a0.z, a0.w, a1.x, a1.y, a1.z, a1.w};
      const float cv[8] = {c0.x, c0.y, c0.z, c0.w, c1.x, c1.y, c1.z, c1.w};
      float wv[8];
      if (GLA) {
        const float4 w0 = *(const float4*)(w_s + tt * 64 + kg * 8), w1 = *(const float4*)(w_s + tt * 64 + kg * 8 + 4);
        wv[0] = w0.x; wv[1] = w0.y; wv[2] = w0.z; wv[3] = w0.w; wv[4] = w1.x; wv[5] = w1.y; wv[6] = w1.z; wv[7] = w1.w;
      } else {
        const float w = w_s[tt];
#pragma unroll
        for (int i = 0; i < 8; ++i) wv[i] = w;
      }
      float bv[NJ], o[NJ];
#pragma unroll
      for (int j = 0; j < NJ; ++j) { bv[j] = b_s[tt * V + vq + 32 * j]; o[j] = 0.f; }
#pragma unroll
      for (int i = 0; i < 8; ++i)
#pragma unroll
        for (int j = 0; j < NJ; ++j) {
          S[i][j] = fmaf(wv[i], S[i][j], av[i] * bv[j]);
          o[j] = fmaf(cv[i], S[i][j], o[j]);
        }
#pragma unroll
      for (int j = 0; j < NJ; ++j) {
        o[j] += __shfl_xor(o[j], 32);
        if (lane < 32) op[(tt * 4 + wave) * V + vq + 32 * j] = o[j];
      }
    }
    __syncthreads();
    {
      const int row = scan_row(b, dir, chunk * CT + st);
#pragma unroll
      for (int q = 0; q < BV / 4; ++q) {
        const int vc = sv + 4 * q;
        float4 o0 = *(const float4*)(op + (st * 4 + 0) * V + vc), o1 = *(const float4*)(op + (st * 4 + 1) * V + vc);
        float4 o2 = *(const float4*)(op + (st * 4 + 2) * V + vc), o3 = *(const float4*)(op + (st * 4 + 3) * V + vc);
        float r0 = o0.x + o1.x + o2.x + o3.x, r1 = o0.y + o1.y + o2.y + o3.y, r2 = o0.z + o1.z + o2.z + o3.z, r3 = o0.w + o1.w + o2.w + o3.w;
        if (!GLA) {
          float4 xv = *(const float4*)(x_s + st * V + vc);
          r0 = fmaf(Dsk, xv.x, r0); r1 = fmaf(Dsk, xv.y, r1); r2 = fmaf(Dsk, xv.z, r2); r3 = fmaf(Dsk, xv.w, r3);
        }
        uint2 pk; pk.x = pack2(r0, r1); pk.y = pack2(r2, r3);
        *(uint2*)(yout + (size_t)row * 512 + ocol + vc) = pk;
      }
    }
  }
  __syncthreads();
#undef SCAN_PREFETCH
#undef GROW
#undef LSIG16
}

DI bf16x8 pack8(const f32x16& x, int s) {
  uint32_t p0 = pack2(x[8 * s], x[8 * s + 1]), p1 = pack2(x[8 * s + 2], x[8 * s + 3]);
  uint32_t p2 = pack2(x[8 * s + 4], x[8 * s + 5]), p3 = pack2(x[8 * s + 6], x[8 * s + 7]);
  uint4 u = make_uint4(p0, p1, p2, p3);
  return __builtin_bit_cast(bf16x8, u);
}

template <bool GLA>
DI void cscan_item(const Params& p, const int wid, int layer, int item, char* lds) {
  constexpr int RS = 72;
  bf16* Qm = (bf16*)lds;
  bf16* Km = Qm + 64 * RS;
  bf16* KeT = Km + 64 * RS;
  bf16* bT = KeT + 64 * RS;
  bf16* ST = bT + 64 * RS;
  char* R = (char*)(ST + 64 * RS);
  float* Gf = (float*)R;
  bf16* Cm = (bf16*)R;
  float* Gs = (float*)(R + 64 * RS * 2);
  float* tot = (float*)(R + 16384);
  float* lr_s = tot + 256;
  const int tid = tid_fresh(p, wid), lane = tid & 63, wave = tid >> 6, l31 = lane & 31, lh = lane >> 5;
  const int nt = wave & 1, vh = wave >> 1;
  int head, dir, b, vhalf = 0;
  if (GLA) { vhalf = item & 1; head = (item >> 1) & 3; } else { head = item & 7; }
  dir = (item >> 3) & 1; b = item >> 4;
  const bf16* xbc = (const bf16*)(p.ws + OFF_XBC2);
  const bf16* gq = (const bf16*)(p.ws + OFF_GQ);
  const bf16* gk = (const bf16*)(p.ws + OFF_GK);
  const bf16* gv = (const bf16*)(p.ws + OFF_GV);
  const float* dtlr = (const float*)(p.ws + OFF_DTLR);
  bf16* yout = (bf16*)(p.ws + (GLA ? (dir ? OFF_YGB : OFF_YGF) : (dir ? OFF_YSB : OFF_YSF)));
  const int ocol = GLA ? head * 128 + vhalf * 64 : head * 64;
  float Aneg = 0.f, Dsk = 0.f, dtb = 0.f, bgk = 0.f;
  float wgk[16];
#pragma unroll
  for (int r = 0; r < 16; ++r) wgk[r] = 0.f;
  if (!GLA) {
    Aneg = -expf(p.a_log[layer * 16 + dir * 8 + head]);
    Dsk = p.ssm_d[layer * 16 + dir * 8 + head];
    dtb = p.dt_bias[layer * 16 + dir * 8 + head];
  } else {
    const float* wg = p.gla_w_gate + ((size_t)(layer * 2 + dir) * 16) * 256 + head * 64 + (tid & 63);
#pragma unroll
    for (int r = 0; r < 16; ++r) wgk[r] = wg[r * 256];
    bgk = p.gla_b_gate[(layer * 2 + dir) * 256 + head * 64 + (tid & 63)];
  }
  const int st = tid >> 2, k16 = (tid & 3) * 16;
  f32x16 Sacc;
#pragma unroll
  for (int i = 0; i < 16; ++i) Sacc[i] = 0.f;

  uint4 ra0, ra1, rc0, rc1, rb0, rb1; float4 rl;
#define CS_PREFETCH(chunk_)                                                                          \
  {                                                                                                  \
    const int row_ = scan_row(b, dir, (chunk_) * 64 + st);                                           \
    if (GLA) {                                                                                       \
      const uint4* ap_ = (const uint4*)(gk + (size_t)row_ * 256 + head * 64 + k16);                  \
      const uint4* cp_ = (const uint4*)(gq + (size_t)row_ * 256 + head * 64 + k16);                  \
      const uint4* bp_ = (const uint4*)(gv + (size_t)row_ * 512 + head * 128 + vhalf * 64 + k16);    \
      ra0 = ap_[0]; ra1 = ap_[1]; rc0 = cp_[0]; rc1 = cp_[1]; rb0 = bp_[0]; rb1 = bp_[1];            \
      rl = *(const float4*)(dtlr + (size_t)row_ * 48 + 16 + dir * 16 + (tid & 3) * 4);               \
    } else {                                                                                         \
      const int g_ = head >> 2;                                                                      \
      const uint4* ap_ = (const uint4*)(xbc + (size_t)row_ * 768 + 512 + g_ * 64 + k16);             \
      const uint4* cp_ = (const uint4*)(xbc + (size_t)row_ * 768 + 640 + g_ * 64 + k16);             \
      const uint4* bp_ = (const uint4*)(xbc + (size_t)row_ * 768 + head * 64 + k16);                 \
      ra0 = ap_[0]; ra1 = ap_[1]; rc0 = cp_[0]; rc1 = cp_[1]; rb0 = bp_[0]; rb1 = bp_[1];            \
      rl.x = dtlr[(size_t)row_ * 48 + dir * 8 + head]; rl.y = 0.f; rl.z = 0.f; rl.w = 0.f;           \
    }                                                                                                \
  }
  CS_PREFETCH(0);
#pragma unroll 1
  for (int chunk = 0; chunk < KEYS / 64; ++chunk) {
    float dt = 0.f;
    if (GLA) {
      *(float4*)(lr_s + st * 16 + (tid & 3) * 4) = rl;
      __syncthreads();
      float Gl[16];
      float run = 0.f;
#pragma unroll
      for (int i = 0; i < 16; ++i) {
        const float* lrp = lr_s + (wave * 16 + i) * 16;
        const float4 l0 = *(const float4*)(lrp), l1 = *(const float4*)(lrp + 4), l2 = *(const float4*)(lrp + 8), l3 = *(const float4*)(lrp + 12);
        float z = bgk;
        z = fmaf(l0.x, wgk[0], z); z = fmaf(l0.y, wgk[1], z); z = fmaf(l0.z, wgk[2], z); z = fmaf(l0.w, wgk[3], z);
        z = fmaf(l1.x, wgk[4], z); z = fmaf(l1.y, wgk[5], z); z = fmaf(l1.z, wgk[6], z); z = fmaf(l1.w, wgk[7], z);
        z = fmaf(l2.x, wgk[8], z); z = fmaf(l2.y, wgk[9], z); z = fmaf(l2.z, wgk[10], z); z = fmaf(l2.w, wgk[11], z);
        z = fmaf(l3.x, wgk[12], z); z = fmaf(l3.y, wgk[13], z); z = fmaf(l3.z, wgk[14], z); z = fmaf(l3.w, wgk[15], z);
        run -= (fmaxf(-z, 0.f) + __logf(1.f + __expf(-fabsf(z)))) * (1.f / 16.f);
        Gl[i] = run;
      }
      tot[wave * 64 + lane] = run;
      __syncthreads();
      float off = 0.f;
      if (wave > 0) off += tot[lane];
      if (wave > 1) off += tot[64 + lane];
      if (wave > 2) off += tot[128 + lane];
#pragma unroll
      for (int i = 0; i < 16; ++i) Gf[(wave * 16 + i) * 64 + lane] = Gl[i] + off;
    } else {
      const float zz = rl.x + dtb;
      dt = zz > 20.f ? zz : log1pf(expf(zz));
      if ((tid & 3) == 0) lr_s[st] = dt;
      __syncthreads();
      if (wave == 0) {
        float g = lr_s[lane] * Aneg;
#pragma unroll
        for (int o = 1; o < 64; o <<= 1) {
          const float v = __shfl_up(g, o);
          if (lane >= o) g += v;
        }
        Gs[lane] = g;
      }
    }
#pragma unroll
    for (int i = 0; i < 16; ++i)
      ST[(32 * (wave >> 1) + (i & 3) + 8 * (i >> 2) + 4 * lh) * RS + 32 * (wave & 1) + l31] = f2b(Sacc[i]);
    __syncthreads();
    {
      const uint32_t au[8] = {ra0.x, ra0.y, ra0.z, ra0.w, ra1.x, ra1.y, ra1.z, ra1.w};
      const uint32_t cu[8] = {rc0.x, rc0.y, rc0.z, rc0.w, rc1.x, rc1.y, rc1.z, rc1.w};
      const uint32_t bu[8] = {rb0.x, rb0.y, rb0.z, rb0.w, rb1.x, rb1.y, rb1.z, rb1.w};
      uint32_t qo[8], ko[8];
      if (GLA) {
#pragma unroll
        for (int q = 0; q < 4; ++q) {
          const float4 G4 = *(const float4*)(Gf + st * 64 + k16 + 4 * q);
          const float4 L4 = *(const float4*)(Gf + 63 * 64 + k16 + 4 * q);
          const float gg[4] = {G4.x, G4.y, G4.z, G4.w}, ll[4] = {L4.x, L4.y, L4.z, L4.w};
#pragma unroll
          for (int h2 = 0; h2 < 2; ++h2) {
            const int w = 2 * q + h2;
            const float a0 = blo(au[w]), a1 = bhi(au[w]), c0 = blo(cu[w]), c1 = bhi(cu[w]);
            const float g0 = gg[2 * h2], g1 = gg[2 * h2 + 1];
            qo[w] = pack2(c0 * 0.125f * __expf(g0), c1 * 0.125f * __expf(g1));
            ko[w] = pack2(a0 * __expf(-g0), a1 * __expf(-g1));
            KeT[(k16 + 2 * w) * RS + st] = f2b(a0 * __expf(ll[2 * h2] - g0));
            KeT[(k16 + 2 * w + 1) * RS + st] = f2b(a1 * __expf(ll[2 * h2 + 1] - g1));
            bT[(k16 + 2 * w) * RS + st] = (bf16)(bu[w] & 0xffffu);
            bT[(k16 + 2 * w + 1) * RS + st] = (bf16)(bu[w] >> 16);
          }
        }
      } else {
        const float Gt = Gs[st], GL = Gs[63];
        const float e1 = __expf(Gt), e3 = __expf(GL - Gt);
#pragma unroll
        for (int w = 0; w < 8; ++w) {
          const float a0 = blo(au[w]), a1 = bhi(au[w]), c0 = blo(cu[w]), c1 = bhi(cu[w]);
          qo[w] = pack2(c0 * e1, c1 * e1);
          ko[w] = au[w];
          KeT[(k16 + 2 * w) * RS + st] = f2b(a0 * e3);
          KeT[(k16 + 2 * w + 1) * RS + st] = f2b(a1 * e3);
          bT[(k16 + 2 * w) * RS + st] = f2b(blo(bu[w]) * dt);
          bT[(k16 + 2 * w + 1) * RS + st] = f2b(bhi(bu[w]) * dt);
        }
        *(uint4*)(Cm + st * RS + k16) = rc0;
        *(uint4*)(Cm + st * RS + k16 + 8) = rc1;
      }
      *(uint4*)(Qm + st * RS + k16) = make_uint4(qo[0], qo[1], qo[2], qo[3]);
      *(uint4*)(Qm + st * RS + k16 + 8) = make_uint4(qo[4], qo[5], qo[6], qo[7]);
      *(uint4*)(Km + st * RS + k16) = make_uint4(ko[0], ko[1], ko[2], ko[3]);
      *(uint4*)(Km + st * RS + k16 + 8) = make_uint4(ko[4], ko[5], ko[6], ko[7]);
    }
    __syncthreads();
    if (chunk + 1 < KEYS / 64) CS_PREFETCH(chunk + 1);
    const int trow = scan_row(b, dir, chunk * 64 + 32 * nt + l31);
    uint2 xr0 = make_uint2(0, 0), xr1 = xr0, xr2 = xr0, xr3 = xr0;
    if (!GLA) {
      const bf16* xp = xbc + (size_t)trow * 768 + head * 64 + 32 * vh + 4 * lh;
      xr0 = *(const uint2*)(xp); xr1 = *(const uint2*)(xp + 8); xr2 = *(const uint2*)(xp + 16); xr3 = *(const uint2*)(xp + 24);
    }
    f32x16 outv;
#pragma unroll
    for (int i = 0; i < 16; ++i) outv[i] = 0.f;
    const bf16* Qp = GLA ? Qm : Cm;
#pragma unroll
    for (int ms = 0; ms < 2; ++ms) {
      if (ms <= nt) {
        f32x16 at;
#pragma unroll
        for (int i = 0; i < 16; ++i) at[i] = 0.f;
#pragma unroll
        for (int ks = 0; ks < 4; ++ks) {
          const bf16x8 kf = *(const bf16x8*)(Km + (32 * ms + l31) * RS + ks * 16 + lh * 8);
          const bf16x8 qf = *(const bf16x8*)(Qp + (32 * nt + l31) * RS + ks * 16 + lh * 8);
          at = MFMA32(kf, qf, at);
        }
        if (!GLA) {
          const float gt = Gs[32 * nt + l31];
#pragma unroll
          for (int g4 = 0; g4 < 4; ++g4) {
            const float4 gs4 = *(const float4*)(Gs + 32 * ms + 8 * g4 + 4 * lh);
            const float gsv[4] = {gs4.x, gs4.y, gs4.z, gs4.w};
#pragma unroll
            for (int j = 0; j < 4; ++j) {
              const int sl = 8 * g4 + 4 * lh + j;
              const bool keep = (ms < nt) || (sl <= l31);
              at[4 * g4 + j] = keep ? at[4 * g4 + j] * __expf(gt - gsv[j]) : 0.f;
            }
          }
        } else if (ms == nt) {
#pragma unroll
          for (int i = 0; i < 16; ++i) {
            const int sl = (i & 3) + 8 * (i >> 2) + 4 * lh;
            at[i] = (sl <= l31) ? at[i] : 0.f;
          }
        }
#pragma unroll
        for (int s2 = 0; s2 < 2; ++s2) {
          const bf16x8 pf = pack8(at, s2);
          const bf16* vp = bT + (32 * vh + l31) * RS + 32 * ms + 16 * s2 + 4 * lh;
          const uint2 lo = *(const uint2*)vp, hi = *(const uint2*)(vp + 8);
          const uint4 u = make_uint4(lo.x, lo.y, hi.x, hi.y);
          outv = MFMA32(__builtin_bit_cast(bf16x8, u), pf, outv);
        }
      }
    }
#pragma unroll
    for (int ks = 0; ks < 4; ++ks) {
      const bf16x8 sf = *(const bf16x8*)(ST + (32 * vh + l31) * RS + ks * 16 + lh * 8);
      const bf16x8 qf = *(const bf16x8*)(Qm + (32 * nt + l31) * RS + ks * 16 + lh * 8);
      outv = MFMA32(sf, qf, outv);
    }
    {
      const float dec = GLA ? __expf(Gf[63 * 64 + 32 * (wave & 1) + l31]) : __expf(Gs[63]);
#pragma unroll
      for (int i = 0; i < 16; ++i) Sacc[i] *= dec;
#pragma unroll
      for (int ks = 0; ks < 4; ++ks) {
        const bf16x8 bf_ = *(const bf16x8*)(bT + (32 * (wave >> 1) + l31) * RS + ks * 16 + lh * 8);
        const bf16x8 kf = *(const bf16x8*)(KeT + (32 * (wave & 1) + l31) * RS + ks * 16 + lh * 8);
        Sacc = MFMA32(bf_, kf, Sacc);
      }
    }
    {
      bf16* yp = yout + (size_t)trow * 512 + ocol + 32 * vh + 4 * lh;
      const uint2 xr[4] = {xr0, xr1, xr2, xr3};
#pragma unroll
      for (int g4 = 0; g4 < 4; ++g4) {
        float r0 = outv[4 * g4], r1 = outv[4 * g4 + 1], r2 = outv[4 * g4 + 2], r3 = outv[4 * g4 + 3];
        if (!GLA) {
          r0 = fmaf(Dsk, blo(xr[g4].x), r0); r1 = fmaf(Dsk, bhi(xr[g4].x), r1);
          r2 = fmaf(Dsk, blo(xr[g4].y), r2); r3 = fmaf(Dsk, bhi(xr[g4].y), r3);
        }
        uint2 pk; pk.x = pack2(r0, r1); pk.y = pack2(r2, r3);
        *(uint2*)(yp + 8 * g4) = pk;
      }
    }
    __syncthreads();
  }
#undef CS_PREFETCH
}


DI void attn_item(const Params& p, const int wid, int layer, int b, int head, int qrow0, int nkeys, char* lds) {
  bf16* Ks = (bf16*)lds;
  bf16* Vs = Ks + 64 * 136;
  bf16* Qa = (bf16*)(p.ws + OFF_QA);
  const bf16* Ka = (const bf16*)(p.ws + OFF_KA);
  const bf16* Vt = (const bf16*)(p.ws + OFF_VT) + (size_t)(b * 4 + head) * 128 * KEYS;
  const int tid = tid_fresh(p, wid), lane = tid & 63, wave = tid >> 6, l31 = lane & 31, lh = lane >> 5;

  bf16* Qs = Vs + 128 * 68;
#pragma unroll
  for (int i = 0; i < 8; ++i) {
    const int ch = tid + 256 * i;
    *(uint4*)(Qs + (ch >> 4) * 136 + (ch & 15) * 8) = *(const uint4*)(Qa + (size_t)(qrow0 + (ch >> 4)) * 512 + head * 128 + (ch & 15) * 8);
  }
  const bf16* qsw = Qs + (wave * 32 + l31) * 136 + lh * 8;
  f32x16 O[2][4];
#pragma unroll
  for (int c = 0; c < 2; ++c)
#pragma unroll
    for (int vt = 0; vt < 4; ++vt)
#pragma unroll
      for (int i = 0; i < 16; ++i) O[c][vt][i] = 0.f;
  float mrun[2] = {-1e30f, -1e30f}, lrun[2] = {0.f, 0.f};

  const int lkey = tid >> 2, lkq = (tid & 3) * 32, lvr = tid >> 1, lvh = (tid & 1) * 32;
#define KROW(key) ((key) < 256 ? NL + b * 256 + (key) : b * 8192 + (key) - 256)
#define KVLOAD(k0_)                                                                                  \
  {                                                                                                  \
    const uint4* kp_ = (const uint4*)(Ka + (size_t)KROW((k0_) + lkey) * 512 + head * 128 + lkq);      \
    rk0 = kp_[0]; rk1 = kp_[1]; rk2 = kp_[2]; rk3 = kp_[3];                                          \
    const uint4* vp_ = (const uint4*)(Vt + (size_t)lvr * KEYS + (k0_) + lvh);                        \
    rv0 = vp_[0]; rv1 = vp_[1]; rv2 = vp_[2]; rv3 = vp_[3];                                          \
  }
#define VST2(dst_, val) { (dst_)[0] = make_uint2((val).x, (val).y); (dst_)[1] = make_uint2((val).z, (val).w); }
  uint4 rk0, rk1, rk2, rk3, rv0, rv1, rv2, rv3;
  KVLOAD(0);
#pragma unroll 1
  for (int k0 = 0; k0 < nkeys; k0 += 64) {
    {
      uint4* kd = (uint4*)(Ks + lkey * 136 + lkq);
      kd[0] = rk0; kd[1] = rk1; kd[2] = rk2; kd[3] = rk3;
      uint2* vd = (uint2*)(Vs + lvr * 68 + lvh);
      VST2(vd, rv0); VST2(vd + 2, rv1); VST2(vd + 4, rv2); VST2(vd + 6, rv3);
    }
    __syncthreads();
    if (k0 + 64 < nkeys) KVLOAD(k0 + 64);
#pragma unroll
    for (int c = 0; c < 2; ++c) {
#pragma unroll
      for (int mt = 0; mt < 2; ++mt) {
        f32x16 sv;
#pragma unroll
        for (int i = 0; i < 16; ++i) sv[i] = 0.f;
#pragma unroll
        for (int ks = 0; ks < 4; ++ks) {
          const bf16x8 qf = *(const bf16x8*)(qsw + c * 64 + ks * 16);
          const bf16x8 kf = *(const bf16x8*)(Ks + (mt * 32 + l31) * 136 + c * 64 + ks * 16 + lh * 8);
          sv = MFMA32(kf, qf, sv);
        }
        __builtin_amdgcn_sched_barrier(0);
        const bf16* vpb = Vs + l31 * 68 + mt * 32 + 4 * lh;
#define VLD_(vt, st) ({ const bf16* vp_ = vpb + (vt) * 32 * 68 + 16 * (st); const uint2 lo_ = *(const uint2*)vp_, hi_ = *(const uint2*)(vp_ + 8); \
                        __builtin_bit_cast(bf16x8, make_uint4(lo_.x, lo_.y, hi_.x, hi_.y)); })
        bf16x8 v0, v1, v2, v3;
        float mx = fmaxf(sv[0], sv[1]);
#pragma unroll
        for (int i = 2; i < 16; i += 2) mx = max3f(mx, sv[i], sv[i + 1]);
        mx = xhalf_max(mx);
        if (__any(mx - mrun[c] > 8.0f)) {
          const float mnew = fmaxf(mrun[c], mx);
          const float alpha = __builtin_amdgcn_exp2f(mrun[c] - mnew);
          mrun[c] = mnew;
          lrun[c] *= alpha;
#pragma unroll
          for (int vt = 0; vt < 4; ++vt)
#pragma unroll
            for (int i = 0; i < 16; ++i) O[c][vt][i] *= alpha;
        }
        float psum = 0.f;
#pragma unroll
        for (int i = 0; i < 16; ++i) {
          float pv = __builtin_amdgcn_exp2f(sv[i] - mrun[c]);
          sv[i] = pv;
          psum += pv;
        }
        lrun[c] += psum;
        v0 = VLD_(0, 0); v1 = VLD_(1, 0); v2 = VLD_(2, 0); v3 = VLD_(3, 0);
        __builtin_amdgcn_sched_barrier(0);
        {
          const bf16x8 pf = pack8(sv, 0);
          O[c][0] = MFMA32(v0, pf, O[c][0]); O[c][1] = MFMA32(v1, pf, O[c][1]);
          O[c][2] = MFMA32(v2, pf, O[c][2]); O[c][3] = MFMA32(v3, pf, O[c][3]);
          v0 = VLD_(0, 1); v1 = VLD_(1, 1); v2 = VLD_(2, 1); v3 = VLD_(3, 1);
        }
        __builtin_amdgcn_sched_barrier(0);
        {
          const bf16x8 pf = pack8(sv, 1);
          O[c][0] = MFMA32(v0, pf, O[c][0]); O[c][1] = MFMA32(v1, pf, O[c][1]);
          O[c][2] = MFMA32(v2, pf, O[c][2]); O[c][3] = MFMA32(v3, pf, O[c][3]);
        }
        __builtin_amdgcn_sched_barrier(0);
#undef VLD_
      }
    }
    __syncthreads();
  }
  const float lam = ((const float*)(p.ws + OFF_MISC))[layer];
  const float lam_init = layer == 0 ? 0.2f : 0.8f - 0.6f * 0.7408182206817179f;
  const float l1 = lrun[0] + __shfl_xor(lrun[0], 32);
  const float l2 = lrun[1] + __shfl_xor(lrun[1], 32);
  const float i1 = 1.f / l1, i2 = lam / l2;
  float ss = 0.f;
#pragma unroll
  for (int vt = 0; vt < 4; ++vt)
#pragma unroll
    for (int i = 0; i < 16; ++i) {
      float o = O[0][vt][i] * i1 - O[1][vt][i] * i2;
      O[0][vt][i] = o;
      ss += o * o;
    }
  ss += __shfl_xor(ss, 32);
  const float rstd = rsqrtf(ss * (1.f / 128.f) + EPS) * (1.f - lam_init);
  const float* nw = p.da_norm_w + layer * 128;
  bf16* orow = Qa + (size_t)(qrow0 + wave * 32 + l31) * 512 + head * 128;
#pragma unroll
  for (int vt = 0; vt < 4; ++vt)
#pragma unroll
    for (int g = 0; g < 4; ++g) {
      const int v0 = vt * 32 + 8 * g + 4 * lh;
      float4 w4 = *(const float4*)(nw + v0);
      uint2 pk;
      pk.x = pack2(O[0][vt][4 * g] * rstd * w4.x, O[0][vt][4 * g + 1] * rstd * w4.y);
      pk.y = pack2(O[0][vt][4 * g + 2] * rstd * w4.z, O[0][vt][4 * g + 3] * rstd * w4.w);
      *(uint2*)(orow + v0) = pk;
    }
}

DI void phase_mixers(const Params& p, const int wid, int layer, char* lds) {
  __shared__ int s_item;
  const int x = blockIdx.x & 7;
  unsigned* counter = (unsigned*)(p.ws + OFF_MISC + 64) + layer * 8 + x;
  const int total = layer == 0 ? 32 + 256 + 8 + TR_PER_LAYER / 8 : 32 + 256;
  bool first = blockIdx.x < 256;
  if (first) {
    phase_conv(p, wid, layer, (int)blockIdx.x, 256);
    asm volatile("s_waitcnt vmcnt(0)" ::: "memory");
    __syncthreads();
    if (tid_fresh(p, wid) == 0) {
      unsigned* cd = (unsigned*)(p.ws + OFF_MISC + 64) + 16 + layer;
      __builtin_amdgcn_fence(__ATOMIC_RELEASE, "agent");
      asm volatile("s_waitcnt vmcnt(0)" ::: "memory");
      (void)xb_add(cd, 1u);
      unsigned sp = 0u;
      while (xb_ld(cd) < 256u) { __builtin_amdgcn_s_sleep(2); if (++sp > (1u << 22)) break; }
      __builtin_amdgcn_fence(__ATOMIC_ACQUIRE, "agent");
      asm volatile("s_waitcnt vmcnt(0)" ::: "memory");
    }
    __syncthreads();
  }
  for (;;) {
    if (tid_fresh(p, wid) == 0) s_item = first ? (int)(blockIdx.x >> 3) : 32 + (int)atomicAdd(counter, 1u);
    first = false;
    __syncthreads();
    const int li = s_item;
    __syncthreads();
    if (li >= total) break;
    if (li < 32) {
      const int sid = li * 8 + x;
      if (sid < 128) cscan_item<true>(p, wid, layer, sid, lds);
      else cscan_item<false>(p, wid, layer, sid - 128, lds);
    } else if (li < 288) {
      const int a = li - 32;
      const int bh = x + 8 * (a >> 6), qb = a & 63;
      attn_item(p, wid, layer, bh >> 2, bh & 3, (bh >> 2) * 8192 + qb * 128, KEYS, lds);
    } else if (li < 296) {
      const int c = x * 8 + (li - 288);
      const int bh = c >> 1, qb = c & 1;
      attn_item(p, wid, layer, bh >> 2, bh & 3, NL + (bh >> 2) * 256 + qb * 128, 256, lds);
    } else {
      tr_job(p, wid, 1, (li - 296) * 8 + x, (float*)lds);
    }
  }
}

DI void phase_z(const Params& p, const int wid, int layer, int M, char* lds) {
  const bf16* h = (const bf16*)(p.ws + OFF_H);
  const bf16* W2 = (const bf16*)(p.ws + OFF_W + (size_t)layer * LW + SZ_W1);
  bf16* Z = (bf16*)(p.ws + OFF_Z);
  const int tidf = tid_fresh(p, wid); const int lane = tidf & 63, wave = tidf >> 6, wm = wave >> 1, wn = wave & 1, l31 = lane & 31, lh = lane >> 5;
  constexpr int NTN = N2 / 128;
  int mt_, nt_;
  for (int it = 0; xcd_tile(it, M / 256, NTN, 12, mt_, nt_); ++it) {
    const int m0 = mt_ * 256, n0 = nt_ * 128;
    f32x16 acc[4][2];
    zero_acc<4, 2>(acc);
    gemm_main256<true>(h + (size_t)m0 * 1024, 1024, W2 + (size_t)n0 * 1024, 1024, 1024, acc, lds, tidf);
#pragma unroll
    for (int tm = 0; tm < 4; ++tm)
#pragma unroll
      for (int tn = 0; tn < 2; ++tn)
        store_rows_bf16(Z + (size_t)(m0 + wm * 128 + tm * 32 + l31) * 1536 + n0 + wn * 64 + tn * 32, acc[tm][tn], lh);
  }
}

DI void phase_post(const Params& p, const int wid, int layer, int M) {
  const int tidf = tid_fresh(p, wid); const int lane = tidf & 63, wave = tidf >> 6;
  bf16* Z = (bf16*)(p.ws + OFF_Z);
  const bf16* oda = (const bf16*)(p.ws + OFF_QA);
  const bf16* ysf = (const bf16*)(p.ws + OFF_YSF);
  const bf16* ysb = (const bf16*)(p.ws + OFF_YSB);
  const bf16* ygf = (const bf16*)(p.ws + OFF_YGF);
  const bf16* ygb = (const bf16*)(p.ws + OFF_YGB);
  const float* snw = p.ssm_norm_w + layer * 512;
  const float* gnw = p.gla_norm_w + layer * 128;
  const int c0 = lane * 8;
  for (int row = blockIdx.x * 4 + wave; row < M; row += gridDim.x * 4) {
    bf16* zr = Z + (size_t)row * 1536;
    {
      uint4 o = *(const uint4*)(oda + (size_t)row * 512 + c0);
      uint4 z = *(const uint4*)(zr + c0);
      const uint32_t ou[4] = {o.x, o.y, o.z, o.w}, zu[4] = {z.x, z.y, z.z, z.w};
      uint32_t r[4];
#pragma unroll
      for (int q = 0; q < 4; ++q) r[q] = pack2(blo(ou[q]) * siluf(blo(zu[q])), bhi(ou[q]) * siluf(bhi(zu[q])));
      *(uint4*)(zr + c0) = make_uint4(r[0], r[1], r[2], r[3]);
    }
    {
      uint4 yf = *(const uint4*)(ysf + (size_t)row * 512 + c0), yb = *(const uint4*)(ysb + (size_t)row * 512 + c0);
      uint4 z = *(const uint4*)(zr + 512 + c0);
      const uint32_t fu[4] = {yf.x, yf.y, yf.z, yf.w}, bu[4] = {yb.x, yb.y, yb.z, yb.w}, zu[4] = {z.x, z.y, z.z, z.w};
      float y[8];
      float ss = 0.f;
#pragma unroll
      for (int q = 0; q < 4; ++q) {
        y[2 * q] = (blo(fu[q]) + blo(bu[q])) * siluf(blo(zu[q]));
        y[2 * q + 1] = (bhi(fu[q]) + bhi(bu[q])) * siluf(bhi(zu[q]));
        ss += y[2 * q] * y[2 * q] + y[2 * q + 1] * y[2 * q + 1];
      }
#pragma unroll
      for (int m = 16; m >= 1; m >>= 1) ss += __shfl_xor(ss, m);
      const float rstd = rsqrtf(ss * (1.f / 256.f) + EPS);
      float4 w0 = *(const float4*)(snw + c0), w1 = *(const float4*)(snw + c0 + 4);
      uint32_t r[4];
      r[0] = pack2(y[0] * rstd * w0.x, y[1] * rstd * w0.y); r[1] = pack2(y[2] * rstd * w0.z, y[3] * rstd * w0.w);
      r[2] = pack2(y[4] * rstd * w1.x, y[5] * rstd * w1.y); r[3] = pack2(y[6] * rstd * w1.z, y[7] * rstd * w1.w);
      *(uint4*)(zr + 512 + c0) = make_uint4(r[0], r[1], r[2], r[3]);
    }
    {
      uint4 yf = *(const uint4*)(ygf + (size_t)row * 512 + c0), yb = *(const uint4*)(ygb + (size_t)row * 512 + c0);
      uint4 z = *(const uint4*)(zr + 1024 + c0);
      const uint32_t fu[4] = {yf.x, yf.y, yf.z, yf.w}, bu[4] = {yb.x, yb.y, yb.z, yb.w}, zu[4] = {z.x, z.y, z.z, z.w};
      float y[8];
      float ss = 0.f;
#pragma unroll
      for (int q = 0; q < 4; ++q) {
        y[2 * q] = blo(fu[q]) + blo(bu[q]);
        y[2 * q + 1] = bhi(fu[q]) + bhi(bu[q]);
        ss += y[2 * q] * y[2 * q] + y[2 * q + 1] * y[2 * q + 1];
      }
#pragma unroll
      for (int m = 8; m >= 1; m >>= 1) ss += __shfl_xor(ss, m);
      const float rstd = rsqrtf(ss * (1.f / 128.f) + EPS);
      const int cw = c0 & 127;
      float4 w0 = *(const float4*)(gnw + cw), w1 = *(const float4*)(gnw + cw + 4);
      uint32_t r[4];
      r[0] = pack2(y[0] * rstd * w0.x * siluf(blo(zu[0])), y[1] * rstd * w0.y * siluf(bhi(zu[0])));
      r[1] = pack2(y[2] * rstd * w0.z * siluf(blo(zu[1])), y[3] * rstd * w0.w * siluf(bhi(zu[1])));
      r[2] = pack2(y[4] * rstd * w1.x * siluf(blo(zu[2])), y[5] * rstd * w1.y * siluf(bhi(zu[2])));
      r[3] = pack2(y[6] * rstd * w1.z * siluf(blo(zu[3])), y[7] * rstd * w1.w * siluf(bhi(zu[3])));
      *(uint4*)(zr + 1024 + c0) = make_uint4(r[0], r[1], r[2], r[3]);
    }
  }
}

DI void phase_merge(const Params& p, const int wid, int layer, int M, char* lds) {
  const bf16* h = (const bf16*)(p.ws + OFF_H);
  const bf16* osg = (const bf16*)(p.ws + OFF_Z);
  const char* wb = p.ws + OFF_W + (size_t)layer * LW;
  const bf16* W3 = (const bf16*)(wb + SZ_W1 + SZ_W2);
  const bf16* Wout = (const bf16*)(wb + SZ_W1 + SZ_W2 + SZ_W3);
  bf16* U = (bf16*)(p.ws + OFF_U);
  const int tidf = tid_fresh(p, wid); const int lane = tidf & 63, wave = tidf >> 6, wm = wave >> 1, wn = wave & 1, l31 = lane & 31, lh = lane >> 5;
  constexpr int NTN = 1024 / 128;
  int mt_, nt_;
  for (int it = 0; xcd_tile(it, M / 128, NTN, 8, mt_, nt_); ++it) {
    const int m0 = mt_ * 128, n0 = nt_ * 128;
    f32x16 u[2][2];
    zero_acc<2, 2>(u);
#pragma unroll 1
    for (int br = 0; br < 3; ++br) {
      uint32_t* sgl = (uint32_t*)(lds + 36864) + tidf;
      {
        f32x16 g[2][2];
        zero_acc<2, 2>(g);
        gemm_main128<true>(h + (size_t)m0 * 1024, 1024, W3 + (size_t)(br * 1024 + n0) * 1024, 1024, 1024, g, lds, tidf);
#pragma unroll
        for (int tm = 0; tm < 2; ++tm)
#pragma unroll
          for (int tn = 0; tn < 2; ++tn)
#pragma unroll
            for (int q = 0; q < 8; ++q) sgl[((tm * 2 + tn) * 8 + q) * 256] = pack2(sigmf(g[tm][tn][2 * q]), sigmf(g[tm][tn][2 * q + 1]));
      }
      f32x16 t[2][2];
      zero_acc<2, 2>(t);
      gemm_main128<true>(osg + (size_t)m0 * 1536 + br * 512, 1536, Wout + (size_t)br * 1024 * 512 + (size_t)n0 * 512, 512, 512, t, lds, tidf);
#pragma unroll
      for (int tm = 0; tm < 2; ++tm)
#pragma unroll
        for (int tn = 0; tn < 2; ++tn)
#pragma unroll
          for (int q = 0; q < 8; ++q) {
            const uint32_t sgv = sgl[((tm * 2 + tn) * 8 + q) * 256];
            u[tm][tn][2 * q] = fmaf(blo(sgv), t[tm][tn][2 * q], u[tm][tn][2 * q]);
            u[tm][tn][2 * q + 1] = fmaf(bhi(sgv), t[tm][tn][2 * q + 1], u[tm][tn][2 * q + 1]);
          }
    }
#pragma unroll
    for (int tm = 0; tm < 2; ++tm)
#pragma unroll
      for (int tn = 0; tn < 2; ++tn)
        store_rows_bf16(U + (size_t)(m0 + wm * 64 + tm * 32 + l31) * 1024 + n0 + wn * 64 + tn * 32, u[tm][tn], lh);
  }
}

DI void phase_out(const Params& p, const int wid, int layer, int M, const float* xl, const float* xc, float* ol, float* oc, char* lds) {
  const bf16* U = (const bf16*)(p.ws + OFF_U);
  const bf16* Wo = (const bf16*)(p.ws + OFF_W + (size_t)layer * LW + SZ_W1 + SZ_W2 + SZ_W3 + 3 * SZ_WOUT);
  const float* modv = (const float*)(p.ws + OFF_MOD) + (size_t)layer * 9 * 3072;
  const int tidf = tid_fresh(p, wid); const int lane = tidf & 63, wave = tidf >> 6, wm = wave >> 1, wn = wave & 1, l31 = lane & 31, lh = lane >> 5;
  constexpr int NTN = 1024 / 128;
  int mt_, nt_;
  for (int it = 0; xcd_tile(it, M / 256, NTN, 8, mt_, nt_); ++it) {
    const int m0 = mt_ * 256, n0 = nt_ * 128;
    f32x16 acc[4][2];
    zero_acc<4, 2>(acc);
    gemm_main256<true>(U + (size_t)m0 * 1024, 1024, Wo + (size_t)n0 * 1024, 1024, 1024, acc, lds, tidf);
    const bool lat = m0 < NL;
    const int j = lat ? (m0 >> 13) : 8;
    const float* gate = modv + j * 3072 + 2048;
    const float* src = lat ? xl + (size_t)m0 * 1024 : xc + (size_t)(m0 - NL) * 1024;
    float* dst = lat ? ol + (size_t)m0 * 1024 : oc + (size_t)(m0 - NL) * 1024;
    uint32_t eoff = (uint32_t)((wm * 128 + l31) * 1024 + n0 + wn * 64 + 4 * lh);
    asm volatile("" : "+v"(eoff));
    const float* sp = src + eoff;
    float* dp = dst + eoff;
    const float* gp = gate + n0 + wn * 64 + 4 * lh;
#pragma unroll
    for (int tm = 0; tm < 4; ++tm)
#pragma unroll
      for (int tn = 0; tn < 2; ++tn) {
#pragma unroll
        for (int g = 0; g < 4; ++g) {
          const int off = tm * 32 * 1024 + tn * 32 + 8 * g;
          const float4 gt = *(const float4*)(gp + tn * 32 + 8 * g);
          const float4 xo = *(const float4*)(sp + off);
          *(float4*)(dp + off) = make_float4(xo.x + gt.x * acc[tm][tn][4 * g], xo.y + gt.y * acc[tm][tn][4 * g + 1],
                                             xo.z + gt.z * acc[tm][tn][4 * g + 2], xo.w + gt.w * acc[tm][tn][4 * g + 3]);
        }
        __builtin_amdgcn_sched_barrier(0);
      }
  }
}

DI void phase_final(const Params& p, const int wid) {
  const int tidf = tid_fresh(p, wid); const int lane = tidf & 63, wave = tidf >> 6;
  const int stride = gridDim.x * 4;
  for (int row0 = blockIdx.x * 4 + wave; row0 < NL; row0 += 2 * stride) {
    float4 v[2][4];
    float ss[2] = {0.f, 0.f};
#pragma unroll
    for (int r = 0; r < 2; ++r) {
      int row = row0 + r * stride;
      if (row >= NL) row = row0;
      const float* src = p.out + (size_t)row * 1024;
#pragma unroll
      for (int i = 0; i < 4; ++i) v[r][i] = *(const float4*)(src + (i * 64 + lane) * 4);
    }
#pragma unroll
    for (int r = 0; r < 2; ++r) {
#pragma unroll
      for (int i = 0; i < 4; ++i) ss[r] += v[r][i].x * v[r][i].x + v[r][i].y * v[r][i].y + v[r][i].z * v[r][i].z + v[r][i].w * v[r][i].w;
      ss[r] = wave_sum(ss[r]);
    }
#pragma unroll
    for (int r = 0; r < 2; ++r) {
      const int row = row0 + r * stride;
      if (row < NL) {
        float* dst = p.out + (size_t)row * 1024;
        const float rstd = rsqrtf(ss[r] * (1.f / 1024.f) + EPS);
#pragma unroll
        for (int i = 0; i < 4; ++i) {
          const int c = (i * 64 + lane) * 4;
          float4 w4 = *(const float4*)(p.final_norm_w + c);
          *(float4*)(dst + c) = make_float4(v[r][i].x * rstd * w4.x, v[r][i].y * rstd * w4.y, v[r][i].z * rstd * w4.z, v[r][i].w * rstd * w4.w);
        }
      }
    }
  }
}

__global__ void __launch_bounds__(256, 2) hybrid_trunk_mega(Params p) {
  cg::grid_group grid = cg::this_grid();
  const int wid = __builtin_amdgcn_readfirstlane((int)(threadIdx.x >> 6));
  __shared__ __attribute__((aligned(16))) char lds[LDS_BYTES];
  __shared__ uint4 xb_words;
  if (tid_fresh(p, wid) == 0) xb_words = make_uint4(0u, 0u, 0u, 0u);
  phase0(p, wid, lds);
  grid.sync();
  if (tid_fresh(p, wid) == 0) (void)xb_add(&((unsigned*)(p.ws + OFF_BAR))[XB_XCNT(xb_xcc_id())], 1u);
  float* ctx1 = (float*)(p.ws + OFF_CTX1);
#pragma unroll 1
  for (int layer = 0; layer < 2; ++layer) {
    const float* xl = layer == 0 ? p.x : p.out;
    const float* xc = layer == 0 ? p.ctx : ctx1;
    const int M = layer == 0 ? NT : NL;
    phase_h(p, wid, layer, xl, xc, NT);
    xcd_barrier(p, wid, (volatile LAS unsigned*)&xb_words);
    phase_p1(p, wid, layer, NT, lds);
    xcd_barrier(p, wid, (volatile LAS unsigned*)&xb_words);
#ifdef DUP_GEMM
    phase_p1(p, wid, layer, NT, lds);
    xcd_barrier(p, wid, (volatile LAS unsigned*)&xb_words);
#endif
#ifdef PROBE_SCAN
    for (int it = blockIdx.x; it < 192; it += gridDim.x) { if (it < 64) scan_item<true>(p, wid, layer, it, lds); else scan_item<false>(p, wid, layer, it - 64, lds); }
    xcd_barrier(p, wid, (volatile LAS unsigned*)&xb_words);
#endif
    phase_mixers(p, wid, layer, lds);
    xcd_barrier(p, wid, (volatile LAS unsigned*)&xb_words);
    phase_z(p, wid, layer, M, lds);
    xcd_barrier(p, wid, (volatile LAS unsigned*)&xb_words);
#ifdef DUP_GEMM
    phase_z(p, wid, layer, M, lds);
    xcd_barrier(p, wid, (volatile LAS unsigned*)&xb_words);
#endif
    phase_post(p, wid, layer, M);
    xcd_barrier(p, wid, (volatile LAS unsigned*)&xb_words);
    phase_merge(p, wid, layer, M, lds);
    xcd_barrier(p, wid, (volatile LAS unsigned*)&xb_words);
#ifdef DUP_GEMM
    phase_merge(p, wid, layer, M, lds);
    xcd_barrier(p, wid, (volatile LAS unsigned*)&xb_words);
#endif
    phase_out(p, wid, layer, M, xl, xc, p.out, ctx1, lds);
    xcd_barrier(p, wid, (volatile LAS unsigned*)&xb_words);
  }
  phase_final(p, wid);
}

extern "C" void kernel_launch(void* const* d_in, const int* in_sizes, int n_in, void* d_out, int out_size, void* d_ws,
                              size_t ws_size, hipStream_t stream) {
  (void)in_sizes; (void)n_in; (void)out_size;
  static int grid_blocks = 0;
  if (!grid_blocks) {
    int dev = 0, cus = 0, per_cu = 0;
    hipGetDevice(&dev);
    hipDeviceGetAttribute(&cus, hipDeviceAttributeMultiprocessorCount, dev);
    hipOccupancyMaxActiveBlocksPerMultiprocessor(&per_cu, hybrid_trunk_mega, 256, 0);
    (void)per_cu;
    grid_blocks = cus * 2;
  }
  if (ws_size < WS_TOTAL) { fprintf(stderr, "workspace too small: %zu < %zu\n", ws_size, (size_t)WS_TOTAL); return; }
  Params p{};
  const float** f = (const float**)&p;
  for (int i = 0; i < 24; ++i) f[i] = (const float*)d_in[i];
  p.wid = 0; p.pad_ = 0;
  p.out = (float*)d_out;
  p.ws = (char*)d_ws;
  void* args[] = {&p};
  hipError_t e = hipLaunchCooperativeKernel((const void*)hybrid_trunk_mega, dim3(grid_blocks), dim3(256), args, 0, stream);
  if (e != hipSuccess && (grid_blocks & 15) == 0) {
    (void)hipGetLastError();
    grid_blocks >>= 1;
    e = hipLaunchCooperativeKernel((const void*)hybrid_trunk_mega, dim3(grid_blocks), dim3(256), args, 0, stream);
  }
  if (e != hipSuccess) fprintf(stderr, "cooperative launch failed: %s (grid %d)\n", hipGetErrorString(e), grid_blocks);
}
```
